# Optimizing an MI355X kernel written in HIP

```python
import math
import jax, jax.numpy as jnp
from jax import lax
import numpy as np

D_MODEL = 1024
BATCH = 4
SEQ = 8192
DEPTH = 1

RMS_EPS = 1e-6
ROPE_THETA = 10000.0
GLA_HEADS = 4
GLA_DK = D_MODEL // 2 // GLA_HEADS
GLA_DV = D_MODEL // GLA_HEADS
GLA_QK = GLA_HEADS * GLA_DK
GLA_V = GLA_HEADS * GLA_DV
GLA_LOWRANK = 16
GLA_GATE_NORM = 16.0
GLA_CHUNK = 64
DIFF_HEADS = 8
DIFF_HD = D_MODEL // (2 * DIFF_HEADS)
DIFF_VD = 2 * DIFF_HD
DIFF_QK = DIFF_HEADS * 2 * DIFF_HD
DIFF_V = DIFF_HEADS * DIFF_VD
Q_BLOCK = 128
PEER_HEADS = 8
PEER_NKEYS = 128
PEER_TOPK = 16
PEER_DQ = 256
PEER_NEXPERTS = PEER_NKEYS * PEER_NKEYS
PEER_BLOCK = 128
N_ADA = 6
POS_OFFSET_MAX = 1024

kernel_name = "hybrid_gla_diffattn_peer_adaln"


def rms_norm(x, g):
    xf = x.astype(jnp.float32)
    y = xf * lax.rsqrt(jnp.mean(xf * xf, axis=-1, keepdims=True) + RMS_EPS)
    return (y * g.astype(jnp.float32)).astype(x.dtype)


def modulate(h, shift, scale):
    return h * (1.0 + scale[:, None, :]) + shift[:, None, :]


def rope(x, pos):
    hd = x.shape[-1]
    inv = ROPE_THETA ** (-jnp.arange(0, hd, 2, dtype=jnp.float32) / hd)
    ang = pos.astype(jnp.float32)[..., None] * inv
    ang = jnp.concatenate([ang, ang], axis=-1)
    shape = ang.shape[:2] + (1,) * (x.ndim - 3) + (hd,)
    cos = jnp.cos(ang).reshape(shape)
    sin = jnp.sin(ang).reshape(shape)
    xf = x.astype(jnp.float32)
    x1, x2 = xf[..., : hd // 2], xf[..., hd // 2:]
    rot = jnp.concatenate([-x2, x1], axis=-1)
    return (xf * cos + rot * sin).astype(x.dtype)


def gla_scan(q, k, v, logg):
    B, H, S, dk = q.shape
    dv = v.shape[-1]
    nc = S // GLA_CHUNK
    f32 = jnp.float32
    qc = q.astype(f32).reshape(B, H, nc, GLA_CHUNK, dk)
    kc = k.astype(f32).reshape(B, H, nc, GLA_CHUNK, dk)
    vc = v.astype(f32).reshape(B, H, nc, GLA_CHUNK, dv)
    b = jnp.cumsum(logg.astype(f32).reshape(B, H, nc, GLA_CHUNK, dk), axis=3)
    b_last = b[..., -1:, :]
    qe = qc * jnp.exp(b)
    ke = kc * jnp.exp(-b)
    kend = kc * jnp.exp(b_last - b)
    mask = jnp.tril(jnp.ones((GLA_CHUNK, GLA_CHUNK), dtype=bool))
    att = jnp.where(mask, jnp.einsum('bhncd,bhnjd->bhncj', qe, ke), 0.0)
    o_intra = jnp.einsum('bhncj,bhnje->bhnce', att, vc)
    dec = jnp.exp(b_last[..., 0, :])

    def step(state, inp):
        qn, kn, vn, dn = inp
        o = jnp.einsum('bhcd,bhde->bhce', qn, state)
        state = dn[..., None] * state + jnp.einsum('bhcd,bhce->bhde', kn, vn)
        return state, o

    xs = (jnp.moveaxis(qe, 2, 0), jnp.moveaxis(kend, 2, 0),
          jnp.moveaxis(vc, 2, 0), jnp.moveaxis(dec, 2, 0))
    _, o_inter = lax.scan(step, jnp.zeros((B, H, dk, dv), f32), xs)
    o = o_intra + jnp.moveaxis(o_inter, 0, 2)
    return o.reshape(B, H, S, dv)


def diff_attention(q, k, v, lam, pos):
    B, S, H, _, hd = q.shape
    vd = v.shape[-1]
    q = rope(q, pos) * (hd ** -0.5)
    k = rope(k, pos)
    qh = q.transpose(0, 2, 3, 1, 4)
    kh = k.transpose(0, 2, 3, 1, 4)
    vh = v.transpose(0, 2, 1, 3)
    nb = S // Q_BLOCK
    qb = jnp.moveaxis(qh.reshape(B, H, 2, nb, Q_BLOCK, hd), 3, 0)

    def block(qblk):
        s = jnp.einsum('bhmqd,bhmkd->bhmqk', qblk, kh).astype(jnp.float32)
        p = jax.nn.softmax(s, axis=-1)
        a = p[:, :, 0] - lam * p[:, :, 1]
        return jnp.einsum('bhqk,bhkd->bhqd', a.astype(vh.dtype), vh)

    o = lax.map(block, qb)
    o = jnp.moveaxis(o, 0, 2).reshape(B, H, S, vd)
    return o.transpose(0, 2, 1, 3)


def peer(h, wq, subkeys, u_tab, v_tab):
    B, S, D = h.shape
    K = PEER_TOPK
    q = (h @ wq).reshape(B, S, PEER_HEADS, 2, PEER_DQ // 2)
    s = jnp.einsum('bshpd,hpnd->bshpn', q, subkeys).astype(jnp.float32)
    s_top, i_top = lax.top_k(s, K)
    cand_s = (s_top[..., 0, :, None] + s_top[..., 1, None, :]).reshape(B, S, PEER_HEADS, K * K)
    cand_i = (i_top[..., 0, :, None] * PEER_NKEYS + i_top[..., 1, None, :]).reshape(B, S, PEER_HEADS, K * K)
    s_fin, sel = lax.top_k(cand_s, K)
    idx = jnp.take_along_axis(cand_i, sel, axis=-1)
    g = jax.nn.softmax(s_fin, axis=-1)
    nb = (B * S) // PEER_BLOCK
    hb = h.reshape(nb, PEER_BLOCK, D)
    ib = idx.reshape(nb, PEER_BLOCK, PEER_HEADS * K)
    gb = g.reshape(nb, PEER_BLOCK, PEER_HEADS * K).astype(h.dtype)

    def block(args):
        hx, ix, gx = args
        u = u_tab[ix]
        act = jax.nn.gelu(jnp.einsum('td,ted->te', hx, u), approximate=False)
        vv = v_tab[ix]
        return jnp.einsum('te,ted->td', gx * act, vv)

    out = lax.map(block, (hb, ib, gb))
    return out.reshape(B, S, D)


def setup_inputs(seed: int = 0) -> dict:
    key = jax.random.key(seed)
    ks = jax.random.split(key, 32)
    D = D_MODEL
    in_width = 2 * GLA_QK + 2 * GLA_V + 2 * GLA_LOWRANK + 2 * DIFF_QK + DIFF_V + 2 * D

    def nrm(k, shape, scale):
        return jax.random.normal(k, shape, jnp.float32) * scale

    def gain(k, shape):
        return 1.0 + 0.02 * jax.random.normal(k, shape, jnp.float32)

    positions = (jnp.arange(SEQ, dtype=jnp.int32)[None, :]
                 + jax.random.randint(ks[2], (BATCH, 1), 0, POS_OFFSET_MAX, dtype=jnp.int32))
    return {
        "x": nrm(ks[0], (BATCH, SEQ, D), 1.0),
        "c": nrm(ks[1], (BATCH, D), 1.0),
        "positions": positions,
        "w_ada": nrm(ks[3], (DEPTH, D, N_ADA * D), 0.5 * D ** -0.5),
        "b_ada": nrm(ks[4], (DEPTH, N_ADA * D), 0.01),
        "norm1_g": gain(ks[5], (DEPTH, D)),
        "w_in": nrm(ks[6], (DEPTH, D, in_width), D ** -0.5),
        "gla_wa_fw": nrm(ks[7], (DEPTH, GLA_LOWRANK, GLA_QK), GLA_LOWRANK ** -0.5),
        "gla_ba_fw": nrm(ks[8], (DEPTH, GLA_QK), 0.01),
        "gla_wa_bw": nrm(ks[9], (DEPTH, GLA_LOWRANK, GLA_QK), GLA_LOWRANK ** -0.5),
        "gla_ba_bw": nrm(ks[10], (DEPTH, GLA_QK), 0.01),
        "gla_norm_g": gain(ks[11], (DEPTH, GLA_V)),
        "diff_lq1": nrm(ks[12], (DEPTH, DIFF_HD), 0.1),
        "diff_lk1": nrm(ks[13], (DEPTH, DIFF_HD), 0.1),
        "diff_lq2": nrm(ks[14], (DEPTH, DIFF_HD), 0.1),
        "diff_lk2": nrm(ks[15], (DEPTH, DIFF_HD), 0.1),
        "diff_norm_g": gain(ks[16], (DEPTH, DIFF_V)),
        "w_gla_proj": nrm(ks[17], (DEPTH, GLA_V, D), GLA_V ** -0.5),
        "w_diff_proj": nrm(ks[18], (DEPTH, DIFF_V, D), DIFF_V ** -0.5),
        "w_out": nrm(ks[19], (DEPTH, D, D), D ** -0.5),
        "norm2_g": gain(ks[20], (DEPTH, D)),
        "peer_wq": nrm(ks[21], (DEPTH, D, PEER_HEADS * PEER_DQ), D ** -0.5),
        "peer_subkeys": nrm(ks[22], (DEPTH, PEER_HEADS, 2, PEER_NKEYS, PEER_DQ // 2), (PEER_DQ // 2) ** -0.5),
        "peer_u": nrm(ks[23], (DEPTH, PEER_NEXPERTS, D), D ** -0.5),
        "peer_v": nrm(ks[24], (DEPTH, PEER_NEXPERTS, D), PEER_HEADS ** -0.5),
        "w_final_ada": nrm(ks[25], (D, 2 * D), 0.5 * D ** -0.5),
        "b_final_ada": nrm(ks[26], (2 * D,), 0.01),
        "normf_g": gain(ks[27], (D,)),
    }


def reference(x, c, positions, w_ada, b_ada, norm1_g, w_in, gla_wa_fw, gla_ba_fw,
              gla_wa_bw, gla_ba_bw, gla_norm_g, diff_lq1, diff_lk1, diff_lq2, diff_lk2,
              diff_norm_g, w_gla_proj, w_diff_proj, w_out, norm2_g, peer_wq,
              peer_subkeys, peer_u, peer_v, w_final_ada, b_final_ada, normf_g):
    B, S, D = x.shape
    splits = [GLA_QK, GLA_QK, GLA_V, GLA_V, GLA_LOWRANK, GLA_LOWRANK,
              DIFF_QK, DIFF_QK, DIFF_V, D, D]
    offsets = np.cumsum(splits)[:-1].tolist()
    c_act = jax.nn.silu(c)

    for l in range(DEPTH):
        lambda_init = 0.8 - 0.6 * math.exp(-0.3 * l)
        mod = c_act @ w_ada[l] + b_ada[l]
        sh1, sc1, gt1, sh2, sc2, gt2 = jnp.split(mod, N_ADA, axis=-1)

        h = modulate(rms_norm(x, norm1_g[l]), sh1, sc1)
        proj = h @ w_in[l]
        (gq, gk, gv, gr, lr_fw, lr_bw, dq, dk, dv, gate_a, gate_b) = jnp.split(proj, offsets, axis=-1)

        def heads(t, d):
            return t.reshape(B, S, GLA_HEADS, d).transpose(0, 2, 1, 3)
        q_g = heads(gq, GLA_DK) * (GLA_DK ** -0.5)
        k_g = heads(gk, GLA_DK)
        v_g = heads(gv, GLA_DV)
        logg_fw = heads(jax.nn.log_sigmoid((lr_fw @ gla_wa_fw[l] + gla_ba_fw[l]).astype(jnp.float32)) / GLA_GATE_NORM, GLA_DK)
        logg_bw = heads(jax.nn.log_sigmoid((lr_bw @ gla_wa_bw[l] + gla_ba_bw[l]).astype(jnp.float32)) / GLA_GATE_NORM, GLA_DK)
        o_fw = gla_scan(q_g, k_g, v_g, logg_fw)
        o_bw = jnp.flip(gla_scan(jnp.flip(q_g, 2), jnp.flip(k_g, 2), jnp.flip(v_g, 2),
                                 jnp.flip(logg_bw, 2)), 2)
        o_g = (o_fw + o_bw).transpose(0, 2, 1, 3).astype(x.dtype)
        o_g = rms_norm(o_g, gla_norm_g[l].reshape(GLA_HEADS, GLA_DV)).reshape(B, S, GLA_V)
        y_gla = (o_g * jax.nn.silu(gr)) @ w_gla_proj[l]

        lam = (jnp.exp(jnp.sum(diff_lq1[l].astype(jnp.float32) * diff_lk1[l].astype(jnp.float32)))
               - jnp.exp(jnp.sum(diff_lq2[l].astype(jnp.float32) * diff_lk2[l].astype(jnp.float32)))
               + lambda_init)
        q_d = dq.reshape(B, S, DIFF_HEADS, 2, DIFF_HD)
        k_d = dk.reshape(B, S, DIFF_HEADS, 2, DIFF_HD)
        v_d = dv.reshape(B, S, DIFF_HEADS, DIFF_VD)
        o_d = diff_attention(q_d, k_d, v_d, lam, positions).astype(x.dtype)
        o_d = rms_norm(o_d, diff_norm_g[l].reshape(DIFF_HEADS, DIFF_VD)) * (1.0 - lambda_init)
        y_diff = o_d.reshape(B, S, DIFF_V) @ w_diff_proj[l]

        merged = jax.nn.sigmoid(gate_a) * y_gla + jax.nn.sigmoid(gate_b) * y_diff
        x = x + gt1[:, None, :] * (merged @ w_out[l])

        h2 = modulate(rms_norm(x, norm2_g[l]), sh2, sc2)
        x = x + gt2[:, None, :] * peer(h2, peer_wq[l], peer_subkeys[l], peer_u[l], peer_v[l])

    fmod = c_act @ w_final_ada + b_final_ada
    f_shift, f_scale = jnp.split(fmod, 2, axis=-1)
    return modulate(rms_norm(x, normf_g), f_shift, f_scale)
```

```cpp
#include <hip/hip_runtime.h>
#include <hip/hip_cooperative_groups.h>
#include <cstdio>
namespace cg = cooperative_groups;

#define DI __device__ __forceinline__
typedef unsigned short u16;
using bf16x8 = __attribute__((ext_vector_type(8))) short;
using f32x16 = __attribute__((ext_vector_type(16))) float;
using u32x4 = __attribute__((ext_vector_type(4))) unsigned;
using u32x2 = __attribute__((ext_vector_type(2))) unsigned;
typedef __bf16 bf16x2_t __attribute__((ext_vector_type(2)));
typedef float f32x2_t __attribute__((ext_vector_type(2)));

constexpr int T = 32768, D = 1024, S = 8192;
constexpr size_t MB = 1ull << 20;
constexpr float RMS_EPS = 1e-6f;

#define MFMA(a, b, c) __builtin_amdgcn_mfma_f32_32x32x16_bf16((a), (b), (c), 0, 0, 0)

struct Params {
  const float *x, *c; const int* pos;
  const float *w_ada, *b_ada, *norm1_g, *w_in, *wa_fw, *ba_fw, *wa_bw, *ba_bw, *gla_norm_g;
  const float *lq1, *lk1, *lq2, *lk2, *diff_norm_g, *w_gla, *w_diff, *w_out, *norm2_g, *peer_wq, *subkeys, *peer_u, *peer_v;
  const float *w_fada, *b_fada, *normf_g;
  float* out;
  u16 *winT, *wgrT, *wgaT, *wgbT, *wglaT, *wdiffT, *woutT, *wqT, *subk;
  float* rope;
  float* mod;
  float* fmod;
  float* lam;
  int* counter;
  float* lr;
  float* dec;
  float* rstd;
  u16 *hA, *gq, *gk, *gvT, *dq, *dk, *dvT;
  u16 *qe_fw, *ke_fw, *qe_bw, *ke_bw, *keT;
  u16 *o_fw, *o_bw, *A1, *merged, *h2, *qp, *uB, *vB;
  float* x1;
  int* idx; float* g;
};

DI u16 f2bf(float x) { unsigned u = __float_as_uint(x); u += 0x7fffu + ((u >> 16) & 1u); return (u16)(u >> 16); }
DI float bf2f(u16 b) { return __uint_as_float(((unsigned)b) << 16); }
DI unsigned pack2(float a, float b) {
  f32x2_t v = {a, b};
  bf16x2_t r = __builtin_convertvector(v, bf16x2_t);
  return __builtin_bit_cast(unsigned, r);
}
DI float bflo(unsigned u) { return __uint_as_float(u << 16); }
DI float bfhi(unsigned u) { return __uint_as_float(u & 0xffff0000u); }
DI int crow(int i, int h) { return (i & 3) + 8 * (i >> 2) + 4 * h; }
DI bf16x8 pack_step(const f32x16& x, int s) {
  u32x4 p;
  p[0] = pack2(x[8 * s + 0], x[8 * s + 1]);
  p[1] = pack2(x[8 * s + 2], x[8 * s + 3]);
  p[2] = pack2(x[8 * s + 4], x[8 * s + 5]);
  p[3] = pack2(x[8 * s + 6], x[8 * s + 7]);
  return __builtin_bit_cast(bf16x8, p);
}
DI bf16x8 ld_frag16(const u16* p) { return __builtin_bit_cast(bf16x8, *(const u32x4*)p); }
DI bf16x8 ld_frag8x2(const u16* p) {
  u32x2 lo = *(const u32x2*)p; u32x2 hi = *(const u32x2*)(p + 8);
  u32x4 v = {lo[0], lo[1], hi[0], hi[1]};
  return __builtin_bit_cast(bf16x8, v);
}
DI float wave_sum(float v) {
#pragma unroll
  for (int o = 32; o >= 1; o >>= 1) v += __shfl_xor(v, o);
  return v;
}
DI f32x16 zero16() { f32x16 z; for (int i = 0; i < 16; ++i) z[i] = 0.f; return z; }

DI void tconv_tile(const float* src, int ld, int c0, int nc, u16* dst, int ct, int kt, float* sm, int tid) {
  __syncthreads();
  int cl = tid & 63, r0 = tid >> 6;
#pragma unroll
  for (int r = 0; r < 16; ++r) {
    int k = kt * 64 + r0 + 4 * r;
    int col = ct * 64 + cl;
    float v = (col < nc) ? src[(size_t)k * ld + c0 + col] : 0.f;
    sm[(r0 + 4 * r) * 65 + cl] = v;
  }
  __syncthreads();
#pragma unroll
  for (int r = 0; r < 16; ++r) {
    int col = r0 + 4 * r;
    int k = cl;
    dst[(size_t)(ct * 64 + col) * 1024 + kt * 64 + k] = f2bf(sm[k * 65 + col]);
  }
}

DI void phase_prep(const Params& p, char* smem, int tid) {
  float* sm = (float*)smem;
  const int nblk = gridDim.x, bid = blockIdx.x;
  const int NCT = 32 + 48 + 2 + 16 * 6 + 32;
  for (int it = bid; it < NCT * 16; it += nblk) {
    int ctg = it >> 4, kt = it & 15;
    const float* src; int ld, c0, nc; u16* dst; int ct;
    if (ctg < 32) { src = p.w_in; ld = 8224; c0 = 0; nc = 2048; dst = p.winT; ct = ctg; }
    else if (ctg < 80) { src = p.w_in; ld = 8224; c0 = 3104; nc = 3072; dst = p.winT + (size_t)2048 * 1024; ct = ctg - 32; }
    else if (ctg < 82) { src = p.w_in; ld = 8224; c0 = 3072; nc = 32; dst = p.winT + (size_t)5120 * 1024; ct = ctg - 80; }
    else if (ctg < 98) { src = p.w_in; ld = 8224; c0 = 2048; nc = 1024; dst = p.wgrT; ct = ctg - 82; }
    else if (ctg < 114) { src = p.w_in; ld = 8224; c0 = 6176; nc = 1024; dst = p.wgaT; ct = ctg - 98; }
    else if (ctg < 130) { src = p.w_in; ld = 8224; c0 = 7200; nc = 1024; dst = p.wgbT; ct = ctg - 114; }
    else if (ctg < 146) { src = p.w_gla; ld = 1024; c0 = 0; nc = 1024; dst = p.wglaT; ct = ctg - 130; }
    else if (ctg < 162) { src = p.w_diff; ld = 1024; c0 = 0; nc = 1024; dst = p.wdiffT; ct = ctg - 146; }
    else if (ctg < 178) { src = p.w_out; ld = 1024; c0 = 0; nc = 1024; dst = p.woutT; ct = ctg - 162; }
    else { src = p.peer_wq; ld = 2048; c0 = 0; nc = 2048; dst = p.wqT; ct = ctg - 178; }
    tconv_tile(src, ld, c0, nc, dst, ct, kt, sm, tid);
  }
  __syncthreads();
  const int gtid = bid * 256 + tid, gsz = nblk * 256;
  for (int i = gtid; i < 8 * 2 * 128 * 128; i += gsz) p.subk[i] = f2bf(p.subkeys[i]);
  for (int i = gtid; i < T * 32; i += gsz) {
    int t = i >> 5, d = i & 31;
    float inv = powf(10000.f, -(float)d / 32.f);
    float ang = (float)p.pos[t] * inv;
    double r = (double)ang * 0.15915494309189535;
    r -= rint(r);
    float rf = (float)r;
    p.rope[2 * i] = __builtin_amdgcn_cosf(rf);
    p.rope[2 * i + 1] = __builtin_amdgcn_sinf(rf);
  }
  if (gtid == 0) {
    float s1 = 0.f, s2 = 0.f;
    for (int i = 0; i < 64; ++i) { s1 += p.lq1[i] * p.lk1[i]; s2 += p.lq2[i] * p.lk2[i]; }
    p.lam[0] = expf(s1) - expf(s2) + 0.2f;
    p.counter[0] = 0; p.counter[1] = 0; p.counter[2] = 0; p.counter[3] = 0;
  }
  {
    float* cact = sm;
    float* red = sm + 4096;
    __syncthreads();
    for (int i = tid; i < 4096; i += 256) { float v = p.c[i]; cact[i] = v / (1.f + __expf(-v)); }
    __syncthreads();
    int w = tid >> 6, lane = tid & 63;
    for (int it = bid; it < 128; it += nblk) {
      int col = it * 64 + lane;
      const float* W; int ld, cc;
      if (col < 6144) { W = p.w_ada; ld = 6144; cc = col; } else { W = p.w_fada; ld = 2048; cc = col - 6144; }
      float a0 = 0, a1 = 0, a2 = 0, a3 = 0;
#pragma unroll 8
      for (int k = w * 256; k < w * 256 + 256; ++k) {
        float wv = W[(size_t)k * ld + cc];
        a0 += cact[k] * wv; a1 += cact[1024 + k] * wv; a2 += cact[2048 + k] * wv; a3 += cact[3072 + k] * wv;
      }
      red[(w * 4 + 0) * 64 + lane] = a0; red[(w * 4 + 1) * 64 + lane] = a1;
      red[(w * 4 + 2) * 64 + lane] = a2; red[(w * 4 + 3) * 64 + lane] = a3;
      __syncthreads();
      {
        int b = w;
        float s = red[(0 * 4 + b) * 64 + lane] + red[(1 * 4 + b) * 64 + lane] + red[(2 * 4 + b) * 64 + lane] + red[(3 * 4 + b) * 64 + lane];
        if (col < 6144) p.mod[b * 6144 + cc] = s + p.b_ada[cc];
        else p.fmod[b * 2048 + cc] = s + p.b_fada[cc];
      }
      __syncthreads();
    }
  }
}

DI void phase_norm_mod(const float* src, const float* g, const float* mod, int sh_off, int sc_off, u16* dst, int tid) {
  int w = tid >> 6, lane = tid & 63;
  for (int row = blockIdx.x * 4 + w; row < T; row += gridDim.x * 4) {
    int b = row >> 13;
    const float* xr = src + (size_t)row * 1024;
    float4 v[4]; float ss = 0.f;
#pragma unroll
    for (int m = 0; m < 4; ++m) { v[m] = *(const float4*)(xr + (m * 64 + lane) * 4); ss += v[m].x * v[m].x + v[m].y * v[m].y + v[m].z * v[m].z + v[m].w * v[m].w; }
    ss = wave_sum(ss);
    float rstd = rsqrtf(ss * (1.f / 1024.f) + RMS_EPS);
#pragma unroll
    for (int m = 0; m < 4; ++m) {
      int col = (m * 64 + lane) * 4;
      float4 gg = *(const float4*)(g + col);
      float4 sh = *(const float4*)(mod + b * 6144 + sh_off + col);
      float4 sc = *(const float4*)(mod + b * 6144 + sc_off + col);
      float y0 = v[m].x * rstd * gg.x * (1.f + sc.x) + sh.x;
      float y1 = v[m].y * rstd * gg.y * (1.f + sc.y) + sh.y;
      float y2 = v[m].z * rstd * gg.z * (1.f + sc.z) + sh.z;
      float y3 = v[m].w * rstd * gg.w * (1.f + sc.w) + sh.w;
      u32x2 o = {pack2(y0, y1), pack2(y2, y3)};
      *(u32x2*)(dst + (size_t)row * 1024 + col) = o;
    }
  }
}

DI void phase_final_plain(const Params& p, const float* src, int tid) {
  int w = tid >> 6, lane = tid & 63;
  for (int row = blockIdx.x * 4 + w; row < T; row += gridDim.x * 4) {
    int b = row >> 13;
    const float* xr = src + (size_t)row * 1024;
    float4 v[4]; float ss = 0.f;
#pragma unroll
    for (int m = 0; m < 4; ++m) { v[m] = *(const float4*)(xr + (m * 64 + lane) * 4); ss += v[m].x * v[m].x + v[m].y * v[m].y + v[m].z * v[m].z + v[m].w * v[m].w; }
    ss = wave_sum(ss);
    float rstd = rsqrtf(ss * (1.f / 1024.f) + RMS_EPS);
#pragma unroll
    for (int m = 0; m < 4; ++m) {
      int col = (m * 64 + lane) * 4;
      float4 gg = *(const float4*)(p.normf_g + col);
      float4 sh = *(const float4*)(p.fmod + b * 2048 + col);
      float4 sc = *(const float4*)(p.fmod + b * 2048 + 1024 + col);
      float4 o;
      o.x = v[m].x * rstd * gg.x * (1.f + sc.x) + sh.x;
      o.y = v[m].y * rstd * gg.y * (1.f + sc.y) + sh.y;
      o.z = v[m].z * rstd * gg.z * (1.f + sc.z) + sh.z;
      o.w = v[m].w * rstd * gg.w * (1.f + sc.w) + sh.w;
      *(float4*)(p.out + (size_t)row * 1024 + col) = o;
    }
  }
}


constexpr int GLD = 72;
DI void gemm_kloop(const u16* A, int lda, const u16* Bt, int ldb, int K, f32x16 (&acc)[2][2], u16* smem, int tid) {
  u16* sA = smem; u16* sB = smem + 128 * GLD;
  const int lrow = tid >> 3, lcol = (tid & 7) * 8;
  const int w = tid >> 6, lane = tid & 63, c = lane & 31, hh = lane >> 5;
  const int wm = w >> 1, wn = w & 1;
  u32x4 ra[4], rb[4];
#pragma unroll
  for (int r = 0; r < 4; ++r) {
    ra[r] = *(const u32x4*)(A + (size_t)(r * 32 + lrow) * lda + lcol);
    rb[r] = *(const u32x4*)(Bt + (size_t)(r * 32 + lrow) * ldb + lcol);
  }
  const int nk = K >> 6;
  for (int kt = 0; kt < nk; ++kt) {
    __syncthreads();
#pragma unroll
    for (int r = 0; r < 4; ++r) {
      *(u32x4*)(sA + (r * 32 + lrow) * GLD + lcol) = ra[r];
      *(u32x4*)(sB + (r * 32 + lrow) * GLD + lcol) = rb[r];
    }
    __syncthreads();
    if (kt + 1 < nk) {
#pragma unroll
      for (int r = 0; r < 4; ++r) {
        ra[r] = *(const u32x4*)(A + (size_t)(r * 32 + lrow) * lda + (kt + 1) * 64 + lcol);
        rb[r] = *(const u32x4*)(Bt + (size_t)(r * 32 + lrow) * ldb + (kt + 1) * 64 + lcol);
      }
    }
#pragma unroll
    for (int s = 0; s < 4; ++s) {
      bf16x8 a0 = ld_frag16(sA + (wm * 64 + c) * GLD + s * 16 + hh * 8);
      bf16x8 a1 = ld_frag16(sA + (wm * 64 + 32 + c) * GLD + s * 16 + hh * 8);
      bf16x8 b0 = ld_frag16(sB + (wn * 64 + c) * GLD + s * 16 + hh * 8);
      bf16x8 b1 = ld_frag16(sB + (wn * 64 + 32 + c) * GLD + s * 16 + hh * 8);
      acc[0][0] = MFMA(a0, b0, acc[0][0]);
      acc[0][1] = MFMA(a0, b1, acc[0][1]);
      acc[1][0] = MFMA(a1, b0, acc[1][0]);
      acc[1][1] = MFMA(a1, b1, acc[1][1]);
    }
  }
}
DI void zero_acc(f32x16 (&acc)[2][2]) {
#pragma unroll
  for (int a = 0; a < 2; ++a)
#pragma unroll
    for (int b = 0; b < 2; ++b) acc[a][b] = zero16();
}

DI void phase_proj(const Params& p, char* smem, int tid) {
  const int w = tid >> 6, lane = tid & 63, c = lane & 31, hh = lane >> 5;
  const int wm = w >> 1, wn = w & 1;
  const int NT = 41;
  for (int id = blockIdx.x; id < 256 * NT; id += gridDim.x) {
    int mt = id / NT, nt = id - mt * NT;
    int m0 = mt * 128, n0 = nt * 128;
    f32x16 acc[2][2]; zero_acc(acc);
    gemm_kloop(p.hA + (size_t)m0 * 1024, 1024, p.winT + (size_t)n0 * 1024, 1024, 1024, acc, (u16*)smem, tid);
    const int rb = m0 + wm * 64, cb = n0 + wn * 64;
    if (n0 < 1024) {
      float sc = (n0 < 512) ? 0.08838834764831845f : 1.f;
      u16* dst = (n0 < 512) ? p.gq : p.gk;
      int cbb = cb & 511;
#pragma unroll
      for (int mi = 0; mi < 2; ++mi)
#pragma unroll
        for (int ni = 0; ni < 2; ++ni)
#pragma unroll
          for (int i = 0; i < 16; ++i) {
            int row = rb + mi * 32 + crow(i, hh), col = cbb + ni * 32 + c;
            dst[(size_t)row * 512 + col] = f2bf(acc[mi][ni][i] * sc);
          }
    } else if (n0 < 2048 || (n0 >= 4096 && n0 < 5120)) {
      bool isg = n0 < 2048;
#pragma unroll
      for (int mi = 0; mi < 2; ++mi)
#pragma unroll
        for (int ni = 0; ni < 2; ++ni) {
          int col = cb + ni * 32 + c;
          size_t rowbase;
          int b = rb >> 13;
          if (isg) { int cc = col - 1024; rowbase = ((size_t)(b * 4 + (cc >> 8)) * 256 + (cc & 255)) * 8192; }
          else { int cc = col - 4096; rowbase = ((size_t)(b * 8 + (cc >> 7)) * 128 + (cc & 127)) * 8192; }
          u16* dst = (isg ? p.gvT : p.dvT) + rowbase;
#pragma unroll
          for (int g = 0; g < 4; ++g) {
            int s = ((rb + mi * 32) & 8191) + 8 * g + 4 * hh;
            u32x2 v = {pack2(acc[mi][ni][4 * g], acc[mi][ni][4 * g + 1]), pack2(acc[mi][ni][4 * g + 2], acc[mi][ni][4 * g + 3])};
            *(u32x2*)(dst + s) = v;
          }
        }
    } else if (n0 < 4096) {
      bool isq = n0 < 3072;
      float sc = isq ? (0.125f * 1.4426950408889634f) : 1.f;
      u16* dst = isq ? p.dq : p.dk;
      int cbb = (cb - (isq ? 2048 : 3072));
#pragma unroll
      for (int mi = 0; mi < 2; ++mi)
#pragma unroll
        for (int i = 0; i < 16; ++i) {
          int row = rb + mi * 32 + crow(i, hh);
          float2 cs = *(const float2*)(p.rope + ((size_t)row * 32 + c) * 2);
          float x1 = acc[mi][0][i], x2 = acc[mi][1][i];
          float o1 = (x1 * cs.x - x2 * cs.y) * sc;
          float o2 = (x2 * cs.x + x1 * cs.y) * sc;
          dst[(size_t)row * 1024 + cbb + c] = f2bf(o1);
          dst[(size_t)row * 1024 + cbb + 32 + c] = f2bf(o2);
        }
    } else {
      if (wn == 0) {
#pragma unroll
        for (int mi = 0; mi < 2; ++mi)
#pragma unroll
          for (int i = 0; i < 16; ++i) {
            int row = rb + mi * 32 + crow(i, hh);
            p.lr[(size_t)row * 32 + c] = acc[mi][0][i];
          }
      }
    }
  }
}

DI float logsig(float x) { return fminf(x, 0.f) - __logf(1.f + __expf(-fabsf(x))); }

DI void phase_gla_pre(const Params& p, char* smem, int tid) {
  float* slr = (float*)smem;
  for (int it = blockIdx.x; it < 512; it += gridDim.x) {
    int b = it >> 7, ch = it & 127;
    size_t t0 = (size_t)b * 8192 + ch * 64;
    __syncthreads();
    for (int i = tid; i < 2048; i += 256) slr[i] = p.lr[t0 * 32 + i];
    __syncthreads();
#pragma unroll 1
    for (int cj = 0; cj < 2; ++cj) {
      int j = tid + cj * 256;
      int h = j >> 7, d = j & 127;
#pragma unroll 1
      for (int dir = 0; dir < 2; ++dir) {
        const float* wa = dir ? p.wa_bw : p.wa_fw;
        float wr[16];
#pragma unroll
        for (int r = 0; r < 16; ++r) wr[r] = wa[r * 512 + j];
        float ba = (dir ? p.ba_bw : p.ba_fw)[j];
        u16* qe = dir ? p.qe_bw : p.qe_fw;
        u16* ke = dir ? p.ke_bw : p.ke_fw;
        u16* keT = p.keT + (size_t)dir * (16ull * 128 * 8192) + ((size_t)(b * 4 + h) * 128 + d) * 8192 + ch * 64;
        float bsum = 0.f;
#pragma unroll 1
        for (int g8 = 0; g8 < 8; ++g8) {
          unsigned kk[8];
#pragma unroll
          for (int u = 0; u < 8; ++u) {
            int tt = g8 * 8 + u;
            int t = dir ? 63 - tt : tt;
            float pre = ba;
#pragma unroll
            for (int r = 0; r < 16; ++r) pre += slr[t * 32 + dir * 16 + r] * wr[r];
            bsum += logsig(pre) * (1.f / 16.f);
            float qv = bf2f(p.gq[(t0 + t) * 512 + j]);
            float kv = bf2f(p.gk[(t0 + t) * 512 + j]);
            float eb = __expf(bsum);
            u16 qo = f2bf(qv * eb);
            u16 ko = f2bf(kv / eb);
            qe[(t0 + t) * 512 + j] = qo;
            ke[(t0 + t) * 512 + j] = ko;
            kk[u] = ko;
          }
          u32x4 v;
          if (!dir) {
            v[0] = kk[0] | (kk[1] << 16); v[1] = kk[2] | (kk[3] << 16); v[2] = kk[4] | (kk[5] << 16); v[3] = kk[6] | (kk[7] << 16);
            *(u32x4*)(keT + g8 * 8) = v;
          } else {
            v[0] = kk[7] | (kk[6] << 16); v[1] = kk[5] | (kk[4] << 16); v[2] = kk[3] | (kk[2] << 16); v[3] = kk[1] | (kk[0] << 16);
            *(u32x4*)(keT + (56 - g8 * 8)) = v;
          }
        }
        p.dec[((size_t)(dir * 4 + b) * 128 + ch) * 512 + j] = __expf(bsum);
      }
    }
  }
}

DI void gla_scan_wave(const Params& p, int stream, int lane) {
  const int slice = stream & 7, dir = (stream >> 3) & 1, bh = stream >> 4;
  const int b = bh >> 2, h = bh & 3;
  const u16* qe = dir ? p.qe_bw : p.qe_fw;
  const u16* ke = dir ? p.ke_bw : p.ke_fw;
  const u16* keT = p.keT + (size_t)dir * (16ull * 128 * 8192) + (size_t)bh * 128 * 8192;
  const u16* vT = p.gvT + ((size_t)bh * 256 + slice * 32) * 8192;
  const float* dec = p.dec + ((size_t)(dir * 4 + b) * 128) * 512 + h * 128;
  u16* o = dir ? p.o_bw : p.o_fw;
  const int c = lane & 31, hh = lane >> 5;
  f32x16 st[4];
#pragma unroll
  for (int i = 0; i < 4; ++i) st[i] = zero16();
#pragma unroll 1
  for (int ci = 0; ci < 128; ++ci) {
    const int ch = dir ? 127 - ci : ci;
    const size_t t0 = (size_t)b * 8192 + ch * 64;
    const int s0 = ch * 64;
    bf16x8 qf[2][8], kf[2][8];
#pragma unroll
    for (int qt = 0; qt < 2; ++qt)
#pragma unroll
      for (int ks = 0; ks < 8; ++ks) {
        qf[qt][ks] = ld_frag8x2(qe + (t0 + qt * 32 + c) * 512 + h * 128 + ks * 16 + 4 * hh);
        kf[qt][ks] = ld_frag8x2(ke + (t0 + qt * 32 + c) * 512 + h * 128 + ks * 16 + 4 * hh);
      }
    bf16x8 vf[4];
#pragma unroll
    for (int k4 = 0; k4 < 4; ++k4) vf[k4] = ld_frag8x2(vT + (size_t)c * 8192 + s0 + 16 * k4 + 4 * hh);
    f32x16 oacc[2];
    oacc[0] = zero16(); oacc[1] = zero16();
#pragma unroll
    for (int ks = 0; ks < 8; ++ks) {
      bf16x8 sf = pack_step(st[ks >> 1], ks & 1);
      oacc[0] = MFMA(qf[0][ks], sf, oacc[0]);
      oacc[1] = MFMA(qf[1][ks], sf, oacc[1]);
    }
#pragma unroll
    for (int kt = 0; kt < 2; ++kt)
#pragma unroll
      for (int qt = 0; qt < 2; ++qt) {
        bool skip = dir ? (kt < qt) : (kt > qt);
        if (skip) continue;
        f32x16 X = zero16();
#pragma unroll
        for (int ks = 0; ks < 8; ++ks) X = MFMA(kf[kt][ks], qf[qt][ks], X);
        if (kt == qt) {
#pragma unroll
          for (int i = 0; i < 16; ++i) {
            int key = crow(i, hh);
            bool keep = dir ? (key >= c) : (key <= c);
            X[i] = keep ? X[i] : 0.f;
          }
        }
        oacc[qt] = MFMA(pack_step(X, 0), vf[kt * 2 + 0], oacc[qt]);
        oacc[qt] = MFMA(pack_step(X, 1), vf[kt * 2 + 1], oacc[qt]);
      }
#pragma unroll
    for (int qt = 0; qt < 2; ++qt)
#pragma unroll
      for (int i = 0; i < 16; ++i)
        o[(t0 + qt * 32 + crow(i, hh)) * 1024 + h * 256 + slice * 32 + c] = f2bf(oacc[qt][i]);
#pragma unroll
    for (int dt = 0; dt < 4; ++dt) {
#pragma unroll
      for (int k4 = 0; k4 < 4; ++k4) {
        bf16x8 kt_f = ld_frag8x2(keT + (size_t)(dt * 32 + c) * 8192 + s0 + 16 * k4 + 4 * hh);
        st[dt] = MFMA(kt_f, vf[k4], st[dt]);
      }
#pragma unroll
      for (int g = 0; g < 4; ++g) {
        float4 dv = *(const float4*)(dec + (size_t)ch * 512 + dt * 32 + 8 * g + 4 * hh);
        st[dt][4 * g + 0] *= dv.x; st[dt][4 * g + 1] *= dv.y; st[dt][4 * g + 2] *= dv.z; st[dt][4 * g + 3] *= dv.w;
      }
    }
  }
}

constexpr int KLD = 136, VLD = 72;
DI void attn_item(const Params& p, int item, char* smem, int tid) {
  const int qb = item & 63, bh = item >> 6;
  const int b = bh >> 3, h = bh & 7;
  const int w = tid >> 6, lane = tid & 63, c = lane & 31, hh = lane >> 5;
  u16* sK = (u16*)smem;
  u16* sV = sK + 64 * KLD;
  const size_t tq = (size_t)b * 8192 + qb * 128 + w * 32 + c;
  bf16x8 qf[2][4];
#pragma unroll
  for (int mp = 0; mp < 2; ++mp)
#pragma unroll
    for (int s = 0; s < 4; ++s) qf[mp][s] = ld_frag16(p.dq + tq * 1024 + h * 128 + mp * 64 + 16 * s + 8 * hh);
  f32x16 O[2][4];
#pragma unroll
  for (int mp = 0; mp < 2; ++mp)
#pragma unroll
    for (int dt = 0; dt < 4; ++dt) O[mp][dt] = zero16();
  float mrun[2] = {-1e30f, -1e30f}, lrun[2] = {0.f, 0.f};
  const u16* Kg = p.dk + (size_t)b * 8192 * 1024 + h * 128;
  const u16* Vg = p.dvT + (size_t)bh * 128 * 8192;
  u32x4 rk[4], rv[4];
#pragma unroll
  for (int r = 0; r < 4; ++r) {
    int id = tid + 256 * r;
    rk[r] = *(const u32x4*)(Kg + (size_t)(id >> 4) * 1024 + (id & 15) * 8);
    rv[r] = *(const u32x4*)(Vg + (size_t)(id >> 3) * 8192 + (id & 7) * 8);
  }
#pragma unroll 1
  for (int kt = 0; kt < 128; ++kt) {
    __syncthreads();
#pragma unroll
    for (int r = 0; r < 4; ++r) {
      int id = tid + 256 * r;
      *(u32x4*)(sK + (id >> 4) * KLD + (id & 15) * 8) = rk[r];
      *(u32x4*)(sV + (id >> 3) * VLD + (id & 7) * 8) = rv[r];
    }
    __syncthreads();
    if (kt + 1 < 128) {
#pragma unroll
      for (int r = 0; r < 4; ++r) {
        int id = tid + 256 * r;
        rk[r] = *(const u32x4*)(Kg + (size_t)((kt + 1) * 64 + (id >> 4)) * 1024 + (id & 15) * 8);
        rv[r] = *(const u32x4*)(Vg + (size_t)(id >> 3) * 8192 + (kt + 1) * 64 + (id & 7) * 8);
      }
    }
    bf16x8 pf[2][2][2];
#pragma unroll
    for (int mp = 0; mp < 2; ++mp) {
      f32x16 sacc[2];
#pragma unroll
      for (int k2 = 0; k2 < 2; ++k2) {
        f32x16 a = zero16();
#pragma unroll
        for (int s = 0; s < 4; ++s) {
          bf16x8 kfr = ld_frag16(sK + (k2 * 32 + c) * KLD + mp * 64 + 16 * s + 8 * hh);
          a = MFMA(kfr, qf[mp][s], a);
        }
        sacc[k2] = a;
      }
      float mx = sacc[0][0];
#pragma unroll
      for (int i = 0; i < 16; ++i) { mx = fmaxf(mx, sacc[0][i]); mx = fmaxf(mx, sacc[1][i]); }
      mx = fmaxf(mx, __shfl_xor(mx, 32));
      float mnew = fmaxf(mrun[mp], mx);
      float alpha = exp2f(mrun[mp] - mnew);
      mrun[mp] = mnew;
      float ls = 0.f;
#pragma unroll
      for (int k2 = 0; k2 < 2; ++k2)
#pragma unroll
        for (int i = 0; i < 16; ++i) { float e = exp2f(sacc[k2][i] - mnew); sacc[k2][i] = e; ls += e; }
      lrun[mp] = lrun[mp] * alpha + ls;
#pragma unroll
      for (int dt = 0; dt < 4; ++dt)
#pragma unroll
        for (int i = 0; i < 16; ++i) O[mp][dt][i] *= alpha;
#pragma unroll
      for (int k2 = 0; k2 < 2; ++k2) { pf[mp][k2][0] = pack_step(sacc[k2], 0); pf[mp][k2][1] = pack_step(sacc[k2], 1); }
    }
#pragma unroll
    for (int k2 = 0; k2 < 2; ++k2)
#pragma unroll
      for (int s2 = 0; s2 < 2; ++s2) {
#pragma unroll
        for (int dt = 0; dt < 4; ++dt) {
          bf16x8 vfr = ld_frag8x2(sV + (dt * 32 + c) * VLD + k2 * 32 + s2 * 16 + 4 * hh);
          O[0][dt] = MFMA(vfr, pf[0][k2][s2], O[0][dt]);
          O[1][dt] = MFMA(vfr, pf[1][k2][s2], O[1][dt]);
        }
      }
  }
  float l0 = lrun[0] + __shfl_xor(lrun[0], 32);
  float l1 = lrun[1] + __shfl_xor(lrun[1], 32);
  float i0 = 1.f / l0, i1 = p.lam[0] / l1;
  float ss = 0.f;
#pragma unroll
  for (int dt = 0; dt < 4; ++dt)
#pragma unroll
    for (int i = 0; i < 16; ++i) { float v = O[0][dt][i] * i0 - O[1][dt][i] * i1; O[0][dt][i] = v; ss += v * v; }
  ss += __shfl_xor(ss, 32);
  float rstd = rsqrtf(ss * (1.f / 128.f) + RMS_EPS) * 0.8f;
#pragma unroll
  for (int dt = 0; dt < 4; ++dt)
#pragma unroll
    for (int g = 0; g < 4; ++g) {
      int dv = dt * 32 + 8 * g + 4 * hh;
      float4 gg = *(const float4*)(p.diff_norm_g + h * 128 + dv);
      u32x2 v = {pack2(O[0][dt][4 * g] * rstd * gg.x, O[0][dt][4 * g + 1] * rstd * gg.y),
                 pack2(O[0][dt][4 * g + 2] * rstd * gg.z, O[0][dt][4 * g + 3] * rstd * gg.w)};
      *(u32x2*)(p.dq + tq * 1024 + h * 128 + dv) = v;
    }
}

DI void phase_mixers(const Params& p, char* smem, int tid) {
  int* sitem = (int*)(smem + 59 * 1024);
  if (blockIdx.x < 64) gla_scan_wave(p, blockIdx.x * 4 + (tid >> 6), tid & 63);
  for (;;) {
    __syncthreads();
    if (tid == 0) *sitem = atomicAdd(p.counter, 1);
    __syncthreads();
    int item = *sitem;
    if (item >= 2048) break;
    attn_item(p, item, smem, tid);
  }
}

DI void phase_post_mixers(const Params& p, int tid) {
  int w = tid >> 6, lane = tid & 63;
  for (int row = blockIdx.x * 4 + w; row < T; row += gridDim.x * 4) {
#pragma unroll
    for (int hd = 0; hd < 4; ++hd) {
      u32x2 a = *(const u32x2*)(p.o_fw + (size_t)row * 1024 + hd * 256 + lane * 4);
      u32x2 bq = *(const u32x2*)(p.o_bw + (size_t)row * 1024 + hd * 256 + lane * 4);
      float v0 = bflo(a[0]) + bflo(bq[0]), v1 = bfhi(a[0]) + bfhi(bq[0]), v2 = bflo(a[1]) + bflo(bq[1]), v3 = bfhi(a[1]) + bfhi(bq[1]);
      float ss = wave_sum(v0 * v0 + v1 * v1 + v2 * v2 + v3 * v3);
      if (lane == 0) p.rstd[row * 4 + hd] = rsqrtf(ss * (1.f / 256.f) + RMS_EPS);
    }
  }
  phase_norm_mod(p.x, p.norm1_g, p.mod, 0, 1024, p.hA, tid);
  const size_t gtid = (size_t)blockIdx.x * 256 + tid, gsz = (size_t)gridDim.x * 256;
  for (size_t i = gtid; i < 16384ull * 1024 / 4; i += gsz) {
    float4 a = *(const float4*)(p.peer_u + i * 4);
    float4 bq = *(const float4*)(p.peer_v + i * 4);
    u32x2 ua = {pack2(a.x, a.y), pack2(a.z, a.w)};
    u32x2 ub = {pack2(bq.x, bq.y), pack2(bq.z, bq.w)};
    *(u32x2*)(p.uB + i * 4) = ua;
    *(u32x2*)(p.vB + i * 4) = ub;
  }
}

DI void phase_gr(const Params& p, char* smem, int tid) {
  const int w = tid >> 6, lane = tid & 63, c = lane & 31, hh = lane >> 5;
  const int wm = w >> 1, wn = w & 1;
  for (int id = blockIdx.x; id < 256 * 8; id += gridDim.x) {
    int mt = id >> 3, nt = id & 7;
    int m0 = mt * 128, n0 = nt * 128;
    f32x16 acc[2][2]; zero_acc(acc);
    gemm_kloop(p.hA + (size_t)m0 * 1024, 1024, p.wgrT + (size_t)n0 * 1024, 1024, 1024, acc, (u16*)smem, tid);
#pragma unroll
    for (int mi = 0; mi < 2; ++mi)
#pragma unroll
      for (int ni = 0; ni < 2; ++ni) {
        int col = n0 + wn * 64 + ni * 32 + c;
        float gn = p.gla_norm_g[col];
#pragma unroll
        for (int i = 0; i < 16; ++i) {
          int row = m0 + wm * 64 + mi * 32 + crow(i, hh);
          float a = acc[mi][ni][i];
          float sl = a / (1.f + __expf(-a));
          float ov = bf2f(p.o_fw[(size_t)row * 1024 + col]) + bf2f(p.o_bw[(size_t)row * 1024 + col]);
          p.A1[(size_t)row * 1024 + col] = f2bf(ov * p.rstd[row * 4 + (col >> 8)] * gn * sl);
        }
      }
  }
}

DI void phase_merge(const Params& p, char* smem, int tid) {
  const int w = tid >> 6, lane = tid & 63, c = lane & 31, hh = lane >> 5;
  const int wm = w >> 1, wn = w & 1;
  for (int id = blockIdx.x; id < 256 * 8; id += gridDim.x) {
    int mt = id >> 3, nt = id & 7;
    int m0 = mt * 128, n0 = nt * 128;
    f32x16 acc[2][2], mg[2][2];
    unsigned gpk[2][2][8];
    zero_acc(acc);
    gemm_kloop(p.hA + (size_t)m0 * 1024, 1024, p.wgaT + (size_t)n0 * 1024, 1024, 1024, acc, (u16*)smem, tid);
#pragma unroll
    for (int mi = 0; mi < 2; ++mi)
#pragma unroll
      for (int ni = 0; ni < 2; ++ni)
#pragma unroll
        for (int i = 0; i < 8; ++i) gpk[mi][ni][i] = pack2(1.f / (1.f + __expf(-acc[mi][ni][2 * i])), 1.f / (1.f + __expf(-acc[mi][ni][2 * i + 1])));
    zero_acc(acc);
    gemm_kloop(p.A1 + (size_t)m0 * 1024, 1024, p.wglaT + (size_t)n0 * 1024, 1024, 1024, acc, (u16*)smem, tid);
#pragma unroll
    for (int mi = 0; mi < 2; ++mi)
#pragma unroll
      for (int ni = 0; ni < 2; ++ni)
#pragma unroll
        for (int i = 0; i < 8; ++i) { mg[mi][ni][2 * i] = acc[mi][ni][2 * i] * bflo(gpk[mi][ni][i]); mg[mi][ni][2 * i + 1] = acc[mi][ni][2 * i + 1] * bfhi(gpk[mi][ni][i]); }
    zero_acc(acc);
    gemm_kloop(p.hA + (size_t)m0 * 1024, 1024, p.wgbT + (size_t)n0 * 1024, 1024, 1024, acc, (u16*)smem, tid);
#pragma unroll
    for (int mi = 0; mi < 2; ++mi)
#pragma unroll
      for (int ni = 0; ni < 2; ++ni)
#pragma unroll
        for (int i = 0; i < 8; ++i) gpk[mi][ni][i] = pack2(1.f / (1.f + __expf(-acc[mi][ni][2 * i])), 1.f / (1.f + __expf(-acc[mi][ni][2 * i + 1])));
    zero_acc(acc);
    gemm_kloop(p.dq + (size_t)m0 * 1024, 1024, p.wdiffT + (size_t)n0 * 1024, 1024, 1024, acc, (u16*)smem, tid);
#pragma unroll
    for (int mi = 0; mi < 2; ++mi)
#pragma unroll
      for (int ni = 0; ni < 2; ++ni)
#pragma unroll
        for (int i = 0; i < 16; ++i) {
          float gv = (i & 1) ? bfhi(gpk[mi][ni][i >> 1]) : bflo(gpk[mi][ni][i >> 1]);
          float v = mg[mi][ni][i] + acc[mi][ni][i] * gv;
          int row = m0 + wm * 64 + mi * 32 + crow(i, hh), col = n0 + wn * 64 + ni * 32 + c;
          p.merged[(size_t)row * 1024 + col] = f2bf(v);
        }
  }
}

DI void phase_out(const Params& p, char* smem, int tid) {
  const int w = tid >> 6, lane = tid & 63, c = lane & 31, hh = lane >> 5;
  const int wm = w >> 1, wn = w & 1;
  for (int id = blockIdx.x; id < 256 * 8; id += gridDim.x) {
    int mt = id >> 3, nt = id & 7;
    int m0 = mt * 128, n0 = nt * 128;
    f32x16 acc[2][2]; zero_acc(acc);
    gemm_kloop(p.merged + (size_t)m0 * 1024, 1024, p.woutT + (size_t)n0 * 1024, 1024, 1024, acc, (u16*)smem, tid);
    int b = m0 >> 13;
#pragma unroll
    for (int mi = 0; mi < 2; ++mi)
#pragma unroll
      for (int ni = 0; ni < 2; ++ni) {
        int col = n0 + wn * 64 + ni * 32 + c;
        float gate = p.mod[b * 6144 + 2048 + col];
#pragma unroll
        for (int i = 0; i < 16; ++i) {
          int row = m0 + wm * 64 + mi * 32 + crow(i, hh);
          p.x1[(size_t)row * 1024 + col] = p.x[(size_t)row * 1024 + col] + gate * acc[mi][ni][i];
        }
      }
  }
}

DI void phase_peerq(const Params& p, char* smem, int tid) {
  const int w = tid >> 6, lane = tid & 63, c = lane & 31, hh = lane >> 5;
  const int wm = w >> 1, wn = w & 1;
  for (int id = blockIdx.x; id < 256 * 16; id += gridDim.x) {
    int mt = id >> 4, nt = id & 15;
    int m0 = mt * 128, n0 = nt * 128;
    f32x16 acc[2][2]; zero_acc(acc);
    gemm_kloop(p.h2 + (size_t)m0 * 1024, 1024, p.wqT + (size_t)n0 * 1024, 1024, 1024, acc, (u16*)smem, tid);
#pragma unroll
    for (int mi = 0; mi < 2; ++mi)
#pragma unroll
      for (int ni = 0; ni < 2; ++ni)
#pragma unroll
        for (int i = 0; i < 16; ++i) {
          int row = m0 + wm * 64 + mi * 32 + crow(i, hh), col = n0 + wn * 64 + ni * 32 + c;
          p.qp[(size_t)row * 2048 + col] = f2bf(acc[mi][ni][i]);
        }
  }
}

DI unsigned fkey(float f) { unsigned u = __float_as_uint(f); return (u & 0x80000000u) ? ~u : (u | 0x80000000u); }
DI unsigned gmax16(unsigned v) {
  v = max(v, (unsigned)__shfl_xor((int)v, 1)); v = max(v, (unsigned)__shfl_xor((int)v, 2));
  v = max(v, (unsigned)__shfl_xor((int)v, 4)); v = max(v, (unsigned)__shfl_xor((int)v, 8));
  return v;
}
DI void phase_topk(const Params& p, char* smem, int tid) {
  float* sc = (float*)smem;
  float* ts = sc + 64 * 132;
  int* ti = (int*)(ts + 64 * 32);
  const int w = tid >> 6, lane = tid & 63, c = lane & 31, hh = lane >> 5;
  const int l16 = tid & 15, grp = tid >> 4;
  for (int item = blockIdx.x; item < 4096; item += gridDim.x) {
    const int h = item & 7;
    const size_t t0 = (size_t)(item >> 3) * 64;
#pragma unroll 1
    for (int pp = 0; pp < 2; ++pp) {
      f32x16 acc[2]; acc[0] = zero16(); acc[1] = zero16();
      const u16* Aq = p.qp + t0 * 2048 + h * 256 + pp * 128;
      const u16* Bk = p.subk + (size_t)(h * 2 + pp) * 128 * 128;
#pragma unroll
      for (int s = 0; s < 8; ++s) {
        bf16x8 bfr = ld_frag16(Bk + (32 * w + c) * 128 + 16 * s + 8 * hh);
        bf16x8 a0 = ld_frag16(Aq + (size_t)c * 2048 + 16 * s + 8 * hh);
        bf16x8 a1 = ld_frag16(Aq + (size_t)(32 + c) * 2048 + 16 * s + 8 * hh);
        acc[0] = MFMA(a0, bfr, acc[0]);
        acc[1] = MFMA(a1, bfr, acc[1]);
      }
      __syncthreads();
#pragma unroll
      for (int mi = 0; mi < 2; ++mi)
#pragma unroll
        for (int i = 0; i < 16; ++i) sc[(mi * 32 + crow(i, hh)) * 132 + 32 * w + c] = acc[mi][i];
      __syncthreads();
#pragma unroll 1
      for (int rr = 0; rr < 4; ++rr) {
        const int row = grp + 16 * rr;
        unsigned k[8];
#pragma unroll
        for (int m = 0; m < 8; ++m) { int n = l16 + 16 * m; k[m] = (fkey(sc[row * 132 + n]) & ~127u) | (unsigned)(127 - n); }
#pragma unroll 1
        for (int round = 0; round < 16; ++round) {
          unsigned mx = max(max(max(k[0], k[1]), max(k[2], k[3])), max(max(k[4], k[5]), max(k[6], k[7])));
          mx = gmax16(mx);
          if (l16 == 0) {
            int n = 127 - (int)(mx & 127u);
            ti[(row * 2 + pp) * 16 + round] = n;
            ts[(row * 2 + pp) * 16 + round] = sc[row * 132 + n];
          }
#pragma unroll
          for (int m = 0; m < 8; ++m) k[m] = (k[m] == mx) ? 0u : k[m];
        }
      }
    }
    __syncthreads();
#pragma unroll 1
    for (int rr = 0; rr < 4; ++rr) {
      const int row = grp + 16 * rr;
      const float s0v = ts[(row * 2) * 16 + l16];
      int ptr = 0; int my_idx = 0; float my_s = 0.f;
#pragma unroll 1
      for (int round = 0; round < 16; ++round) {
        float v = s0v + ts[(row * 2 + 1) * 16 + (ptr & 15)];
        unsigned key = (ptr < 16) ? ((fkey(v) & ~255u) | (unsigned)(255 - (l16 * 16 + ptr))) : 0u;
        unsigned mx = gmax16(key);
        int flat = 255 - (int)(mx & 255u);
        int aw = flat >> 4, bw = flat & 15;
        if (l16 == round) {
          my_idx = ti[(row * 2) * 16 + aw] * 128 + ti[(row * 2 + 1) * 16 + bw];
          my_s = ts[(row * 2) * 16 + aw] + ts[(row * 2 + 1) * 16 + bw];
        }
        if (l16 == aw) ptr++;
      }
      float mxs = my_s;
      mxs = fmaxf(mxs, __shfl_xor(mxs, 1)); mxs = fmaxf(mxs, __shfl_xor(mxs, 2));
      mxs = fmaxf(mxs, __shfl_xor(mxs, 4)); mxs = fmaxf(mxs, __shfl_xor(mxs, 8));
      float e = __expf(my_s - mxs);
      float sum = e;
      sum += __shfl_xor(sum, 1); sum += __shfl_xor(sum, 2); sum += __shfl_xor(sum, 4); sum += __shfl_xor(sum, 8);
      p.idx[(t0 + row) * 128 + h * 16 + l16] = my_idx;
      p.g[(t0 + row) * 128 + h * 16 + l16] = e / sum;
    }
    __syncthreads();
  }
}

DI float dot8(u32x4 a, u32x4 b, float acc) {
#pragma unroll
  for (int i = 0; i < 4; ++i) acc += bflo(a[i]) * bflo(b[i]) + bfhi(a[i]) * bfhi(b[i]);
  return acc;
}
DI void phase_peer_final(const Params& p, char* smem, int tid) {
  const int w = tid >> 6, lane = tid & 63, q = lane & 15, gq = lane >> 4;
  float* wl = (float*)smem + w * 128;
  for (int item = blockIdx.x; item < T / 4; item += gridDim.x) {
    const size_t t = (size_t)item * 4 + w;
    const int b = (int)(t >> 13);
    u32x4 hreg[8];
#pragma unroll
    for (int m = 0; m < 8; ++m) hreg[m] = *(const u32x4*)(p.h2 + t * 1024 + (q + 16 * m) * 8);
    const int* idxp = p.idx + t * 128;
    const float* gp = p.g + t * 128;
    __syncthreads();
#pragma unroll 2
    for (int r = 0; r < 32; ++r) {
      int e = r * 4 + gq;
      int row = idxp[e];
      const u16* up = p.uB + (size_t)row * 1024;
      float acc = 0.f;
#pragma unroll
      for (int m = 0; m < 8; ++m) { u32x4 uv = *(const u32x4*)(up + (q + 16 * m) * 8); acc = dot8(uv, hreg[m], acc); }
      acc += __shfl_xor(acc, 1); acc += __shfl_xor(acc, 2); acc += __shfl_xor(acc, 4); acc += __shfl_xor(acc, 8);
      float act = 0.5f * acc * (1.f + erff(acc * 0.7071067811865476f));
      if (q == 0) wl[e] = gp[e] * act;
    }
    __syncthreads();
    float o[64];
#pragma unroll
    for (int i = 0; i < 64; ++i) o[i] = 0.f;
#pragma unroll 2
    for (int r = 0; r < 32; ++r) {
      int e = r * 4 + gq;
      int row = idxp[e];
      float wg = wl[e];
      const u16* vp = p.vB + (size_t)row * 1024;
#pragma unroll
      for (int m = 0; m < 8; ++m) {
        u32x4 vv = *(const u32x4*)(vp + (q + 16 * m) * 8);
#pragma unroll
        for (int i = 0; i < 4; ++i) { o[m * 8 + 2 * i] += wg * bflo(vv[i]); o[m * 8 + 2 * i + 1] += wg * bfhi(vv[i]); }
      }
    }
#pragma unroll
    for (int i = 0; i < 64; ++i) { o[i] += __shfl_xor(o[i], 16); o[i] += __shfl_xor(o[i], 32); }
    float ss = 0.f;
#pragma unroll
    for (int m = 0; m < 8; ++m) {
      int col = (q + 16 * m) * 8;
      float4 xa = *(const float4*)(p.x1 + t * 1024 + col), xb = *(const float4*)(p.x1 + t * 1024 + col + 4);
      float4 ga = *(const float4*)(p.mod + b * 6144 + 5120 + col), gb = *(const float4*)(p.mod + b * 6144 + 5120 + col + 4);
      o[m * 8 + 0] = xa.x + ga.x * o[m * 8 + 0]; o[m * 8 + 1] = xa.y + ga.y * o[m * 8 + 1];
      o[m * 8 + 2] = xa.z + ga.z * o[m * 8 + 2]; o[m * 8 + 3] = xa.w + ga.w * o[m * 8 + 3];
      o[m * 8 + 4] = xb.x + gb.x * o[m * 8 + 4]; o[m * 8 + 5] = xb.y + gb.y * o[m * 8 + 5];
      o[m * 8 + 6] = xb.z + gb.z * o[m * 8 + 6]; o[m * 8 + 7] = xb.w + gb.w * o[m * 8 + 7];
#pragma unroll
      for (int j = 0; j < 8; ++j) ss += o[m * 8 + j] * o[m * 8 + j];
    }
    ss += __shfl_xor(ss, 1); ss += __shfl_xor(ss, 2); ss += __shfl_xor(ss, 4); ss += __shfl_xor(ss, 8);
    float rstd = rsqrtf(ss * (1.f / 1024.f) + RMS_EPS);
#pragma unroll
    for (int m = 0; m < 8; ++m) {
      if ((m >> 1) == gq) {
        int col = (q + 16 * m) * 8;
#pragma unroll
        for (int j4 = 0; j4 < 2; ++j4) {
          float4 gg = *(const float4*)(p.normf_g + col + 4 * j4);
          float4 sh = *(const float4*)(p.fmod + b * 2048 + col + 4 * j4);
          float4 sc = *(const float4*)(p.fmod + b * 2048 + 1024 + col + 4 * j4);
          float4 r;
          r.x = o[m * 8 + 4 * j4 + 0] * rstd * gg.x * (1.f + sc.x) + sh.x;
          r.y = o[m * 8 + 4 * j4 + 1] * rstd * gg.y * (1.f + sc.y) + sh.y;
          r.z = o[m * 8 + 4 * j4 + 2] * rstd * gg.z * (1.f + sc.z) + sh.z;
          r.w = o[m * 8 + 4 * j4 + 3] * rstd * gg.w * (1.f + sc.w) + sh.w;
          *(float4*)(p.out + t * 1024 + col + 4 * j4) = r;
        }
      }
    }
  }
}

__global__ void __launch_bounds__(256) fwd_megakernel(Params p) {
  cg::grid_group grid = cg::this_grid();
  __shared__ __attribute__((aligned(16))) char smem[60 * 1024];
  const int tid = threadIdx.x;
  phase_prep(p, smem, tid);
  grid.sync();
  phase_norm_mod(p.x, p.norm1_g, p.mod, 0, 1024, p.hA, tid);
  grid.sync();
  phase_proj(p, smem, tid);
  grid.sync();
  phase_gla_pre(p, smem, tid);
  grid.sync();
  phase_mixers(p, smem, tid);
  grid.sync();
  phase_post_mixers(p, tid);
  grid.sync();
  phase_gr(p, smem, tid);
  grid.sync();
  phase_merge(p, smem, tid);
  grid.sync();
  phase_out(p, smem, tid);
  grid.sync();
  phase_norm_mod(p.x1, p.norm2_g, p.mod, 3072, 4096, p.h2, tid);
  grid.sync();
  phase_peerq(p, smem, tid);
  grid.sync();
  phase_topk(p, smem, tid);
  grid.sync();
  phase_peer_final(p, smem, tid);
}

extern "C" void kernel_launch(void* const* d_in, const int* in_sizes, int n_in, void* d_out, int out_size, void* d_ws,
                              size_t ws_size, hipStream_t stream) {
  static int grid_blocks = 0;
  if (!grid_blocks) {
    int dev = 0, cus = 0, per_cu = 0;
    hipGetDevice(&dev);
    hipDeviceGetAttribute(&cus, hipDeviceAttributeMultiprocessorCount, dev);
    hipOccupancyMaxActiveBlocksPerMultiprocessor(&per_cu, fwd_megakernel, 256, 0);
    if (per_cu < 1) per_cu = 1;
    grid_blocks = cus * per_cu;
  }
  if (ws_size < 492 * MB) { fprintf(stderr, "ws too small: %zu\n", ws_size); return; }
  Params p{};
  p.x = (const float*)d_in[0]; p.c = (const float*)d_in[1]; p.pos = (const int*)d_in[2];
  p.w_ada = (const float*)d_in[3]; p.b_ada = (const float*)d_in[4]; p.norm1_g = (const float*)d_in[5];
  p.w_in = (const float*)d_in[6]; p.wa_fw = (const float*)d_in[7]; p.ba_fw = (const float*)d_in[8];
  p.wa_bw = (const float*)d_in[9]; p.ba_bw = (const float*)d_in[10]; p.gla_norm_g = (const float*)d_in[11];
  p.lq1 = (const float*)d_in[12]; p.lk1 = (const float*)d_in[13]; p.lq2 = (const float*)d_in[14]; p.lk2 = (const float*)d_in[15];
  p.diff_norm_g = (const float*)d_in[16]; p.w_gla = (const float*)d_in[17]; p.w_diff = (const float*)d_in[18];
  p.w_out = (const float*)d_in[19]; p.norm2_g = (const float*)d_in[20]; p.peer_wq = (const float*)d_in[21];
  p.subkeys = (const float*)d_in[22]; p.peer_u = (const float*)d_in[23]; p.peer_v = (const float*)d_in[24];
  p.w_fada = (const float*)d_in[25]; p.b_fada = (const float*)d_in[26]; p.normf_g = (const float*)d_in[27];
  p.out = (float*)d_out;
  char* ws = (char*)d_ws;
  p.winT = (u16*)(ws + 0 * MB); p.wgrT = (u16*)(ws + 11 * MB); p.wgaT = (u16*)(ws + 13 * MB); p.wgbT = (u16*)(ws + 15 * MB);
  p.wglaT = (u16*)(ws + 17 * MB); p.wdiffT = (u16*)(ws + 19 * MB); p.woutT = (u16*)(ws + 21 * MB); p.wqT = (u16*)(ws + 23 * MB);
  p.subk = (u16*)(ws + 27 * MB); p.rope = (float*)(ws + 28 * MB);
  p.mod = (float*)(ws + 36 * MB); p.fmod = (float*)(ws + 36 * MB + 128 * 1024); p.lam = (float*)(ws + 36 * MB + 192 * 1024);
  p.counter = (int*)(ws + 36 * MB + 196 * 1024);
  p.lr = (float*)(ws + 37 * MB); p.dec = (float*)(ws + 41 * MB); p.rstd = (float*)(ws + 43 * MB);
  char* slot[9];
  for (int i = 0; i < 7; ++i) slot[i] = ws + (44 + 64 * (size_t)i) * MB;
  slot[7] = (char*)d_out; slot[8] = (char*)d_out + 64 * MB;
  p.hA = (u16*)slot[0];
  p.gq = (u16*)slot[1]; p.gk = (u16*)(slot[1] + 32 * MB);
  p.gvT = (u16*)slot[2]; p.dq = (u16*)slot[3]; p.dk = (u16*)slot[4]; p.dvT = (u16*)slot[5];
  p.qe_fw = (u16*)slot[0]; p.ke_fw = (u16*)(slot[0] + 32 * MB);
  p.qe_bw = (u16*)slot[6]; p.ke_bw = (u16*)(slot[6] + 32 * MB);
  p.keT = (u16*)slot[7];
  p.o_fw = (u16*)slot[1]; p.o_bw = (u16*)slot[8];
  p.uB = (u16*)slot[6]; p.vB = (u16*)(slot[6] + 32 * MB);
  p.A1 = (u16*)slot[2]; p.merged = (u16*)slot[4];
  p.x1 = (float*)slot[0];
  p.h2 = (u16*)slot[2]; p.qp = (u16*)slot[3];
  p.idx = (int*)slot[5]; p.g = (float*)(slot[5] + 16 * MB);
  void* args[] = {&p};
  hipError_t e = hipLaunchCooperativeKernel((void*)fwd_megakernel, dim3(grid_blocks), dim3(256), args, 0, stream);
  if (e != hipSuccess) fprintf(stderr, "cooperative launch failed: %s (grid %d)\n", hipGetErrorString(e), grid_blocks);
}
```

```cpp
#include <hip/hip_runtime.h>
#include <hip/hip_cooperative_groups.h>
#include <cstdio>
namespace cg = cooperative_groups;

#define DI __device__ __forceinline__
typedef unsigned short u16;
using bf16x8 = __attribute__((ext_vector_type(8))) short;
using f32x16 = __attribute__((ext_vector_type(16))) float;
using u32x4 = __attribute__((ext_vector_type(4))) unsigned;
using u32x2 = __attribute__((ext_vector_type(2))) unsigned;
typedef __bf16 bf16x2_t __attribute__((ext_vector_type(2)));
typedef float f32x2_t __attribute__((ext_vector_type(2)));

constexpr int T = 32768, D = 1024, S = 8192;
constexpr size_t MB = 1ull << 20;
constexpr float RMS_EPS = 1e-6f;

#define MFMA(a, b, c) __builtin_amdgcn_mfma_f32_32x32x16_bf16((a), (b), (c), 0, 0, 0)

struct Params {
  const float *x, *c; const int* pos;
  const float *w_ada, *b_ada, *norm1_g, *w_in, *wa_fw, *ba_fw, *wa_bw, *ba_bw, *gla_norm_g;
  const float *lq1, *lk1, *lq2, *lk2, *diff_norm_g, *w_gla, *w_diff, *w_out, *norm2_g, *peer_wq, *subkeys, *peer_u, *peer_v;
  const float *w_fada, *b_fada, *normf_g;
  float* out;
  u16 *winT, *wgrT, *wgaT, *wgbT, *wglaT, *wdiffT, *woutT, *wqT, *subk;
  float* rope;
  float* mod;
  float* fmod;
  float* lam;
  int* counter;
  float* lr;
  float* dec;
  float* rstd;
  u16 *hA, *gq, *gk, *gvT, *dq, *dk, *dvT;
  u16 *qe_fw, *ke_fw, *qe_bw, *ke_bw, *keT;
  u16 *o_fw, *o_bw, *A1, *merged, *h2, *qp, *uB, *vB;
  float* x1;
  int* idx; float* g;
  float *us, *vs;
};

DI u16 f2bf(float x) { unsigned u = __float_as_uint(x); u += 0x7fffu + ((u >> 16) & 1u); return (u16)(u >> 16); }
DI float bf2f(u16 b) { return __uint_as_float(((unsigned)b) << 16); }
DI unsigned pack2(float a, float b) {
  f32x2_t v = {a, b};
  bf16x2_t r = __builtin_convertvector(v, bf16x2_t);
  return __builtin_bit_cast(unsigned, r);
}
DI float bflo(unsigned u) { return __uint_as_float(u << 16); }
DI float bfhi(unsigned u) { return __uint_as_float(u & 0xffff0000u); }
DI int crow(int i, int h) { return (i & 3) + 8 * (i >> 2) + 4 * h; }
DI bf16x8 pack_step(const f32x16& x, int s) {
  u32x4 p;
  p[0] = pack2(x[8 * s + 0], x[8 * s + 1]);
  p[1] = pack2(x[8 * s + 2], x[8 * s + 3]);
  p[2] = pack2(x[8 * s + 4], x[8 * s + 5]);
  p[3] = pack2(x[8 * s + 6], x[8 * s + 7]);
  return __builtin_bit_cast(bf16x8, p);
}
DI bf16x8 ld_frag16(const u16* p) { return __builtin_bit_cast(bf16x8, *(const u32x4*)p); }
DI bf16x8 ld_frag8x2(const u16* p) {
  u32x2 lo = *(const u32x2*)p; u32x2 hi = *(const u32x2*)(p + 8);
  u32x4 v = {lo[0], lo[1], hi[0], hi[1]};
  return __builtin_bit_cast(bf16x8, v);
}
DI float wave_sum(float v) {
#pragma unroll
  for (int o = 32; o >= 1; o >>= 1) v += __shfl_xor(v, o);
  return v;
}

template <int CTRL> DI float dpp_f(float v) { return __builtin_bit_cast(float, __builtin_amdgcn_update_dpp(0, __builtin_bit_cast(int, v), CTRL, 0xF, 0xF, false)); }
template <int CTRL> DI unsigned dpp_u(unsigned v) { return (unsigned)__builtin_amdgcn_update_dpp(0, (int)v, CTRL, 0xF, 0xF, false); }
DI float gsum16(float v) { v += dpp_f<0x121>(v); v += dpp_f<0x122>(v); v += dpp_f<0x124>(v); v += dpp_f<0x128>(v); return v; }
DI float gmaxf16(float v) { v = fmaxf(v, dpp_f<0x121>(v)); v = fmaxf(v, dpp_f<0x122>(v)); v = fmaxf(v, dpp_f<0x124>(v)); v = fmaxf(v, dpp_f<0x128>(v)); return v; }
DI unsigned gmax16(unsigned v) { v = max(v, dpp_u<0x121>(v)); v = max(v, dpp_u<0x122>(v)); v = max(v, dpp_u<0x124>(v)); v = max(v, dpp_u<0x128>(v)); return v; }
DI f32x16 zero16() { f32x16 z; for (int i = 0; i < 16; ++i) z[i] = 0.f; return z; }

DI void tconv_tile(const float* src, int ld, int c0, int nc, u16* dst, int ct, int kt, float* sm, int tid) {
  __syncthreads();
  int cl = tid & 63, r0 = tid >> 6;
#pragma unroll
  for (int r = 0; r < 16; ++r) {
    int k = kt * 64 + r0 + 4 * r;
    int col = ct * 64 + cl;
    float v = (col < nc) ? src[(size_t)k * ld + c0 + col] : 0.f;
    sm[(r0 + 4 * r) * 65 + cl] = v;
  }
  __syncthreads();
#pragma unroll
  for (int r = 0; r < 16; ++r) {
    int col = r0 + 4 * r;
    int k = cl;
    dst[(size_t)(ct * 64 + col) * 1024 + kt * 64 + k] = f2bf(sm[k * 65 + col]);
  }
}

DI void phase_prep(const Params& p, char* smem, int tid) {
  float* sm = (float*)smem;
  const int nblk = gridDim.x, bid = blockIdx.x;
  const int NCT = 32 + 48 + 2 + 16 * 6 + 32;
  for (int it = bid; it < NCT * 16; it += nblk) {
    int ctg = it >> 4, kt = it & 15;
    const float* src; int ld, c0, nc; u16* dst; int ct;
    if (ctg < 32) { src = p.w_in; ld = 8224; c0 = 0; nc = 2048; dst = p.winT; ct = ctg; }
    else if (ctg < 80) { src = p.w_in; ld = 8224; c0 = 3104; nc = 3072; dst = p.winT + (size_t)2048 * 1024; ct = ctg - 32; }
    else if (ctg < 82) { src = p.w_in; ld = 8224; c0 = 3072; nc = 32; dst = p.winT + (size_t)5120 * 1024; ct = ctg - 80; }
    else if (ctg < 98) { src = p.w_in; ld = 8224; c0 = 2048; nc = 1024; dst = p.wgrT; ct = ctg - 82; }
    else if (ctg < 114) { src = p.w_in; ld = 8224; c0 = 6176; nc = 1024; dst = p.wgaT; ct = ctg - 98; }
    else if (ctg < 130) { src = p.w_in; ld = 8224; c0 = 7200; nc = 1024; dst = p.wgbT; ct = ctg - 114; }
    else if (ctg < 146) { src = p.w_gla; ld = 1024; c0 = 0; nc = 1024; dst = p.wglaT; ct = ctg - 130; }
    else if (ctg < 162) { src = p.w_diff; ld = 1024; c0 = 0; nc = 1024; dst = p.wdiffT; ct = ctg - 146; }
    else if (ctg < 178) { src = p.w_out; ld = 1024; c0 = 0; nc = 1024; dst = p.woutT; ct = ctg - 162; }
    else { src = p.peer_wq; ld = 2048; c0 = 0; nc = 2048; dst = p.wqT; ct = ctg - 178; }
    tconv_tile(src, ld, c0, nc, dst, ct, kt, sm, tid);
  }
  __syncthreads();
  const int gtid = bid * 256 + tid, gsz = nblk * 256;
  for (int i = gtid; i < 8 * 2 * 128 * 128; i += gsz) p.subk[i] = f2bf(p.subkeys[i]);
  for (int i = gtid; i < T * 32; i += gsz) {
    int t = i >> 5, d = i & 31;
    float inv = powf(10000.f, -(float)d / 32.f);
    float ang = (float)p.pos[t] * inv;
    double r = (double)ang * 0.15915494309189535;
    r -= rint(r);
    float rf = (float)r;
    p.rope[2 * i] = __builtin_amdgcn_cosf(rf);
    p.rope[2 * i + 1] = __builtin_amdgcn_sinf(rf);
  }
  if (gtid == 0) {
    float s1 = 0.f, s2 = 0.f;
    for (int i = 0; i < 64; ++i) { s1 += p.lq1[i] * p.lk1[i]; s2 += p.lq2[i] * p.lk2[i]; }
    p.lam[0] = expf(s1) - expf(s2) + 0.2f;
    p.counter[0] = 0; p.counter[1] = 0; p.counter[2] = 0; p.counter[3] = 0;
  }
  {
    float* cact = sm;
    float* red = sm + 4096;
    __syncthreads();
    for (int i = tid; i < 4096; i += 256) { float v = p.c[i]; cact[i] = v / (1.f + __expf(-v)); }
    __syncthreads();
    int w = tid >> 6, lane = tid & 63;
    for (int it = bid; it < 128; it += nblk) {
      int col = it * 64 + lane;
      const float* W; int ld, cc;
      if (col < 6144) { W = p.w_ada; ld = 6144; cc = col; } else { W = p.w_fada; ld = 2048; cc = col - 6144; }
      float a0 = 0, a1 = 0, a2 = 0, a3 = 0;
#pragma unroll 8
      for (int k = w * 256; k < w * 256 + 256; ++k) {
        float wv = W[(size_t)k * ld + cc];
        a0 += cact[k] * wv; a1 += cact[1024 + k] * wv; a2 += cact[2048 + k] * wv; a3 += cact[3072 + k] * wv;
      }
      red[(w * 4 + 0) * 64 + lane] = a0; red[(w * 4 + 1) * 64 + lane] = a1;
      red[(w * 4 + 2) * 64 + lane] = a2; red[(w * 4 + 3) * 64 + lane] = a3;
      __syncthreads();
      {
        int b = w;
        float s = red[(0 * 4 + b) * 64 + lane] + red[(1 * 4 + b) * 64 + lane] + red[(2 * 4 + b) * 64 + lane] + red[(3 * 4 + b) * 64 + lane];
        if (col < 6144) p.mod[b * 6144 + cc] = s + p.b_ada[cc];
        else p.fmod[b * 2048 + cc] = s + p.b_fada[cc];
      }
      __syncthreads();
    }
  }
}

DI void phase_norm_mod(const float* src, const float* g, const float* mod, int sh_off, int sc_off, u16* dst, int tid) {
  int w = tid >> 6, lane = tid & 63;
  for (int row = blockIdx.x * 4 + w; row < T; row += gridDim.x * 4) {
    int b = row >> 13;
    const float* xr = src + (size_t)row * 1024;
    float4 v[4]; float ss = 0.f;
#pragma unroll
    for (int m = 0; m < 4; ++m) { v[m] = *(const float4*)(xr + (m * 64 + lane) * 4); ss += v[m].x * v[m].x + v[m].y * v[m].y + v[m].z * v[m].z + v[m].w * v[m].w; }
    ss = wave_sum(ss);
    float rstd = rsqrtf(ss * (1.f / 1024.f) + RMS_EPS);
#pragma unroll
    for (int m = 0; m < 4; ++m) {
      int col = (m * 64 + lane) * 4;
      float4 gg = *(const float4*)(g + col);
      float4 sh = *(const float4*)(mod + b * 6144 + sh_off + col);
      float4 sc = *(const float4*)(mod + b * 6144 + sc_off + col);
      float y0 = v[m].x * rstd * gg.x * (1.f + sc.x) + sh.x;
      float y1 = v[m].y * rstd * gg.y * (1.f + sc.y) + sh.y;
      float y2 = v[m].z * rstd * gg.z * (1.f + sc.z) + sh.z;
      float y3 = v[m].w * rstd * gg.w * (1.f + sc.w) + sh.w;
      u32x2 o = {pack2(y0, y1), pack2(y2, y3)};
      *(u32x2*)(dst + (size_t)row * 1024 + col) = o;
    }
  }
}

DI void phase_final_plain(const Params& p, const float* src, int tid) {
  int w = tid >> 6, lane = tid & 63;
  for (int row = blockIdx.x * 4 + w; row < T; row += gridDim.x * 4) {
    int b = row >> 13;
    const float* xr = src + (size_t)row * 1024;
    float4 v[4]; float ss = 0.f;
#pragma unroll
    for (int m = 0; m < 4; ++m) { v[m] = *(const float4*)(xr + (m * 64 + lane) * 4); ss += v[m].x * v[m].x + v[m].y * v[m].y + v[m].z * v[m].z + v[m].w * v[m].w; }
    ss = wave_sum(ss);
    float rstd = rsqrtf(ss * (1.f / 1024.f) + RMS_EPS);
#pragma unroll
    for (int m = 0; m < 4; ++m) {
      int col = (m * 64 + lane) * 4;
      float4 gg = *(const float4*)(p.normf_g + col);
      float4 sh = *(const float4*)(p.fmod + b * 2048 + col);
      float4 sc = *(const float4*)(p.fmod + b * 2048 + 1024 + col);
      float4 o;
      o.x = v[m].x * rstd * gg.x * (1.f + sc.x) + sh.x;
      o.y = v[m].y * rstd * gg.y * (1.f + sc.y) + sh.y;
      o.z = v[m].z * rstd * gg.z * (1.f + sc.z) + sh.z;
      o.w = v[m].w * rstd * gg.w * (1.f + sc.w) + sh.w;
      *(float4*)(p.out + (size_t)row * 1024 + col) = o;
    }
  }
}


constexpr int GLD = 72;
DI void gemm_kloop(const u16* A, int lda, const u16* Bt, int ldb, int K, f32x16 (&acc)[2][2], u16* smem, int tid) {
  u16* sA = smem; u16* sB = smem + 128 * GLD;
  const int lrow = tid >> 3, lcol = (tid & 7) * 8;
  const int w = tid >> 6, lane = tid & 63, c = lane & 31, hh = lane >> 5;
  const int wm = w >> 1, wn = w & 1;
  u32x4 ra[4], rb[4];
#pragma unroll
  for (int r = 0; r < 4; ++r) {
    ra[r] = *(const u32x4*)(A + (size_t)(r * 32 + lrow) * lda + lcol);
    rb[r] = *(const u32x4*)(Bt + (size_t)(r * 32 + lrow) * ldb + lcol);
  }
  const int nk = K >> 6;
  for (int kt = 0; kt < nk; ++kt) {
    __syncthreads();
#pragma unroll
    for (int r = 0; r < 4; ++r) {
      *(u32x4*)(sA + (r * 32 + lrow) * GLD + lcol) = ra[r];
      *(u32x4*)(sB + (r * 32 + lrow) * GLD + lcol) = rb[r];
    }
    __syncthreads();
    if (kt + 1 < nk) {
#pragma unroll
      for (int r = 0; r < 4; ++r) {
        ra[r] = *(const u32x4*)(A + (size_t)(r * 32 + lrow) * lda + (kt + 1) * 64 + lcol);
        rb[r] = *(const u32x4*)(Bt + (size_t)(r * 32 + lrow) * ldb + (kt + 1) * 64 + lcol);
      }
    }
#pragma unroll
    for (int s = 0; s < 4; ++s) {
      bf16x8 a0 = ld_frag16(sA + (wm * 64 + c) * GLD + s * 16 + hh * 8);
      bf16x8 a1 = ld_frag16(sA + (wm * 64 + 32 + c) * GLD + s * 16 + hh * 8);
      bf16x8 b0 = ld_frag16(sB + (wn * 64 + c) * GLD + s * 16 + hh * 8);
      bf16x8 b1 = ld_frag16(sB + (wn * 64 + 32 + c) * GLD + s * 16 + hh * 8);
      acc[0][0] = MFMA(a0, b0, acc[0][0]);
      acc[0][1] = MFMA(a0, b1, acc[0][1]);
      acc[1][0] = MFMA(a1, b0, acc[1][0]);
      acc[1][1] = MFMA(a1, b1, acc[1][1]);
    }
  }
}
DI void zero_acc(f32x16 (&acc)[2][2]) {
#pragma unroll
  for (int a = 0; a < 2; ++a)
#pragma unroll
    for (int b = 0; b < 2; ++b) acc[a][b] = zero16();
}

DI void phase_proj(const Params& p, char* smem, int tid) {
  const int w = tid >> 6, lane = tid & 63, c = lane & 31, hh = lane >> 5;
  const int wm = w >> 1, wn = w & 1;
  const int NT = 41;
  for (int id = blockIdx.x; id < 256 * NT; id += gridDim.x) {
    int mt = id / NT, nt = id - mt * NT;
    int m0 = mt * 128, n0 = nt * 128;
    f32x16 acc[2][2]; zero_acc(acc);
    gemm_kloop(p.hA + (size_t)m0 * 1024, 1024, p.winT + (size_t)n0 * 1024, 1024, 1024, acc, (u16*)smem, tid);
    const int rb = m0 + wm * 64, cb = n0 + wn * 64;
    if (n0 < 1024) {
      float sc = (n0 < 512) ? 0.08838834764831845f : 1.f;
      u16* dst = (n0 < 512) ? p.gq : p.gk;
      int cbb = cb & 511;
#pragma unroll
      for (int mi = 0; mi < 2; ++mi)
#pragma unroll
        for (int ni = 0; ni < 2; ++ni)
#pragma unroll
          for (int i = 0; i < 16; ++i) {
            int row = rb + mi * 32 + crow(i, hh), col = cbb + ni * 32 + c;
            dst[(size_t)row * 512 + col] = f2bf(acc[mi][ni][i] * sc);
          }
    } else if (n0 < 2048 || (n0 >= 4096 && n0 < 5120)) {
      bool isg = n0 < 2048;
#pragma unroll
      for (int mi = 0; mi < 2; ++mi)
#pragma unroll
        for (int ni = 0; ni < 2; ++ni) {
          int col = cb + ni * 32 + c;
          size_t rowbase;
          int b = rb >> 13;
          if (isg) { int cc = col - 1024; rowbase = ((size_t)(b * 4 + (cc >> 8)) * 256 + (cc & 255)) * 8192; }
          else { int cc = col - 4096; rowbase = ((size_t)(b * 8 + (cc >> 7)) * 128 + (cc & 127)) * 8192; }
          u16* dst = (isg ? p.gvT : p.dvT) + rowbase;
#pragma unroll
          for (int g = 0; g < 4; ++g) {
            int s = ((rb + mi * 32) & 8191) + 8 * g + 4 * hh;
            u32x2 v = {pack2(acc[mi][ni][4 * g], acc[mi][ni][4 * g + 1]), pack2(acc[mi][ni][4 * g + 2], acc[mi][ni][4 * g + 3])};
            *(u32x2*)(dst + s) = v;
          }
        }
    } else if (n0 < 4096) {
      bool isq = n0 < 3072;
      float sc = isq ? (0.125f * 1.4426950408889634f) : 1.f;
      u16* dst = isq ? p.dq : p.dk;
      int cbb = (cb - (isq ? 2048 : 3072));
#pragma unroll
      for (int mi = 0; mi < 2; ++mi)
#pragma unroll
        for (int i = 0; i < 16; ++i) {
          int row = rb + mi * 32 + crow(i, hh);
          float2 cs = *(const float2*)(p.rope + ((size_t)row * 32 + c) * 2);
          float x1 = acc[mi][0][i], x2 = acc[mi][1][i];
          float o1 = (x1 * cs.x - x2 * cs.y) * sc;
          float o2 = (x2 * cs.x + x1 * cs.y) * sc;
          dst[(size_t)row * 1024 + cbb + c] = f2bf(o1);
          dst[(size_t)row * 1024 + cbb + 32 + c] = f2bf(o2);
        }
    } else {
      if (wn == 0) {
#pragma unroll
        for (int mi = 0; mi < 2; ++mi)
#pragma unroll
          for (int i = 0; i < 16; ++i) {
            int row = rb + mi * 32 + crow(i, hh);
            p.lr[(size_t)row * 32 + c] = acc[mi][0][i];
          }
      }
    }
  }
}

DI float logsig(float x) { return fminf(x, 0.f) - __logf(1.f + __expf(-fabsf(x))); }

DI void phase_gla_pre(const Params& p, char* smem, int tid) {
  float* slr = (float*)smem;
  for (int it = blockIdx.x; it < 512; it += gridDim.x) {
    int b = it >> 7, ch = it & 127;
    size_t t0 = (size_t)b * 8192 + ch * 64;
    __syncthreads();
    for (int i = tid; i < 2048; i += 256) slr[i] = p.lr[t0 * 32 + i];
    __syncthreads();
#pragma unroll 1
    for (int cj = 0; cj < 2; ++cj) {
      int j = tid + cj * 256;
      int h = j >> 7, d = j & 127;
#pragma unroll 1
      for (int dir = 0; dir < 2; ++dir) {
        const float* wa = dir ? p.wa_bw : p.wa_fw;
        float wr[16];
#pragma unroll
        for (int r = 0; r < 16; ++r) wr[r] = wa[r * 512 + j];
        float ba = (dir ? p.ba_bw : p.ba_fw)[j];
        u16* qe = dir ? p.qe_bw : p.qe_fw;
        u16* ke = dir ? p.ke_bw : p.ke_fw;
        u16* keT = p.keT + (size_t)dir * (16ull * 128 * 8192) + ((size_t)(b * 4 + h) * 128 + d) * 8192 + ch * 64;
        float bsum = 0.f;
#pragma unroll 1
        for (int g8 = 0; g8 < 8; ++g8) {
          unsigned kk[8];
#pragma unroll
          for (int u = 0; u < 8; ++u) {
            int tt = g8 * 8 + u;
            int t = dir ? 63 - tt : tt;
            float pre = ba;
#pragma unroll
            for (int r = 0; r < 16; ++r) pre += slr[t * 32 + dir * 16 + r] * wr[r];
            bsum += logsig(pre) * (1.f / 16.f);
            float qv = bf2f(p.gq[(t0 + t) * 512 + j]);
            float kv = bf2f(p.gk[(t0 + t) * 512 + j]);
            float eb = __expf(bsum);
            u16 qo = f2bf(qv * eb);
            u16 ko = f2bf(kv / eb);
            qe[(t0 + t) * 512 + j] = qo;
            ke[(t0 + t) * 512 + j] = ko;
            kk[u] = ko;
          }
          u32x4 v;
          if (!dir) {
            v[0] = kk[0] | (kk[1] << 16); v[1] = kk[2] | (kk[3] << 16); v[2] = kk[4] | (kk[5] << 16); v[3] = kk[6] | (kk[7] << 16);
            *(u32x4*)(keT + g8 * 8) = v;
          } else {
            v[0] = kk[7] | (kk[6] << 16); v[1] = kk[5] | (kk[4] << 16); v[2] = kk[3] | (kk[2] << 16); v[3] = kk[1] | (kk[0] << 16);
            *(u32x4*)(keT + (56 - g8 * 8)) = v;
          }
        }
        p.dec[((size_t)(dir * 4 + b) * 128 + ch) * 512 + j] = __expf(bsum);
      }
    }
  }
}

DI void gla_scan_wave(const Params& p, int stream, int lane) {
  const int slice = stream & 7, dir = (stream >> 3) & 1, bh = stream >> 4;
  const int b = bh >> 2, h = bh & 3;
  const u16* qe = dir ? p.qe_bw : p.qe_fw;
  const u16* ke = dir ? p.ke_bw : p.ke_fw;
  const u16* keT = p.keT + (size_t)dir * (16ull * 128 * 8192) + (size_t)bh * 128 * 8192;
  const u16* vT = p.gvT + ((size_t)bh * 256 + slice * 32) * 8192;
  const float* dec = p.dec + ((size_t)(dir * 4 + b) * 128) * 512 + h * 128;
  u16* o = dir ? p.o_bw : p.o_fw;
  const int c = lane & 31, hh = lane >> 5;
  f32x16 st[4];
#pragma unroll
  for (int i = 0; i < 4; ++i) st[i] = zero16();
#pragma unroll 1
  for (int ci = 0; ci < 128; ++ci) {
    const int ch = dir ? 127 - ci : ci;
    const size_t t0 = (size_t)b * 8192 + ch * 64;
    const int s0 = ch * 64;
    bf16x8 qf[2][8], kf[2][8];
#pragma unroll
    for (int qt = 0; qt < 2; ++qt)
#pragma unroll
      for (int ks = 0; ks < 8; ++ks) {
        qf[qt][ks] = ld_frag8x2(qe + (t0 + qt * 32 + c) * 512 + h * 128 + ks * 16 + 4 * hh);
        kf[qt][ks] = ld_frag8x2(ke + (t0 + qt * 32 + c) * 512 + h * 128 + ks * 16 + 4 * hh);
      }
    bf16x8 vf[4];
#pragma unroll
    for (int k4 = 0; k4 < 4; ++k4) vf[k4] = ld_frag8x2(vT + (size_t)c * 8192 + s0 + 16 * k4 + 4 * hh);
    f32x16 oacc[2];
    oacc[0] = zero16(); oacc[1] = zero16();
#pragma unroll
    for (int ks = 0; ks < 8; ++ks) {
      bf16x8 sf = pack_step(st[ks >> 1], ks & 1);
      oacc[0] = MFMA(qf[0][ks], sf, oacc[0]);
      oacc[1] = MFMA(qf[1][ks], sf, oacc[1]);
    }
#pragma unroll
    for (int kt = 0; kt < 2; ++kt)
#pragma unroll
      for (int qt = 0; qt < 2; ++qt) {
        bool skip = dir ? (kt < qt) : (kt > qt);
        if (skip) continue;
        f32x16 X = zero16();
#pragma unroll
        for (int ks = 0; ks < 8; ++ks) X = MFMA(kf[kt][ks], qf[qt][ks], X);
        if (kt == qt) {
#pragma unroll
          for (int i = 0; i < 16; ++i) {
            int key = crow(i, hh);
            bool keep = dir ? (key >= c) : (key <= c);
            X[i] = keep ? X[i] : 0.f;
          }
        }
        oacc[qt] = MFMA(pack_step(X, 0), vf[kt * 2 + 0], oacc[qt]);
        oacc[qt] = MFMA(pack_step(X, 1), vf[kt * 2 + 1], oacc[qt]);
      }
#pragma unroll
    for (int qt = 0; qt < 2; ++qt)
#pragma unroll
      for (int i = 0; i < 16; ++i)
        o[(t0 + qt * 32 + crow(i, hh)) * 1024 + h * 256 + slice * 32 + c] = f2bf(oacc[qt][i]);
#pragma unroll
    for (int dt = 0; dt < 4; ++dt) {
#pragma unroll
      for (int k4 = 0; k4 < 4; ++k4) {
        bf16x8 kt_f = ld_frag8x2(keT + (size_t)(dt * 32 + c) * 8192 + s0 + 16 * k4 + 4 * hh);
        st[dt] = MFMA(kt_f, vf[k4], st[dt]);
      }
#pragma unroll
      for (int g = 0; g < 4; ++g) {
        float4 dv = *(const float4*)(dec + (size_t)ch * 512 + dt * 32 + 8 * g + 4 * hh);
        st[dt][4 * g + 0] *= dv.x; st[dt][4 * g + 1] *= dv.y; st[dt][4 * g + 2] *= dv.z; st[dt][4 * g + 3] *= dv.w;
      }
    }
  }
}

constexpr int KLD = 136, VLD = 72;
DI void attn_item(const Params& p, int item, char* smem, int tid) {
  const int qb = item & 63, bh = item >> 6;
  const int b = bh >> 3, h = bh & 7;
  const int w = tid >> 6, lane = tid & 63, c = lane & 31, hh = lane >> 5;
  u16* sK = (u16*)smem;
  u16* sV = sK + 64 * KLD;
  const size_t tq = (size_t)b * 8192 + qb * 128 + w * 32 + c;
  bf16x8 qf[2][4];
#pragma unroll
  for (int mp = 0; mp < 2; ++mp)
#pragma unroll
    for (int s = 0; s < 4; ++s) qf[mp][s] = ld_frag16(p.dq + tq * 1024 + h * 128 + mp * 64 + 16 * s + 8 * hh);
  f32x16 O[2][4];
#pragma unroll
  for (int mp = 0; mp < 2; ++mp)
#pragma unroll
    for (int dt = 0; dt < 4; ++dt) O[mp][dt] = zero16();
  float mrun[2] = {-1e30f, -1e30f}, lrun[2] = {0.f, 0.f};
  const u16* Kg = p.dk + (size_t)b * 8192 * 1024 + h * 128;
  const u16* Vg = p.dvT + (size_t)bh * 128 * 8192;
  u32x4 rk[4], rv[4];
#pragma unroll
  for (int r = 0; r < 4; ++r) {
    int id = tid + 256 * r;
    rk[r] = *(const u32x4*)(Kg + (size_t)(id >> 4) * 1024 + (id & 15) * 8);
    rv[r] = *(const u32x4*)(Vg + (size_t)(id >> 3) * 8192 + (id & 7) * 8);
  }
#pragma unroll 1
  for (int kt = 0; kt < 128; ++kt) {
    __syncthreads();
#pragma unroll
    for (int r = 0; r < 4; ++r) {
      int id = tid + 256 * r;
      *(u32x4*)(sK + (id >> 4) * KLD + (id & 15) * 8) = rk[r];
      *(u32x4*)(sV + (id >> 3) * VLD + (id & 7) * 8) = rv[r];
    }
    __syncthreads();
    if (kt + 1 < 128) {
#pragma unroll
      for (int r = 0; r < 4; ++r) {
        int id = tid + 256 * r;
        rk[r] = *(const u32x4*)(Kg + (size_t)((kt + 1) * 64 + (id >> 4)) * 1024 + (id & 15) * 8);
        rv[r] = *(const u32x4*)(Vg + (size_t)(id >> 3) * 8192 + (kt + 1) * 64 + (id & 7) * 8);
      }
    }
    bf16x8 pf[2][2][2];
#pragma unroll
    for (int mp = 0; mp < 2; ++mp) {
      f32x16 sacc[2];
#pragma unroll
      for (int k2 = 0; k2 < 2; ++k2) {
        f32x16 a = zero16();
#pragma unroll
        for (int s = 0; s < 4; ++s) {
          bf16x8 kfr = ld_frag16(sK + (k2 * 32 + c) * KLD + mp * 64 + 16 * s + 8 * hh);
          a = MFMA(kfr, qf[mp][s], a);
        }
        sacc[k2] = a;
      }
      float mx = sacc[0][0];
#pragma unroll
      for (int i = 0; i < 16; ++i) { mx = fmaxf(mx, sacc[0][i]); mx = fmaxf(mx, sacc[1][i]); }
      mx = fmaxf(mx, __shfl_xor(mx, 32));
      float mnew = fmaxf(mrun[mp], mx);
      float alpha = exp2f(mrun[mp] - mnew);
      mrun[mp] = mnew;
      float ls = 0.f;
#pragma unroll
      for (int k2 = 0; k2 < 2; ++k2)
#pragma unroll
        for (int i = 0; i < 16; ++i) { float e = exp2f(sacc[k2][i] - mnew); sacc[k2][i] = e; ls += e; }
      lrun[mp] = lrun[mp] * alpha + ls;
#pragma unroll
      for (int dt = 0; dt < 4; ++dt)
#pragma unroll
        for (int i = 0; i < 16; ++i) O[mp][dt][i] *= alpha;
#pragma unroll
      for (int k2 = 0; k2 < 2; ++k2) { pf[mp][k2][0] = pack_step(sacc[k2], 0); pf[mp][k2][1] = pack_step(sacc[k2], 1); }
    }
#pragma unroll
    for (int k2 = 0; k2 < 2; ++k2)
#pragma unroll
      for (int s2 = 0; s2 < 2; ++s2) {
#pragma unroll
        for (int dt = 0; dt < 4; ++dt) {
          bf16x8 vfr = ld_frag8x2(sV + (dt * 32 + c) * VLD + k2 * 32 + s2 * 16 + 4 * hh);
          O[0][dt] = MFMA(vfr, pf[0][k2][s2], O[0][dt]);
          O[1][dt] = MFMA(vfr, pf[1][k2][s2], O[1][dt]);
        }
      }
  }
  float l0 = lrun[0] + __shfl_xor(lrun[0], 32);
  float l1 = lrun[1] + __shfl_xor(lrun[1], 32);
  float i0 = 1.f / l0, i1 = p.lam[0] / l1;
  float ss = 0.f;
#pragma unroll
  for (int dt = 0; dt < 4; ++dt)
#pragma unroll
    for (int i = 0; i < 16; ++i) { float v = O[0][dt][i] * i0 - O[1][dt][i] * i1; O[0][dt][i] = v; ss += v * v; }
  ss += __shfl_xor(ss, 32);
  float rstd = rsqrtf(ss * (1.f / 128.f) + RMS_EPS) * 0.8f;
#pragma unroll
  for (int dt = 0; dt < 4; ++dt)
#pragma unroll
    for (int g = 0; g < 4; ++g) {
      int dv = dt * 32 + 8 * g + 4 * hh;
      float4 gg = *(const float4*)(p.diff_norm_g + h * 128 + dv);
      u32x2 v = {pack2(O[0][dt][4 * g] * rstd * gg.x, O[0][dt][4 * g + 1] * rstd * gg.y),
                 pack2(O[0][dt][4 * g + 2] * rstd * gg.z, O[0][dt][4 * g + 3] * rstd * gg.w)};
      *(u32x2*)(p.dq + tq * 1024 + h * 128 + dv) = v;
    }
}

DI void phase_mixers(const Params& p, char* smem, int tid) {
  int* sitem = (int*)(smem + 59 * 1024);
  if (blockIdx.x < 64) gla_scan_wave(p, blockIdx.x * 4 + (tid >> 6), tid & 63);
  for (;;) {
    __syncthreads();
    if (tid == 0) *sitem = atomicAdd(p.counter, 1);
    __syncthreads();
    int item = *sitem;
    if (item >= 2048) break;
    attn_item(p, item, smem, tid);
  }
}

DI void phase_post_mixers(const Params& p, int tid) {
  int w = tid >> 6, lane = tid & 63;
  for (int row = blockIdx.x * 4 + w; row < T; row += gridDim.x * 4) {
#pragma unroll
    for (int hd = 0; hd < 4; ++hd) {
      u32x2 a = *(const u32x2*)(p.o_fw + (size_t)row * 1024 + hd * 256 + lane * 4);
      u32x2 bq = *(const u32x2*)(p.o_bw + (size_t)row * 1024 + hd * 256 + lane * 4);
      float v0 = bflo(a[0]) + bflo(bq[0]), v1 = bfhi(a[0]) + bfhi(bq[0]), v2 = bflo(a[1]) + bflo(bq[1]), v3 = bfhi(a[1]) + bfhi(bq[1]);
      float ss = wave_sum(v0 * v0 + v1 * v1 + v2 * v2 + v3 * v3);
      if (lane == 0) p.rstd[row * 4 + hd] = rsqrtf(ss * (1.f / 256.f) + RMS_EPS);
    }
  }
  phase_norm_mod(p.x, p.norm1_g, p.mod, 0, 1024, p.hA, tid);
  for (int row = blockIdx.x * 4 + w; row < 32768; row += gridDim.x * 4) {
    const bool isv = row >= 16384;
    const int r = row & 16383;
    const float* srcp = (isv ? p.peer_v : p.peer_u) + (size_t)r * 1024 + lane * 16;
    float4 a0 = *(const float4*)(srcp), a1 = *(const float4*)(srcp + 4), a2 = *(const float4*)(srcp + 8), a3 = *(const float4*)(srcp + 12);
    float am = fmaxf(fmaxf(fmaxf(fabsf(a0.x), fabsf(a0.y)), fmaxf(fabsf(a0.z), fabsf(a0.w))), fmaxf(fmaxf(fabsf(a1.x), fabsf(a1.y)), fmaxf(fabsf(a1.z), fabsf(a1.w))));
    am = fmaxf(am, fmaxf(fmaxf(fmaxf(fabsf(a2.x), fabsf(a2.y)), fmaxf(fabsf(a2.z), fabsf(a2.w))), fmaxf(fmaxf(fabsf(a3.x), fabsf(a3.y)), fmaxf(fabsf(a3.z), fabsf(a3.w)))));
#pragma unroll
    for (int o = 32; o >= 1; o >>= 1) am = fmaxf(am, __shfl_xor(am, o));
    am = fmaxf(am, 1e-30f);
    const float sc = 256.f / am;
    u32x4 v;
    int t0 = __builtin_amdgcn_cvt_pk_fp8_f32(a0.x * sc, a0.y * sc, 0, false); t0 = __builtin_amdgcn_cvt_pk_fp8_f32(a0.z * sc, a0.w * sc, t0, true);
    int t1 = __builtin_amdgcn_cvt_pk_fp8_f32(a1.x * sc, a1.y * sc, 0, false); t1 = __builtin_amdgcn_cvt_pk_fp8_f32(a1.z * sc, a1.w * sc, t1, true);
    int t2 = __builtin_amdgcn_cvt_pk_fp8_f32(a2.x * sc, a2.y * sc, 0, false); t2 = __builtin_amdgcn_cvt_pk_fp8_f32(a2.z * sc, a2.w * sc, t2, true);
    int t3 = __builtin_amdgcn_cvt_pk_fp8_f32(a3.x * sc, a3.y * sc, 0, false); t3 = __builtin_amdgcn_cvt_pk_fp8_f32(a3.z * sc, a3.w * sc, t3, true);
    v[0] = (unsigned)t0; v[1] = (unsigned)t1; v[2] = (unsigned)t2; v[3] = (unsigned)t3;
    unsigned char* dst = (unsigned char*)(isv ? p.vB : p.uB) + (size_t)r * 1024 + lane * 16;
    *(u32x4*)dst = v;
    if (lane == 0) (isv ? p.vs : p.us)[r] = am * (1.f / 256.f);
  }
}

DI void phase_gr(const Params& p, char* smem, int tid) {
  const int w = tid >> 6, lane = tid & 63, c = lane & 31, hh = lane >> 5;
  const int wm = w >> 1, wn = w & 1;
  for (int id = blockIdx.x; id < 256 * 8; id += gridDim.x) {
    int mt = id >> 3, nt = id & 7;
    int m0 = mt * 128, n0 = nt * 128;
    f32x16 acc[2][2]; zero_acc(acc);
    gemm_kloop(p.hA + (size_t)m0 * 1024, 1024, p.wgrT + (size_t)n0 * 1024, 1024, 1024, acc, (u16*)smem, tid);
#pragma unroll
    for (int mi = 0; mi < 2; ++mi)
#pragma unroll
      for (int ni = 0; ni < 2; ++ni) {
        int col = n0 + wn * 64 + ni * 32 + c;
        float gn = p.gla_norm_g[col];
#pragma unroll
        for (int i = 0; i < 16; ++i) {
          int row = m0 + wm * 64 + mi * 32 + crow(i, hh);
          float a = acc[mi][ni][i];
          float sl = a / (1.f + __expf(-a));
          float ov = bf2f(p.o_fw[(size_t)row * 1024 + col]) + bf2f(p.o_bw[(size_t)row * 1024 + col]);
          p.A1[(size_t)row * 1024 + col] = f2bf(ov * p.rstd[row * 4 + (col >> 8)] * gn * sl);
        }
      }
  }
}

DI void phase_merge(const Params& p, char* smem, int tid) {
  const int w = tid >> 6, lane = tid & 63, c = lane & 31, hh = lane >> 5;
  const int wm = w >> 1, wn = w & 1;
  for (int id = blockIdx.x; id < 256 * 8; id += gridDim.x) {
    int mt = id >> 3, nt = id & 7;
    int m0 = mt * 128, n0 = nt * 128;
    f32x16 acc[2][2], mg[2][2];
    unsigned gpk[2][2][8];
    zero_acc(acc);
    gemm_kloop(p.hA + (size_t)m0 * 1024, 1024, p.wgaT + (size_t)n0 * 1024, 1024, 1024, acc, (u16*)smem, tid);
#pragma unroll
    for (int mi = 0; mi < 2; ++mi)
#pragma unroll
      for (int ni = 0; ni < 2; ++ni)
#pragma unroll
        for (int i = 0; i < 8; ++i) gpk[mi][ni][i] = pack2(1.f / (1.f + __expf(-acc[mi][ni][2 * i])), 1.f / (1.f + __expf(-acc[mi][ni][2 * i + 1])));
    zero_acc(acc);
    gemm_kloop(p.A1 + (size_t)m0 * 1024, 1024, p.wglaT + (size_t)n0 * 1024, 1024, 1024, acc, (u16*)smem, tid);
#pragma unroll
    for (int mi = 0; mi < 2; ++mi)
#pragma unroll
      for (int ni = 0; ni < 2; ++ni)
#pragma unroll
        for (int i = 0; i < 8; ++i) { mg[mi][ni][2 * i] = acc[mi][ni][2 * i] * bflo(gpk[mi][ni][i]); mg[mi][ni][2 * i + 1] = acc[mi][ni][2 * i + 1] * bfhi(gpk[mi][ni][i]); }
    zero_acc(acc);
    gemm_kloop(p.hA + (size_t)m0 * 1024, 1024, p.wgbT + (size_t)n0 * 1024, 1024, 1024, acc, (u16*)smem, tid);
#pragma unroll
    for (int mi = 0; mi < 2; ++mi)
#pragma unroll
      for (int ni = 0; ni < 2; ++ni)
#pragma unroll
        for (int i = 0; i < 8; ++i) gpk[mi][ni][i] = pack2(1.f / (1.f + __expf(-acc[mi][ni][2 * i])), 1.f / (1.f + __expf(-acc[mi][ni][2 * i + 1])));
    zero_acc(acc);
    gemm_kloop(p.dq + (size_t)m0 * 1024, 1024, p.wdiffT + (size_t)n0 * 1024, 1024, 1024, acc, (u16*)smem, tid);
#pragma unroll
    for (int mi = 0; mi < 2; ++mi)
#pragma unroll
      for (int ni = 0; ni < 2; ++ni)
#pragma unroll
        for (int i = 0; i < 16; ++i) {
          float gv = (i & 1) ? bfhi(gpk[mi][ni][i >> 1]) : bflo(gpk[mi][ni][i >> 1]);
          float v = mg[mi][ni][i] + acc[mi][ni][i] * gv;
          int row = m0 + wm * 64 + mi * 32 + crow(i, hh), col = n0 + wn * 64 + ni * 32 + c;
          p.merged[(size_t)row * 1024 + col] = f2bf(v);
        }
  }
}

DI void phase_out(const Params& p, char* smem, int tid) {
  const int w = tid >> 6, lane = tid & 63, c = lane & 31, hh = lane >> 5;
  const int wm = w >> 1, wn = w & 1;
  for (int id = blockIdx.x; id < 256 * 8; id += gridDim.x) {
    int mt = id >> 3, nt = id & 7;
    int m0 = mt * 128, n0 = nt * 128;
    f32x16 acc[2][2]; zero_acc(acc);
    gemm_kloop(p.merged + (size_t)m0 * 1024, 1024, p.woutT + (size_t)n0 * 1024, 1024, 1024, acc, (u16*)smem, tid);
    int b = m0 >> 13;
#pragma unroll
    for (int mi = 0; mi < 2; ++mi)
#pragma unroll
      for (int ni = 0; ni < 2; ++ni) {
        int col = n0 + wn * 64 + ni * 32 + c;
        float gate = p.mod[b * 6144 + 2048 + col];
#pragma unroll
        for (int i = 0; i < 16; ++i) {
          int row = m0 + wm * 64 + mi * 32 + crow(i, hh);
          p.x1[(size_t)row * 1024 + col] = p.x[(size_t)row * 1024 + col] + gate * acc[mi][ni][i];
        }
      }
  }
}

DI void phase_peerq(const Params& p, char* smem, int tid) {
  const int w = tid >> 6, lane = tid & 63, c = lane & 31, hh = lane >> 5;
  const int wm = w >> 1, wn = w & 1;
  for (int id = blockIdx.x; id < 256 * 16; id += gridDim.x) {
    int mt = id >> 4, nt = id & 15;
    int m0 = mt * 128, n0 = nt * 128;
    f32x16 acc[2][2]; zero_acc(acc);
    gemm_kloop(p.h2 + (size_t)m0 * 1024, 1024, p.wqT + (size_t)n0 * 1024, 1024, 1024, acc, (u16*)smem, tid);
#pragma unroll
    for (int mi = 0; mi < 2; ++mi)
#pragma unroll
      for (int ni = 0; ni < 2; ++ni)
#pragma unroll
        for (int i = 0; i < 16; ++i) {
          int row = m0 + wm * 64 + mi * 32 + crow(i, hh), col = n0 + wn * 64 + ni * 32 + c;
          p.qp[(size_t)row * 2048 + col] = f2bf(acc[mi][ni][i]);
        }
  }
}

DI unsigned fkey(float f) { unsigned u = __float_as_uint(f); return (u & 0x80000000u) ? ~u : (u | 0x80000000u); }
DI void phase_topk(const Params& p, char* smem, int tid) {
  float* sc = (float*)smem;
  float* ts = sc + 64 * 132;
  int* ti = (int*)(ts + 64 * 32);
  const int w = tid >> 6, lane = tid & 63, c = lane & 31, hh = lane >> 5;
  const int l16 = tid & 15, grp = tid >> 4;
  for (int item = blockIdx.x; item < 4096; item += gridDim.x) {
    const int h = item & 7;
    const size_t t0 = (size_t)(item >> 3) * 64;
#pragma unroll 1
    for (int pp = 0; pp < 2; ++pp) {
      f32x16 acc[2]; acc[0] = zero16(); acc[1] = zero16();
      const u16* Aq = p.qp + t0 * 2048 + h * 256 + pp * 128;
      const u16* Bk = p.subk + (size_t)(h * 2 + pp) * 128 * 128;
#pragma unroll
      for (int s = 0; s < 8; ++s) {
        bf16x8 bfr = ld_frag16(Bk + (32 * w + c) * 128 + 16 * s + 8 * hh);
        bf16x8 a0 = ld_frag16(Aq + (size_t)c * 2048 + 16 * s + 8 * hh);
        bf16x8 a1 = ld_frag16(Aq + (size_t)(32 + c) * 2048 + 16 * s + 8 * hh);
        acc[0] = MFMA(a0, bfr, acc[0]);
        acc[1] = MFMA(a1, bfr, acc[1]);
      }
      __syncthreads();
#pragma unroll
      for (int mi = 0; mi < 2; ++mi)
#pragma unroll
        for (int i = 0; i < 16; ++i) sc[(mi * 32 + crow(i, hh)) * 132 + 32 * w + c] = acc[mi][i];
      __syncthreads();
      unsigned k[4][8], sel[4];
#pragma unroll
      for (int rr = 0; rr < 4; ++rr) {
        sel[rr] = 0;
#pragma unroll
        for (int m = 0; m < 8; ++m) { int n = l16 + 16 * m; k[rr][m] = (fkey(sc[(grp + 16 * rr) * 132 + n]) & ~127u) | (unsigned)(127 - n); }
      }
#pragma unroll 1
      for (int round = 0; round < 16; ++round) {
#pragma unroll
        for (int rr = 0; rr < 4; ++rr) {
          unsigned mx = max(max(max(k[rr][0], k[rr][1]), max(k[rr][2], k[rr][3])), max(max(k[rr][4], k[rr][5]), max(k[rr][6], k[rr][7])));
          mx = gmax16(mx);
          sel[rr] = (l16 == round) ? mx : sel[rr];
#pragma unroll
          for (int m = 0; m < 8; ++m) k[rr][m] = (k[rr][m] == mx) ? 0u : k[rr][m];
        }
      }
#pragma unroll
      for (int rr = 0; rr < 4; ++rr) {
        const int row = grp + 16 * rr;
        int n = 127 - (int)(sel[rr] & 127u);
        ti[(row * 2 + pp) * 16 + l16] = n;
        ts[(row * 2 + pp) * 16 + l16] = sc[row * 132 + n];
      }
    }
    __syncthreads();
    {
      float s0v[4]; int ptr[4]; unsigned selk[4];
#pragma unroll
      for (int rr = 0; rr < 4; ++rr) { s0v[rr] = ts[((grp + 16 * rr) * 2) * 16 + l16]; ptr[rr] = 0; selk[rr] = 0; }
#pragma unroll 1
      for (int round = 0; round < 16; ++round) {
#pragma unroll
        for (int rr = 0; rr < 4; ++rr) {
          const int row = grp + 16 * rr;
          float v = s0v[rr] + ts[(row * 2 + 1) * 16 + (ptr[rr] & 15)];
          unsigned key = (ptr[rr] < 16) ? ((fkey(v) & ~255u) | (unsigned)(255 - (l16 * 16 + ptr[rr]))) : 0u;
          unsigned mx = gmax16(key);
          selk[rr] = (l16 == round) ? mx : selk[rr];
          int aw = (255 - (int)(mx & 255u)) >> 4;
          ptr[rr] += (l16 == aw) ? 1 : 0;
        }
      }
#pragma unroll
      for (int rr = 0; rr < 4; ++rr) {
        const int row = grp + 16 * rr;
        int flat = 255 - (int)(selk[rr] & 255u);
        int aw = flat >> 4, bw = flat & 15;
        int my_idx = ti[(row * 2) * 16 + aw] * 128 + ti[(row * 2 + 1) * 16 + bw];
        float my_s = ts[(row * 2) * 16 + aw] + ts[(row * 2 + 1) * 16 + bw];
        float mxs = gmaxf16(my_s);
        float e = __expf(my_s - mxs);
        float sum = gsum16(e);
        p.idx[(t0 + row) * 128 + h * 16 + l16] = my_idx;
        p.g[(t0 + row) * 128 + h * 16 + l16] = e / sum;
      }
    }
    __syncthreads();
  }
}

DI void peer_load_batch(const unsigned char* tab, const float* rsc, int ireg, int ebase, int q, int gq, u32x4 (&buf)[16], float (&scl)[4]) {
#pragma unroll
  for (int rr = 0; rr < 4; ++rr) {
    int e = ebase + 4 * rr + gq;
    int row = __shfl(ireg, e & 63);
    const unsigned char* rp = tab + (size_t)row * 1024 + q * 16;
#pragma unroll
    for (int j = 0; j < 4; ++j) buf[rr * 4 + j] = *(const u32x4*)(rp + j * 256);
    scl[rr] = rsc[row];
  }
}
DI void phase_peer_final(const Params& p, char* smem, int tid) {
  const int w = tid >> 6, lane = tid & 63, q = lane & 15, gq = lane >> 4;
  float* wl = (float*)smem + w * 128;
  const unsigned char* U8 = (const unsigned char*)p.uB;
  const unsigned char* V8 = (const unsigned char*)p.vB;
  for (int item = blockIdx.x; item < T / 4; item += gridDim.x) {
    const size_t t = (size_t)item * 4 + w;
    const int b = (int)(t >> 13);
    float hf[64];
#pragma unroll
    for (int j = 0; j < 4; ++j) {
      u32x4 ha = *(const u32x4*)(p.h2 + t * 1024 + (q + 16 * j) * 16);
      u32x4 hb = *(const u32x4*)(p.h2 + t * 1024 + (q + 16 * j) * 16 + 8);
#pragma unroll
      for (int i = 0; i < 4; ++i) { hf[j * 16 + 2 * i] = bflo(ha[i]); hf[j * 16 + 2 * i + 1] = bfhi(ha[i]); hf[j * 16 + 8 + 2 * i] = bflo(hb[i]); hf[j * 16 + 8 + 2 * i + 1] = bfhi(hb[i]); }
    }
    const int i0 = p.idx[t * 128 + lane], i1 = p.idx[t * 128 + 64 + lane];
    const float g0 = p.g[t * 128 + lane], g1 = p.g[t * 128 + 64 + lane];
    float o[64];
#pragma unroll
    for (int i = 0; i < 64; ++i) o[i] = 0.f;
    u32x4 buf[2][16]; float scl[2][4];
    peer_load_batch(U8, p.us, i0, 0, q, gq, buf[0], scl[0]);
#pragma unroll
    for (int bi = 0; bi < 16; ++bi) {
      if (bi + 1 < 16) {
        const int nb = bi + 1;
        peer_load_batch(nb < 8 ? U8 : V8, nb < 8 ? p.us : p.vs, (nb & 4) ? i1 : i0, 16 * (nb & 7), q, gq, buf[nb & 1], scl[nb & 1]);
      }
      if (bi == 8) __syncthreads();
      const int ebase = 16 * (bi & 7);
      if (bi < 8) {
#pragma unroll
        for (int rr = 0; rr < 4; ++rr) {
          float acc = 0.f;
#pragma unroll
          for (int j = 0; j < 4; ++j)
#pragma unroll
            for (int i = 0; i < 4; ++i) {
              f32x2_t lo = __builtin_amdgcn_cvt_pk_f32_fp8((int)buf[bi & 1][rr * 4 + j][i], false);
              f32x2_t hi = __builtin_amdgcn_cvt_pk_f32_fp8((int)buf[bi & 1][rr * 4 + j][i], true);
              acc += lo[0] * hf[j * 16 + 4 * i] + lo[1] * hf[j * 16 + 4 * i + 1] + hi[0] * hf[j * 16 + 4 * i + 2] + hi[1] * hf[j * 16 + 4 * i + 3];
            }
          acc = gsum16(acc) * scl[bi & 1][rr];
          float act = 0.5f * acc * (1.f + erff(acc * 0.7071067811865476f));
          if (q == 0) wl[ebase + 4 * rr + gq] = act;
        }
      } else {
#pragma unroll
        for (int rr = 0; rr < 4; ++rr) {
          const int e = ebase + 4 * rr + gq;
          float ge = __shfl((bi & 4) ? g1 : g0, e & 63);
          float wg = wl[e] * ge * scl[bi & 1][rr];
#pragma unroll
          for (int j = 0; j < 4; ++j)
#pragma unroll
            for (int i = 0; i < 4; ++i) {
              f32x2_t lo = __builtin_amdgcn_cvt_pk_f32_fp8((int)buf[bi & 1][rr * 4 + j][i], false);
              f32x2_t hi = __builtin_amdgcn_cvt_pk_f32_fp8((int)buf[bi & 1][rr * 4 + j][i], true);
              o[j * 16 + 4 * i] += wg * lo[0]; o[j * 16 + 4 * i + 1] += wg * lo[1];
              o[j * 16 + 4 * i + 2] += wg * hi[0]; o[j * 16 + 4 * i + 3] += wg * hi[1];
            }
        }
      }
    }
#pragma unroll
    for (int i = 0; i < 64; ++i) { o[i] += __shfl_xor(o[i], 16); o[i] += __shfl_xor(o[i], 32); }
    float ss = 0.f;
#pragma unroll
    for (int j = 0; j < 4; ++j)
#pragma unroll
      for (int i4 = 0; i4 < 4; ++i4) {
        int col = (q + 16 * j) * 16 + 4 * i4;
        float4 xa = *(const float4*)(p.x1 + t * 1024 + col);
        float4 ga = *(const float4*)(p.mod + b * 6144 + 5120 + col);
        float v0 = xa.x + ga.x * o[j * 16 + 4 * i4], v1 = xa.y + ga.y * o[j * 16 + 4 * i4 + 1];
        float v2 = xa.z + ga.z * o[j * 16 + 4 * i4 + 2], v3 = xa.w + ga.w * o[j * 16 + 4 * i4 + 3];
        o[j * 16 + 4 * i4] = v0; o[j * 16 + 4 * i4 + 1] = v1; o[j * 16 + 4 * i4 + 2] = v2; o[j * 16 + 4 * i4 + 3] = v3;
        ss += v0 * v0 + v1 * v1 + v2 * v2 + v3 * v3;
      }
    ss = gsum16(ss);
    const float rstd = rsqrtf(ss * (1.f / 1024.f) + RMS_EPS);
#pragma unroll
    for (int j = 0; j < 4; ++j) {
      if (j == gq) {
#pragma unroll
        for (int i4 = 0; i4 < 4; ++i4) {
          int col = (q + 16 * j) * 16 + 4 * i4;
          float4 gg = *(const float4*)(p.normf_g + col);
          float4 sh = *(const float4*)(p.fmod + b * 2048 + col);
          float4 sc = *(const float4*)(p.fmod + b * 2048 + 1024 + col);
          float4 r;
          r.x = o[j * 16 + 4 * i4 + 0] * rstd * gg.x * (1.f + sc.x) + sh.x;
          r.y = o[j * 16 + 4 * i4 + 1] * rstd * gg.y * (1.f + sc.y) + sh.y;
          r.z = o[j * 16 + 4 * i4 + 2] * rstd * gg.z * (1.f + sc.z) + sh.z;
          r.w = o[j * 16 + 4 * i4 + 3] * rstd * gg.w * (1.f + sc.w) + sh.w;
          *(float4*)(p.out + t * 1024 + col) = r;
        }
      }
    }
    __syncthreads();
  }
}

__global__ void __launch_bounds__(256) fwd_megakernel(Params p) {
  cg::grid_group grid = cg::this_grid();
  __shared__ __attribute__((aligned(16))) char smem[60 * 1024];
  const int tid = threadIdx.x;
  phase_prep(p, smem, tid);
  grid.sync();
  phase_norm_mod(p.x, p.norm1_g, p.mod, 0, 1024, p.hA, tid);
  grid.sync();
  phase_proj(p, smem, tid);
  grid.sync();
  phase_gla_pre(p, smem, tid);
  grid.sync();
  phase_mixers(p, smem, tid);
  grid.sync();
  phase_post_mixers(p, tid);
  grid.sync();
  phase_gr(p, smem, tid);
  grid.sync();
  phase_merge(p, smem, tid);
  grid.sync();
  phase_out(p, smem, tid);
  grid.sync();
  phase_norm_mod(p.x1, p.norm2_g, p.mod, 3072, 4096, p.h2, tid);
  grid.sync();
  phase_peerq(p, smem, tid);
  grid.sync();
  phase_topk(p, smem, tid);
  grid.sync();
  phase_peer_final(p, smem, tid);
}

extern "C" void kernel_launch(void* const* d_in, const int* in_sizes, int n_in, void* d_out, int out_size, void* d_ws,
                              size_t ws_size, hipStream_t stream) {
  static int grid_blocks = 0;
  if (!grid_blocks) {
    int dev = 0, cus = 0, per_cu = 0;
    hipGetDevice(&dev);
    hipDeviceGetAttribute(&cus, hipDeviceAttributeMultiprocessorCount, dev);
    hipOccupancyMaxActiveBlocksPerMultiprocessor(&per_cu, fwd_megakernel, 256, 0);
    if (per_cu < 1) per_cu = 1;
    grid_blocks = cus * per_cu;
  }
  if (ws_size < 492 * MB) { fprintf(stderr, "ws too small: %zu\n", ws_size); return; }
  Params p{};
  p.x = (const float*)d_in[0]; p.c = (const float*)d_in[1]; p.pos = (const int*)d_in[2];
  p.w_ada = (const float*)d_in[3]; p.b_ada = (const float*)d_in[4]; p.norm1_g = (const float*)d_in[5];
  p.w_in = (const float*)d_in[6]; p.wa_fw = (const float*)d_in[7]; p.ba_fw = (const float*)d_in[8];
  p.wa_bw = (const float*)d_in[9]; p.ba_bw = (const float*)d_in[10]; p.gla_norm_g = (const float*)d_in[11];
  p.lq1 = (const float*)d_in[12]; p.lk1 = (const float*)d_in[13]; p.lq2 = (const float*)d_in[14]; p.lk2 = (const float*)d_in[15];
  p.diff_norm_g = (const float*)d_in[16]; p.w_gla = (const float*)d_in[17]; p.w_diff = (const float*)d_in[18];
  p.w_out = (const float*)d_in[19]; p.norm2_g = (const float*)d_in[20]; p.peer_wq = (const float*)d_in[21];
  p.subkeys = (const float*)d_in[22]; p.peer_u = (const float*)d_in[23]; p.peer_v = (const float*)d_in[24];
  p.w_fada = (const float*)d_in[25]; p.b_fada = (const float*)d_in[26]; p.normf_g = (const float*)d_in[27];
  p.out = (float*)d_out;
  char* ws = (char*)d_ws;
  p.winT = (u16*)(ws + 0 * MB); p.wgrT = (u16*)(ws + 11 * MB); p.wgaT = (u16*)(ws + 13 * MB); p.wgbT = (u16*)(ws + 15 * MB);
  p.wglaT = (u16*)(ws + 17 * MB); p.wdiffT = (u16*)(ws + 19 * MB); p.woutT = (u16*)(ws + 21 * MB); p.wqT = (u16*)(ws + 23 * MB);
  p.subk = (u16*)(ws + 27 * MB); p.rope = (float*)(ws + 28 * MB);
  p.mod = (float*)(ws + 36 * MB); p.fmod = (float*)(ws + 36 * MB + 128 * 1024); p.lam = (float*)(ws + 36 * MB + 192 * 1024);
  p.counter = (int*)(ws + 36 * MB + 196 * 1024);
  p.lr = (float*)(ws + 37 * MB); p.dec = (float*)(ws + 41 * MB); p.rstd = (float*)(ws + 43 * MB);
  char* slot[9];
  for (int i = 0; i < 7; ++i) slot[i] = ws + (44 + 64 * (size_t)i) * MB;
  slot[7] = (char*)d_out; slot[8] = (char*)d_out + 64 * MB;
  p.hA = (u16*)slot[0];
  p.gq = (u16*)slot[1]; p.gk = (u16*)(slot[1] + 32 * MB);
  p.gvT = (u16*)slot[2]; p.dq = (u16*)slot[3]; p.dk = (u16*)slot[4]; p.dvT = (u16*)slot[5];
  p.qe_fw = (u16*)slot[0]; p.ke_fw = (u16*)(slot[0] + 32 * MB);
  p.qe_bw = (u16*)slot[6]; p.ke_bw = (u16*)(slot[6] + 32 * MB);
  p.keT = (u16*)slot[7];
  p.o_fw = (u16*)slot[1]; p.o_bw = (u16*)slot[8];
  p.uB = (u16*)slot[6]; p.vB = (u16*)(slot[6] + 16 * MB);
  p.A1 = (u16*)slot[2]; p.merged = (u16*)slot[4];
  p.x1 = (float*)slot[0];
  p.h2 = (u16*)slot[2]; p.qp = (u16*)slot[3];
  p.us = (float*)(slot[6] + 32 * MB); p.vs = (float*)(slot[6] + 33 * MB);
  p.idx = (int*)slot[5]; p.g = (float*)(slot[5] + 16 * MB);
  void* args[] = {&p};
  hipError_t e = hipLaunchCooperativeKernel((void*)fwd_megakernel, dim3(grid_blocks), dim3(256), args, 0, stream);
  if (e != hipSuccess) fprintf(stderr, "cooperative launch failed: %s (grid %d)\n", hipGetErrorString(e), grid_blocks);
}
```

```cpp
#include <hip/hip_runtime.h>
#include <hip/hip_cooperative_groups.h>
#include <cstdio>
namespace cg = cooperative_groups;

#define DI __device__ __forceinline__
typedef unsigned short u16;
using bf16x8 = __attribute__((ext_vector_type(8))) short;
using f32x16 = __attribute__((ext_vector_type(16))) float;
using u32x4 = __attribute__((ext_vector_type(4))) unsigned;
using u32x2 = __attribute__((ext_vector_type(2))) unsigned;
typedef __bf16 bf16x2_t __attribute__((ext_vector_type(2)));
typedef float f32x2_t __attribute__((ext_vector_type(2)));

constexpr int T = 32768, D = 1024, S = 8192;
constexpr size_t MB = 1ull << 20;
constexpr float RMS_EPS = 1e-6f;
constexpr int LDS_BYTES = 144 * 1024;

#define MFMA(a, b, c) __builtin_amdgcn_mfma_f32_32x32x16_bf16((a), (b), (c), 0, 0, 0)

struct Params {
  const float *x, *c; const int* pos;
  const float *w_ada, *b_ada, *norm1_g, *w_in, *wa_fw, *ba_fw, *wa_bw, *ba_bw, *gla_norm_g;
  const float *lq1, *lk1, *lq2, *lk2, *diff_norm_g, *w_gla, *w_diff, *w_out, *norm2_g, *peer_wq, *subkeys, *peer_u, *peer_v;
  const float *w_fada, *b_fada, *normf_g;
  float* out;
  u16 *winT, *wgrT, *wgaT, *wgbT, *wglaT, *wdiffT, *woutT, *wqT, *subk;
  float* rope;
  float* mod;
  float* fmod;
  float* lam;
  int* counter;
  float* lr;
  float* dec;
  float* rstd;
  u16 *hA, *gq, *gk, *gvT, *dq, *dk, *dvT;
  u16 *qe_fw, *ke_fw, *qe_bw, *ke_bw, *keT;
  u16 *o_fw, *o_bw, *A1, *merged, *h2, *qp, *uB, *vB;
  float* x1;
  int* idx; float* g;
  float *us, *vs;
};

DI u16 f2bf(float x) { unsigned u = __float_as_uint(x); u += 0x7fffu + ((u >> 16) & 1u); return (u16)(u >> 16); }
DI float bf2f(u16 b) { return __uint_as_float(((unsigned)b) << 16); }
DI unsigned pack2(float a, float b) {
  f32x2_t v = {a, b};
  bf16x2_t r = __builtin_convertvector(v, bf16x2_t);
  return __builtin_bit_cast(unsigned, r);
}
DI float bflo(unsigned u) { return __uint_as_float(u << 16); }
DI float bfhi(unsigned u) { return __uint_as_float(u & 0xffff0000u); }
DI int crow(int i, int h) { return (i & 3) + 8 * (i >> 2) + 4 * h; }
DI bf16x8 pack_step(const f32x16& x, int s) {
  u32x4 p;
  p[0] = pack2(x[8 * s + 0], x[8 * s + 1]);
  p[1] = pack2(x[8 * s + 2], x[8 * s + 3]);
  p[2] = pack2(x[8 * s + 4], x[8 * s + 5]);
  p[3] = pack2(x[8 * s + 6], x[8 * s + 7]);
  return __builtin_bit_cast(bf16x8, p);
}
DI bf16x8 ld_frag16(const u16* p) { return __builtin_bit_cast(bf16x8, *(const u32x4*)p); }
DI bf16x8 ld_frag8x2(const u16* p) {
  u32x2 lo = *(const u32x2*)p; u32x2 hi = *(const u32x2*)(p + 8);
  u32x4 v = {lo[0], lo[1], hi[0], hi[1]};
  return __builtin_bit_cast(bf16x8, v);
}
DI float wave_sum(float v) {
#pragma unroll
  for (int o = 32; o >= 1; o >>= 1) v += __shfl_xor(v, o);
  return v;
}

template <int CTRL> DI float dpp_f(float v) { return __builtin_bit_cast(float, __builtin_amdgcn_update_dpp(0, __builtin_bit_cast(int, v), CTRL, 0xF, 0xF, false)); }
template <int CTRL> DI unsigned dpp_u(unsigned v) { return (unsigned)__builtin_amdgcn_update_dpp(0, (int)v, CTRL, 0xF, 0xF, false); }
DI float gsum16(float v) { v += dpp_f<0x121>(v); v += dpp_f<0x122>(v); v += dpp_f<0x124>(v); v += dpp_f<0x128>(v); return v; }
DI float gmaxf16(float v) { v = fmaxf(v, dpp_f<0x121>(v)); v = fmaxf(v, dpp_f<0x122>(v)); v = fmaxf(v, dpp_f<0x124>(v)); v = fmaxf(v, dpp_f<0x128>(v)); return v; }
DI unsigned gmax16(unsigned v) { v = max(v, dpp_u<0x121>(v)); v = max(v, dpp_u<0x122>(v)); v = max(v, dpp_u<0x124>(v)); v = max(v, dpp_u<0x128>(v)); return v; }
DI f32x16 zero16() { f32x16 z; for (int i = 0; i < 16; ++i) z[i] = 0.f; return z; }

DI void tconv_tile(const float* src, int ld, int c0, int nc, u16* dst, int ct, int kt, float* sm, int tid) {
  __syncthreads();
  int cl = tid & 63, r0 = tid >> 6;
#pragma unroll
  for (int r = 0; r < 8; ++r) {
    int k = kt * 64 + r0 + 8 * r;
    int col = ct * 64 + cl;
    float v = (col < nc) ? src[(size_t)k * ld + c0 + col] : 0.f;
    sm[(r0 + 8 * r) * 65 + cl] = v;
  }
  __syncthreads();
#pragma unroll
  for (int r = 0; r < 8; ++r) {
    int col = r0 + 8 * r;
    int k = cl;
    dst[(size_t)(ct * 64 + col) * 1024 + kt * 64 + k] = f2bf(sm[k * 65 + col]);
  }
}

DI void phase_prep(const Params& p, char* smem, int tid) {
  float* sm = (float*)smem;
  const int nblk = gridDim.x, bid = blockIdx.x;
  const int NCT = 32 + 48 + 2 + 16 * 6 + 32;
  for (int it = bid; it < NCT * 16; it += nblk) {
    int ctg = it >> 4, kt = it & 15;
    const float* src; int ld, c0, nc; u16* dst; int ct;
    if (ctg < 32) { src = p.w_in; ld = 8224; c0 = 0; nc = 2048; dst = p.winT; ct = ctg; }
    else if (ctg < 80) { src = p.w_in; ld = 8224; c0 = 3104; nc = 3072; dst = p.winT + (size_t)2048 * 1024; ct = ctg - 32; }
    else if (ctg < 82) { src = p.w_in; ld = 8224; c0 = 3072; nc = 32; dst = p.winT + (size_t)5120 * 1024; ct = ctg - 80; }
    else if (ctg < 98) { src = p.w_in; ld = 8224; c0 = 2048; nc = 1024; dst = p.wgrT; ct = ctg - 82; }
    else if (ctg < 114) { src = p.w_in; ld = 8224; c0 = 6176; nc = 1024; dst = p.wgaT; ct = ctg - 98; }
    else if (ctg < 130) { src = p.w_in; ld = 8224; c0 = 7200; nc = 1024; dst = p.wgbT; ct = ctg - 114; }
    else if (ctg < 146) { src = p.w_gla; ld = 1024; c0 = 0; nc = 1024; dst = p.wglaT; ct = ctg - 130; }
    else if (ctg < 162) { src = p.w_diff; ld = 1024; c0 = 0; nc = 1024; dst = p.wdiffT; ct = ctg - 146; }
    else if (ctg < 178) { src = p.w_out; ld = 1024; c0 = 0; nc = 1024; dst = p.woutT; ct = ctg - 162; }
    else { src = p.peer_wq; ld = 2048; c0 = 0; nc = 2048; dst = p.wqT; ct = ctg - 178; }
    tconv_tile(src, ld, c0, nc, dst, ct, kt, sm, tid);
  }
  __syncthreads();
  const int gtid = bid * 512 + tid, gsz = nblk * 512;
  for (int i = gtid; i < 8 * 2 * 128 * 128; i += gsz) p.subk[i] = f2bf(p.subkeys[i]);
  for (int i = gtid; i < T * 32; i += gsz) {
    int t = i >> 5, d = i & 31;
    float inv = powf(10000.f, -(float)d / 32.f);
    float ang = (float)p.pos[t] * inv;
    double r = (double)ang * 0.15915494309189535;
    r -= rint(r);
    float rf = (float)r;
    p.rope[2 * i] = __builtin_amdgcn_cosf(rf);
    p.rope[2 * i + 1] = __builtin_amdgcn_sinf(rf);
  }
  if (gtid == 0) {
    float s1 = 0.f, s2 = 0.f;
    for (int i = 0; i < 64; ++i) { s1 += p.lq1[i] * p.lk1[i]; s2 += p.lq2[i] * p.lk2[i]; }
    p.lam[0] = expf(s1) - expf(s2) + 0.2f;
    p.counter[0] = 0; p.counter[1] = 0; p.counter[2] = 0; p.counter[3] = 0;
  }
  {
    float* cact = sm;
    float* red = sm + 4096;
    __syncthreads();
    for (int i = tid; i < 4096; i += 512) { float v = p.c[i]; cact[i] = v / (1.f + __expf(-v)); }
    __syncthreads();
    int w = tid >> 6, lane = tid & 63;
    for (int it = bid; it < 128; it += nblk) {
      int col = it * 64 + lane;
      const float* W; int ld, cc;
      if (col < 6144) { W = p.w_ada; ld = 6144; cc = col; } else { W = p.w_fada; ld = 2048; cc = col - 6144; }
      float a0 = 0, a1 = 0, a2 = 0, a3 = 0;
#pragma unroll 8
      for (int k = w * 128; k < w * 128 + 128; ++k) {
        float wv = W[(size_t)k * ld + cc];
        a0 += cact[k] * wv; a1 += cact[1024 + k] * wv; a2 += cact[2048 + k] * wv; a3 += cact[3072 + k] * wv;
      }
      red[(w * 4 + 0) * 64 + lane] = a0; red[(w * 4 + 1) * 64 + lane] = a1;
      red[(w * 4 + 2) * 64 + lane] = a2; red[(w * 4 + 3) * 64 + lane] = a3;
      __syncthreads();
      if (tid < 256) {
        int b = w;
        float s = 0.f;
#pragma unroll
        for (int ww = 0; ww < 8; ++ww) s += red[(ww * 4 + b) * 64 + lane];
        if (col < 6144) p.mod[b * 6144 + cc] = s + p.b_ada[cc];
        else p.fmod[b * 2048 + cc] = s + p.b_fada[cc];
      }
      __syncthreads();
    }
  }
}

DI void phase_norm_mod(const float* src, const float* g, const float* mod, int sh_off, int sc_off, u16* dst, int tid) {
  int w = tid >> 6, lane = tid & 63;
  for (int row = blockIdx.x * 8 + w; row < T; row += gridDim.x * 8) {
    int b = row >> 13;
    const float* xr = src + (size_t)row * 1024;
    float4 v[4]; float ss = 0.f;
#pragma unroll
    for (int m = 0; m < 4; ++m) { v[m] = *(const float4*)(xr + (m * 64 + lane) * 4); ss += v[m].x * v[m].x + v[m].y * v[m].y + v[m].z * v[m].z + v[m].w * v[m].w; }
    ss = wave_sum(ss);
    float rstd = rsqrtf(ss * (1.f / 1024.f) + RMS_EPS);
#pragma unroll
    for (int m = 0; m < 4; ++m) {
      int col = (m * 64 + lane) * 4;
      float4 gg = *(const float4*)(g + col);
      float4 sh = *(const float4*)(mod + b * 6144 + sh_off + col);
      float4 sc = *(const float4*)(mod + b * 6144 + sc_off + col);
      float y0 = v[m].x * rstd * gg.x * (1.f + sc.x) + sh.x;
      float y1 = v[m].y * rstd * gg.y * (1.f + sc.y) + sh.y;
      float y2 = v[m].z * rstd * gg.z * (1.f + sc.z) + sh.z;
      float y3 = v[m].w * rstd * gg.w * (1.f + sc.w) + sh.w;
      u32x2 o = {pack2(y0, y1), pack2(y2, y3)};
      *(u32x2*)(dst + (size_t)row * 1024 + col) = o;
    }
  }
}

constexpr int GLD = 72;
constexpr int GSTAGE = (256 + 128) * GLD;
DI void gemm_kloop(const u16* A, int lda, const u16* Bt, int ldb, int K, f32x16 (&acc)[2][2], u16* smem, int tid) {
  const int w = tid >> 6, lane = tid & 63, c = lane & 31, hh = lane >> 5;
  const int wm = w >> 1, wn = w & 1;
  const int lrow = tid >> 3, lcol = (tid & 7) * 8;
  u32x4 ra[4], rb[2];
  const int nk = K >> 6;
#pragma unroll
  for (int r = 0; r < 4; ++r) ra[r] = *(const u32x4*)(A + (size_t)(r * 64 + lrow) * lda + lcol);
#pragma unroll
  for (int r = 0; r < 2; ++r) rb[r] = *(const u32x4*)(Bt + (size_t)(r * 64 + lrow) * ldb + lcol);
  __syncthreads();
  {
    u16* sA = smem; u16* sB = smem + 256 * GLD;
#pragma unroll
    for (int r = 0; r < 4; ++r) *(u32x4*)(sA + (r * 64 + lrow) * GLD + lcol) = ra[r];
#pragma unroll
    for (int r = 0; r < 2; ++r) *(u32x4*)(sB + (r * 64 + lrow) * GLD + lcol) = rb[r];
  }
  if (nk > 1) {
#pragma unroll
    for (int r = 0; r < 4; ++r) ra[r] = *(const u32x4*)(A + (size_t)(r * 64 + lrow) * lda + 64 + lcol);
#pragma unroll
    for (int r = 0; r < 2; ++r) rb[r] = *(const u32x4*)(Bt + (size_t)(r * 64 + lrow) * ldb + 64 + lcol);
  }
  __syncthreads();
  for (int kt = 0; kt < nk; ++kt) {
    const u16* sA = smem + (kt & 1) * GSTAGE; const u16* sB = sA + 256 * GLD;
    if (kt + 1 < nk) {
      u16* nA = smem + ((kt + 1) & 1) * GSTAGE; u16* nB = nA + 256 * GLD;
#pragma unroll
      for (int r = 0; r < 4; ++r) *(u32x4*)(nA + (r * 64 + lrow) * GLD + lcol) = ra[r];
#pragma unroll
      for (int r = 0; r < 2; ++r) *(u32x4*)(nB + (r * 64 + lrow) * GLD + lcol) = rb[r];
      if (kt + 2 < nk) {
#pragma unroll
        for (int r = 0; r < 4; ++r) ra[r] = *(const u32x4*)(A + (size_t)(r * 64 + lrow) * lda + (kt + 2) * 64 + lcol);
#pragma unroll
        for (int r = 0; r < 2; ++r) rb[r] = *(const u32x4*)(Bt + (size_t)(r * 64 + lrow) * ldb + (kt + 2) * 64 + lcol);
      }
    }
#pragma unroll
    for (int s = 0; s < 4; ++s) {
      bf16x8 a0 = ld_frag16(sA + (wm * 64 + c) * GLD + s * 16 + hh * 8);
      bf16x8 a1 = ld_frag16(sA + (wm * 64 + 32 + c) * GLD + s * 16 + hh * 8);
      bf16x8 b0 = ld_frag16(sB + (wn * 64 + c) * GLD + s * 16 + hh * 8);
      bf16x8 b1 = ld_frag16(sB + (wn * 64 + 32 + c) * GLD + s * 16 + hh * 8);
      acc[0][0] = MFMA(a0, b0, acc[0][0]);
      acc[0][1] = MFMA(a0, b1, acc[0][1]);
      acc[1][0] = MFMA(a1, b0, acc[1][0]);
      acc[1][1] = MFMA(a1, b1, acc[1][1]);
    }
    __syncthreads();
  }
}
DI void zero_acc(f32x16 (&acc)[2][2]) {
#pragma unroll
  for (int a = 0; a < 2; ++a)
#pragma unroll
    for (int b = 0; b < 2; ++b) acc[a][b] = zero16();
}

DI void phase_proj(const Params& p, char* smem, int tid) {
  const int w = tid >> 6, lane = tid & 63, c = lane & 31, hh = lane >> 5;
  const int wm = w >> 1, wn = w & 1;
  const int NT = 41;
  for (int id = blockIdx.x; id < 128 * NT; id += gridDim.x) {
    int mt = id / NT, nt = id - mt * NT;
    int m0 = mt * 256, n0 = nt * 128;
    f32x16 acc[2][2]; zero_acc(acc);
    gemm_kloop(p.hA + (size_t)m0 * 1024, 1024, p.winT + (size_t)n0 * 1024, 1024, 1024, acc, (u16*)smem, tid);
    const int rb = m0 + wm * 64, cb = n0 + wn * 64;
    if (n0 < 1024) {
      float sc = (n0 < 512) ? 0.08838834764831845f : 1.f;
      u16* dst = (n0 < 512) ? p.gq : p.gk;
      int cbb = cb & 511;
#pragma unroll
      for (int mi = 0; mi < 2; ++mi)
#pragma unroll
        for (int ni = 0; ni < 2; ++ni)
#pragma unroll
          for (int i = 0; i < 16; ++i) {
            int row = rb + mi * 32 + crow(i, hh), col = cbb + ni * 32 + c;
            dst[(size_t)row * 512 + col] = f2bf(acc[mi][ni][i] * sc);
          }
    } else if (n0 < 2048 || (n0 >= 4096 && n0 < 5120)) {
      bool isg = n0 < 2048;
#pragma unroll
      for (int mi = 0; mi < 2; ++mi)
#pragma unroll
        for (int ni = 0; ni < 2; ++ni) {
          int col = cb + ni * 32 + c;
          size_t rowbase;
          int b = rb >> 13;
          if (isg) { int cc = col - 1024; rowbase = ((size_t)(b * 4 + (cc >> 8)) * 256 + (cc & 255)) * 8192; }
          else { int cc = col - 4096; rowbase = ((size_t)(b * 8 + (cc >> 7)) * 128 + (cc & 127)) * 8192; }
          u16* dst = (isg ? p.gvT : p.dvT) + rowbase;
#pragma unroll
          for (int g = 0; g < 4; ++g) {
            int s = ((rb + mi * 32) & 8191) + 8 * g + 4 * hh;
            u32x2 v = {pack2(acc[mi][ni][4 * g], acc[mi][ni][4 * g + 1]), pack2(acc[mi][ni][4 * g + 2], acc[mi][ni][4 * g + 3])};
            *(u32x2*)(dst + s) = v;
          }
        }
    } else if (n0 < 4096) {
      bool isq = n0 < 3072;
      float sc = isq ? (0.125f * 1.4426950408889634f) : 1.f;
      u16* dst = isq ? p.dq : p.dk;
      int cbb = (cb - (isq ? 2048 : 3072));
#pragma unroll
      for (int mi = 0; mi < 2; ++mi)
#pragma unroll
        for (int i = 0; i < 16; ++i) {
          int row = rb + mi * 32 + crow(i, hh);
          float2 cs = *(const float2*)(p.rope + ((size_t)row * 32 + c) * 2);
          float x1 = acc[mi][0][i], x2 = acc[mi][1][i];
          float o1 = (x1 * cs.x - x2 * cs.y) * sc;
          float o2 = (x2 * cs.x + x1 * cs.y) * sc;
          dst[(size_t)row * 1024 + cbb + c] = f2bf(o1);
          dst[(size_t)row * 1024 + cbb + 32 + c] = f2bf(o2);
        }
    } else {
      if (wn == 0) {
#pragma unroll
        for (int mi = 0; mi < 2; ++mi)
#pragma unroll
          for (int i = 0; i < 16; ++i) {
            int row = rb + mi * 32 + crow(i, hh);
            p.lr[(size_t)row * 32 + c] = acc[mi][0][i];
          }
      }
    }
  }
}

DI float logsig(float x) { return fminf(x, 0.f) - __logf(1.f + __expf(-fabsf(x))); }

DI void phase_gla_pre(const Params& p, char* smem, int tid) {
  float* slr = (float*)smem;
  for (int it = blockIdx.x; it < 512; it += gridDim.x) {
    int b = it >> 7, ch = it & 127;
    size_t t0 = (size_t)b * 8192 + ch * 64;
    __syncthreads();
    for (int i = tid; i < 2048; i += 512) slr[i] = p.lr[t0 * 32 + i];
    __syncthreads();
#pragma unroll 1
    for (int cj = 0; cj < 1; ++cj) {
      int j = tid;
      int h = j >> 7, d = j & 127;
#pragma unroll 1
      for (int dir = 0; dir < 2; ++dir) {
        const float* wa = dir ? p.wa_bw : p.wa_fw;
        float wr[16];
#pragma unroll
        for (int r = 0; r < 16; ++r) wr[r] = wa[r * 512 + j];
        float ba = (dir ? p.ba_bw : p.ba_fw)[j];
        u16* qe = dir ? p.qe_bw : p.qe_fw;
        u16* ke = dir ? p.ke_bw : p.ke_fw;
        u16* keT = p.keT + (size_t)dir * (16ull * 128 * 8192) + ((size_t)(b * 4 + h) * 128 + d) * 8192 + ch * 64;
        float bsum = 0.f;
#pragma unroll 1
        for (int g8 = 0; g8 < 8; ++g8) {
          unsigned kk[8];
#pragma unroll
          for (int u = 0; u < 8; ++u) {
            int tt = g8 * 8 + u;
            int t = dir ? 63 - tt : tt;
            float pre = ba;
#pragma unroll
            for (int r = 0; r < 16; ++r) pre += slr[t * 32 + dir * 16 + r] * wr[r];
            bsum += logsig(pre) * (1.f / 16.f);
            float qv = bf2f(p.gq[(t0 + t) * 512 + j]);
            float kv = bf2f(p.gk[(t0 + t) * 512 + j]);
            float eb = __expf(bsum);
            u16 qo = f2bf(qv * eb);
            u16 ko = f2bf(kv / eb);
            qe[(t0 + t) * 512 + j] = qo;
            ke[(t0 + t) * 512 + j] = ko;
            kk[u] = ko;
          }
          u32x4 v;
          if (!dir) {
            v[0] = kk[0] | (kk[1] << 16); v[1] = kk[2] | (kk[3] << 16); v[2] = kk[4] | (kk[5] << 16); v[3] = kk[6] | (kk[7] << 16);
            *(u32x4*)(keT + g8 * 8) = v;
          } else {
            v[0] = kk[7] | (kk[6] << 16); v[1] = kk[5] | (kk[4] << 16); v[2] = kk[3] | (kk[2] << 16); v[3] = kk[1] | (kk[0] << 16);
            *(u32x4*)(keT + (56 - g8 * 8)) = v;
          }
        }
        p.dec[((size_t)(dir * 4 + b) * 128 + ch) * 512 + j] = __expf(bsum);
      }
    }
  }
}

constexpr int QLD = 136, TLD = 72;
DI void gla_scan_block(const Params& p, int g, char* smem, int tid) {
  const int dir = g & 1, bh = g >> 1;
  const int b = bh >> 2, h = bh & 3;
  const int w = tid >> 6, lane = tid & 63, c = lane & 31, hh = lane >> 5;
  const int slice = w;
  u16* sQ = (u16*)smem;
  u16* sK = sQ + 64 * QLD;
  u16* sKT = sK + 64 * QLD;
  u16* sVT = sKT + 128 * TLD;
  const u16* qe = (dir ? p.qe_bw : p.qe_fw) + (size_t)b * 8192 * 512 + h * 128;
  const u16* ke = (dir ? p.ke_bw : p.ke_fw) + (size_t)b * 8192 * 512 + h * 128;
  const u16* keT = p.keT + (size_t)dir * (16ull * 128 * 8192) + (size_t)bh * 128 * 8192;
  const u16* vT = p.gvT + (size_t)bh * 256 * 8192;
  const float* dec = p.dec + ((size_t)(dir * 4 + b) * 128) * 512 + h * 128;
  u16* o = dir ? p.o_bw : p.o_fw;
  f32x16 st[4];
#pragma unroll
  for (int i = 0; i < 4; ++i) st[i] = zero16();
  u32x4 rq[2], rk[2], rt[2];
  unsigned offq[2], offt[2];
#pragma unroll
  for (int r = 0; r < 2; ++r) {
    int id = tid + 512 * r;
    offq[r] = (unsigned)(((id >> 4) * 512 + (id & 15) * 8) * 2);
    offt[r] = (unsigned)(((id >> 3) * 8192 + (id & 7) * 8) * 2);
  }
  const unsigned offv = (unsigned)(((w * 32 + c) * 8192 + 4 * hh) * 2);
  {
    const int ch = dir ? 127 : 0;
#pragma unroll
    for (int r = 0; r < 2; ++r) {
      int id = tid + 512 * r;
      rq[r] = *(const u32x4*)((const char*)(qe + (size_t)ch * 64 * 512) + offq[r]);
      rk[r] = *(const u32x4*)((const char*)(ke + (size_t)ch * 64 * 512) + offq[r]);
      rt[r] = *(const u32x4*)((const char*)(keT + ch * 64) + offt[r]);
    }
  }
#pragma unroll 1
  for (int ci = 0; ci < 128; ++ci) {
    const int ch = dir ? 127 - ci : ci;
    const size_t t0 = (size_t)b * 8192 + ch * 64;
    __syncthreads();
#pragma unroll
    for (int r = 0; r < 2; ++r) {
      int id = tid + 512 * r;
      *(u32x4*)(sQ + (id >> 4) * QLD + (id & 15) * 8) = rq[r];
      *(u32x4*)(sK + (id >> 4) * QLD + (id & 15) * 8) = rk[r];
      *(u32x4*)(sKT + (id >> 3) * TLD + (id & 7) * 8) = rt[r];
    }
    __syncthreads();
    if (ci + 1 < 128) {
      const int chn = dir ? ch - 1 : ch + 1;
#pragma unroll
      for (int r = 0; r < 2; ++r) {
        int id = tid + 512 * r;
        rq[r] = *(const u32x4*)((const char*)(qe + (size_t)chn * 64 * 512) + offq[r]);
        rk[r] = *(const u32x4*)((const char*)(ke + (size_t)chn * 64 * 512) + offq[r]);
        rt[r] = *(const u32x4*)((const char*)(keT + chn * 64) + offt[r]);
      }
    }
    bf16x8 vf[4];
#pragma unroll
    for (int k4 = 0; k4 < 4; ++k4) vf[k4] = ld_frag8x2((const u16*)((const char*)(vT + ch * 64 + 16 * k4) + offv));
#pragma unroll 1
    for (int qt = 0; qt < 2; ++qt) {
      f32x16 oacc = zero16();
#pragma unroll
      for (int ks = 0; ks < 8; ++ks) {
        bf16x8 sf = pack_step(st[ks >> 1], ks & 1);
        bf16x8 q0 = ld_frag8x2(sQ + (qt * 32 + c) * QLD + ks * 16 + 4 * hh);
        oacc = MFMA(q0, sf, oacc);
        if (ks & 1) __builtin_amdgcn_sched_barrier(0);
      }
#pragma unroll
      for (int kt = 0; kt < 2; ++kt) {
        bool skip = dir ? (kt < qt) : (kt > qt);
        if (skip) continue;
        f32x16 X = zero16();
#pragma unroll 1
        for (int ks = 0; ks < 8; ++ks) {
          bf16x8 kf = ld_frag8x2(sK + (kt * 32 + c) * QLD + ks * 16 + 4 * hh);
          bf16x8 qf = ld_frag8x2(sQ + (qt * 32 + c) * QLD + ks * 16 + 4 * hh);
          X = MFMA(kf, qf, X);
        }
        if (kt == qt) {
#pragma unroll
          for (int i = 0; i < 16; ++i) {
            int key = crow(i, hh);
            bool keep = dir ? (key >= c) : (key <= c);
            X[i] = keep ? X[i] : 0.f;
          }
        }
        oacc = MFMA(pack_step(X, 0), vf[kt * 2 + 0], oacc);
        oacc = MFMA(pack_step(X, 1), vf[kt * 2 + 1], oacc);
        __builtin_amdgcn_sched_barrier(0);
      }
#pragma unroll
      for (int i = 0; i < 16; ++i)
        o[(t0 + qt * 32 + crow(i, hh)) * 1024 + h * 256 + slice * 32 + c] = f2bf(oacc[i]);
      __builtin_amdgcn_sched_barrier(0);
    }
#pragma unroll
    for (int dt = 0; dt < 4; ++dt) {
#pragma unroll
      for (int k4 = 0; k4 < 4; ++k4) {
        bf16x8 kt_f = ld_frag8x2(sKT + (dt * 32 + c) * TLD + 16 * k4 + 4 * hh);
        st[dt] = MFMA(kt_f, vf[k4], st[dt]);
      }
#pragma unroll
      for (int gg = 0; gg < 4; ++gg) {
        float4 dv = *(const float4*)(dec + (size_t)ch * 512 + dt * 32 + 8 * gg + 4 * hh);
        st[dt][4 * gg + 0] *= dv.x; st[dt][4 * gg + 1] *= dv.y; st[dt][4 * gg + 2] *= dv.z; st[dt][4 * gg + 3] *= dv.w;
      }
      __builtin_amdgcn_sched_barrier(0);
    }
  }
}

constexpr int KLD = 136, VLD = 72;
constexpr int ATT_BUF = 64 * KLD + 128 * VLD;
DI void attn_item(const Params& p, int item, char* smem, int tid) {
  const int qb = item & 63, bh = item >> 6;
  const int b = bh >> 3, h = bh & 7;
  const int w = tid >> 6, lane = tid & 63, c = lane & 31, hh = lane >> 5;
  const int qg = w & 3, mp = w >> 2;
  u16* sbase = (u16*)smem;
  float* sex = (float*)(smem + 2 * ATT_BUF * 2);
  const size_t tq = (size_t)b * 8192 + qb * 128 + qg * 32 + c;
  bf16x8 qf[4];
#pragma unroll
  for (int s = 0; s < 4; ++s) qf[s] = ld_frag16(p.dq + tq * 1024 + h * 128 + mp * 64 + 16 * s + 8 * hh);
  f32x16 O[4];
#pragma unroll
  for (int dt = 0; dt < 4; ++dt) O[dt] = zero16();
  float mrun = -1e30f, lrun = 0.f;
  const u16* Kg = p.dk + (size_t)b * 8192 * 1024 + h * 128;
  const u16* Vg = p.dvT + (size_t)bh * 128 * 8192;
  u32x4 rk[2], rv[2];
#pragma unroll
  for (int r = 0; r < 2; ++r) {
    int id = tid + 512 * r;
    rk[r] = *(const u32x4*)(Kg + (size_t)(id >> 4) * 1024 + (id & 15) * 8);
    rv[r] = *(const u32x4*)(Vg + (size_t)(id >> 3) * 8192 + (id & 7) * 8);
  }
  __syncthreads();
#pragma unroll
  for (int r = 0; r < 2; ++r) {
    int id = tid + 512 * r;
    *(u32x4*)(sbase + (id >> 4) * KLD + (id & 15) * 8) = rk[r];
    *(u32x4*)(sbase + 64 * KLD + (id >> 3) * VLD + (id & 7) * 8) = rv[r];
  }
#pragma unroll
  for (int r = 0; r < 2; ++r) {
    int id = tid + 512 * r;
    rk[r] = *(const u32x4*)(Kg + (size_t)(64 + (id >> 4)) * 1024 + (id & 15) * 8);
    rv[r] = *(const u32x4*)(Vg + (size_t)(id >> 3) * 8192 + 64 + (id & 7) * 8);
  }
  __syncthreads();
#pragma unroll 1
  for (int kt = 0; kt < 128; ++kt) {
    const u16* sK = sbase + (kt & 1) * ATT_BUF;
    const u16* sV = sK + 64 * KLD;
    if (kt + 1 < 128) {
      u16* nK = sbase + ((kt + 1) & 1) * ATT_BUF;
      u16* nV = nK + 64 * KLD;
#pragma unroll
      for (int r = 0; r < 2; ++r) {
        int id = tid + 512 * r;
        *(u32x4*)(nK + (id >> 4) * KLD + (id & 15) * 8) = rk[r];
        *(u32x4*)(nV + (id >> 3) * VLD + (id & 7) * 8) = rv[r];
      }
      if (kt + 2 < 128) {
#pragma unroll
        for (int r = 0; r < 2; ++r) {
          int id = tid + 512 * r;
          rk[r] = *(const u32x4*)(Kg + (size_t)((kt + 2) * 64 + (id >> 4)) * 1024 + (id & 15) * 8);
          rv[r] = *(const u32x4*)(Vg + (size_t)(id >> 3) * 8192 + (kt + 2) * 64 + (id & 7) * 8);
        }
      }
    }
    f32x16 sacc[2];
    sacc[0] = zero16(); sacc[1] = zero16();
#pragma unroll
    for (int s = 0; s < 4; ++s)
#pragma unroll
      for (int k2 = 0; k2 < 2; ++k2) {
        bf16x8 kfr = ld_frag16(sK + (k2 * 32 + c) * KLD + mp * 64 + 16 * s + 8 * hh);
        sacc[k2] = MFMA(kfr, qf[s], sacc[k2]);
      }
    float mx = sacc[0][0];
#pragma unroll
    for (int i = 0; i < 16; ++i) { mx = fmaxf(mx, sacc[0][i]); mx = fmaxf(mx, sacc[1][i]); }
    mx = fmaxf(mx, __shfl_xor(mx, 32));
    if (__any(mx > mrun)) {
      float mnew = fmaxf(mrun, mx);
      float alpha = __builtin_amdgcn_exp2f(mrun - mnew);
      mrun = mnew;
      lrun *= alpha;
#pragma unroll
      for (int dt = 0; dt < 4; ++dt)
#pragma unroll
        for (int i = 0; i < 16; ++i) O[dt][i] *= alpha;
    }
    float ls = 0.f;
#pragma unroll
    for (int k2 = 0; k2 < 2; ++k2)
#pragma unroll
      for (int i = 0; i < 16; ++i) { float e = __builtin_amdgcn_exp2f(sacc[k2][i] - mrun); sacc[k2][i] = e; ls += e; }
    lrun += ls;
#pragma unroll
    for (int k2 = 0; k2 < 2; ++k2)
#pragma unroll
      for (int s2 = 0; s2 < 2; ++s2) {
        bf16x8 pfr = pack_step(sacc[k2], s2);
#pragma unroll
        for (int dt = 0; dt < 4; ++dt) {
          bf16x8 vfr = ld_frag8x2(sV + (dt * 32 + c) * VLD + k2 * 32 + s2 * 16 + 4 * hh);
          O[dt] = MFMA(vfr, pfr, O[dt]);
        }
      }
    __syncthreads();
  }
  float ltot = lrun + __shfl_xor(lrun, 32);
  if (mp == 1) {
    float sc = p.lam[0] / ltot;
#pragma unroll
    for (int dt = 0; dt < 4; ++dt)
#pragma unroll
      for (int i = 0; i < 16; ++i) sex[(qg * 64 + dt * 16 + i) * 64 + lane] = O[dt][i] * sc;
  }
  __syncthreads();
  if (mp == 0) {
    float i0 = 1.f / ltot;
    float ss = 0.f;
#pragma unroll
    for (int dt = 0; dt < 4; ++dt)
#pragma unroll
      for (int i = 0; i < 16; ++i) { float v = O[dt][i] * i0 - sex[(qg * 64 + dt * 16 + i) * 64 + lane]; O[dt][i] = v; ss += v * v; }
    ss += __shfl_xor(ss, 32);
    float rstd = rsqrtf(ss * (1.f / 128.f) + RMS_EPS) * 0.8f;
#pragma unroll
    for (int dt = 0; dt < 4; ++dt)
#pragma unroll
      for (int g = 0; g < 4; ++g) {
        int dv = dt * 32 + 8 * g + 4 * hh;
        float4 gg = *(const float4*)(p.diff_norm_g + h * 128 + dv);
        u32x2 v = {pack2(O[dt][4 * g] * rstd * gg.x, O[dt][4 * g + 1] * rstd * gg.y),
                   pack2(O[dt][4 * g + 2] * rstd * gg.z, O[dt][4 * g + 3] * rstd * gg.w)};
        *(u32x2*)(p.dq + tq * 1024 + h * 128 + dv) = v;
      }
  }
}

DI void phase_mixers(const Params& p, char* smem, int tid) {
  int* sitem = (int*)(smem + 143 * 1024);
  if (blockIdx.x < 32) gla_scan_block(p, blockIdx.x, smem, tid);
  for (;;) {
    __syncthreads();
    if (tid == 0) *sitem = atomicAdd(p.counter, 1);
    __syncthreads();
    int item = *sitem;
    if (item >= 2048) break;
    attn_item(p, item, smem, tid);
  }
}

DI void phase_post_mixers(const Params& p, int tid) {
  int w = tid >> 6, lane = tid & 63;
  for (int row = blockIdx.x * 8 + w; row < T; row += gridDim.x * 8) {
#pragma unroll
    for (int hd = 0; hd < 4; ++hd) {
      u32x2 a = *(const u32x2*)(p.o_fw + (size_t)row * 1024 + hd * 256 + lane * 4);
      u32x2 bq = *(const u32x2*)(p.o_bw + (size_t)row * 1024 + hd * 256 + lane * 4);
      float v0 = bflo(a[0]) + bflo(bq[0]), v1 = bfhi(a[0]) + bfhi(bq[0]), v2 = bflo(a[1]) + bflo(bq[1]), v3 = bfhi(a[1]) + bfhi(bq[1]);
      float ss = wave_sum(v0 * v0 + v1 * v1 + v2 * v2 + v3 * v3);
      if (lane == 0) p.rstd[row * 4 + hd] = rsqrtf(ss * (1.f / 256.f) + RMS_EPS);
    }
  }
  phase_norm_mod(p.x, p.norm1_g, p.mod, 0, 1024, p.hA, tid);
  for (int row = blockIdx.x * 8 + w; row < 32768; row += gridDim.x * 8) {
    const bool isv = row >= 16384;
    const int r = row & 16383;
    const float* srcp = (isv ? p.peer_v : p.peer_u) + (size_t)r * 1024 + lane * 16;
    float4 a0 = *(const float4*)(srcp), a1 = *(const float4*)(srcp + 4), a2 = *(const float4*)(srcp + 8), a3 = *(const float4*)(srcp + 12);
    float am = fmaxf(fmaxf(fmaxf(fabsf(a0.x), fabsf(a0.y)), fmaxf(fabsf(a0.z), fabsf(a0.w))), fmaxf(fmaxf(fabsf(a1.x), fabsf(a1.y)), fmaxf(fabsf(a1.z), fabsf(a1.w))));
    am = fmaxf(am, fmaxf(fmaxf(fmaxf(fabsf(a2.x), fabsf(a2.y)), fmaxf(fabsf(a2.z), fabsf(a2.w))), fmaxf(fmaxf(fabsf(a3.x), fabsf(a3.y)), fmaxf(fabsf(a3.z), fabsf(a3.w)))));
#pragma unroll
    for (int o = 32; o >= 1; o >>= 1) am = fmaxf(am, __shfl_xor(am, o));
    am = fmaxf(am, 1e-30f);
    const float sc = 256.f / am;
    u32x4 v;
    int t0 = __builtin_amdgcn_cvt_pk_fp8_f32(a0.x * sc, a0.y * sc, 0, false); t0 = __builtin_amdgcn_cvt_pk_fp8_f32(a0.z * sc, a0.w * sc, t0, true);
    int t1 = __builtin_amdgcn_cvt_pk_fp8_f32(a1.x * sc, a1.y * sc, 0, false); t1 = __builtin_amdgcn_cvt_pk_fp8_f32(a1.z * sc, a1.w * sc, t1, true);
    int t2 = __builtin_amdgcn_cvt_pk_fp8_f32(a2.x * sc, a2.y * sc, 0, false); t2 = __builtin_amdgcn_cvt_pk_fp8_f32(a2.z * sc, a2.w * sc, t2, true);
    int t3 = __builtin_amdgcn_cvt_pk_fp8_f32(a3.x * sc, a3.y * sc, 0, false); t3 = __builtin_amdgcn_cvt_pk_fp8_f32(a3.z * sc, a3.w * sc, t3, true);
    v[0] = (unsigned)t0; v[1] = (unsigned)t1; v[2] = (unsigned)t2; v[3] = (unsigned)t3;
    unsigned char* dst = (unsigned char*)(isv ? p.vB : p.uB) + (size_t)r * 1024 + lane * 16;
    *(u32x4*)dst = v;
    if (lane == 0) (isv ? p.vs : p.us)[r] = am * (1.f / 256.f);
  }
}

DI void phase_gr(const Params& p, char* smem, int tid) {
  const int w = tid >> 6, lane = tid & 63, c = lane & 31, hh = lane >> 5;
  const int wm = w >> 1, wn = w & 1;
  for (int id = blockIdx.x; id < 128 * 8; id += gridDim.x) {
    int mt = id >> 3, nt = id & 7;
    int m0 = mt * 256, n0 = nt * 128;
    f32x16 acc[2][2]; zero_acc(acc);
    gemm_kloop(p.hA + (size_t)m0 * 1024, 1024, p.wgrT + (size_t)n0 * 1024, 1024, 1024, acc, (u16*)smem, tid);
#pragma unroll
    for (int mi = 0; mi < 2; ++mi)
#pragma unroll
      for (int ni = 0; ni < 2; ++ni) {
        int col = n0 + wn * 64 + ni * 32 + c;
        float gn = p.gla_norm_g[col];
#pragma unroll
        for (int i = 0; i < 16; ++i) {
          int row = m0 + wm * 64 + mi * 32 + crow(i, hh);
          float a = acc[mi][ni][i];
          float sl = a / (1.f + __expf(-a));
          float ov = bf2f(p.o_fw[(size_t)row * 1024 + col]) + bf2f(p.o_bw[(size_t)row * 1024 + col]);
          p.A1[(size_t)row * 1024 + col] = f2bf(ov * p.rstd[row * 4 + (col >> 8)] * gn * sl);
        }
      }
  }
}

DI void phase_merge(const Params& p, char* smem, int tid) {
  const int w = tid >> 6, lane = tid & 63, c = lane & 31, hh = lane >> 5;
  const int wm = w >> 1, wn = w & 1;
  for (int id = blockIdx.x; id < 128 * 8; id += gridDim.x) {
    int mt = id >> 3, nt = id & 7;
    int m0 = mt * 256, n0 = nt * 128;
    f32x16 acc[2][2];
    unsigned gpk[2][2][8], mgp[2][2][8];
    zero_acc(acc);
    gemm_kloop(p.hA + (size_t)m0 * 1024, 1024, p.wgaT + (size_t)n0 * 1024, 1024, 1024, acc, (u16*)smem, tid);
#pragma unroll
    for (int mi = 0; mi < 2; ++mi)
#pragma unroll
      for (int ni = 0; ni < 2; ++ni)
#pragma unroll
        for (int i = 0; i < 8; ++i) gpk[mi][ni][i] = pack2(1.f / (1.f + __expf(-acc[mi][ni][2 * i])), 1.f / (1.f + __expf(-acc[mi][ni][2 * i + 1])));
    zero_acc(acc);
    gemm_kloop(p.A1 + (size_t)m0 * 1024, 1024, p.wglaT + (size_t)n0 * 1024, 1024, 1024, acc, (u16*)smem, tid);
#pragma unroll
    for (int mi = 0; mi < 2; ++mi)
#pragma unroll
      for (int ni = 0; ni < 2; ++ni)
#pragma unroll
        for (int i = 0; i < 8; ++i) mgp[mi][ni][i] = pack2(acc[mi][ni][2 * i] * bflo(gpk[mi][ni][i]), acc[mi][ni][2 * i + 1] * bfhi(gpk[mi][ni][i]));
    zero_acc(acc);
    gemm_kloop(p.hA + (size_t)m0 * 1024, 1024, p.wgbT + (size_t)n0 * 1024, 1024, 1024, acc, (u16*)smem, tid);
#pragma unroll
    for (int mi = 0; mi < 2; ++mi)
#pragma unroll
      for (int ni = 0; ni < 2; ++ni)
#pragma unroll
        for (int i = 0; i < 8; ++i) gpk[mi][ni][i] = pack2(1.f / (1.f + __expf(-acc[mi][ni][2 * i])), 1.f / (1.f + __expf(-acc[mi][ni][2 * i + 1])));
    zero_acc(acc);
    gemm_kloop(p.dq + (size_t)m0 * 1024, 1024, p.wdiffT + (size_t)n0 * 1024, 1024, 1024, acc, (u16*)smem, tid);
#pragma unroll
    for (int mi = 0; mi < 2; ++mi)
#pragma unroll
      for (int ni = 0; ni < 2; ++ni)
#pragma unroll
        for (int i = 0; i < 16; ++i) {
          float gv = (i & 1) ? bfhi(gpk[mi][ni][i >> 1]) : bflo(gpk[mi][ni][i >> 1]);
          float mv = (i & 1) ? bfhi(mgp[mi][ni][i >> 1]) : bflo(mgp[mi][ni][i >> 1]);
          float v = mv + acc[mi][ni][i] * gv;
          int row = m0 + wm * 64 + mi * 32 + crow(i, hh), col = n0 + wn * 64 + ni * 32 + c;
          p.merged[(size_t)row * 1024 + col] = f2bf(v);
        }
  }
}

DI void phase_out(const Params& p, char* smem, int tid) {
  const int w = tid >> 6, lane = tid & 63, c = lane & 31, hh = lane >> 5;
  const int wm = w >> 1, wn = w & 1;
  for (int id = blockIdx.x; id < 128 * 8; id += gridDim.x) {
    int mt = id >> 3, nt = id & 7;
    int m0 = mt * 256, n0 = nt * 128;
    f32x16 acc[2][2]; zero_acc(acc);
    gemm_kloop(p.merged + (size_t)m0 * 1024, 1024, p.woutT + (size_t)n0 * 1024, 1024, 1024, acc, (u16*)smem, tid);
    int b = m0 >> 13;
#pragma unroll
    for (int mi = 0; mi < 2; ++mi)
#pragma unroll
      for (int ni = 0; ni < 2; ++ni) {
        int col = n0 + wn * 64 + ni * 32 + c;
        float gate = p.mod[b * 6144 + 2048 + col];
#pragma unroll
        for (int i = 0; i < 16; ++i) {
          int row = m0 + wm * 64 + mi * 32 + crow(i, hh);
          p.x1[(size_t)row * 1024 + col] = p.x[(size_t)row * 1024 + col] + gate * acc[mi][ni][i];
        }
      }
  }
}

DI void phase_peerq(const Params& p, char* smem, int tid) {
  const int w = tid >> 6, lane = tid & 63, c = lane & 31, hh = lane >> 5;
  const int wm = w >> 1, wn = w & 1;
  for (int id = blockIdx.x; id < 128 * 16; id += gridDim.x) {
    int mt = id >> 4, nt = id & 15;
    int m0 = mt * 256, n0 = nt * 128;
    f32x16 acc[2][2]; zero_acc(acc);
    gemm_kloop(p.h2 + (size_t)m0 * 1024, 1024, p.wqT + (size_t)n0 * 1024, 1024, 1024, acc, (u16*)smem, tid);
#pragma unroll
    for (int mi = 0; mi < 2; ++mi)
#pragma unroll
      for (int ni = 0; ni < 2; ++ni)
#pragma unroll
        for (int i = 0; i < 16; ++i) {
          int row = m0 + wm * 64 + mi * 32 + crow(i, hh), col = n0 + wn * 64 + ni * 32 + c;
          p.qp[(size_t)row * 2048 + col] = f2bf(acc[mi][ni][i]);
        }
  }
}

DI unsigned fkey(float f) { unsigned u = __float_as_uint(f); return (u & 0x80000000u) ? ~u : (u | 0x80000000u); }
DI void phase_topk(const Params& p, char* smem, int tid) {
  float* sc = (float*)smem;
  float* ts = sc + 64 * 132;
  int* ti = (int*)(ts + 64 * 32);
  const int w = tid >> 6, lane = tid & 63, c = lane & 31, hh = lane >> 5;
  const int l16 = tid & 15, grp = tid >> 4;
  for (int item = blockIdx.x; item < 4096; item += gridDim.x) {
    const int h = item & 7;
    const size_t t0 = (size_t)(item >> 3) * 64;
#pragma unroll 1
    for (int pp = 0; pp < 2; ++pp) {
      f32x16 acc = zero16();
      const int nt = w & 3, mt = w >> 2;
      const u16* Aq = p.qp + t0 * 2048 + h * 256 + pp * 128;
      const u16* Bk = p.subk + (size_t)(h * 2 + pp) * 128 * 128;
#pragma unroll
      for (int s = 0; s < 8; ++s) {
        bf16x8 bfr = ld_frag16(Bk + (32 * nt + c) * 128 + 16 * s + 8 * hh);
        bf16x8 a0 = ld_frag16(Aq + (size_t)(32 * mt + c) * 2048 + 16 * s + 8 * hh);
        acc = MFMA(a0, bfr, acc);
      }
      __syncthreads();
#pragma unroll
      for (int i = 0; i < 16; ++i) sc[(mt * 32 + crow(i, hh)) * 132 + 32 * nt + c] = acc[i];
      __syncthreads();
      unsigned k[2][8], sel[2];
#pragma unroll
      for (int rr = 0; rr < 2; ++rr) {
        sel[rr] = 0;
#pragma unroll
        for (int m = 0; m < 8; ++m) { int n = l16 + 16 * m; k[rr][m] = (fkey(sc[(grp + 32 * rr) * 132 + n]) & ~127u) | (unsigned)(127 - n); }
      }
#pragma unroll 1
      for (int round = 0; round < 16; ++round) {
#pragma unroll
        for (int rr = 0; rr < 2; ++rr) {
          unsigned mx = max(max(max(k[rr][0], k[rr][1]), max(k[rr][2], k[rr][3])), max(max(k[rr][4], k[rr][5]), max(k[rr][6], k[rr][7])));
          mx = gmax16(mx);
          sel[rr] = (l16 == round) ? mx : sel[rr];
#pragma unroll
          for (int m = 0; m < 8; ++m) k[rr][m] = (k[rr][m] == mx) ? 0u : k[rr][m];
        }
      }
#pragma unroll
      for (int rr = 0; rr < 2; ++rr) {
        const int row = grp + 32 * rr;
        int n = 127 - (int)(sel[rr] & 127u);
        ti[(row * 2 + pp) * 16 + l16] = n;
        ts[(row * 2 + pp) * 16 + l16] = sc[row * 132 + n];
      }
    }
    __syncthreads();
    {
      float s0v[2]; int ptr[2]; unsigned selk[2];
#pragma unroll
      for (int rr = 0; rr < 2; ++rr) { s0v[rr] = ts[((grp + 32 * rr) * 2) * 16 + l16]; ptr[rr] = 0; selk[rr] = 0; }
#pragma unroll 1
      for (int round = 0; round < 16; ++round) {
#pragma unroll
        for (int rr = 0; rr < 2; ++rr) {
          const int row = grp + 32 * rr;
          float v = s0v[rr] + ts[(row * 2 + 1) * 16 + (ptr[rr] & 15)];
          unsigned key = (ptr[rr] < 16) ? ((fkey(v) & ~255u) | (unsigned)(255 - (l16 * 16 + ptr[rr]))) : 0u;
          unsigned mx = gmax16(key);
          selk[rr] = (l16 == round) ? mx : selk[rr];
          int aw = (255 - (int)(mx & 255u)) >> 4;
          ptr[rr] += (l16 == aw) ? 1 : 0;
        }
      }
#pragma unroll
      for (int rr = 0; rr < 2; ++rr) {
        const int row = grp + 32 * rr;
        int flat = 255 - (int)(selk[rr] & 255u);
        int aw = flat >> 4, bw = flat & 15;
        int my_idx = ti[(row * 2) * 16 + aw] * 128 + ti[(row * 2 + 1) * 16 + bw];
        float my_s = ts[(row * 2) * 16 + aw] + ts[(row * 2 + 1) * 16 + bw];
        float mxs = gmaxf16(my_s);
        float e = __expf(my_s - mxs);
        float sum = gsum16(e);
        p.idx[(t0 + row) * 128 + h * 16 + l16] = my_idx;
        p.g[(t0 + row) * 128 + h * 16 + l16] = e / sum;
      }
    }
    __syncthreads();
  }
}

DI void peer_load_batch(const unsigned char* tab, const float* rsc, int ireg, int ebase, int q, int gq, u32x4 (&buf)[4], float (&scl)[1]) {
#pragma unroll
  for (int rr = 0; rr < 1; ++rr) {
    int e = ebase + 4 * rr + gq;
    int row = __shfl(ireg, e & 63);
    const unsigned char* rp = tab + (size_t)row * 1024 + q * 16;
#pragma unroll
    for (int j = 0; j < 4; ++j) buf[rr * 4 + j] = *(const u32x4*)(rp + j * 256);
    scl[rr] = rsc[row];
  }
}
DI void peer_u_compute(const u32x4 (&buf)[4], const float (&scl)[1], const float (&hf)[64], float* wl, int ebase, int q, int gq) {
#pragma unroll
  for (int rr = 0; rr < 1; ++rr) {
    float acc = 0.f;
#pragma unroll
    for (int j = 0; j < 4; ++j)
#pragma unroll
      for (int i = 0; i < 4; ++i) {
        f32x2_t lo = __builtin_amdgcn_cvt_pk_f32_fp8((int)buf[rr * 4 + j][i], false);
        f32x2_t hi = __builtin_amdgcn_cvt_pk_f32_fp8((int)buf[rr * 4 + j][i], true);
        acc += lo[0] * hf[j * 16 + 4 * i] + lo[1] * hf[j * 16 + 4 * i + 1] + hi[0] * hf[j * 16 + 4 * i + 2] + hi[1] * hf[j * 16 + 4 * i + 3];
      }
    acc = gsum16(acc) * scl[rr];
    float act = 0.5f * acc * (1.f + erff(acc * 0.7071067811865476f));
    if (q == 0) wl[ebase + 4 * rr + gq] = act;
  }
}
DI void peer_v_compute(const u32x4 (&buf)[4], const float (&scl)[1], float (&o)[64], const float* wl, float greg, int ebase, int gq) {
#pragma unroll
  for (int rr = 0; rr < 1; ++rr) {
    const int e = ebase + 4 * rr + gq;
    float ge = __shfl(greg, e & 63);
    float wg = wl[e] * ge * scl[rr];
#pragma unroll
    for (int j = 0; j < 4; ++j)
#pragma unroll
      for (int i = 0; i < 4; ++i) {
        f32x2_t lo = __builtin_amdgcn_cvt_pk_f32_fp8((int)buf[rr * 4 + j][i], false);
        f32x2_t hi = __builtin_amdgcn_cvt_pk_f32_fp8((int)buf[rr * 4 + j][i], true);
        o[j * 16 + 4 * i] += wg * lo[0]; o[j * 16 + 4 * i + 1] += wg * lo[1];
        o[j * 16 + 4 * i + 2] += wg * hi[0]; o[j * 16 + 4 * i + 3] += wg * hi[1];
      }
  }
}
DI void phase_peer_final(const Params& p, char* smem, int tid) {
  const int w = tid >> 6, lane = tid & 63, q = lane & 15, gq = lane >> 4;
  float* wl = (float*)smem + w * 128;
  const unsigned char* U8 = (const unsigned char*)p.uB;
  const unsigned char* V8 = (const unsigned char*)p.vB;
  for (int item = blockIdx.x; item < T / 8; item += gridDim.x) {
    const size_t t = (size_t)item * 8 + w;
    const int b = (int)(t >> 13);
    float hf[64];
#pragma unroll
    for (int j = 0; j < 4; ++j) {
      u32x4 ha = *(const u32x4*)(p.h2 + t * 1024 + (q + 16 * j) * 16);
      u32x4 hb = *(const u32x4*)(p.h2 + t * 1024 + (q + 16 * j) * 16 + 8);
#pragma unroll
      for (int i = 0; i < 4; ++i) { hf[j * 16 + 2 * i] = bflo(ha[i]); hf[j * 16 + 2 * i + 1] = bfhi(ha[i]); hf[j * 16 + 8 + 2 * i] = bflo(hb[i]); hf[j * 16 + 8 + 2 * i + 1] = bfhi(hb[i]); }
    }
    const int i0 = p.idx[t * 128 + lane], i1 = p.idx[t * 128 + 64 + lane];
    const float g0 = p.g[t * 128 + lane], g1 = p.g[t * 128 + 64 + lane];
    u32x4 bA[4], bB[4]; float sA[1], sB[1];
    peer_load_batch(U8, p.us, i0, 0, q, gq, bA, sA);
#pragma unroll 1
    for (int it = 0; it < 16; ++it) {
      const int e0 = 8 * it;
      peer_load_batch(U8, p.us, (e0 & 64) ? i1 : i0, e0 + 4, q, gq, bB, sB);
      peer_u_compute(bA, sA, hf, wl, e0, q, gq);
      if (it < 15) peer_load_batch(U8, p.us, ((e0 + 8) & 64) ? i1 : i0, e0 + 8, q, gq, bA, sA);
      else peer_load_batch(V8, p.vs, i0, 0, q, gq, bA, sA);
      peer_u_compute(bB, sB, hf, wl, e0 + 4, q, gq);
    }
    __syncthreads();
    float o[64];
#pragma unroll
    for (int i = 0; i < 64; ++i) o[i] = 0.f;
#pragma unroll 1
    for (int it = 0; it < 16; ++it) {
      const int e0 = 8 * it;
      peer_load_batch(V8, p.vs, (e0 & 64) ? i1 : i0, e0 + 4, q, gq, bB, sB);
      peer_v_compute(bA, sA, o, wl, (e0 & 64) ? g1 : g0, e0, gq);
      if (it < 15) peer_load_batch(V8, p.vs, ((e0 + 8) & 64) ? i1 : i0, e0 + 8, q, gq, bA, sA);
      peer_v_compute(bB, sB, o, wl, (e0 & 64) ? g1 : g0, e0 + 4, gq);
    }
    float h1[32];
#pragma unroll
    for (int i = 0; i < 32; ++i) {
      float send = (gq < 2) ? o[32 + i] : o[i];
      float keep = (gq < 2) ? o[i] : o[32 + i];
      h1[i] = keep + __shfl_xor(send, 32);
    }
    float fin[16];
#pragma unroll
    for (int i = 0; i < 16; ++i) {
      float send = (gq & 1) ? h1[i] : h1[16 + i];
      float keep = (gq & 1) ? h1[16 + i] : h1[i];
      fin[i] = keep + __shfl_xor(send, 16);
    }
    const int colb = (q + 16 * gq) * 16;
    float ss = 0.f;
#pragma unroll
    for (int i4 = 0; i4 < 4; ++i4) {
      float4 xa = *(const float4*)(p.x1 + t * 1024 + colb + 4 * i4);
      float4 ga = *(const float4*)(p.mod + b * 6144 + 5120 + colb + 4 * i4);
      fin[4 * i4 + 0] = xa.x + ga.x * fin[4 * i4 + 0]; fin[4 * i4 + 1] = xa.y + ga.y * fin[4 * i4 + 1];
      fin[4 * i4 + 2] = xa.z + ga.z * fin[4 * i4 + 2]; fin[4 * i4 + 3] = xa.w + ga.w * fin[4 * i4 + 3];
      ss += fin[4 * i4] * fin[4 * i4] + fin[4 * i4 + 1] * fin[4 * i4 + 1] + fin[4 * i4 + 2] * fin[4 * i4 + 2] + fin[4 * i4 + 3] * fin[4 * i4 + 3];
    }
    ss = wave_sum(ss);
    const float rstd = rsqrtf(ss * (1.f / 1024.f) + RMS_EPS);
#pragma unroll
    for (int i4 = 0; i4 < 4; ++i4) {
      int col = colb + 4 * i4;
      float4 gg = *(const float4*)(p.normf_g + col);
      float4 sh = *(const float4*)(p.fmod + b * 2048 + col);
      float4 sc = *(const float4*)(p.fmod + b * 2048 + 1024 + col);
      float4 r;
      r.x = fin[4 * i4 + 0] * rstd * gg.x * (1.f + sc.x) + sh.x;
      r.y = fin[4 * i4 + 1] * rstd * gg.y * (1.f + sc.y) + sh.y;
      r.z = fin[4 * i4 + 2] * rstd * gg.z * (1.f + sc.z) + sh.z;
      r.w = fin[4 * i4 + 3] * rstd * gg.w * (1.f + sc.w) + sh.w;
      *(float4*)(p.out + t * 1024 + col) = r;
    }
    __syncthreads();
  }
}

__global__ void __launch_bounds__(512) fwd_megakernel(Params p) {
  cg::grid_group grid = cg::this_grid();
  extern __shared__ __attribute__((aligned(16))) char smem[];
  const int tid = threadIdx.x;
  phase_prep(p, smem, tid);
  grid.sync();
  phase_norm_mod(p.x, p.norm1_g, p.mod, 0, 1024, p.hA, tid);
  grid.sync();
  phase_proj(p, smem, tid);
  grid.sync();
  phase_gla_pre(p, smem, tid);
  grid.sync();
  phase_mixers(p, smem, tid);
  grid.sync();
  phase_post_mixers(p, tid);
  grid.sync();
  phase_gr(p, smem, tid);
  grid.sync();
  phase_merge(p, smem, tid);
  grid.sync();
  phase_out(p, smem, tid);
  grid.sync();
  phase_norm_mod(p.x1, p.norm2_g, p.mod, 3072, 4096, p.h2, tid);
  grid.sync();
  phase_peerq(p, smem, tid);
  grid.sync();
  phase_topk(p, smem, tid);
  grid.sync();
  phase_peer_final(p, smem, tid);
}

extern "C" void kernel_launch(void* const* d_in, const int* in_sizes, int n_in, void* d_out, int out_size, void* d_ws,
                              size_t ws_size, hipStream_t stream) {
  static int grid_blocks = 0;
  if (!grid_blocks) {
    int dev = 0, cus = 0, per_cu = 0;
    hipGetDevice(&dev);
    hipDeviceGetAttribute(&cus, hipDeviceAttributeMultiprocessorCount, dev);
    if (hipFuncSetAttribute((const void*)fwd_megakernel, hipFuncAttributeMaxDynamicSharedMemorySize, LDS_BYTES) != hipSuccess) { fprintf(stderr, "hipFuncSetAttribute failed\n"); }
    hipOccupancyMaxActiveBlocksPerMultiprocessor(&per_cu, fwd_megakernel, 512, LDS_BYTES);
    if (per_cu < 1) per_cu = 1;
    grid_blocks = cus * per_cu;
  }
  if (ws_size < 492 * MB) { fprintf(stderr, "ws too small: %zu\n", ws_size); return; }
  Params p{};
  p.x = (const float*)d_in[0]; p.c = (const float*)d_in[1]; p.pos = (const int*)d_in[2];
  p.w_ada = (const float*)d_in[3]; p.b_ada = (const float*)d_in[4]; p.norm1_g = (const float*)d_in[5];
  p.w_in = (const float*)d_in[6]; p.wa_fw = (const float*)d_in[7]; p.ba_fw = (const float*)d_in[8];
  p.wa_bw = (const float*)d_in[9]; p.ba_bw = (const float*)d_in[10]; p.gla_norm_g = (const float*)d_in[11];
  p.lq1 = (const float*)d_in[12]; p.lk1 = (const float*)d_in[13]; p.lq2 = (const float*)d_in[14]; p.lk2 = (const float*)d_in[15];
  p.diff_norm_g = (const float*)d_in[16]; p.w_gla = (const float*)d_in[17]; p.w_diff = (const float*)d_in[18];
  p.w_out = (const float*)d_in[19]; p.norm2_g = (const float*)d_in[20]; p.peer_wq = (const float*)d_in[21];
  p.subkeys = (const float*)d_in[22]; p.peer_u = (const float*)d_in[23]; p.peer_v = (const float*)d_in[24];
  p.w_fada = (const float*)d_in[25]; p.b_fada = (const float*)d_in[26]; p.normf_g = (const float*)d_in[27];
  p.out = (float*)d_out;
  char* ws = (char*)d_ws;
  p.winT = (u16*)(ws + 0 * MB); p.wgrT = (u16*)(ws + 11 * MB); p.wgaT = (u16*)(ws + 13 * MB); p.wgbT = (u16*)(ws + 15 * MB);
  p.wglaT = (u16*)(ws + 17 * MB); p.wdiffT = (u16*)(ws + 19 * MB); p.woutT = (u16*)(ws + 21 * MB); p.wqT = (u16*)(ws + 23 * MB);
  p.subk = (u16*)(ws + 27 * MB); p.rope = (float*)(ws + 28 * MB);
  p.mod = (float*)(ws + 36 * MB); p.fmod = (float*)(ws + 36 * MB + 128 * 1024); p.lam = (float*)(ws + 36 * MB + 192 * 1024);
  p.counter = (int*)(ws + 36 * MB + 196 * 1024);
  p.lr = (float*)(ws + 37 * MB); p.dec = (float*)(ws + 41 * MB); p.rstd = (float*)(ws + 43 * MB);
  char* slot[9];
  for (int i = 0; i < 7; ++i) slot[i] = ws + (44 + 64 * (size_t)i) * MB;
  slot[7] = (char*)d_out; slot[8] = (char*)d_out + 64 * MB;
  p.hA = (u16*)slot[0];
  p.gq = (u16*)slot[1]; p.gk = (u16*)(slot[1] + 32 * MB);
  p.gvT = (u16*)slot[2]; p.dq = (u16*)slot[3]; p.dk = (u16*)slot[4]; p.dvT = (u16*)slot[5];
  p.qe_fw = (u16*)slot[0]; p.ke_fw = (u16*)(slot[0] + 32 * MB);
  p.qe_bw = (u16*)slot[6]; p.ke_bw = (u16*)(slot[6] + 32 * MB);
  p.keT = (u16*)slot[7];
  p.o_fw = (u16*)slot[1]; p.o_bw = (u16*)slot[8];
  p.uB = (u16*)slot[6]; p.vB = (u16*)(slot[6] + 16 * MB);
  p.A1 = (u16*)slot[2]; p.merged = (u16*)slot[4];
  p.x1 = (float*)slot[0];
  p.h2 = (u16*)slot[2]; p.qp = (u16*)slot[3];
  p.us = (float*)(slot[6] + 32 * MB); p.vs = (float*)(slot[6] + 33 * MB);
  p.idx = (int*)slot[5]; p.g = (float*)(slot[5] + 16 * MB);
  void* args[] = {&p};
  hipError_t e = hipLaunchCooperativeKernel((void*)fwd_megakernel, dim3(grid_blocks), dim3(512), args, LDS_BYTES, stream);
  if (e != hipSuccess) fprintf(stderr, "cooperative launch failed: %s (grid %d)\n", hipGetErrorString(e), grid_blocks);
}
```

```cpp
#include <hip/hip_runtime.h>
#include <hip/hip_cooperative_groups.h>
#include <cstdio>
namespace cg = cooperative_groups;

#define DI __device__ __forceinline__
typedef unsigned short u16;
using bf16x8 = __attribute__((ext_vector_type(8))) short;
using f32x16 = __attribute__((ext_vector_type(16))) float;
using u32x4 = __attribute__((ext_vector_type(4))) unsigned;
using u32x2 = __attribute__((ext_vector_type(2))) unsigned;
typedef __bf16 bf16x2_t __attribute__((ext_vector_type(2)));
typedef float f32x2_t __attribute__((ext_vector_type(2)));

constexpr int T = 32768, D = 1024, S = 8192;
constexpr size_t MB = 1ull << 20;
constexpr float RMS_EPS = 1e-6f;
constexpr int LDS_BYTES = 144 * 1024;

#define MFMA(a, b, c) __builtin_amdgcn_mfma_f32_32x32x16_bf16((a), (b), (c), 0, 0, 0)

struct Params {
  const float *x, *c; const int* pos;
  const float *w_ada, *b_ada, *norm1_g, *w_in, *wa_fw, *ba_fw, *wa_bw, *ba_bw, *gla_norm_g;
  const float *lq1, *lk1, *lq2, *lk2, *diff_norm_g, *w_gla, *w_diff, *w_out, *norm2_g, *peer_wq, *subkeys, *peer_u, *peer_v;
  const float *w_fada, *b_fada, *normf_g;
  float* out;
  u16 *winT, *wgrT, *wgaT, *wgbT, *wglaT, *wdiffT, *woutT, *wqT, *subk;
  float* rope;
  float* mod;
  float* fmod;
  float* lam;
  int* counter;
  float* lr;
  float* dec;
  float* rstd;
  u16 *hA, *gq, *gk, *gvT, *dq, *dk, *dvT;
  u16 *qe_fw, *ke_fw, *qe_bw, *ke_bw, *keT;
  u16 *o_fw, *o_bw, *A1, *merged, *h2, *qp, *uB, *vB;
  float* x1;
  int* idx; float* g;
  float *us, *vs;
  int* kmax;
};

DI u16 f2bf(float x) { unsigned u = __float_as_uint(x); u += 0x7fffu + ((u >> 16) & 1u); return (u16)(u >> 16); }
DI float bf2f(u16 b) { return __uint_as_float(((unsigned)b) << 16); }
DI unsigned pack2(float a, float b) {
  f32x2_t v = {a, b};
  bf16x2_t r = __builtin_convertvector(v, bf16x2_t);
  return __builtin_bit_cast(unsigned, r);
}
DI float bflo(unsigned u) { return __uint_as_float(u << 16); }
DI float bfhi(unsigned u) { return __uint_as_float(u & 0xffff0000u); }
DI int crow(int i, int h) { return (i & 3) + 8 * (i >> 2) + 4 * h; }
DI bf16x8 pack_step(const f32x16& x, int s) {
  u32x4 p;
  p[0] = pack2(x[8 * s + 0], x[8 * s + 1]);
  p[1] = pack2(x[8 * s + 2], x[8 * s + 3]);
  p[2] = pack2(x[8 * s + 4], x[8 * s + 5]);
  p[3] = pack2(x[8 * s + 6], x[8 * s + 7]);
  return __builtin_bit_cast(bf16x8, p);
}
DI bf16x8 ld_frag16(const u16* p) { return __builtin_bit_cast(bf16x8, *(const u32x4*)p); }
DI bf16x8 ld_frag8x2(const u16* p) {
  u32x2 lo = *(const u32x2*)p; u32x2 hi = *(const u32x2*)(p + 8);
  u32x4 v = {lo[0], lo[1], hi[0], hi[1]};
  return __builtin_bit_cast(bf16x8, v);
}
DI void st_perm(u16* rowp, int ch, u32x4 v) {
  u16* d = rowp + (ch >> 1) * 16 + (ch & 1) * 4;
  u32x2 lo = {v[0], v[1]}, hi = {v[2], v[3]};
  *(u32x2*)d = lo;
  *(u32x2*)(d + 8) = hi;
}
DI float wave_sum(float v) {
#pragma unroll
  for (int o = 32; o >= 1; o >>= 1) v += __shfl_xor(v, o);
  return v;
}

template <int CTRL> DI float dpp_f(float v) { return __builtin_bit_cast(float, __builtin_amdgcn_update_dpp(0, __builtin_bit_cast(int, v), CTRL, 0xF, 0xF, false)); }
template <int CTRL> DI unsigned dpp_u(unsigned v) { return (unsigned)__builtin_amdgcn_update_dpp(0, (int)v, CTRL, 0xF, 0xF, false); }
DI float gsum16(float v) { v += dpp_f<0x121>(v); v += dpp_f<0x122>(v); v += dpp_f<0x124>(v); v += dpp_f<0x128>(v); return v; }
DI float gmaxf16(float v) { v = fmaxf(v, dpp_f<0x121>(v)); v = fmaxf(v, dpp_f<0x122>(v)); v = fmaxf(v, dpp_f<0x124>(v)); v = fmaxf(v, dpp_f<0x128>(v)); return v; }
DI unsigned gmax16(unsigned v) { v = max(v, dpp_u<0x121>(v)); v = max(v, dpp_u<0x122>(v)); v = max(v, dpp_u<0x124>(v)); v = max(v, dpp_u<0x128>(v)); return v; }
DI f32x16 zero16() { f32x16 z; for (int i = 0; i < 16; ++i) z[i] = 0.f; return z; }

DI void tconv_tile(const float* src, int ld, int c0, int nc, u16* dst, int ct, int kt, float* sm, int tid) {
  __syncthreads();
  int cl = tid & 63, r0 = tid >> 6;
#pragma unroll
  for (int r = 0; r < 8; ++r) {
    int k = kt * 64 + r0 + 8 * r;
    int col = ct * 64 + cl;
    float v = (col < nc) ? src[(size_t)k * ld + c0 + col] : 0.f;
    sm[(r0 + 8 * r) * 65 + cl] = v;
  }
  __syncthreads();
#pragma unroll
  for (int r = 0; r < 8; ++r) {
    int col = r0 + 8 * r;
    int k = cl;
    dst[(size_t)(ct * 64 + col) * 1024 + kt * 64 + k] = f2bf(sm[k * 65 + col]);
  }
}

DI void phase_prep(const Params& p, char* smem, int tid) {
  float* sm = (float*)smem;
  const int nblk = gridDim.x, bid = blockIdx.x;
  const int NCT = 32 + 48 + 2 + 16 * 6 + 32;
  for (int it = bid; it < NCT * 16; it += nblk) {
    int ctg = it >> 4, kt = it & 15;
    const float* src; int ld, c0, nc; u16* dst; int ct;
    if (ctg < 32) { src = p.w_in; ld = 8224; c0 = 0; nc = 2048; dst = p.winT; ct = ctg; }
    else if (ctg < 80) { src = p.w_in; ld = 8224; c0 = 3104; nc = 3072; dst = p.winT + (size_t)2048 * 1024; ct = ctg - 32; }
    else if (ctg < 82) { src = p.w_in; ld = 8224; c0 = 3072; nc = 32; dst = p.winT + (size_t)5120 * 1024; ct = ctg - 80; }
    else if (ctg < 98) { src = p.w_in; ld = 8224; c0 = 2048; nc = 1024; dst = p.wgrT; ct = ctg - 82; }
    else if (ctg < 114) { src = p.w_in; ld = 8224; c0 = 6176; nc = 1024; dst = p.wgaT; ct = ctg - 98; }
    else if (ctg < 130) { src = p.w_in; ld = 8224; c0 = 7200; nc = 1024; dst = p.wgbT; ct = ctg - 114; }
    else if (ctg < 146) { src = p.w_gla; ld = 1024; c0 = 0; nc = 1024; dst = p.wglaT; ct = ctg - 130; }
    else if (ctg < 162) { src = p.w_diff; ld = 1024; c0 = 0; nc = 1024; dst = p.wdiffT; ct = ctg - 146; }
    else if (ctg < 178) { src = p.w_out; ld = 1024; c0 = 0; nc = 1024; dst = p.woutT; ct = ctg - 162; }
    else { src = p.peer_wq; ld = 2048; c0 = 0; nc = 2048; dst = p.wqT; ct = ctg - 178; }
    tconv_tile(src, ld, c0, nc, dst, ct, kt, sm, tid);
  }
  __syncthreads();
  const int gtid = bid * 512 + tid, gsz = nblk * 512;
  for (int i = gtid; i < 8 * 2 * 128 * 128; i += gsz) p.subk[i] = f2bf(p.subkeys[i]);
  for (int i = gtid; i < T * 32; i += gsz) {
    int t = i >> 5, d = i & 31;
    float inv = powf(10000.f, -(float)d / 32.f);
    float ang = (float)p.pos[t] * inv;
    double r = (double)ang * 0.15915494309189535;
    r -= rint(r);
    float rf = (float)r;
    p.rope[2 * i] = __builtin_amdgcn_cosf(rf);
    p.rope[2 * i + 1] = __builtin_amdgcn_sinf(rf);
  }
  if (gtid == 0) {
    float s1 = 0.f, s2 = 0.f;
    for (int i = 0; i < 64; ++i) { s1 += p.lq1[i] * p.lk1[i]; s2 += p.lq2[i] * p.lk2[i]; }
    p.lam[0] = expf(s1) - expf(s2) + 0.2f;
    for (int i = 0; i < 16; ++i) p.counter[i] = 0;
    for (int i = 0; i < 64; ++i) p.kmax[i] = 0;
  }
  {
    float* cact = sm;
    float* red = sm + 4096;
    __syncthreads();
    for (int i = tid; i < 4096; i += 512) { float v = p.c[i]; cact[i] = v / (1.f + __expf(-v)); }
    __syncthreads();
    int w = tid >> 6, lane = tid & 63;
    for (int it = bid; it < 128; it += nblk) {
      int col = it * 64 + lane;
      const float* W; int ld, cc;
      if (col < 6144) { W = p.w_ada; ld = 6144; cc = col; } else { W = p.w_fada; ld = 2048; cc = col - 6144; }
      float a0 = 0, a1 = 0, a2 = 0, a3 = 0;
#pragma unroll 8
      for (int k = w * 128; k < w * 128 + 128; ++k) {
        float wv = W[(size_t)k * ld + cc];
        a0 += cact[k] * wv; a1 += cact[1024 + k] * wv; a2 += cact[2048 + k] * wv; a3 += cact[3072 + k] * wv;
      }
      red[(w * 4 + 0) * 64 + lane] = a0; red[(w * 4 + 1) * 64 + lane] = a1;
      red[(w * 4 + 2) * 64 + lane] = a2; red[(w * 4 + 3) * 64 + lane] = a3;
      __syncthreads();
      if (tid < 256) {
        int b = w;
        float s = 0.f;
#pragma unroll
        for (int ww = 0; ww < 8; ++ww) s += red[(ww * 4 + b) * 64 + lane];
        if (col < 6144) p.mod[b * 6144 + cc] = s + p.b_ada[cc];
        else p.fmod[b * 2048 + cc] = s + p.b_fada[cc];
      }
      __syncthreads();
    }
  }
}

DI void phase_norm_mod(const float* src, const float* g, const float* mod, int sh_off, int sc_off, u16* dst, int tid) {
  int w = tid >> 6, lane = tid & 63;
  for (int row = blockIdx.x * 8 + w; row < T; row += gridDim.x * 8) {
    int b = row >> 13;
    const float* xr = src + (size_t)row * 1024;
    float4 v[4]; float ss = 0.f;
#pragma unroll
    for (int m = 0; m < 4; ++m) { v[m] = *(const float4*)(xr + (m * 64 + lane) * 4); ss += v[m].x * v[m].x + v[m].y * v[m].y + v[m].z * v[m].z + v[m].w * v[m].w; }
    ss = wave_sum(ss);
    float rstd = rsqrtf(ss * (1.f / 1024.f) + RMS_EPS);
#pragma unroll
    for (int m = 0; m < 4; ++m) {
      int col = (m * 64 + lane) * 4;
      float4 gg = *(const float4*)(g + col);
      float4 sh = *(const float4*)(mod + b * 6144 + sh_off + col);
      float4 sc = *(const float4*)(mod + b * 6144 + sc_off + col);
      float y0 = v[m].x * rstd * gg.x * (1.f + sc.x) + sh.x;
      float y1 = v[m].y * rstd * gg.y * (1.f + sc.y) + sh.y;
      float y2 = v[m].z * rstd * gg.z * (1.f + sc.z) + sh.z;
      float y3 = v[m].w * rstd * gg.w * (1.f + sc.w) + sh.w;
      u32x2 o = {pack2(y0, y1), pack2(y2, y3)};
      *(u32x2*)(dst + (size_t)row * 1024 + col) = o;
    }
  }
}

constexpr int GLD = 72;
constexpr int GSTAGE = (256 + 128) * GLD;
DI void gemm_kloop(const u16* A, int lda, const u16* Bt, int ldb, int K, f32x16 (&acc)[2][2], u16* smem, int tid) {
  const int w = tid >> 6, lane = tid & 63, c = lane & 31, hh = lane >> 5;
  const int wm = w >> 1, wn = w & 1;
  const int lrow = tid >> 3, lcol = (tid & 7) * 8;
  u32x4 ra[4], rb[2];
  const int nk = K >> 6;
#pragma unroll
  for (int r = 0; r < 4; ++r) ra[r] = *(const u32x4*)(A + (size_t)(r * 64 + lrow) * lda + lcol);
#pragma unroll
  for (int r = 0; r < 2; ++r) rb[r] = *(const u32x4*)(Bt + (size_t)(r * 64 + lrow) * ldb + lcol);
  __syncthreads();
  {
    u16* sA = smem; u16* sB = smem + 256 * GLD;
#pragma unroll
    for (int r = 0; r < 4; ++r) *(u32x4*)(sA + (r * 64 + lrow) * GLD + lcol) = ra[r];
#pragma unroll
    for (int r = 0; r < 2; ++r) *(u32x4*)(sB + (r * 64 + lrow) * GLD + lcol) = rb[r];
  }
  if (nk > 1) {
#pragma unroll
    for (int r = 0; r < 4; ++r) ra[r] = *(const u32x4*)(A + (size_t)(r * 64 + lrow) * lda + 64 + lcol);
#pragma unroll
    for (int r = 0; r < 2; ++r) rb[r] = *(const u32x4*)(Bt + (size_t)(r * 64 + lrow) * ldb + 64 + lcol);
  }
  __syncthreads();
  for (int kt = 0; kt < nk; ++kt) {
    const u16* sA = smem + (kt & 1) * GSTAGE; const u16* sB = sA + 256 * GLD;
    if (kt + 1 < nk) {
      u16* nA = smem + ((kt + 1) & 1) * GSTAGE; u16* nB = nA + 256 * GLD;
#pragma unroll
      for (int r = 0; r < 4; ++r) *(u32x4*)(nA + (r * 64 + lrow) * GLD + lcol) = ra[r];
#pragma unroll
      for (int r = 0; r < 2; ++r) *(u32x4*)(nB + (r * 64 + lrow) * GLD + lcol) = rb[r];
      if (kt + 2 < nk) {
#pragma unroll
        for (int r = 0; r < 4; ++r) ra[r] = *(const u32x4*)(A + (size_t)(r * 64 + lrow) * lda + (kt + 2) * 64 + lcol);
#pragma unroll
        for (int r = 0; r < 2; ++r) rb[r] = *(const u32x4*)(Bt + (size_t)(r * 64 + lrow) * ldb + (kt + 2) * 64 + lcol);
      }
    }
#pragma unroll
    for (int s = 0; s < 4; ++s) {
      bf16x8 a0 = ld_frag16(sA + (wm * 64 + c) * GLD + s * 16 + hh * 8);
      bf16x8 a1 = ld_frag16(sA + (wm * 64 + 32 + c) * GLD + s * 16 + hh * 8);
      bf16x8 b0 = ld_frag16(sB + (wn * 64 + c) * GLD + s * 16 + hh * 8);
      bf16x8 b1 = ld_frag16(sB + (wn * 64 + 32 + c) * GLD + s * 16 + hh * 8);
      acc[0][0] = MFMA(a0, b0, acc[0][0]);
      acc[0][1] = MFMA(a0, b1, acc[0][1]);
      acc[1][0] = MFMA(a1, b0, acc[1][0]);
      acc[1][1] = MFMA(a1, b1, acc[1][1]);
    }
    __syncthreads();
  }
}
DI void zero_acc(f32x16 (&acc)[2][2]) {
#pragma unroll
  for (int a = 0; a < 2; ++a)
#pragma unroll
    for (int b = 0; b < 2; ++b) acc[a][b] = zero16();
}

DI void phase_proj(const Params& p, char* smem, int tid) {
  const int w = tid >> 6, lane = tid & 63, c = lane & 31, hh = lane >> 5;
  const int wm = w >> 1, wn = w & 1;
  const int NT = 41;
  for (int id = blockIdx.x; id < 128 * NT; id += gridDim.x) {
    int mt = id / NT, nt = id - mt * NT;
    int m0 = mt * 256, n0 = nt * 128;
    f32x16 acc[2][2]; zero_acc(acc);
    gemm_kloop(p.hA + (size_t)m0 * 1024, 1024, p.winT + (size_t)n0 * 1024, 1024, 1024, acc, (u16*)smem, tid);
    const int rb = m0 + wm * 64, cb = n0 + wn * 64;
    if (n0 < 1024) {
      float sc = (n0 < 512) ? 0.08838834764831845f : 1.f;
      u16* dst = (n0 < 512) ? p.gq : p.gk;
      int cbb = cb & 511;
#pragma unroll
      for (int mi = 0; mi < 2; ++mi)
#pragma unroll
        for (int ni = 0; ni < 2; ++ni)
#pragma unroll
          for (int i = 0; i < 16; ++i) {
            int row = rb + mi * 32 + crow(i, hh), col = cbb + ni * 32 + c;
            dst[(size_t)row * 512 + col] = f2bf(acc[mi][ni][i] * sc);
          }
    } else if (n0 < 2048 || (n0 >= 4096 && n0 < 5120)) {
      bool isg = n0 < 2048;
#pragma unroll
      for (int mi = 0; mi < 2; ++mi)
#pragma unroll
        for (int ni = 0; ni < 2; ++ni) {
          int col = cb + ni * 32 + c;
          size_t rowbase;
          int b = rb >> 13;
          if (isg) { int cc = col - 1024; rowbase = ((size_t)(b * 4 + (cc >> 8)) * 256 + (cc & 255)) * 8192; }
          else { int cc = col - 4096; rowbase = ((size_t)(b * 8 + (cc >> 7)) * 128 + (cc & 127)) * 8192; }
          u16* dst = (isg ? p.gvT : p.dvT) + rowbase;
#pragma unroll
          for (int g = 0; g < 4; ++g) {
            int s = ((rb + mi * 32) & 8191) + 8 * g + 4 * hh;
            u32x2 v = {pack2(acc[mi][ni][4 * g], acc[mi][ni][4 * g + 1]), pack2(acc[mi][ni][4 * g + 2], acc[mi][ni][4 * g + 3])};
            *(u32x2*)(dst + s) = v;
          }
        }
    } else if (n0 < 4096) {
      bool isq = n0 < 3072;
      float sc = isq ? (0.125f * 1.4426950408889634f) : 1.f;
      u16* dst = isq ? p.dq : p.dk;
      int cbb = (cb - (isq ? 2048 : 3072));
      float knmax = 0.f;
#pragma unroll
      for (int mi = 0; mi < 2; ++mi)
#pragma unroll
        for (int i = 0; i < 16; ++i) {
          int row = rb + mi * 32 + crow(i, hh);
          float2 cs = *(const float2*)(p.rope + ((size_t)row * 32 + c) * 2);
          float x1 = acc[mi][0][i], x2 = acc[mi][1][i];
          float o1 = (x1 * cs.x - x2 * cs.y) * sc;
          float o2 = (x2 * cs.x + x1 * cs.y) * sc;
          dst[(size_t)row * 1024 + cbb + c] = f2bf(o1);
          dst[(size_t)row * 1024 + cbb + 32 + c] = f2bf(o2);
          if (!isq) {
            float ssq = o1 * o1 + o2 * o2;
            ssq += __shfl_xor(ssq, 1); ssq += __shfl_xor(ssq, 2); ssq += __shfl_xor(ssq, 4); ssq += __shfl_xor(ssq, 8); ssq += __shfl_xor(ssq, 16);
            knmax = fmaxf(knmax, ssq);
          }
        }
      if (!isq && c == 0) atomicMax(p.kmax + ((rb >> 13) * 8 + (cbb >> 7)) * 2 + ((cbb >> 6) & 1), __float_as_int(knmax));
    } else {
      if (wn == 0) {
#pragma unroll
        for (int mi = 0; mi < 2; ++mi)
#pragma unroll
          for (int i = 0; i < 16; ++i) {
            int row = rb + mi * 32 + crow(i, hh);
            p.lr[(size_t)row * 32 + c] = acc[mi][0][i];
          }
      }
    }
  }
}

DI float logsig(float x) { return fminf(x, 0.f) - __logf(1.f + __expf(-fabsf(x))); }

DI void phase_gla_pre(const Params& p, char* smem, int tid) {
  float* slr = (float*)smem;
  for (int it = blockIdx.x; it < 512; it += gridDim.x) {
    int b = it >> 7, ch = it & 127;
    size_t t0 = (size_t)b * 8192 + ch * 64;
    __syncthreads();
    for (int i = tid; i < 2048; i += 512) slr[i] = p.lr[t0 * 32 + i];
    __syncthreads();
#pragma unroll 1
    for (int cj = 0; cj < 1; ++cj) {
      int j = tid;
      int h = j >> 7, d = j & 127;
#pragma unroll 1
      for (int dir = 0; dir < 2; ++dir) {
        const float* wa = dir ? p.wa_bw : p.wa_fw;
        float wr[16];
#pragma unroll
        for (int r = 0; r < 16; ++r) wr[r] = wa[r * 512 + j];
        float ba = (dir ? p.ba_bw : p.ba_fw)[j];
        u16* qe = dir ? p.qe_bw : p.qe_fw;
        u16* ke = dir ? p.ke_bw : p.ke_fw;
        u16* keT = p.keT + (size_t)dir * (16ull * 128 * 8192) + ((size_t)(b * 4 + h) * 128 + d) * 8192 + ch * 64;
        float bsum = 0.f;
#pragma unroll 1
        for (int g8 = 0; g8 < 8; ++g8) {
          unsigned kk[8];
#pragma unroll
          for (int u = 0; u < 8; ++u) {
            int tt = g8 * 8 + u;
            int t = dir ? 63 - tt : tt;
            float pre = ba;
#pragma unroll
            for (int r = 0; r < 16; ++r) pre += slr[t * 32 + dir * 16 + r] * wr[r];
            bsum += logsig(pre) * (1.f / 16.f);
            float qv = bf2f(p.gq[(t0 + t) * 512 + j]);
            float kv = bf2f(p.gk[(t0 + t) * 512 + j]);
            float eb = __expf(bsum);
            u16 qo = f2bf(qv * eb);
            u16 ko = f2bf(kv / eb);
            qe[(t0 + t) * 512 + j] = qo;
            ke[(t0 + t) * 512 + j] = ko;
            kk[u] = ko;
          }
          u32x4 v;
          if (!dir) {
            v[0] = kk[0] | (kk[1] << 16); v[1] = kk[2] | (kk[3] << 16); v[2] = kk[4] | (kk[5] << 16); v[3] = kk[6] | (kk[7] << 16);
            *(u32x4*)(keT + g8 * 8) = v;
          } else {
            v[0] = kk[7] | (kk[6] << 16); v[1] = kk[5] | (kk[4] << 16); v[2] = kk[3] | (kk[2] << 16); v[3] = kk[1] | (kk[0] << 16);
            *(u32x4*)(keT + (56 - g8 * 8)) = v;
          }
        }
        p.dec[((size_t)(dir * 4 + b) * 128 + ch) * 512 + j] = __expf(bsum);
      }
    }
  }
}

constexpr int QLD = 136, TLD = 72;
DI void gla_scan_block(const Params& p, int g, char* smem, int tid) {
  const int dir = g & 1, bh = g >> 1;
  const int b = bh >> 2, h = bh & 3;
  const int w = tid >> 6, lane = tid & 63, c = lane & 31, hh = lane >> 5;
  const int slice = w;
  u16* sQ = (u16*)smem;
  u16* sK = sQ + 64 * QLD;
  u16* sKT = sK + 64 * QLD;
  u16* sVT = sKT + 128 * TLD;
  const u16* qe = (dir ? p.qe_bw : p.qe_fw) + (size_t)b * 8192 * 512 + h * 128;
  const u16* ke = (dir ? p.ke_bw : p.ke_fw) + (size_t)b * 8192 * 512 + h * 128;
  const u16* keT = p.keT + (size_t)dir * (16ull * 128 * 8192) + (size_t)bh * 128 * 8192;
  const u16* vT = p.gvT + (size_t)bh * 256 * 8192;
  const float* dec = p.dec + ((size_t)(dir * 4 + b) * 128) * 512 + h * 128;
  u16* o = dir ? p.o_bw : p.o_fw;
  f32x16 st[4];
#pragma unroll
  for (int i = 0; i < 4; ++i) st[i] = zero16();
  u32x4 rq[2], rk[2], rt[2];
  unsigned offq[2], offt[2];
#pragma unroll
  for (int r = 0; r < 2; ++r) {
    int id = tid + 512 * r;
    offq[r] = (unsigned)(((id >> 4) * 512 + (id & 15) * 8) * 2);
    offt[r] = (unsigned)(((id >> 3) * 8192 + (id & 7) * 8) * 2);
  }
  const unsigned offv = (unsigned)(((w * 32 + c) * 8192 + 4 * hh) * 2);
  {
    const int ch = dir ? 127 : 0;
#pragma unroll
    for (int r = 0; r < 2; ++r) {
      int id = tid + 512 * r;
      rq[r] = *(const u32x4*)((const char*)(qe + (size_t)ch * 64 * 512) + offq[r]);
      rk[r] = *(const u32x4*)((const char*)(ke + (size_t)ch * 64 * 512) + offq[r]);
      rt[r] = *(const u32x4*)((const char*)(keT + ch * 64) + offt[r]);
    }
  }
#pragma unroll 1
  for (int ci = 0; ci < 128; ++ci) {
    const int ch = dir ? 127 - ci : ci;
    const size_t t0 = (size_t)b * 8192 + ch * 64;
    __syncthreads();
#pragma unroll
    for (int r = 0; r < 2; ++r) {
      int id = tid + 512 * r;
      st_perm(sQ + (id >> 4) * QLD, id & 15, rq[r]);
      st_perm(sK + (id >> 4) * QLD, id & 15, rk[r]);
      st_perm(sKT + (id >> 3) * TLD, id & 7, rt[r]);
    }
    __syncthreads();
    if (ci + 1 < 128) {
      const int chn = dir ? ch - 1 : ch + 1;
#pragma unroll
      for (int r = 0; r < 2; ++r) {
        int id = tid + 512 * r;
        rq[r] = *(const u32x4*)((const char*)(qe + (size_t)chn * 64 * 512) + offq[r]);
        rk[r] = *(const u32x4*)((const char*)(ke + (size_t)chn * 64 * 512) + offq[r]);
        rt[r] = *(const u32x4*)((const char*)(keT + chn * 64) + offt[r]);
      }
    }
    bf16x8 vf[4];
#pragma unroll
    for (int k4 = 0; k4 < 4; ++k4) vf[k4] = ld_frag8x2((const u16*)((const char*)(vT + ch * 64 + 16 * k4) + offv));
#pragma unroll 1
    for (int qt = 0; qt < 2; ++qt) {
      f32x16 oacc = zero16();
#pragma unroll
      for (int ks = 0; ks < 8; ++ks) {
        bf16x8 sf = pack_step(st[ks >> 1], ks & 1);
        bf16x8 q0 = ld_frag16(sQ + (qt * 32 + c) * QLD + ks * 16 + 8 * hh);
        oacc = MFMA(q0, sf, oacc);
        if (ks & 1) __builtin_amdgcn_sched_barrier(0);
      }
#pragma unroll
      for (int kt = 0; kt < 2; ++kt) {
        bool skip = dir ? (kt < qt) : (kt > qt);
        if (skip) continue;
        f32x16 X = zero16();
#pragma unroll 1
        for (int ks = 0; ks < 8; ++ks) {
          bf16x8 kf = ld_frag16(sK + (kt * 32 + c) * QLD + ks * 16 + 8 * hh);
          bf16x8 qf = ld_frag16(sQ + (qt * 32 + c) * QLD + ks * 16 + 8 * hh);
          X = MFMA(kf, qf, X);
        }
        if (kt == qt) {
#pragma unroll
          for (int i = 0; i < 16; ++i) {
            int key = crow(i, hh);
            bool keep = dir ? (key >= c) : (key <= c);
            X[i] = keep ? X[i] : 0.f;
          }
        }
        oacc = MFMA(pack_step(X, 0), vf[kt * 2 + 0], oacc);
        oacc = MFMA(pack_step(X, 1), vf[kt * 2 + 1], oacc);
        __builtin_amdgcn_sched_barrier(0);
      }
#pragma unroll
      for (int i = 0; i < 16; ++i)
        o[(t0 + qt * 32 + crow(i, hh)) * 1024 + h * 256 + slice * 32 + c] = f2bf(oacc[i]);
      __builtin_amdgcn_sched_barrier(0);
    }
#pragma unroll
    for (int dt = 0; dt < 4; ++dt) {
#pragma unroll
      for (int k4 = 0; k4 < 4; ++k4) {
        bf16x8 kt_f = ld_frag16(sKT + (dt * 32 + c) * TLD + 16 * k4 + 8 * hh);
        st[dt] = MFMA(kt_f, vf[k4], st[dt]);
      }
#pragma unroll
      for (int gg = 0; gg < 4; ++gg) {
        float4 dv = *(const float4*)(dec + (size_t)ch * 512 + dt * 32 + 8 * gg + 4 * hh);
        st[dt][4 * gg + 0] *= dv.x; st[dt][4 * gg + 1] *= dv.y; st[dt][4 * gg + 2] *= dv.z; st[dt][4 * gg + 3] *= dv.w;
      }
      __builtin_amdgcn_sched_barrier(0);
    }
  }
}

constexpr int KLD = 136, VLD = 72;
constexpr int ATT_BUF = 64 * KLD + 128 * VLD;
DI void attn_item(const Params& p, int item, char* smem, int tid) {
  const int qb = item & 63, bh = item >> 6;
  const int b = bh >> 3, h = bh & 7;
  const int w = tid >> 6, lane = tid & 63, c = lane & 31, hh = lane >> 5;
  const int qg = w & 3, mp = w >> 2;
  u16* sbase = (u16*)smem;
  float* sex = (float*)(smem + 2 * ATT_BUF * 2);
  const size_t tq = (size_t)b * 8192 + qb * 128 + qg * 32 + c;
  bf16x8 qf[4];
#pragma unroll
  for (int s = 0; s < 4; ++s) qf[s] = ld_frag16(p.dq + tq * 1024 + h * 128 + mp * 64 + 16 * s + 8 * hh);
  f32x16 O[4];
#pragma unroll
  for (int dt = 0; dt < 4; ++dt) O[dt] = zero16();
  float lrun = 0.f;
  f32x16 negm;
  {
    float qn = 0.f;
#pragma unroll
    for (int s = 0; s < 4; ++s) {
      u32x4 qq = __builtin_bit_cast(u32x4, qf[s]);
#pragma unroll
      for (int i = 0; i < 4; ++i) { float x0 = bflo(qq[i]), x1 = bfhi(qq[i]); qn += x0 * x0 + x1 * x1; }
    }
    qn += __shfl_xor(qn, 32);
    float kn = __int_as_float(p.kmax[(b * 8 + h) * 2 + mp]);
    float mb = sqrtf(qn * kn) * 1.01f + 1e-3f;
#pragma unroll
    for (int i = 0; i < 16; ++i) negm[i] = -mb;
  }
  const u16* Kg = p.dk + (size_t)b * 8192 * 1024 + h * 128;
  const u16* Vg = p.dvT + (size_t)bh * 128 * 8192;
  u32x4 rk[2], rv[2];
#pragma unroll
  for (int r = 0; r < 2; ++r) {
    int id = tid + 512 * r;
    rk[r] = *(const u32x4*)(Kg + (size_t)(id >> 4) * 1024 + (id & 15) * 8);
    rv[r] = *(const u32x4*)(Vg + (size_t)(id >> 3) * 8192 + (id & 7) * 8);
  }
  __syncthreads();
#pragma unroll
  for (int r = 0; r < 2; ++r) {
    int id = tid + 512 * r;
    *(u32x4*)(sbase + (id >> 4) * KLD + (id & 15) * 8) = rk[r];
    st_perm(sbase + 64 * KLD + (id >> 3) * VLD, id & 7, rv[r]);
  }
#pragma unroll
  for (int r = 0; r < 2; ++r) {
    int id = tid + 512 * r;
    rk[r] = *(const u32x4*)(Kg + (size_t)(64 + (id >> 4)) * 1024 + (id & 15) * 8);
    rv[r] = *(const u32x4*)(Vg + (size_t)(id >> 3) * 8192 + 64 + (id & 7) * 8);
  }
  __syncthreads();
#pragma unroll 1
  for (int kt = 0; kt < 128; ++kt) {
    const u16* sK = sbase + (kt & 1) * ATT_BUF;
    const u16* sV = sK + 64 * KLD;
    if (kt + 1 < 128) {
      u16* nK = sbase + ((kt + 1) & 1) * ATT_BUF;
      u16* nV = nK + 64 * KLD;
#pragma unroll
      for (int r = 0; r < 2; ++r) {
        int id = tid + 512 * r;
        *(u32x4*)(nK + (id >> 4) * KLD + (id & 15) * 8) = rk[r];
        st_perm(nV + (id >> 3) * VLD, id & 7, rv[r]);
      }
      if (kt + 2 < 128) {
#pragma unroll
        for (int r = 0; r < 2; ++r) {
          int id = tid + 512 * r;
          rk[r] = *(const u32x4*)(Kg + (size_t)((kt + 2) * 64 + (id >> 4)) * 1024 + (id & 15) * 8);
          rv[r] = *(const u32x4*)(Vg + (size_t)(id >> 3) * 8192 + (kt + 2) * 64 + (id & 7) * 8);
        }
      }
    }
    f32x16 sacc[2];
#pragma unroll
    for (int s = 0; s < 4; ++s)
#pragma unroll
      for (int k2 = 0; k2 < 2; ++k2) {
        bf16x8 kfr = ld_frag16(sK + (k2 * 32 + c) * KLD + mp * 64 + 16 * s + 8 * hh);
        sacc[k2] = (s == 0) ? MFMA(kfr, qf[s], negm) : MFMA(kfr, qf[s], sacc[k2]);
      }
    f32x2_t ls2 = {0.f, 0.f};
#pragma unroll
    for (int k2 = 0; k2 < 2; ++k2)
#pragma unroll
      for (int i = 0; i < 8; ++i) {
        float e0 = __builtin_amdgcn_exp2f(sacc[k2][2 * i]), e1 = __builtin_amdgcn_exp2f(sacc[k2][2 * i + 1]);
        sacc[k2][2 * i] = e0; sacc[k2][2 * i + 1] = e1;
        f32x2_t ev = {e0, e1};
        ls2 += ev;
      }
    lrun += ls2[0] + ls2[1];
#pragma unroll
    for (int k2 = 0; k2 < 2; ++k2)
#pragma unroll
      for (int s2 = 0; s2 < 2; ++s2) {
        bf16x8 pfr = pack_step(sacc[k2], s2);
#pragma unroll
        for (int dt = 0; dt < 4; ++dt) {
          bf16x8 vfr = ld_frag16(sV + (dt * 32 + c) * VLD + k2 * 32 + s2 * 16 + 8 * hh);
          O[dt] = MFMA(vfr, pfr, O[dt]);
        }
      }
    __syncthreads();
  }
  float ltot = lrun + __shfl_xor(lrun, 32);
  if (mp == 1) {
    float sc = p.lam[0] / ltot;
#pragma unroll
    for (int dt = 0; dt < 4; ++dt)
#pragma unroll
      for (int i = 0; i < 16; ++i) sex[(qg * 64 + dt * 16 + i) * 64 + lane] = O[dt][i] * sc;
  }
  __syncthreads();
  if (mp == 0) {
    float i0 = 1.f / ltot;
    float ss = 0.f;
#pragma unroll
    for (int dt = 0; dt < 4; ++dt)
#pragma unroll
      for (int i = 0; i < 16; ++i) { float v = O[dt][i] * i0 - sex[(qg * 64 + dt * 16 + i) * 64 + lane]; O[dt][i] = v; ss += v * v; }
    ss += __shfl_xor(ss, 32);
    float rstd = rsqrtf(ss * (1.f / 128.f) + RMS_EPS) * 0.8f;
#pragma unroll
    for (int dt = 0; dt < 4; ++dt)
#pragma unroll
      for (int g = 0; g < 4; ++g) {
        int dv = dt * 32 + 8 * g + 4 * hh;
        float4 gg = *(const float4*)(p.diff_norm_g + h * 128 + dv);
        u32x2 v = {pack2(O[dt][4 * g] * rstd * gg.x, O[dt][4 * g + 1] * rstd * gg.y),
                   pack2(O[dt][4 * g + 2] * rstd * gg.z, O[dt][4 * g + 3] * rstd * gg.w)};
        *(u32x2*)(p.dq + tq * 1024 + h * 128 + dv) = v;
      }
  }
}

DI void phase_mixers(const Params& p, char* smem, int tid) {
  int* sitem = (int*)(smem + 143 * 1024);
  if (blockIdx.x < 32) gla_scan_block(p, blockIdx.x, smem, tid);
  for (;;) {
    __syncthreads();
    if (tid == 0) *sitem = atomicAdd(p.counter, 1);
    __syncthreads();
    int item = *sitem;
    if (item >= 2048) break;
    attn_item(p, item, smem, tid);
  }
}

DI void phase_post_mixers(const Params& p, int tid) {
  int w = tid >> 6, lane = tid & 63;
  for (int row = blockIdx.x * 8 + w; row < T; row += gridDim.x * 8) {
#pragma unroll
    for (int hd = 0; hd < 4; ++hd) {
      u32x2 a = *(const u32x2*)(p.o_fw + (size_t)row * 1024 + hd * 256 + lane * 4);
      u32x2 bq = *(const u32x2*)(p.o_bw + (size_t)row * 1024 + hd * 256 + lane * 4);
      float v0 = bflo(a[0]) + bflo(bq[0]), v1 = bfhi(a[0]) + bfhi(bq[0]), v2 = bflo(a[1]) + bflo(bq[1]), v3 = bfhi(a[1]) + bfhi(bq[1]);
      float ss = wave_sum(v0 * v0 + v1 * v1 + v2 * v2 + v3 * v3);
      if (lane == 0) p.rstd[row * 4 + hd] = rsqrtf(ss * (1.f / 256.f) + RMS_EPS);
    }
  }
  phase_norm_mod(p.x, p.norm1_g, p.mod, 0, 1024, p.hA, tid);
  for (int row = blockIdx.x * 8 + w; row < 32768; row += gridDim.x * 8) {
    const bool isv = row >= 16384;
    const int r = row & 16383;
    const float* srcp = (isv ? p.peer_v : p.peer_u) + (size_t)r * 1024 + lane * 16;
    float4 a0 = *(const float4*)(srcp), a1 = *(const float4*)(srcp + 4), a2 = *(const float4*)(srcp + 8), a3 = *(const float4*)(srcp + 12);
    float am = fmaxf(fmaxf(fmaxf(fabsf(a0.x), fabsf(a0.y)), fmaxf(fabsf(a0.z), fabsf(a0.w))), fmaxf(fmaxf(fabsf(a1.x), fabsf(a1.y)), fmaxf(fabsf(a1.z), fabsf(a1.w))));
    am = fmaxf(am, fmaxf(fmaxf(fmaxf(fabsf(a2.x), fabsf(a2.y)), fmaxf(fabsf(a2.z), fabsf(a2.w))), fmaxf(fmaxf(fabsf(a3.x), fabsf(a3.y)), fmaxf(fabsf(a3.z), fabsf(a3.w)))));
#pragma unroll
    for (int o = 32; o >= 1; o >>= 1) am = fmaxf(am, __shfl_xor(am, o));
    am = fmaxf(am, 1e-30f);
    const float sc = 256.f / am;
    u32x4 v;
    int t0 = __builtin_amdgcn_cvt_pk_fp8_f32(a0.x * sc, a0.y * sc, 0, false); t0 = __builtin_amdgcn_cvt_pk_fp8_f32(a0.z * sc, a0.w * sc, t0, true);
    int t1 = __builtin_amdgcn_cvt_pk_fp8_f32(a1.x * sc, a1.y * sc, 0, false); t1 = __builtin_amdgcn_cvt_pk_fp8_f32(a1.z * sc, a1.w * sc, t1, true);
    int t2 = __builtin_amdgcn_cvt_pk_fp8_f32(a2.x * sc, a2.y * sc, 0, false); t2 = __builtin_amdgcn_cvt_pk_fp8_f32(a2.z * sc, a2.w * sc, t2, true);
    int t3 = __builtin_amdgcn_cvt_pk_fp8_f32(a3.x * sc, a3.y * sc, 0, false); t3 = __builtin_amdgcn_cvt_pk_fp8_f32(a3.z * sc, a3.w * sc, t3, true);
    v[0] = (unsigned)t0; v[1] = (unsigned)t1; v[2] = (unsigned)t2; v[3] = (unsigned)t3;
    unsigned char* dst = (unsigned char*)(isv ? p.vB : p.uB) + (size_t)r * 1024 + lane * 16;
    *(u32x4*)dst = v;
    if (lane == 0) (isv ? p.vs : p.us)[r] = am * (1.f / 256.f);
  }
}

DI void phase_gr(const Params& p, char* smem, int tid) {
  const int w = tid >> 6, lane = tid & 63, c = lane & 31, hh = lane >> 5;
  const int wm = w >> 1, wn = w & 1;
  for (int id = blockIdx.x; id < 128 * 8; id += gridDim.x) {
    int mt = id >> 3, nt = id & 7;
    int m0 = mt * 256, n0 = nt * 128;
    f32x16 acc[2][2]; zero_acc(acc);
    gemm_kloop(p.hA + (size_t)m0 * 1024, 1024, p.wgrT + (size_t)n0 * 1024, 1024, 1024, acc, (u16*)smem, tid);
#pragma unroll
    for (int mi = 0; mi < 2; ++mi)
#pragma unroll
      for (int ni = 0; ni < 2; ++ni) {
        int col = n0 + wn * 64 + ni * 32 + c;
        float gn = p.gla_norm_g[col];
#pragma unroll
        for (int i = 0; i < 16; ++i) {
          int row = m0 + wm * 64 + mi * 32 + crow(i, hh);
          float a = acc[mi][ni][i];
          float sl = a / (1.f + __expf(-a));
          float ov = bf2f(p.o_fw[(size_t)row * 1024 + col]) + bf2f(p.o_bw[(size_t)row * 1024 + col]);
          p.A1[(size_t)row * 1024 + col] = f2bf(ov * p.rstd[row * 4 + (col >> 8)] * gn * sl);
        }
      }
  }
}

DI void phase_merge(const Params& p, char* smem, int tid) {
  const int w = tid >> 6, lane = tid & 63, c = lane & 31, hh = lane >> 5;
  const int wm = w >> 1, wn = w & 1;
  for (int id = blockIdx.x; id < 128 * 8; id += gridDim.x) {
    int mt = id >> 3, nt = id & 7;
    int m0 = mt * 256, n0 = nt * 128;
    f32x16 acc[2][2];
    unsigned gpk[2][2][8], mgp[2][2][8];
    zero_acc(acc);
    gemm_kloop(p.hA + (size_t)m0 * 1024, 1024, p.wgaT + (size_t)n0 * 1024, 1024, 1024, acc, (u16*)smem, tid);
#pragma unroll
    for (int mi = 0; mi < 2; ++mi)
#pragma unroll
      for (int ni = 0; ni < 2; ++ni)
#pragma unroll
        for (int i = 0; i < 8; ++i) gpk[mi][ni][i] = pack2(1.f / (1.f + __expf(-acc[mi][ni][2 * i])), 1.f / (1.f + __expf(-acc[mi][ni][2 * i + 1])));
    zero_acc(acc);
    gemm_kloop(p.A1 + (size_t)m0 * 1024, 1024, p.wglaT + (size_t)n0 * 1024, 1024, 1024, acc, (u16*)smem, tid);
#pragma unroll
    for (int mi = 0; mi < 2; ++mi)
#pragma unroll
      for (int ni = 0; ni < 2; ++ni)
#pragma unroll
        for (int i = 0; i < 8; ++i) mgp[mi][ni][i] = pack2(acc[mi][ni][2 * i] * bflo(gpk[mi][ni][i]), acc[mi][ni][2 * i + 1] * bfhi(gpk[mi][ni][i]));
    zero_acc(acc);
    gemm_kloop(p.hA + (size_t)m0 * 1024, 1024, p.wgbT + (size_t)n0 * 1024, 1024, 1024, acc, (u16*)smem, tid);
#pragma unroll
    for (int mi = 0; mi < 2; ++mi)
#pragma unroll
      for (int ni = 0; ni < 2; ++ni)
#pragma unroll
        for (int i = 0; i < 8; ++i) gpk[mi][ni][i] = pack2(1.f / (1.f + __expf(-acc[mi][ni][2 * i])), 1.f / (1.f + __expf(-acc[mi][ni][2 * i + 1])));
    zero_acc(acc);
    gemm_kloop(p.dq + (size_t)m0 * 1024, 1024, p.wdiffT + (size_t)n0 * 1024, 1024, 1024, acc, (u16*)smem, tid);
#pragma unroll
    for (int mi = 0; mi < 2; ++mi)
#pragma unroll
      for (int ni = 0; ni < 2; ++ni)
#pragma unroll
        for (int i = 0; i < 16; ++i) {
          float gv = (i & 1) ? bfhi(gpk[mi][ni][i >> 1]) : bflo(gpk[mi][ni][i >> 1]);
          float mv = (i & 1) ? bfhi(mgp[mi][ni][i >> 1]) : bflo(mgp[mi][ni][i >> 1]);
          float v = mv + acc[mi][ni][i] * gv;
          int row = m0 + wm * 64 + mi * 32 + crow(i, hh), col = n0 + wn * 64 + ni * 32 + c;
          p.merged[(size_t)row * 1024 + col] = f2bf(v);
        }
  }
}

DI void phase_out(const Params& p, char* smem, int tid) {
  const int w = tid >> 6, lane = tid & 63, c = lane & 31, hh = lane >> 5;
  const int wm = w >> 1, wn = w & 1;
  for (int id = blockIdx.x; id < 128 * 8; id += gridDim.x) {
    int mt = id >> 3, nt = id & 7;
    int m0 = mt * 256, n0 = nt * 128;
    f32x16 acc[2][2]; zero_acc(acc);
    gemm_kloop(p.merged + (size_t)m0 * 1024, 1024, p.woutT + (size_t)n0 * 1024, 1024, 1024, acc, (u16*)smem, tid);
    int b = m0 >> 13;
#pragma unroll
    for (int mi = 0; mi < 2; ++mi)
#pragma unroll
      for (int ni = 0; ni < 2; ++ni) {
        int col = n0 + wn * 64 + ni * 32 + c;
        float gate = p.mod[b * 6144 + 2048 + col];
#pragma unroll
        for (int i = 0; i < 16; ++i) {
          int row = m0 + wm * 64 + mi * 32 + crow(i, hh);
          p.x1[(size_t)row * 1024 + col] = p.x[(size_t)row * 1024 + col] + gate * acc[mi][ni][i];
        }
      }
  }
}

DI void phase_peerq(const Params& p, char* smem, int tid) {
  const int w = tid >> 6, lane = tid & 63, c = lane & 31, hh = lane >> 5;
  const int wm = w >> 1, wn = w & 1;
  for (int id = blockIdx.x; id < 128 * 16; id += gridDim.x) {
    int mt = id >> 4, nt = id & 15;
    int m0 = mt * 256, n0 = nt * 128;
    f32x16 acc[2][2]; zero_acc(acc);
    gemm_kloop(p.h2 + (size_t)m0 * 1024, 1024, p.wqT + (size_t)n0 * 1024, 1024, 1024, acc, (u16*)smem, tid);
#pragma unroll
    for (int mi = 0; mi < 2; ++mi)
#pragma unroll
      for (int ni = 0; ni < 2; ++ni)
#pragma unroll
        for (int i = 0; i < 16; ++i) {
          int row = m0 + wm * 64 + mi * 32 + crow(i, hh), col = n0 + wn * 64 + ni * 32 + c;
          p.qp[(size_t)row * 2048 + col] = f2bf(acc[mi][ni][i]);
        }
  }
}

DI unsigned fkey(float f) { unsigned u = __float_as_uint(f); return (u & 0x80000000u) ? ~u : (u | 0x80000000u); }
DI void phase_topk(const Params& p, char* smem, int tid) {
  float* sc = (float*)smem;
  float* ts = sc + 64 * 132;
  int* ti = (int*)(ts + 64 * 32);
  const int w = tid >> 6, lane = tid & 63, c = lane & 31, hh = lane >> 5;
  const int l16 = tid & 15, grp = tid >> 4;
  for (int item = blockIdx.x; item < 4096; item += gridDim.x) {
    const int h = item & 7;
    const size_t t0 = (size_t)(item >> 3) * 64;
#pragma unroll 1
    for (int pp = 0; pp < 2; ++pp) {
      f32x16 acc = zero16();
      const int nt = w & 3, mt = w >> 2;
      const u16* Aq = p.qp + t0 * 2048 + h * 256 + pp * 128;
      const u16* Bk = p.subk + (size_t)(h * 2 + pp) * 128 * 128;
#pragma unroll
      for (int s = 0; s < 8; ++s) {
        bf16x8 bfr = ld_frag16(Bk + (32 * nt + c) * 128 + 16 * s + 8 * hh);
        bf16x8 a0 = ld_frag16(Aq + (size_t)(32 * mt + c) * 2048 + 16 * s + 8 * hh);
        acc = MFMA(a0, bfr, acc);
      }
      __syncthreads();
#pragma unroll
      for (int i = 0; i < 16; ++i) sc[(mt * 32 + crow(i, hh)) * 132 + 32 * nt + c] = acc[i];
      __syncthreads();
      unsigned k[2][8], sel[2];
#pragma unroll
      for (int rr = 0; rr < 2; ++rr) {
        sel[rr] = 0;
#pragma unroll
        for (int m = 0; m < 8; ++m) { int n = l16 + 16 * m; k[rr][m] = (fkey(sc[(grp + 32 * rr) * 132 + n]) & ~127u) | (unsigned)(127 - n); }
      }
#pragma unroll 1
      for (int round = 0; round < 16; ++round) {
#pragma unroll
        for (int rr = 0; rr < 2; ++rr) {
          unsigned mx = max(max(max(k[rr][0], k[rr][1]), max(k[rr][2], k[rr][3])), max(max(k[rr][4], k[rr][5]), max(k[rr][6], k[rr][7])));
          mx = gmax16(mx);
          sel[rr] = (l16 == round) ? mx : sel[rr];
#pragma unroll
          for (int m = 0; m < 8; ++m) k[rr][m] = (k[rr][m] == mx) ? 0u : k[rr][m];
        }
      }
#pragma unroll
      for (int rr = 0; rr < 2; ++rr) {
        const int row = grp + 32 * rr;
        int n = 127 - (int)(sel[rr] & 127u);
        ti[(row * 2 + pp) * 16 + l16] = n;
        ts[(row * 2 + pp) * 16 + l16] = sc[row * 132 + n];
      }
    }
    __syncthreads();
    {
      float s0v[2]; int ptr[2]; unsigned selk[2];
#pragma unroll
      for (int rr = 0; rr < 2; ++rr) { s0v[rr] = ts[((grp + 32 * rr) * 2) * 16 + l16]; ptr[rr] = 0; selk[rr] = 0; }
#pragma unroll 1
      for (int round = 0; round < 16; ++round) {
#pragma unroll
        for (int rr = 0; rr < 2; ++rr) {
          const int row = grp + 32 * rr;
          float v = s0v[rr] + ts[(row * 2 + 1) * 16 + (ptr[rr] & 15)];
          unsigned key = (ptr[rr] < 16) ? ((fkey(v) & ~255u) | (unsigned)(255 - (l16 * 16 + ptr[rr]))) : 0u;
          unsigned mx = gmax16(key);
          selk[rr] = (l16 == round) ? mx : selk[rr];
          int aw = (255 - (int)(mx & 255u)) >> 4;
          ptr[rr] += (l16 == aw) ? 1 : 0;
        }
      }
#pragma unroll
      for (int rr = 0; rr < 2; ++rr) {
        const int row = grp + 32 * rr;
        int flat = 255 - (int)(selk[rr] & 255u);
        int aw = flat >> 4, bw = flat & 15;
        int my_idx = ti[(row * 2) * 16 + aw] * 128 + ti[(row * 2 + 1) * 16 + bw];
        float my_s = ts[(row * 2) * 16 + aw] + ts[(row * 2 + 1) * 16 + bw];
        float mxs = gmaxf16(my_s);
        float e = __expf(my_s - mxs);
        float sum = gsum16(e);
        p.idx[(t0 + row) * 128 + h * 16 + l16] = my_idx;
        p.g[(t0 + row) * 128 + h * 16 + l16] = e / sum;
      }
    }
    __syncthreads();
  }
}

DI void peer_load_batch(const unsigned char* tab, const float* rsc, int ireg, int ebase, int q, int gq, u32x4 (&buf)[4], float (&scl)[1]) {
#pragma unroll
  for (int rr = 0; rr < 1; ++rr) {
    int e = ebase + 4 * rr + gq;
    int row = __shfl(ireg, e & 63);
    const unsigned char* rp = tab + (size_t)row * 1024 + q * 16;
#pragma unroll
    for (int j = 0; j < 4; ++j) buf[rr * 4 + j] = *(const u32x4*)(rp + j * 256);
    scl[rr] = rsc[row];
  }
}
DI void peer_u_compute(const u32x4 (&buf)[4], const float (&scl)[1], const float (&hf)[64], float* wl, int ebase, int q, int gq) {
#pragma unroll
  for (int rr = 0; rr < 1; ++rr) {
    float acc = 0.f;
#pragma unroll
    for (int j = 0; j < 4; ++j)
#pragma unroll
      for (int i = 0; i < 4; ++i) {
        f32x2_t lo = __builtin_amdgcn_cvt_pk_f32_fp8((int)buf[rr * 4 + j][i], false);
        f32x2_t hi = __builtin_amdgcn_cvt_pk_f32_fp8((int)buf[rr * 4 + j][i], true);
        acc += lo[0] * hf[j * 16 + 4 * i] + lo[1] * hf[j * 16 + 4 * i + 1] + hi[0] * hf[j * 16 + 4 * i + 2] + hi[1] * hf[j * 16 + 4 * i + 3];
      }
    acc = gsum16(acc) * scl[rr];
    float act = 0.5f * acc * (1.f + erff(acc * 0.7071067811865476f));
    if (q == 0) wl[ebase + 4 * rr + gq] = act;
  }
}
DI void peer_v_compute(const u32x4 (&buf)[4], const float (&scl)[1], float (&o)[64], const float* wl, float greg, int ebase, int gq) {
#pragma unroll
  for (int rr = 0; rr < 1; ++rr) {
    const int e = ebase + 4 * rr + gq;
    float ge = __shfl(greg, e & 63);
    float wg = wl[e] * ge * scl[rr];
#pragma unroll
    for (int j = 0; j < 4; ++j)
#pragma unroll
      for (int i = 0; i < 4; ++i) {
        f32x2_t lo = __builtin_amdgcn_cvt_pk_f32_fp8((int)buf[rr * 4 + j][i], false);
        f32x2_t hi = __builtin_amdgcn_cvt_pk_f32_fp8((int)buf[rr * 4 + j][i], true);
        o[j * 16 + 4 * i] += wg * lo[0]; o[j * 16 + 4 * i + 1] += wg * lo[1];
        o[j * 16 + 4 * i + 2] += wg * hi[0]; o[j * 16 + 4 * i + 3] += wg * hi[1];
      }
  }
}
DI void phase_peer_final(const Params& p, char* smem, int tid) {
  const int w = tid >> 6, lane = tid & 63, q = lane & 15, gq = lane >> 4;
  float* wl = (float*)smem + w * 128;
  const unsigned char* U8 = (const unsigned char*)p.uB;
  const unsigned char* V8 = (const unsigned char*)p.vB;
  for (int item = blockIdx.x; item < T / 8; item += gridDim.x) {
    const size_t t = (size_t)item * 8 + w;
    const int b = (int)(t >> 13);
    float hf[64];
#pragma unroll
    for (int j = 0; j < 4; ++j) {
      u32x4 ha = *(const u32x4*)(p.h2 + t * 1024 + (q + 16 * j) * 16);
      u32x4 hb = *(const u32x4*)(p.h2 + t * 1024 + (q + 16 * j) * 16 + 8);
#pragma unroll
      for (int i = 0; i < 4; ++i) { hf[j * 16 + 2 * i] = bflo(ha[i]); hf[j * 16 + 2 * i + 1] = bfhi(ha[i]); hf[j * 16 + 8 + 2 * i] = bflo(hb[i]); hf[j * 16 + 8 + 2 * i + 1] = bfhi(hb[i]); }
    }
    const int i0 = p.idx[t * 128 + lane], i1 = p.idx[t * 128 + 64 + lane];
    const float g0 = p.g[t * 128 + lane], g1 = p.g[t * 128 + 64 + lane];
    u32x4 bA[4], bB[4]; float sA[1], sB[1];
    peer_load_batch(U8, p.us, i0, 0, q, gq, bA, sA);
#pragma unroll 1
    for (int it = 0; it < 16; ++it) {
      const int e0 = 8 * it;
      peer_load_batch(U8, p.us, (e0 & 64) ? i1 : i0, e0 + 4, q, gq, bB, sB);
      peer_u_compute(bA, sA, hf, wl, e0, q, gq);
      if (it < 15) peer_load_batch(U8, p.us, ((e0 + 8) & 64) ? i1 : i0, e0 + 8, q, gq, bA, sA);
      else peer_load_batch(V8, p.vs, i0, 0, q, gq, bA, sA);
      peer_u_compute(bB, sB, hf, wl, e0 + 4, q, gq);
    }
    __syncthreads();
    float o[64];
#pragma unroll
    for (int i = 0; i < 64; ++i) o[i] = 0.f;
#pragma unroll 1
    for (int it = 0; it < 16; ++it) {
      const int e0 = 8 * it;
      peer_load_batch(V8, p.vs, (e0 & 64) ? i1 : i0, e0 + 4, q, gq, bB, sB);
      peer_v_compute(bA, sA, o, wl, (e0 & 64) ? g1 : g0, e0, gq);
      if (it < 15) peer_load_batch(V8, p.vs, ((e0 + 8) & 64) ? i1 : i0, e0 + 8, q, gq, bA, sA);
      peer_v_compute(bB, sB, o, wl, (e0 & 64) ? g1 : g0, e0 + 4, gq);
    }
    float h1[32];
#pragma unroll
    for (int i = 0; i < 32; ++i) {
      float send = (gq < 2) ? o[32 + i] : o[i];
      float keep = (gq < 2) ? o[i] : o[32 + i];
      h1[i] = keep + __shfl_xor(send, 32);
    }
    float fin[16];
#pragma unroll
    for (int i = 0; i < 16; ++i) {
      float send = (gq & 1) ? h1[i] : h1[16 + i];
      float keep = (gq & 1) ? h1[16 + i] : h1[i];
      fin[i] = keep + __shfl_xor(send, 16);
    }
    const int colb = (q + 16 * gq) * 16;
    float ss = 0.f;
#pragma unroll
    for (int i4 = 0; i4 < 4; ++i4) {
      float4 xa = *(const float4*)(p.x1 + t * 1024 + colb + 4 * i4);
      float4 ga = *(const float4*)(p.mod + b * 6144 + 5120 + colb + 4 * i4);
      fin[4 * i4 + 0] = xa.x + ga.x * fin[4 * i4 + 0]; fin[4 * i4 + 1] = xa.y + ga.y * fin[4 * i4 + 1];
      fin[4 * i4 + 2] = xa.z + ga.z * fin[4 * i4 + 2]; fin[4 * i4 + 3] = xa.w + ga.w * fin[4 * i4 + 3];
      ss += fin[4 * i4] * fin[4 * i4] + fin[4 * i4 + 1] * fin[4 * i4 + 1] + fin[4 * i4 + 2] * fin[4 * i4 + 2] + fin[4 * i4 + 3] * fin[4 * i4 + 3];
    }
    ss = wave_sum(ss);
    const float rstd = rsqrtf(ss * (1.f / 1024.f) + RMS_EPS);
#pragma unroll
    for (int i4 = 0; i4 < 4; ++i4) {
      int col = colb + 4 * i4;
      float4 gg = *(const float4*)(p.normf_g + col);
      float4 sh = *(const float4*)(p.fmod + b * 2048 + col);
      float4 sc = *(const float4*)(p.fmod + b * 2048 + 1024 + col);
      float4 r;
      r.x = fin[4 * i4 + 0] * rstd * gg.x * (1.f + sc.x) + sh.x;
      r.y = fin[4 * i4 + 1] * rstd * gg.y * (1.f + sc.y) + sh.y;
      r.z = fin[4 * i4 + 2] * rstd * gg.z * (1.f + sc.z) + sh.z;
      r.w = fin[4 * i4 + 3] * rstd * gg.w * (1.f + sc.w) + sh.w;
      *(float4*)(p.out + t * 1024 + col) = r;
    }
    __syncthreads();
  }
}

__global__ void __launch_bounds__(512) fwd_megakernel(Params p) {
  cg::grid_group grid = cg::this_grid();
  extern __shared__ __attribute__((aligned(16))) char smem[];
  const int tid = threadIdx.x;
  phase_prep(p, smem, tid);
  grid.sync();
  phase_norm_mod(p.x, p.norm1_g, p.mod, 0, 1024, p.hA, tid);
  grid.sync();
  phase_proj(p, smem, tid);
  grid.sync();
  phase_gla_pre(p, smem, tid);
  grid.sync();
  phase_mixers(p, smem, tid);
  grid.sync();
  phase_post_mixers(p, tid);
  grid.sync();
  phase_gr(p, smem, tid);
  grid.sync();
  phase_merge(p, smem, tid);
  grid.sync();
  phase_out(p, smem, tid);
  grid.sync();
  phase_norm_mod(p.x1, p.norm2_g, p.mod, 3072, 4096, p.h2, tid);
  grid.sync();
  phase_peerq(p, smem, tid);
  grid.sync();
  phase_topk(p, smem, tid);
  grid.sync();
  phase_peer_final(p, smem, tid);
}

extern "C" void kernel_launch(void* const* d_in, const int* in_sizes, int n_in, void* d_out, int out_size, void* d_ws,
                              size_t ws_size, hipStream_t stream) {
  static int grid_blocks = 0;
  if (!grid_blocks) {
    int dev = 0, cus = 0, per_cu = 0;
    hipGetDevice(&dev);
    hipDeviceGetAttribute(&cus, hipDeviceAttributeMultiprocessorCount, dev);
    if (hipFuncSetAttribute((const void*)fwd_megakernel, hipFuncAttributeMaxDynamicSharedMemorySize, LDS_BYTES) != hipSuccess) { fprintf(stderr, "hipFuncSetAttribute failed\n"); }
    hipOccupancyMaxActiveBlocksPerMultiprocessor(&per_cu, fwd_megakernel, 512, LDS_BYTES);
    if (per_cu < 1) per_cu = 1;
    grid_blocks = cus * per_cu;
  }
  if (ws_size < 492 * MB) { fprintf(stderr, "ws too small: %zu\n", ws_size); return; }
  Params p{};
  p.x = (const float*)d_in[0]; p.c = (const float*)d_in[1]; p.pos = (const int*)d_in[2];
  p.w_ada = (const float*)d_in[3]; p.b_ada = (const float*)d_in[4]; p.norm1_g = (const float*)d_in[5];
  p.w_in = (const float*)d_in[6]; p.wa_fw = (const float*)d_in[7]; p.ba_fw = (const float*)d_in[8];
  p.wa_bw = (const float*)d_in[9]; p.ba_bw = (const float*)d_in[10]; p.gla_norm_g = (const float*)d_in[11];
  p.lq1 = (const float*)d_in[12]; p.lk1 = (const float*)d_in[13]; p.lq2 = (const float*)d_in[14]; p.lk2 = (const float*)d_in[15];
  p.diff_norm_g = (const float*)d_in[16]; p.w_gla = (const float*)d_in[17]; p.w_diff = (const float*)d_in[18];
  p.w_out = (const float*)d_in[19]; p.norm2_g = (const float*)d_in[20]; p.peer_wq = (const float*)d_in[21];
  p.subkeys = (const float*)d_in[22]; p.peer_u = (const float*)d_in[23]; p.peer_v = (const float*)d_in[24];
  p.w_fada = (const float*)d_in[25]; p.b_fada = (const float*)d_in[26]; p.normf_g = (const float*)d_in[27];
  p.out = (float*)d_out;
  char* ws = (char*)d_ws;
  p.winT = (u16*)(ws + 0 * MB); p.wgrT = (u16*)(ws + 11 * MB); p.wgaT = (u16*)(ws + 13 * MB); p.wgbT = (u16*)(ws + 15 * MB);
  p.wglaT = (u16*)(ws + 17 * MB); p.wdiffT = (u16*)(ws + 19 * MB); p.woutT = (u16*)(ws + 21 * MB); p.wqT = (u16*)(ws + 23 * MB);
  p.subk = (u16*)(ws + 27 * MB); p.rope = (float*)(ws + 28 * MB);
  p.mod = (float*)(ws + 36 * MB); p.fmod = (float*)(ws + 36 * MB + 128 * 1024); p.lam = (float*)(ws + 36 * MB + 192 * 1024);
  p.counter = (int*)(ws + 36 * MB + 196 * 1024);
  p.kmax = (int*)(ws + 36 * MB + 200 * 1024);
  p.lr = (float*)(ws + 37 * MB); p.dec = (float*)(ws + 41 * MB); p.rstd = (float*)(ws + 43 * MB);
  char* slot[9];
  for (int i = 0; i < 7; ++i) slot[i] = ws + (44 + 64 * (size_t)i) * MB;
  slot[7] = (char*)d_out; slot[8] = (char*)d_out + 64 * MB;
  p.hA = (u16*)slot[0];
  p.gq = (u16*)slot[1]; p.gk = (u16*)(slot[1] + 32 * MB);
  p.gvT = (u16*)slot[2]; p.dq = (u16*)slot[3]; p.dk = (u16*)slot[4]; p.dvT = (u16*)slot[5];
  p.qe_fw = (u16*)slot[0]; p.ke_fw = (u16*)(slot[0] + 32 * MB);
  p.qe_bw = (u16*)slot[6]; p.ke_bw = (u16*)(slot[6] + 32 * MB);
  p.keT = (u16*)slot[7];
  p.o_fw = (u16*)slot[1]; p.o_bw = (u16*)slot[8];
  p.uB = (u16*)slot[6]; p.vB = (u16*)(slot[6] + 16 * MB);
  p.A1 = (u16*)slot[2]; p.merged = (u16*)slot[4];
  p.x1 = (float*)slot[0];
  p.h2 = (u16*)slot[2]; p.qp = (u16*)slot[3];
  p.us = (float*)(slot[6] + 32 * MB); p.vs = (float*)(slot[6] + 33 * MB);
  p.idx = (int*)slot[5]; p.g = (float*)(slot[5] + 16 * MB);
  void* args[] = {&p};
  hipError_t e = hipLaunchCooperativeKernel((void*)fwd_megakernel, dim3(grid_blocks), dim3(512), args, LDS_BYTES, stream);
  if (e != hipSuccess) fprintf(stderr, "cooperative launch failed: %s (grid %d)\n", hipGetErrorString(e), grid_blocks);
}
```

```cpp
#include <hip/hip_runtime.h>
#include <hip/hip_cooperative_groups.h>
#include <cstdio>
namespace cg = cooperative_groups;

#define DI __device__ __forceinline__
typedef unsigned short u16;
using bf16x8 = __attribute__((ext_vector_type(8))) short;
using f32x16 = __attribute__((ext_vector_type(16))) float;
using u32x4 = __attribute__((ext_vector_type(4))) unsigned;
using u32x2 = __attribute__((ext_vector_type(2))) unsigned;
typedef __bf16 bf16x2_t __attribute__((ext_vector_type(2)));
typedef float f32x2_t __attribute__((ext_vector_type(2)));

constexpr int T = 32768, D = 1024, S = 8192;
constexpr size_t MB = 1ull << 20;
constexpr float RMS_EPS = 1e-6f;
constexpr int LDS_BYTES = 144 * 1024;

#define MFMA(a, b, c) __builtin_amdgcn_mfma_f32_32x32x16_bf16((a), (b), (c), 0, 0, 0)

struct Params {
  const float *x, *c; const int* pos;
  const float *w_ada, *b_ada, *norm1_g, *w_in, *wa_fw, *ba_fw, *wa_bw, *ba_bw, *gla_norm_g;
  const float *lq1, *lk1, *lq2, *lk2, *diff_norm_g, *w_gla, *w_diff, *w_out, *norm2_g, *peer_wq, *subkeys, *peer_u, *peer_v;
  const float *w_fada, *b_fada, *normf_g;
  float* out;
  u16 *winT, *wgrT, *wgaT, *wgbT, *wglaT, *wdiffT, *woutT, *wqT, *subk;
  float* rope;
  float* mod;
  float* fmod;
  float* lam;
  int* counter;
  float* lr;
  float* dec;
  float* rstd;
  u16 *hA, *gq, *gk, *gvT, *dq, *dk, *dvT;
  u16 *qe_fw, *ke_fw, *qe_bw, *ke_bw, *keT;
  u16 *o_fw, *o_bw, *A1, *merged, *h2, *qp, *uB, *vB;
  float* x1;
  int* idx; float* g;
  float *us, *vs;
  u16 *sga, *sgb;
  int* kmax;
};

DI u16 f2bf(float x) { unsigned u = __float_as_uint(x); u += 0x7fffu + ((u >> 16) & 1u); return (u16)(u >> 16); }
DI float bf2f(u16 b) { return __uint_as_float(((unsigned)b) << 16); }
DI unsigned pack2(float a, float b) {
  f32x2_t v = {a, b};
  bf16x2_t r = __builtin_convertvector(v, bf16x2_t);
  return __builtin_bit_cast(unsigned, r);
}
DI float bflo(unsigned u) { return __uint_as_float(u << 16); }
DI float bfhi(unsigned u) { return __uint_as_float(u & 0xffff0000u); }
DI int crow(int i, int h) { return (i & 3) + 8 * (i >> 2) + 4 * h; }
DI bf16x8 pack_step(const f32x16& x, int s) {
  u32x4 p;
  p[0] = pack2(x[8 * s + 0], x[8 * s + 1]);
  p[1] = pack2(x[8 * s + 2], x[8 * s + 3]);
  p[2] = pack2(x[8 * s + 4], x[8 * s + 5]);
  p[3] = pack2(x[8 * s + 6], x[8 * s + 7]);
  return __builtin_bit_cast(bf16x8, p);
}
DI bf16x8 ld_frag16(const u16* p) { return __builtin_bit_cast(bf16x8, *(const u32x4*)p); }
DI bf16x8 ld_frag8x2(const u16* p) {
  u32x2 lo = *(const u32x2*)p; u32x2 hi = *(const u32x2*)(p + 8);
  u32x4 v = {lo[0], lo[1], hi[0], hi[1]};
  return __builtin_bit_cast(bf16x8, v);
}
DI void st_perm(u16* rowp, int ch, u32x4 v) {
  u16* d = rowp + (ch >> 1) * 16 + (ch & 1) * 4;
  u32x2 lo = {v[0], v[1]}, hi = {v[2], v[3]};
  *(u32x2*)d = lo;
  *(u32x2*)(d + 8) = hi;
}
DI float wave_sum(float v) {
#pragma unroll
  for (int o = 32; o >= 1; o >>= 1) v += __shfl_xor(v, o);
  return v;
}

template <int CTRL> DI float dpp_f(float v) { return __builtin_bit_cast(float, __builtin_amdgcn_update_dpp(0, __builtin_bit_cast(int, v), CTRL, 0xF, 0xF, false)); }
template <int CTRL> DI unsigned dpp_u(unsigned v) { return (unsigned)__builtin_amdgcn_update_dpp(0, (int)v, CTRL, 0xF, 0xF, false); }
DI float gsum16(float v) { v += dpp_f<0x121>(v); v += dpp_f<0x122>(v); v += dpp_f<0x124>(v); v += dpp_f<0x128>(v); return v; }
DI float gmaxf16(float v) { v = fmaxf(v, dpp_f<0x121>(v)); v = fmaxf(v, dpp_f<0x122>(v)); v = fmaxf(v, dpp_f<0x124>(v)); v = fmaxf(v, dpp_f<0x128>(v)); return v; }
DI unsigned gmax16(unsigned v) { v = max(v, dpp_u<0x121>(v)); v = max(v, dpp_u<0x122>(v)); v = max(v, dpp_u<0x124>(v)); v = max(v, dpp_u<0x128>(v)); return v; }
DI int opq(int x) { asm volatile("" : "+v"(x)); return x; }
DI f32x16 zero16() { f32x16 z; for (int i = 0; i < 16; ++i) z[i] = 0.f; return z; }

DI void tconv_tile(const float* src, int ld, int c0, int nc, u16* dst, int ct, int kt, float* sm, int tid) {
  __syncthreads();
  int cl = tid & 63, r0 = tid >> 6;
#pragma unroll
  for (int r = 0; r < 8; ++r) {
    int k = kt * 64 + r0 + 8 * r;
    int col = ct * 64 + cl;
    float v = (col < nc) ? src[(size_t)k * ld + c0 + col] : 0.f;
    sm[(r0 + 8 * r) * 65 + cl] = v;
  }
  __syncthreads();
#pragma unroll
  for (int r = 0; r < 8; ++r) {
    int col = r0 + 8 * r;
    int k = cl;
    dst[(size_t)(ct * 64 + col) * 1024 + kt * 64 + k] = f2bf(sm[k * 65 + col]);
  }
}

DI void phase_prep(const Params& p, char* smem, int tid) {
  float* sm = (float*)smem;
  const int nblk = gridDim.x, bid = blockIdx.x;
  const int NCT = 32 + 48 + 2 + 16 * 6 + 32;
  for (int it = bid; it < NCT * 16; it += nblk) {
    int ctg = it >> 4, kt = it & 15;
    const float* src; int ld, c0, nc; u16* dst; int ct;
    if (ctg < 32) { src = p.w_in; ld = 8224; c0 = 0; nc = 2048; dst = p.winT; ct = ctg; }
    else if (ctg < 80) { src = p.w_in; ld = 8224; c0 = 3104; nc = 3072; dst = p.winT + (size_t)2048 * 1024; ct = ctg - 32; }
    else if (ctg < 82) { src = p.w_in; ld = 8224; c0 = 3072; nc = 32; dst = p.winT + (size_t)5120 * 1024; ct = ctg - 80; }
    else if (ctg < 98) { src = p.w_in; ld = 8224; c0 = 2048; nc = 1024; dst = p.wgrT; ct = ctg - 82; }
    else if (ctg < 114) { src = p.w_in; ld = 8224; c0 = 6176; nc = 1024; dst = p.wgaT; ct = ctg - 98; }
    else if (ctg < 130) { src = p.w_in; ld = 8224; c0 = 7200; nc = 1024; dst = p.wgbT; ct = ctg - 114; }
    else if (ctg < 146) { src = p.w_gla; ld = 1024; c0 = 0; nc = 1024; dst = p.wglaT; ct = ctg - 130; }
    else if (ctg < 162) { src = p.w_diff; ld = 1024; c0 = 0; nc = 1024; dst = p.wdiffT; ct = ctg - 146; }
    else if (ctg < 178) { src = p.w_out; ld = 1024; c0 = 0; nc = 1024; dst = p.woutT; ct = ctg - 162; }
    else { src = p.peer_wq; ld = 2048; c0 = 0; nc = 2048; dst = p.wqT; ct = ctg - 178; }
    tconv_tile(src, ld, c0, nc, dst, ct, kt, sm, tid);
  }
  __syncthreads();
  const int gtid = bid * 512 + tid, gsz = nblk * 512;
  for (int i = gtid; i < 8 * 2 * 128 * 128; i += gsz) p.subk[i] = f2bf(p.subkeys[i]);
  for (int i = gtid; i < T * 32; i += gsz) {
    int t = i >> 5, d = i & 31;
    float inv = powf(10000.f, -(float)d / 32.f);
    float ang = (float)p.pos[t] * inv;
    double r = (double)ang * 0.15915494309189535;
    r -= rint(r);
    float rf = (float)r;
    p.rope[2 * i] = __builtin_amdgcn_cosf(rf);
    p.rope[2 * i + 1] = __builtin_amdgcn_sinf(rf);
  }
  if (gtid == 0) {
    float s1 = 0.f, s2 = 0.f;
    for (int i = 0; i < 64; ++i) { s1 += p.lq1[i] * p.lk1[i]; s2 += p.lq2[i] * p.lk2[i]; }
    p.lam[0] = expf(s1) - expf(s2) + 0.2f;
    for (int i = 0; i < 16; ++i) p.counter[i] = 0;
    for (int i = 0; i < 64; ++i) p.kmax[i] = 0;
  }
  {
    float* cact = sm;
    float* red = sm + 4096;
    __syncthreads();
    for (int i = tid; i < 4096; i += 512) { float v = p.c[i]; cact[i] = v / (1.f + __expf(-v)); }
    __syncthreads();
    int w = tid >> 6, lane = tid & 63;
    for (int it = bid; it < 128; it += nblk) {
      int col = it * 64 + lane;
      const float* W; int ld, cc;
      if (col < 6144) { W = p.w_ada; ld = 6144; cc = col; } else { W = p.w_fada; ld = 2048; cc = col - 6144; }
      float a0 = 0, a1 = 0, a2 = 0, a3 = 0;
#pragma unroll 8
      for (int k = w * 128; k < w * 128 + 128; ++k) {
        float wv = W[(size_t)k * ld + cc];
        a0 += cact[k] * wv; a1 += cact[1024 + k] * wv; a2 += cact[2048 + k] * wv; a3 += cact[3072 + k] * wv;
      }
      red[(w * 4 + 0) * 64 + lane] = a0; red[(w * 4 + 1) * 64 + lane] = a1;
      red[(w * 4 + 2) * 64 + lane] = a2; red[(w * 4 + 3) * 64 + lane] = a3;
      __syncthreads();
      if (tid < 256) {
        int b = w;
        float s = 0.f;
#pragma unroll
        for (int ww = 0; ww < 8; ++ww) s += red[(ww * 4 + b) * 64 + lane];
        if (col < 6144) p.mod[b * 6144 + cc] = s + p.b_ada[cc];
        else p.fmod[b * 2048 + cc] = s + p.b_fada[cc];
      }
      __syncthreads();
    }
  }
}

DI void phase_norm_mod(const float* src, const float* g, const float* mod, int sh_off, int sc_off, u16* dst, int tid) {
  int w = tid >> 6, lane = tid & 63;
  for (int row = blockIdx.x * 8 + w; row < T; row += gridDim.x * 8) {
    int b = row >> 13;
    const float* xr = src + (size_t)row * 1024;
    float4 v[4]; float ss = 0.f;
#pragma unroll
    for (int m = 0; m < 4; ++m) { v[m] = *(const float4*)(xr + (m * 64 + lane) * 4); ss += v[m].x * v[m].x + v[m].y * v[m].y + v[m].z * v[m].z + v[m].w * v[m].w; }
    ss = wave_sum(ss);
    float rstd = rsqrtf(ss * (1.f / 1024.f) + RMS_EPS);
#pragma unroll
    for (int m = 0; m < 4; ++m) {
      int col = (m * 64 + lane) * 4;
      float4 gg = *(const float4*)(g + col);
      float4 sh = *(const float4*)(mod + b * 6144 + sh_off + col);
      float4 sc = *(const float4*)(mod + b * 6144 + sc_off + col);
      float y0 = v[m].x * rstd * gg.x * (1.f + sc.x) + sh.x;
      float y1 = v[m].y * rstd * gg.y * (1.f + sc.y) + sh.y;
      float y2 = v[m].z * rstd * gg.z * (1.f + sc.z) + sh.z;
      float y3 = v[m].w * rstd * gg.w * (1.f + sc.w) + sh.w;
      u32x2 o = {pack2(y0, y1), pack2(y2, y3)};
      *(u32x2*)(dst + (size_t)row * 1024 + col) = o;
    }
  }
}

constexpr int GLD = 72;
constexpr int GSTAGE = (256 + 128) * GLD;
DI void gemm_kloop(const u16* A, int lda, const u16* Bt, int ldb, int K, f32x16 (&acc)[2][2], u16* smem, int tid) {
  const int w = tid >> 6, lane = tid & 63, c = lane & 31, hh = lane >> 5;
  const int wm = w >> 1, wn = w & 1;
  const int lrow = tid >> 3, lcol = (tid & 7) * 8;
  u32x4 ra[4], rb[2];
  const int nk = K >> 6;
#pragma unroll
  for (int r = 0; r < 4; ++r) ra[r] = *(const u32x4*)(A + (size_t)(r * 64 + lrow) * lda + lcol);
#pragma unroll
  for (int r = 0; r < 2; ++r) rb[r] = *(const u32x4*)(Bt + (size_t)(r * 64 + lrow) * ldb + lcol);
  __syncthreads();
  {
    u16* sA = smem; u16* sB = smem + 256 * GLD;
#pragma unroll
    for (int r = 0; r < 4; ++r) *(u32x4*)(sA + (r * 64 + lrow) * GLD + lcol) = ra[r];
#pragma unroll
    for (int r = 0; r < 2; ++r) *(u32x4*)(sB + (r * 64 + lrow) * GLD + lcol) = rb[r];
  }
  if (nk > 1) {
#pragma unroll
    for (int r = 0; r < 4; ++r) ra[r] = *(const u32x4*)(A + (size_t)(r * 64 + lrow) * lda + 64 + lcol);
#pragma unroll
    for (int r = 0; r < 2; ++r) rb[r] = *(const u32x4*)(Bt + (size_t)(r * 64 + lrow) * ldb + 64 + lcol);
  }
  __syncthreads();
  for (int kt = 0; kt < nk; ++kt) {
    const u16* sA = smem + (kt & 1) * GSTAGE; const u16* sB = sA + 256 * GLD;
    if (kt + 1 < nk) {
      u16* nA = smem + ((kt + 1) & 1) * GSTAGE; u16* nB = nA + 256 * GLD;
#pragma unroll
      for (int r = 0; r < 4; ++r) *(u32x4*)(nA + (r * 64 + lrow) * GLD + lcol) = ra[r];
#pragma unroll
      for (int r = 0; r < 2; ++r) *(u32x4*)(nB + (r * 64 + lrow) * GLD + lcol) = rb[r];
      if (kt + 2 < nk) {
#pragma unroll
        for (int r = 0; r < 4; ++r) ra[r] = *(const u32x4*)(A + (size_t)(r * 64 + lrow) * lda + (kt + 2) * 64 + lcol);
#pragma unroll
        for (int r = 0; r < 2; ++r) rb[r] = *(const u32x4*)(Bt + (size_t)(r * 64 + lrow) * ldb + (kt + 2) * 64 + lcol);
      }
    }
    bf16x8 fr[2][4];
#define GLOADF(set, s) { fr[set][0] = ld_frag16(sA + (wm * 64 + c) * GLD + (s) * 16 + hh * 8); fr[set][1] = ld_frag16(sA + (wm * 64 + 32 + c) * GLD + (s) * 16 + hh * 8); \
                         fr[set][2] = ld_frag16(sB + (wn * 64 + c) * GLD + (s) * 16 + hh * 8); fr[set][3] = ld_frag16(sB + (wn * 64 + 32 + c) * GLD + (s) * 16 + hh * 8); }
#define GMM(set) { acc[0][0] = MFMA(fr[set][0], fr[set][2], acc[0][0]); acc[0][1] = MFMA(fr[set][0], fr[set][3], acc[0][1]); \
                   acc[1][0] = MFMA(fr[set][1], fr[set][2], acc[1][0]); acc[1][1] = MFMA(fr[set][1], fr[set][3], acc[1][1]); }
    GLOADF(0, 0);
    __builtin_amdgcn_sched_barrier(0);
    GLOADF(1, 1); GMM(0);
    __builtin_amdgcn_sched_barrier(0);
    GLOADF(0, 2); GMM(1);
    __builtin_amdgcn_sched_barrier(0);
    GLOADF(1, 3); GMM(0);
    __builtin_amdgcn_sched_barrier(0);
    GMM(1);
#undef GLOADF
#undef GMM
    __syncthreads();
  }
}
DI void zero_acc(f32x16 (&acc)[2][2]) {
#pragma unroll
  for (int a = 0; a < 2; ++a)
#pragma unroll
    for (int b = 0; b < 2; ++b) acc[a][b] = zero16();
}


constexpr int EPS = 68, EPT = 65;
DI float* wave_stage(char* smem, int w) { return (float*)smem + w * (64 * EPS); }
template <int STR> DI void stage_acc(const f32x16 (&acc)[2][2], float* wl, int c, int hh) {
#pragma unroll
  for (int mi = 0; mi < 2; ++mi)
#pragma unroll
    for (int ni = 0; ni < 2; ++ni)
#pragma unroll
      for (int i = 0; i < 16; ++i) wl[(mi * 32 + crow(i, hh)) * STR + ni * 32 + c] = acc[mi][ni][i];
}
DI void st_bf16x8(u16* dst, const float (&v)[8]) {
  u32x4 o = {pack2(v[0], v[1]), pack2(v[2], v[3]), pack2(v[4], v[5]), pack2(v[6], v[7])};
  *(u32x4*)dst = o;
}
DI void ld_bf16x8(const u16* srcp, float (&v)[8]) {
  u32x4 o = *(const u32x4*)srcp;
#pragma unroll
  for (int i = 0; i < 4; ++i) { v[2 * i] = bflo(o[i]); v[2 * i + 1] = bfhi(o[i]); }
}
template <class F> DI void epi_rows(const float* wl, int lane, F f) {
#pragma unroll
  for (int ps = 0; ps < 8; ++ps) {
    const int r = (lane >> 3) + 8 * ps, cc = (lane & 7) * 8;
    float4 v0 = *(const float4*)(wl + r * EPS + cc), v1 = *(const float4*)(wl + r * EPS + cc + 4);
    float v[8] = {v0.x, v0.y, v0.z, v0.w, v1.x, v1.y, v1.z, v1.w};
    f(r, cc, v);
  }
}
DI void epi_cols_bf16(const float* wl, int lane, u16* dstT, size_t ldt) {
#pragma unroll
  for (int ps = 0; ps < 8; ++ps) {
    const int col = (lane >> 3) + 8 * ps, r0 = (lane & 7) * 8;
    float v[8];
#pragma unroll
    for (int j = 0; j < 8; ++j) v[j] = wl[(r0 + j) * EPT + col];
    st_bf16x8(dstT + (size_t)col * ldt + r0, v);
  }
}

DI void phase_proj(const Params& p, char* smem, int tid) {
  const int w = tid >> 6, lane = tid & 63, c_inv = lane & 31, hh_inv = lane >> 5;
  const int wm = w >> 1, wn = w & 1;
  float* wl = wave_stage(smem, w);
  const int NT = 41;
  for (int id = blockIdx.x; id < 128 * NT; id += gridDim.x) {
    int mt = id / NT, nt = id - mt * NT;
    int m0 = mt * 256, n0 = nt * 128;
    f32x16 acc[2][2]; zero_acc(acc);
    gemm_kloop(p.hA + (size_t)m0 * 1024, 1024, p.winT + (size_t)n0 * 1024, 1024, 1024, acc, (u16*)smem, tid);
    const int c = opq(c_inv), hh = opq(hh_inv);
    const int rb = m0 + wm * 64, cb = n0 + wn * 64;
    if (n0 < 1024) {
      const float sc = (n0 < 512) ? 0.08838834764831845f : 1.f;
      u16* dst = ((n0 < 512) ? p.gq : p.gk) + (size_t)rb * 512 + (cb & 511);
      stage_acc<EPS>(acc, wl, c, hh);
      epi_rows(wl, lane, [&](int r, int cc, float (&v)[8]) {
#pragma unroll
        for (int j = 0; j < 8; ++j) v[j] *= sc;
        st_bf16x8(dst + (size_t)r * 512 + cc, v);
      });
    } else if (n0 < 2048 || (n0 >= 4096 && n0 < 5120)) {
      const bool isg = n0 < 2048;
      const int b = rb >> 13;
      u16* dstT;
      if (isg) { int cc0 = cb - 1024; dstT = p.gvT + ((size_t)(b * 4 + (cc0 >> 8)) * 256 + (cc0 & 255)) * 8192 + (rb & 8191); }
      else { int cc0 = cb - 4096; dstT = p.dvT + ((size_t)(b * 8 + (cc0 >> 7)) * 128 + (cc0 & 127)) * 8192 + (rb & 8191); }
      stage_acc<EPT>(acc, wl, c, hh);
      epi_cols_bf16(wl, lane, dstT, 8192);
    } else if (n0 < 4096) {
      const bool isq = n0 < 3072;
      const float sc = isq ? (0.125f * 1.4426950408889634f) : 1.f;
      const int cbb = cb - (isq ? 2048 : 3072);
      float knmax = 0.f;
#pragma unroll
      for (int mi = 0; mi < 2; ++mi)
#pragma unroll
        for (int i = 0; i < 16; ++i) {
          int row = rb + mi * 32 + crow(i, hh);
          float2 cs = *(const float2*)(p.rope + ((size_t)row * 32 + c) * 2);
          float x1 = acc[mi][0][i], x2 = acc[mi][1][i];
          float o1 = (x1 * cs.x - x2 * cs.y) * sc;
          float o2 = (x2 * cs.x + x1 * cs.y) * sc;
          acc[mi][0][i] = o1; acc[mi][1][i] = o2;
          if (!isq) {
            float ssq = o1 * o1 + o2 * o2;
            ssq += __shfl_xor(ssq, 1); ssq += __shfl_xor(ssq, 2); ssq += __shfl_xor(ssq, 4); ssq += __shfl_xor(ssq, 8); ssq += __shfl_xor(ssq, 16);
            knmax = fmaxf(knmax, ssq);
          }
        }
      if (!isq && c == 0) atomicMax(p.kmax + ((rb >> 13) * 8 + (cbb >> 7)) * 2 + ((cbb >> 6) & 1), __float_as_int(knmax));
      u16* dst = (isq ? p.dq : p.dk) + (size_t)rb * 1024 + cbb;
      stage_acc<EPS>(acc, wl, c, hh);
      epi_rows(wl, lane, [&](int r, int cc, float (&v)[8]) { st_bf16x8(dst + (size_t)r * 1024 + cc, v); });
    } else {
      if (wn == 0) {
#pragma unroll
        for (int mi = 0; mi < 2; ++mi)
#pragma unroll
          for (int i = 0; i < 16; ++i) {
            int row = rb + mi * 32 + crow(i, hh);
            p.lr[(size_t)row * 32 + c] = acc[mi][0][i];
          }
      }
    }
  }
}

DI float logsig(float x) { return fminf(x, 0.f) - __logf(1.f + __expf(-fabsf(x))); }

DI void phase_gla_pre(const Params& p, char* smem, int tid) {
  float* slr = (float*)smem;
  for (int it = blockIdx.x; it < 512; it += gridDim.x) {
    int b = it >> 7, ch = it & 127;
    size_t t0 = (size_t)b * 8192 + ch * 64;
    __syncthreads();
    for (int i = tid; i < 2048; i += 512) slr[i] = p.lr[t0 * 32 + i];
    __syncthreads();
#pragma unroll 1
    for (int cj = 0; cj < 1; ++cj) {
      int j = tid;
      int h = j >> 7, d = j & 127;
#pragma unroll 1
      for (int dir = 0; dir < 2; ++dir) {
        const float* wa = dir ? p.wa_bw : p.wa_fw;
        float wr[16];
#pragma unroll
        for (int r = 0; r < 16; ++r) wr[r] = wa[r * 512 + j];
        float ba = (dir ? p.ba_bw : p.ba_fw)[j];
        u16* qe = dir ? p.qe_bw : p.qe_fw;
        u16* ke = dir ? p.ke_bw : p.ke_fw;
        u16* keT = p.keT + (size_t)dir * (16ull * 128 * 8192) + ((size_t)(b * 4 + h) * 128 + d) * 8192 + ch * 64;
        float bsum = 0.f;
#pragma unroll 1
        for (int g8 = 0; g8 < 8; ++g8) {
          unsigned kk[8];
#pragma unroll
          for (int u = 0; u < 8; ++u) {
            int tt = g8 * 8 + u;
            int t = dir ? 63 - tt : tt;
            float pre = ba;
#pragma unroll
            for (int r = 0; r < 16; ++r) pre += slr[t * 32 + dir * 16 + r] * wr[r];
            bsum += logsig(pre) * (1.f / 16.f);
            float qv = bf2f(p.gq[(t0 + t) * 512 + j]);
            float kv = bf2f(p.gk[(t0 + t) * 512 + j]);
            float eb = __expf(bsum);
            u16 qo = f2bf(qv * eb);
            u16 ko = f2bf(kv / eb);
            qe[(t0 + t) * 512 + j] = qo;
            ke[(t0 + t) * 512 + j] = ko;
            kk[u] = ko;
          }
          u32x4 v;
          if (!dir) {
            v[0] = kk[0] | (kk[1] << 16); v[1] = kk[2] | (kk[3] << 16); v[2] = kk[4] | (kk[5] << 16); v[3] = kk[6] | (kk[7] << 16);
            *(u32x4*)(keT + g8 * 8) = v;
          } else {
            v[0] = kk[7] | (kk[6] << 16); v[1] = kk[5] | (kk[4] << 16); v[2] = kk[3] | (kk[2] << 16); v[3] = kk[1] | (kk[0] << 16);
            *(u32x4*)(keT + (56 - g8 * 8)) = v;
          }
        }
        p.dec[((size_t)(dir * 4 + b) * 128 + ch) * 512 + j] = __expf(bsum);
      }
    }
  }
}

constexpr int QLD = 136, TLD = 72;
DI void gla_scan_block(const Params& p, int g, char* smem, int tid) {
  const int dir = g & 1, bh = g >> 1;
  const int b = bh >> 2, h = bh & 3;
  const int w = tid >> 6, lane = tid & 63, c = lane & 31, hh = lane >> 5;
  const int slice = w;
  u16* sQ = (u16*)smem;
  u16* sK = sQ + 64 * QLD;
  u16* sKT = sK + 64 * QLD;
  u16* sVT = sKT + 128 * TLD;
  const u16* qe = (dir ? p.qe_bw : p.qe_fw) + (size_t)b * 8192 * 512 + h * 128;
  const u16* ke = (dir ? p.ke_bw : p.ke_fw) + (size_t)b * 8192 * 512 + h * 128;
  const u16* keT = p.keT + (size_t)dir * (16ull * 128 * 8192) + (size_t)bh * 128 * 8192;
  const u16* vT = p.gvT + (size_t)bh * 256 * 8192;
  const float* dec = p.dec + ((size_t)(dir * 4 + b) * 128) * 512 + h * 128;
  u16* o = dir ? p.o_bw : p.o_fw;
  f32x16 st[4];
#pragma unroll
  for (int i = 0; i < 4; ++i) st[i] = zero16();
  u32x4 rq[2], rk[2], rt[2];
  unsigned offq[2], offt[2];
#pragma unroll
  for (int r = 0; r < 2; ++r) {
    int id = tid + 512 * r;
    offq[r] = (unsigned)(((id >> 4) * 512 + (id & 15) * 8) * 2);
    offt[r] = (unsigned)(((id >> 3) * 8192 + (id & 7) * 8) * 2);
  }
  const unsigned offv = (unsigned)(((w * 32 + c) * 8192 + 4 * hh) * 2);
  {
    const int ch = dir ? 127 : 0;
#pragma unroll
    for (int r = 0; r < 2; ++r) {
      int id = tid + 512 * r;
      rq[r] = *(const u32x4*)((const char*)(qe + (size_t)ch * 64 * 512) + offq[r]);
      rk[r] = *(const u32x4*)((const char*)(ke + (size_t)ch * 64 * 512) + offq[r]);
      rt[r] = *(const u32x4*)((const char*)(keT + ch * 64) + offt[r]);
    }
  }
#pragma unroll 1
  for (int ci = 0; ci < 128; ++ci) {
    const int ch = dir ? 127 - ci : ci;
    const size_t t0 = (size_t)b * 8192 + ch * 64;
    __syncthreads();
#pragma unroll
    for (int r = 0; r < 2; ++r) {
      int id = tid + 512 * r;
      st_perm(sQ + (id >> 4) * QLD, id & 15, rq[r]);
      st_perm(sK + (id >> 4) * QLD, id & 15, rk[r]);
      st_perm(sKT + (id >> 3) * TLD, id & 7, rt[r]);
    }
    __syncthreads();
    if (ci + 1 < 128) {
      const int chn = dir ? ch - 1 : ch + 1;
#pragma unroll
      for (int r = 0; r < 2; ++r) {
        int id = tid + 512 * r;
        rq[r] = *(const u32x4*)((const char*)(qe + (size_t)chn * 64 * 512) + offq[r]);
        rk[r] = *(const u32x4*)((const char*)(ke + (size_t)chn * 64 * 512) + offq[r]);
        rt[r] = *(const u32x4*)((const char*)(keT + chn * 64) + offt[r]);
      }
    }
    bf16x8 vf[4];
#pragma unroll
    for (int k4 = 0; k4 < 4; ++k4) vf[k4] = ld_frag8x2((const u16*)((const char*)(vT + ch * 64 + 16 * k4) + offv));
#pragma unroll 1
    for (int qt = 0; qt < 2; ++qt) {
      f32x16 oacc = zero16();
#pragma unroll
      for (int ks = 0; ks < 8; ++ks) {
        bf16x8 sf = pack_step(st[ks >> 1], ks & 1);
        bf16x8 q0 = ld_frag16(sQ + (qt * 32 + c) * QLD + ks * 16 + 8 * hh);
        oacc = MFMA(q0, sf, oacc);
        if (ks & 1) __builtin_amdgcn_sched_barrier(0);
      }
#pragma unroll
      for (int kt = 0; kt < 2; ++kt) {
        bool skip = dir ? (kt < qt) : (kt > qt);
        if (skip) continue;
        f32x16 X = zero16();
#pragma unroll 1
        for (int ks = 0; ks < 8; ++ks) {
          bf16x8 kf = ld_frag16(sK + (kt * 32 + c) * QLD + ks * 16 + 8 * hh);
          bf16x8 qf = ld_frag16(sQ + (qt * 32 + c) * QLD + ks * 16 + 8 * hh);
          X = MFMA(kf, qf, X);
        }
        if (kt == qt) {
#pragma unroll
          for (int i = 0; i < 16; ++i) {
            int key = crow(i, hh);
            bool keep = dir ? (key >= c) : (key <= c);
            X[i] = keep ? X[i] : 0.f;
          }
        }
        oacc = MFMA(pack_step(X, 0), vf[kt * 2 + 0], oacc);
        oacc = MFMA(pack_step(X, 1), vf[kt * 2 + 1], oacc);
        __builtin_amdgcn_sched_barrier(0);
      }
#pragma unroll
      for (int i = 0; i < 16; ++i)
        o[(t0 + qt * 32 + crow(i, hh)) * 1024 + h * 256 + slice * 32 + c] = f2bf(oacc[i]);
      __builtin_amdgcn_sched_barrier(0);
    }
#pragma unroll
    for (int dt = 0; dt < 4; ++dt) {
#pragma unroll
      for (int k4 = 0; k4 < 4; ++k4) {
        bf16x8 kt_f = ld_frag16(sKT + (dt * 32 + c) * TLD + 16 * k4 + 8 * hh);
        st[dt] = MFMA(kt_f, vf[k4], st[dt]);
      }
#pragma unroll
      for (int gg = 0; gg < 4; ++gg) {
        float4 dv = *(const float4*)(dec + (size_t)ch * 512 + dt * 32 + 8 * gg + 4 * hh);
        st[dt][4 * gg + 0] *= dv.x; st[dt][4 * gg + 1] *= dv.y; st[dt][4 * gg + 2] *= dv.z; st[dt][4 * gg + 3] *= dv.w;
      }
      __builtin_amdgcn_sched_barrier(0);
    }
  }
}

constexpr int KLD = 136, VLD = 72;
constexpr int ATT_BUF = 64 * KLD + 128 * VLD;
DI void attn_item(const Params& p, int item, char* smem, int tid) {
  const int qb = item & 63, bh = item >> 6;
  const int b = bh >> 3, h = bh & 7;
  const int w = tid >> 6, lane = tid & 63, c = lane & 31, hh = lane >> 5;
  const int qg = w & 3, mp = w >> 2;
  u16* sbase = (u16*)smem;
  float* sex = (float*)(smem + 2 * ATT_BUF * 2);
  const size_t tq = (size_t)b * 8192 + qb * 128 + qg * 32 + c;
  bf16x8 qf[4];
#pragma unroll
  for (int s = 0; s < 4; ++s) qf[s] = ld_frag16(p.dq + tq * 1024 + h * 128 + mp * 64 + 16 * s + 8 * hh);
  f32x16 O[4];
#pragma unroll
  for (int dt = 0; dt < 4; ++dt) O[dt] = zero16();
  float lrun = 0.f;
  float negmb;
  {
    float qn = 0.f;
#pragma unroll
    for (int s = 0; s < 4; ++s) {
      u32x4 qq = __builtin_bit_cast(u32x4, qf[s]);
#pragma unroll
      for (int i = 0; i < 4; ++i) { float x0 = bflo(qq[i]), x1 = bfhi(qq[i]); qn += x0 * x0 + x1 * x1; }
    }
    qn += __shfl_xor(qn, 32);
    float kn = __int_as_float(p.kmax[(b * 8 + h) * 2 + mp]);
    float mb = sqrtf(qn * kn) * 1.01f + 1e-3f;
    negmb = -mb;
  }
  const u16* Kg = p.dk + (size_t)b * 8192 * 1024 + h * 128;
  const u16* Vg = p.dvT + (size_t)bh * 128 * 8192;
  u32x4 rk[2], rv[2];
#pragma unroll
  for (int r = 0; r < 2; ++r) {
    int id = tid + 512 * r;
    rk[r] = *(const u32x4*)(Kg + (size_t)(id >> 4) * 1024 + (id & 15) * 8);
    rv[r] = *(const u32x4*)(Vg + (size_t)(id >> 3) * 8192 + (id & 7) * 8);
  }
  __syncthreads();
#pragma unroll
  for (int r = 0; r < 2; ++r) {
    int id = tid + 512 * r;
    *(u32x4*)(sbase + (id >> 4) * KLD + (id & 15) * 8) = rk[r];
    st_perm(sbase + 64 * KLD + (id >> 3) * VLD, id & 7, rv[r]);
  }
#pragma unroll
  for (int r = 0; r < 2; ++r) {
    int id = tid + 512 * r;
    rk[r] = *(const u32x4*)(Kg + (size_t)(64 + (id >> 4)) * 1024 + (id & 15) * 8);
    rv[r] = *(const u32x4*)(Vg + (size_t)(id >> 3) * 8192 + 64 + (id & 7) * 8);
  }
  __syncthreads();
#pragma unroll 1
  for (int kt = 0; kt < 128; ++kt) {
    const u16* sK = sbase + (kt & 1) * ATT_BUF;
    const u16* sV = sK + 64 * KLD;
    if (kt + 1 < 128) {
      u16* nK = sbase + ((kt + 1) & 1) * ATT_BUF;
      u16* nV = nK + 64 * KLD;
#pragma unroll
      for (int r = 0; r < 2; ++r) {
        int id = tid + 512 * r;
        *(u32x4*)(nK + (id >> 4) * KLD + (id & 15) * 8) = rk[r];
        st_perm(nV + (id >> 3) * VLD, id & 7, rv[r]);
      }
      if (kt + 2 < 128) {
#pragma unroll
        for (int r = 0; r < 2; ++r) {
          int id = tid + 512 * r;
          rk[r] = *(const u32x4*)(Kg + (size_t)((kt + 2) * 64 + (id >> 4)) * 1024 + (id & 15) * 8);
          rv[r] = *(const u32x4*)(Vg + (size_t)(id >> 3) * 8192 + (kt + 2) * 64 + (id & 7) * 8);
        }
      }
    }
    f32x16 sacc[2];
    bf16x8 kf[8];
#pragma unroll
    for (int s = 0; s < 4; ++s)
#pragma unroll
      for (int k2 = 0; k2 < 2; ++k2) kf[s * 2 + k2] = ld_frag16(sK + (k2 * 32 + c) * KLD + mp * 64 + 16 * s + 8 * hh);
    __builtin_amdgcn_sched_barrier(0);
#pragma unroll
    for (int i = 0; i < 16; ++i) { sacc[0][i] = negmb; sacc[1][i] = negmb; }
#pragma unroll
    for (int s = 0; s < 4; ++s) {
      sacc[0] = MFMA(kf[s * 2 + 0], qf[s], sacc[0]);
      sacc[1] = MFMA(kf[s * 2 + 1], qf[s], sacc[1]);
    }
    bf16x8 vfA[4], vfB[4];
#define VLOAD(dst, k2, s2) { _Pragma("unroll") for (int dt = 0; dt < 4; ++dt) dst[dt] = ld_frag16(sV + (dt * 32 + c) * VLD + (k2) * 32 + (s2) * 16 + 8 * hh); }
#define PVMM(vf, pf) { _Pragma("unroll") for (int dt = 0; dt < 4; ++dt) O[dt] = MFMA(vf[dt], pf, O[dt]); }
#define EXPS(k2) { _Pragma("unroll") for (int i = 0; i < 8; ++i) { \
        float e0 = __builtin_amdgcn_exp2f(sacc[k2][2 * i]), e1 = __builtin_amdgcn_exp2f(sacc[k2][2 * i + 1]); \
        sacc[k2][2 * i] = e0; sacc[k2][2 * i + 1] = e1; f32x2_t ev = {e0, e1}; ls2 += ev; } }
    VLOAD(vfA, 0, 0);
    __builtin_amdgcn_sched_barrier(0);
    f32x2_t ls2 = {0.f, 0.f};
    EXPS(0);
    bf16x8 p0 = pack_step(sacc[0], 0), p1 = pack_step(sacc[0], 1);
    __builtin_amdgcn_sched_barrier(0);
    VLOAD(vfB, 0, 1);
    PVMM(vfA, p0);
    __builtin_amdgcn_sched_barrier(0);
    VLOAD(vfA, 1, 0);
    PVMM(vfB, p1);
    __builtin_amdgcn_sched_barrier(0);
    EXPS(1);
    p0 = pack_step(sacc[1], 0); p1 = pack_step(sacc[1], 1);
    __builtin_amdgcn_sched_barrier(0);
    VLOAD(vfB, 1, 1);
    PVMM(vfA, p0);
    __builtin_amdgcn_sched_barrier(0);
    PVMM(vfB, p1);
    lrun += ls2[0] + ls2[1];
#undef VLOAD
#undef PVMM
#undef EXPS
    __syncthreads();
  }
  float ltot = lrun + __shfl_xor(lrun, 32);
  if (mp == 1) {
    float sc = p.lam[0] / ltot;
#pragma unroll
    for (int dt = 0; dt < 4; ++dt)
#pragma unroll
      for (int i = 0; i < 16; ++i) sex[(qg * 64 + dt * 16 + i) * 64 + lane] = O[dt][i] * sc;
  }
  __syncthreads();
  if (mp == 0) {
    float i0 = 1.f / ltot;
    float ss = 0.f;
#pragma unroll
    for (int dt = 0; dt < 4; ++dt)
#pragma unroll
      for (int i = 0; i < 16; ++i) { float v = O[dt][i] * i0 - sex[(qg * 64 + dt * 16 + i) * 64 + lane]; O[dt][i] = v; ss += v * v; }
    ss += __shfl_xor(ss, 32);
    float rstd = rsqrtf(ss * (1.f / 128.f) + RMS_EPS) * 0.8f;
#pragma unroll
    for (int dt = 0; dt < 4; ++dt)
#pragma unroll
      for (int g = 0; g < 4; ++g) {
        int dv = dt * 32 + 8 * g + 4 * hh;
        float4 gg = *(const float4*)(p.diff_norm_g + h * 128 + dv);
        u32x2 v = {pack2(O[dt][4 * g] * rstd * gg.x, O[dt][4 * g + 1] * rstd * gg.y),
                   pack2(O[dt][4 * g + 2] * rstd * gg.z, O[dt][4 * g + 3] * rstd * gg.w)};
        *(u32x2*)(p.dq + tq * 1024 + h * 128 + dv) = v;
      }
  }
}

DI void phase_mixers(const Params& p, char* smem, int tid) {
  int* sitem = (int*)(smem + 143 * 1024);
  if (blockIdx.x < 32) gla_scan_block(p, blockIdx.x, smem, opq(tid));
  for (;;) {
    __syncthreads();
    if (tid == 0) *sitem = atomicAdd(p.counter, 1);
    __syncthreads();
    int item = *sitem;
    if (item >= 2048) break;
    attn_item(p, item, smem, opq(tid));
  }
}

DI void phase_post_mixers(const Params& p, int tid) {
  int w = tid >> 6, lane = tid & 63;
  for (int row = blockIdx.x * 8 + w; row < T; row += gridDim.x * 8) {
#pragma unroll
    for (int hd = 0; hd < 4; ++hd) {
      u32x2 a = *(const u32x2*)(p.o_fw + (size_t)row * 1024 + hd * 256 + lane * 4);
      u32x2 bq = *(const u32x2*)(p.o_bw + (size_t)row * 1024 + hd * 256 + lane * 4);
      float v0 = bflo(a[0]) + bflo(bq[0]), v1 = bfhi(a[0]) + bfhi(bq[0]), v2 = bflo(a[1]) + bflo(bq[1]), v3 = bfhi(a[1]) + bfhi(bq[1]);
      float ss = wave_sum(v0 * v0 + v1 * v1 + v2 * v2 + v3 * v3);
      if (lane == 0) p.rstd[row * 4 + hd] = rsqrtf(ss * (1.f / 256.f) + RMS_EPS);
    }
  }
  phase_norm_mod(p.x, p.norm1_g, p.mod, 0, 1024, p.hA, tid);
  for (int row = blockIdx.x * 8 + w; row < 32768; row += gridDim.x * 8) {
    const bool isv = row >= 16384;
    const int r = row & 16383;
    const float* srcp = (isv ? p.peer_v : p.peer_u) + (size_t)r * 1024 + lane * 16;
    float4 a0 = *(const float4*)(srcp), a1 = *(const float4*)(srcp + 4), a2 = *(const float4*)(srcp + 8), a3 = *(const float4*)(srcp + 12);
    float am = fmaxf(fmaxf(fmaxf(fabsf(a0.x), fabsf(a0.y)), fmaxf(fabsf(a0.z), fabsf(a0.w))), fmaxf(fmaxf(fabsf(a1.x), fabsf(a1.y)), fmaxf(fabsf(a1.z), fabsf(a1.w))));
    am = fmaxf(am, fmaxf(fmaxf(fmaxf(fabsf(a2.x), fabsf(a2.y)), fmaxf(fabsf(a2.z), fabsf(a2.w))), fmaxf(fmaxf(fabsf(a3.x), fabsf(a3.y)), fmaxf(fabsf(a3.z), fabsf(a3.w)))));
#pragma unroll
    for (int o = 32; o >= 1; o >>= 1) am = fmaxf(am, __shfl_xor(am, o));
    am = fmaxf(am, 1e-30f);
    const float sc = 256.f / am;
    u32x4 v;
    int t0 = __builtin_amdgcn_cvt_pk_fp8_f32(a0.x * sc, a0.y * sc, 0, false); t0 = __builtin_amdgcn_cvt_pk_fp8_f32(a0.z * sc, a0.w * sc, t0, true);
    int t1 = __builtin_amdgcn_cvt_pk_fp8_f32(a1.x * sc, a1.y * sc, 0, false); t1 = __builtin_amdgcn_cvt_pk_fp8_f32(a1.z * sc, a1.w * sc, t1, true);
    int t2 = __builtin_amdgcn_cvt_pk_fp8_f32(a2.x * sc, a2.y * sc, 0, false); t2 = __builtin_amdgcn_cvt_pk_fp8_f32(a2.z * sc, a2.w * sc, t2, true);
    int t3 = __builtin_amdgcn_cvt_pk_fp8_f32(a3.x * sc, a3.y * sc, 0, false); t3 = __builtin_amdgcn_cvt_pk_fp8_f32(a3.z * sc, a3.w * sc, t3, true);
    v[0] = (unsigned)t0; v[1] = (unsigned)t1; v[2] = (unsigned)t2; v[3] = (unsigned)t3;
    unsigned char* dst = (unsigned char*)(isv ? p.vB : p.uB) + (size_t)r * 1024 + lane * 16;
    *(u32x4*)dst = v;
    if (lane == 0) (isv ? p.vs : p.us)[r] = am * (1.f / 256.f);
  }
}

DI void phase_gr(const Params& p, char* smem, int tid) {
  const int w = tid >> 6, lane = tid & 63, c_inv = lane & 31, hh_inv = lane >> 5;
  const int wm = w >> 1, wn = w & 1;
  float* wl = wave_stage(smem, w);
  for (int id = blockIdx.x; id < 128 * 24; id += gridDim.x) {
    int mt = id / 24, nt = id - mt * 24;
    int m0 = mt * 256, n0 = nt * 128;
    f32x16 acc[2][2]; zero_acc(acc);
    gemm_kloop(p.hA + (size_t)m0 * 1024, 1024, p.wgrT + (size_t)n0 * 1024, 1024, 1024, acc, (u16*)smem, tid);
    const int c = opq(c_inv), hh = opq(hh_inv);
    const int rb = m0 + wm * 64;
    stage_acc<EPS>(acc, wl, c, hh);
    if (n0 < 1024) {
      const int cb = n0 + wn * 64;
      epi_rows(wl, lane, [&](int r, int cc, float (&v)[8]) {
        const size_t off = (size_t)(rb + r) * 1024 + cb + cc;
        float of[8], ob[8];
        ld_bf16x8(p.o_fw + off, of); ld_bf16x8(p.o_bw + off, ob);
        const float rs = p.rstd[(rb + r) * 4 + ((cb + cc) >> 8)];
        float4 g0 = *(const float4*)(p.gla_norm_g + cb + cc), g1 = *(const float4*)(p.gla_norm_g + cb + cc + 4);
        const float gg[8] = {g0.x, g0.y, g0.z, g0.w, g1.x, g1.y, g1.z, g1.w};
#pragma unroll
        for (int j = 0; j < 8; ++j) { float a = v[j]; v[j] = (of[j] + ob[j]) * rs * gg[j] * (a / (1.f + __expf(-a))); }
        st_bf16x8(p.A1 + off, v);
      });
    } else {
      u16* dst = ((n0 < 2048) ? p.sga : p.sgb) + (size_t)rb * 1024 + (n0 & 1023) + wn * 64;
      epi_rows(wl, lane, [&](int r, int cc, float (&v)[8]) {
#pragma unroll
        for (int j = 0; j < 8; ++j) v[j] = 1.f / (1.f + __expf(-v[j]));
        st_bf16x8(dst + (size_t)r * 1024 + cc, v);
      });
    }
  }
}

DI void phase_merge(const Params& p, char* smem, int tid) {
  const int w = tid >> 6, lane = tid & 63, c_inv = lane & 31, hh_inv = lane >> 5;
  const int wm = w >> 1, wn = w & 1;
  float* wl = wave_stage(smem, w);
  for (int id = blockIdx.x; id < 128 * 8; id += gridDim.x) {
    int mt = id >> 3, nt = id & 7;
    int m0 = mt * 256, n0 = nt * 128;
    const size_t tb = (size_t)(m0 + wm * 64) * 1024 + n0 + wn * 64;
    f32x16 acc[2][2];
    zero_acc(acc);
    gemm_kloop(p.A1 + (size_t)m0 * 1024, 1024, p.wglaT + (size_t)n0 * 1024, 1024, 1024, acc, (u16*)smem, tid);
    {
      const int c = opq(c_inv), hh = opq(hh_inv);
      stage_acc<EPS>(acc, wl, c, hh);
      epi_rows(wl, lane, [&](int r, int cc, float (&v)[8]) {
        float gv[8];
        ld_bf16x8(p.sga + tb + (size_t)r * 1024 + cc, gv);
#pragma unroll
        for (int j = 0; j < 8; ++j) v[j] *= gv[j];
        st_bf16x8(p.sga + tb + (size_t)r * 1024 + cc, v);
      });
    }
    zero_acc(acc);
    gemm_kloop(p.dq + (size_t)m0 * 1024, 1024, p.wdiffT + (size_t)n0 * 1024, 1024, 1024, acc, (u16*)smem, tid);
    {
      const int c = opq(c_inv), hh = opq(hh_inv);
      stage_acc<EPS>(acc, wl, c, hh);
      epi_rows(wl, lane, [&](int r, int cc, float (&v)[8]) {
        float gv[8], mv[8];
        ld_bf16x8(p.sgb + tb + (size_t)r * 1024 + cc, gv);
        ld_bf16x8(p.sga + tb + (size_t)r * 1024 + cc, mv);
#pragma unroll
        for (int j = 0; j < 8; ++j) v[j] = mv[j] + v[j] * gv[j];
        st_bf16x8(p.merged + tb + (size_t)r * 1024 + cc, v);
      });
    }
  }
}

DI void phase_out(const Params& p, char* smem, int tid) {
  const int w = tid >> 6, lane = tid & 63, c_inv = lane & 31, hh_inv = lane >> 5;
  const int wm = w >> 1, wn = w & 1;
  float* wl = wave_stage(smem, w);
  for (int id = blockIdx.x; id < 128 * 8; id += gridDim.x) {
    int mt = id >> 3, nt = id & 7;
    int m0 = mt * 256, n0 = nt * 128;
    f32x16 acc[2][2]; zero_acc(acc);
    gemm_kloop(p.merged + (size_t)m0 * 1024, 1024, p.woutT + (size_t)n0 * 1024, 1024, 1024, acc, (u16*)smem, tid);
    const int c = opq(c_inv), hh = opq(hh_inv);
    const int b = m0 >> 13;
    const int cb = n0 + wn * 64;
    const size_t tb = (size_t)(m0 + wm * 64) * 1024 + cb;
    stage_acc<EPS>(acc, wl, c, hh);
    epi_rows(wl, lane, [&](int r, int cc, float (&v)[8]) {
      const float* xp = p.x + tb + (size_t)r * 1024 + cc;
      const float* gp = p.mod + b * 6144 + 2048 + cb + cc;
      float4 x0 = *(const float4*)xp, x1v = *(const float4*)(xp + 4);
      float4 g0 = *(const float4*)gp, g1 = *(const float4*)(gp + 4);
      float4 o0 = {x0.x + g0.x * v[0], x0.y + g0.y * v[1], x0.z + g0.z * v[2], x0.w + g0.w * v[3]};
      float4 o1 = {x1v.x + g1.x * v[4], x1v.y + g1.y * v[5], x1v.z + g1.z * v[6], x1v.w + g1.w * v[7]};
      float* op = p.x1 + tb + (size_t)r * 1024 + cc;
      *(float4*)op = o0; *(float4*)(op + 4) = o1;
    });
  }
}

DI void phase_peerq(const Params& p, char* smem, int tid) {
  const int w = tid >> 6, lane = tid & 63, c_inv = lane & 31, hh_inv = lane >> 5;
  const int wm = w >> 1, wn = w & 1;
  float* wl = wave_stage(smem, w);
  for (int id = blockIdx.x; id < 128 * 16; id += gridDim.x) {
    int mt = id >> 4, nt = id & 15;
    int m0 = mt * 256, n0 = nt * 128;
    f32x16 acc[2][2]; zero_acc(acc);
    gemm_kloop(p.h2 + (size_t)m0 * 1024, 1024, p.wqT + (size_t)n0 * 1024, 1024, 1024, acc, (u16*)smem, tid);
    const int c = opq(c_inv), hh = opq(hh_inv);
    u16* dst = p.qp + (size_t)(m0 + wm * 64) * 2048 + n0 + wn * 64;
    stage_acc<EPS>(acc, wl, c, hh);
    epi_rows(wl, lane, [&](int r, int cc, float (&v)[8]) { st_bf16x8(dst + (size_t)r * 2048 + cc, v); });
  }
}

DI unsigned fkey(float f) { unsigned u = __float_as_uint(f); return (u & 0x80000000u) ? ~u : (u | 0x80000000u); }
DI void phase_topk(const Params& p, char* smem, int tid) {
  float* sc = (float*)smem;
  float* ts = sc + 64 * 132;
  int* ti = (int*)(ts + 64 * 32);
  const int w = tid >> 6, lane = tid & 63, c = lane & 31, hh = lane >> 5;
  const int l16 = tid & 15, grp = tid >> 4;
  for (int item = blockIdx.x; item < 4096; item += gridDim.x) {
    const int h = item & 7;
    const size_t t0 = (size_t)(item >> 3) * 64;
#pragma unroll 1
    for (int pp = 0; pp < 2; ++pp) {
      f32x16 acc = zero16();
      const int nt = w & 3, mt = w >> 2;
      const u16* Aq = p.qp + t0 * 2048 + h * 256 + pp * 128;
      const u16* Bk = p.subk + (size_t)(h * 2 + pp) * 128 * 128;
#pragma unroll
      for (int s = 0; s < 8; ++s) {
        bf16x8 bfr = ld_frag16(Bk + (32 * nt + c) * 128 + 16 * s + 8 * hh);
        bf16x8 a0 = ld_frag16(Aq + (size_t)(32 * mt + c) * 2048 + 16 * s + 8 * hh);
        acc = MFMA(a0, bfr, acc);
      }
      __syncthreads();
#pragma unroll
      for (int i = 0; i < 16; ++i) sc[(mt * 32 + crow(i, hh)) * 132 + 32 * nt + c] = acc[i];
      __syncthreads();
      unsigned k[2][8], sel[2];
#pragma unroll
      for (int rr = 0; rr < 2; ++rr) {
        sel[rr] = 0;
#pragma unroll
        for (int m = 0; m < 8; ++m) { int n = l16 + 16 * m; k[rr][m] = (fkey(sc[(grp + 32 * rr) * 132 + n]) & ~127u) | (unsigned)(127 - n); }
      }
#pragma unroll 1
      for (int round = 0; round < 16; ++round) {
#pragma unroll
        for (int rr = 0; rr < 2; ++rr) {
          unsigned mx = max(max(max(k[rr][0], k[rr][1]), max(k[rr][2], k[rr][3])), max(max(k[rr][4], k[rr][5]), max(k[rr][6], k[rr][7])));
          mx = gmax16(mx);
          sel[rr] = (l16 == round) ? mx : sel[rr];
#pragma unroll
          for (int m = 0; m < 8; ++m) k[rr][m] = (k[rr][m] == mx) ? 0u : k[rr][m];
        }
      }
#pragma unroll
      for (int rr = 0; rr < 2; ++rr) {
        const int row = grp + 32 * rr;
        int n = 127 - (int)(sel[rr] & 127u);
        ti[(row * 2 + pp) * 16 + l16] = n;
        ts[(row * 2 + pp) * 16 + l16] = sc[row * 132 + n];
      }
    }
    __syncthreads();
    {
      float s0v[2]; int ptr[2]; unsigned selk[2];
#pragma unroll
      for (int rr = 0; rr < 2; ++rr) { s0v[rr] = ts[((grp + 32 * rr) * 2) * 16 + l16]; ptr[rr] = 0; selk[rr] = 0; }
#pragma unroll 1
      for (int round = 0; round < 16; ++round) {
#pragma unroll
        for (int rr = 0; rr < 2; ++rr) {
          const int row = grp + 32 * rr;
          float v = s0v[rr] + ts[(row * 2 + 1) * 16 + (ptr[rr] & 15)];
          unsigned key = (ptr[rr] < 16) ? ((fkey(v) & ~255u) | (unsigned)(255 - (l16 * 16 + ptr[rr]))) : 0u;
          unsigned mx = gmax16(key);
          selk[rr] = (l16 == round) ? mx : selk[rr];
          int aw = (255 - (int)(mx & 255u)) >> 4;
          ptr[rr] += (l16 == aw) ? 1 : 0;
        }
      }
#pragma unroll
      for (int rr = 0; rr < 2; ++rr) {
        const int row = grp + 32 * rr;
        int flat = 255 - (int)(selk[rr] & 255u);
        int aw = flat >> 4, bw = flat & 15;
        int my_idx = ti[(row * 2) * 16 + aw] * 128 + ti[(row * 2 + 1) * 16 + bw];
        float my_s = ts[(row * 2) * 16 + aw] + ts[(row * 2 + 1) * 16 + bw];
        float mxs = gmaxf16(my_s);
        float e = __expf(my_s - mxs);
        float sum = gsum16(e);
        p.idx[(t0 + row) * 128 + h * 16 + l16] = my_idx;
        p.g[(t0 + row) * 128 + h * 16 + l16] = e / sum;
      }
    }
    __syncthreads();
  }
}

DI void peer_load_batch(const unsigned char* tab, const float* rsc, int ireg, int ebase, int q, int gq, u32x4 (&buf)[4], float (&scl)[1]) {
#pragma unroll
  for (int rr = 0; rr < 1; ++rr) {
    int e = ebase + 4 * rr + gq;
    int row = __shfl(ireg, e & 63);
    const unsigned char* rp = tab + (size_t)row * 1024 + q * 16;
#pragma unroll
    for (int j = 0; j < 4; ++j) buf[rr * 4 + j] = *(const u32x4*)(rp + j * 256);
    scl[rr] = rsc[row];
  }
}
DI void peer_u_compute(const u32x4 (&buf)[4], const float (&scl)[1], const float (&hf)[64], float* wl, int ebase, int q, int gq) {
#pragma unroll
  for (int rr = 0; rr < 1; ++rr) {
    float acc = 0.f;
#pragma unroll
    for (int j = 0; j < 4; ++j)
#pragma unroll
      for (int i = 0; i < 4; ++i) {
        f32x2_t lo = __builtin_amdgcn_cvt_pk_f32_fp8((int)buf[rr * 4 + j][i], false);
        f32x2_t hi = __builtin_amdgcn_cvt_pk_f32_fp8((int)buf[rr * 4 + j][i], true);
        acc += lo[0] * hf[j * 16 + 4 * i] + lo[1] * hf[j * 16 + 4 * i + 1] + hi[0] * hf[j * 16 + 4 * i + 2] + hi[1] * hf[j * 16 + 4 * i + 3];
      }
    acc = gsum16(acc) * scl[rr];
    float act = 0.5f * acc * (1.f + erff(acc * 0.7071067811865476f));
    if (q == 0) wl[ebase + 4 * rr + gq] = act;
  }
}
DI void peer_v_compute(const u32x4 (&buf)[4], const float (&scl)[1], float (&o)[64], const float* wl, float greg, int ebase, int gq) {
#pragma unroll
  for (int rr = 0; rr < 1; ++rr) {
    const int e = ebase + 4 * rr + gq;
    float ge = __shfl(greg, e & 63);
    float wg = wl[e] * ge * scl[rr];
#pragma unroll
    for (int j = 0; j < 4; ++j)
#pragma unroll
      for (int i = 0; i < 4; ++i) {
        f32x2_t lo = __builtin_amdgcn_cvt_pk_f32_fp8((int)buf[rr * 4 + j][i], false);
        f32x2_t hi = __builtin_amdgcn_cvt_pk_f32_fp8((int)buf[rr * 4 + j][i], true);
        o[j * 16 + 4 * i] += wg * lo[0]; o[j * 16 + 4 * i + 1] += wg * lo[1];
        o[j * 16 + 4 * i + 2] += wg * hi[0]; o[j * 16 + 4 * i + 3] += wg * hi[1];
      }
  }
}
DI void phase_peer_final(const Params& p, char* smem, int tid) {
  const int w = tid >> 6, lane = tid & 63, q = lane & 15, gq = lane >> 4;
  float* wl = (float*)smem + w * 128;
  const unsigned char* U8 = (const unsigned char*)p.uB;
  const unsigned char* V8 = (const unsigned char*)p.vB;
  for (int item = blockIdx.x; item < T / 8; item += gridDim.x) {
    const size_t t = (size_t)item * 8 + w;
    const int b = (int)(t >> 13);
    float hf[64];
#pragma unroll
    for (int j = 0; j < 4; ++j) {
      u32x4 ha = *(const u32x4*)(p.h2 + t * 1024 + (q + 16 * j) * 16);
      u32x4 hb = *(const u32x4*)(p.h2 + t * 1024 + (q + 16 * j) * 16 + 8);
#pragma unroll
      for (int i = 0; i < 4; ++i) { hf[j * 16 + 2 * i] = bflo(ha[i]); hf[j * 16 + 2 * i + 1] = bfhi(ha[i]); hf[j * 16 + 8 + 2 * i] = bflo(hb[i]); hf[j * 16 + 8 + 2 * i + 1] = bfhi(hb[i]); }
    }
    const int i0 = p.idx[t * 128 + lane], i1 = p.idx[t * 128 + 64 + lane];
    const float g0 = p.g[t * 128 + lane], g1 = p.g[t * 128 + 64 + lane];
    u32x4 bA[4], bB[4]; float sA[1], sB[1];
    peer_load_batch(U8, p.us, i0, 0, q, gq, bA, sA);
#pragma unroll 1
    for (int it = 0; it < 16; ++it) {
      const int e0 = 8 * it;
      peer_load_batch(U8, p.us, (e0 & 64) ? i1 : i0, e0 + 4, q, gq, bB, sB);
      peer_u_compute(bA, sA, hf, wl, e0, q, gq);
      if (it < 15) peer_load_batch(U8, p.us, ((e0 + 8) & 64) ? i1 : i0, e0 + 8, q, gq, bA, sA);
      else peer_load_batch(V8, p.vs, i0, 0, q, gq, bA, sA);
      peer_u_compute(bB, sB, hf, wl, e0 + 4, q, gq);
    }
    __syncthreads();
    float o[64];
#pragma unroll
    for (int i = 0; i < 64; ++i) o[i] = 0.f;
#pragma unroll 1
    for (int it = 0; it < 16; ++it) {
      const int e0 = 8 * it;
      peer_load_batch(V8, p.vs, (e0 & 64) ? i1 : i0, e0 + 4, q, gq, bB, sB);
      peer_v_compute(bA, sA, o, wl, (e0 & 64) ? g1 : g0, e0, gq);
      if (it < 15) peer_load_batch(V8, p.vs, ((e0 + 8) & 64) ? i1 : i0, e0 + 8, q, gq, bA, sA);
      peer_v_compute(bB, sB, o, wl, (e0 & 64) ? g1 : g0, e0 + 4, gq);
    }
    float h1[32];
#pragma unroll
    for (int i = 0; i < 32; ++i) {
      float send = (gq < 2) ? o[32 + i] : o[i];
      float keep = (gq < 2) ? o[i] : o[32 + i];
      h1[i] = keep + __shfl_xor(send, 32);
    }
    float fin[16];
#pragma unroll
    for (int i = 0; i < 16; ++i) {
      float send = (gq & 1) ? h1[i] : h1[16 + i];
      float keep = (gq & 1) ? h1[16 + i] : h1[i];
      fin[i] = keep + __shfl_xor(send, 16);
    }
    const int colb = (q + 16 * gq) * 16;
    float ss = 0.f;
#pragma unroll
    for (int i4 = 0; i4 < 4; ++i4) {
      float4 xa = *(const float4*)(p.x1 + t * 1024 + colb + 4 * i4);
      float4 ga = *(const float4*)(p.mod + b * 6144 + 5120 + colb + 4 * i4);
      fin[4 * i4 + 0] = xa.x + ga.x * fin[4 * i4 + 0]; fin[4 * i4 + 1] = xa.y + ga.y * fin[4 * i4 + 1];
      fin[4 * i4 + 2] = xa.z + ga.z * fin[4 * i4 + 2]; fin[4 * i4 + 3] = xa.w + ga.w * fin[4 * i4 + 3];
      ss += fin[4 * i4] * fin[4 * i4] + fin[4 * i4 + 1] * fin[4 * i4 + 1] + fin[4 * i4 + 2] * fin[4 * i4 + 2] + fin[4 * i4 + 3] * fin[4 * i4 + 3];
    }
    ss = wave_sum(ss);
    const float rstd = rsqrtf(ss * (1.f / 1024.f) + RMS_EPS);
#pragma unroll
    for (int i4 = 0; i4 < 4; ++i4) {
      int col = colb + 4 * i4;
      float4 gg = *(const float4*)(p.normf_g + col);
      float4 sh = *(const float4*)(p.fmod + b * 2048 + col);
      float4 sc = *(const float4*)(p.fmod + b * 2048 + 1024 + col);
      float4 r;
      r.x = fin[4 * i4 + 0] * rstd * gg.x * (1.f + sc.x) + sh.x;
      r.y = fin[4 * i4 + 1] * rstd * gg.y * (1.f + sc.y) + sh.y;
      r.z = fin[4 * i4 + 2] * rstd * gg.z * (1.f + sc.z) + sh.z;
      r.w = fin[4 * i4 + 3] * rstd * gg.w * (1.f + sc.w) + sh.w;
      *(float4*)(p.out + t * 1024 + col) = r;
    }
    __syncthreads();
  }
}

__global__ void __launch_bounds__(512) fwd_megakernel(Params p) {
  cg::grid_group grid = cg::this_grid();
  extern __shared__ __attribute__((aligned(16))) char smem[];
  const int tid = threadIdx.x;
  phase_prep(p, smem, opq(tid));
  grid.sync();
  phase_norm_mod(p.x, p.norm1_g, p.mod, 0, 1024, p.hA, opq(tid));
  grid.sync();
  phase_proj(p, smem, opq(tid));
  grid.sync();
  phase_gla_pre(p, smem, opq(tid));
  grid.sync();
  phase_mixers(p, smem, opq(tid));
  grid.sync();
  phase_post_mixers(p, opq(tid));
  grid.sync();
  phase_gr(p, smem, opq(tid));
  grid.sync();
  phase_merge(p, smem, opq(tid));
  grid.sync();
  phase_out(p, smem, opq(tid));
  grid.sync();
  phase_norm_mod(p.x1, p.norm2_g, p.mod, 3072, 4096, p.h2, opq(tid));
  grid.sync();
  phase_peerq(p, smem, opq(tid));
  grid.sync();
  phase_topk(p, smem, opq(tid));
  grid.sync();
  phase_peer_final(p, smem, opq(tid));
}

extern "C" void kernel_launch(void* const* d_in, const int* in_sizes, int n_in, void* d_out, int out_size, void* d_ws,
                              size_t ws_size, hipStream_t stream) {
  static int grid_blocks = 0;
  if (!grid_blocks) {
    int dev = 0, cus = 0, per_cu = 0;
    hipGetDevice(&dev);
    hipDeviceGetAttribute(&cus, hipDeviceAttributeMultiprocessorCount, dev);
    if (hipFuncSetAttribute((const void*)fwd_megakernel, hipFuncAttributeMaxDynamicSharedMemorySize, LDS_BYTES) != hipSuccess) { fprintf(stderr, "hipFuncSetAttribute failed\n"); }
    hipOccupancyMaxActiveBlocksPerMultiprocessor(&per_cu, fwd_megakernel, 512, LDS_BYTES);
    if (per_cu < 1) per_cu = 1;
    grid_blocks = cus * per_cu;
  }
  if (ws_size < 492 * MB) { fprintf(stderr, "ws too small: %zu\n", ws_size); return; }
  Params p{};
  p.x = (const float*)d_in[0]; p.c = (const float*)d_in[1]; p.pos = (const int*)d_in[2];
  p.w_ada = (const float*)d_in[3]; p.b_ada = (const float*)d_in[4]; p.norm1_g = (const float*)d_in[5];
  p.w_in = (const float*)d_in[6]; p.wa_fw = (const float*)d_in[7]; p.ba_fw = (const float*)d_in[8];
  p.wa_bw = (const float*)d_in[9]; p.ba_bw = (const float*)d_in[10]; p.gla_norm_g = (const float*)d_in[11];
  p.lq1 = (const float*)d_in[12]; p.lk1 = (const float*)d_in[13]; p.lq2 = (const float*)d_in[14]; p.lk2 = (const float*)d_in[15];
  p.diff_norm_g = (const float*)d_in[16]; p.w_gla = (const float*)d_in[17]; p.w_diff = (const float*)d_in[18];
  p.w_out = (const float*)d_in[19]; p.norm2_g = (const float*)d_in[20]; p.peer_wq = (const float*)d_in[21];
  p.subkeys = (const float*)d_in[22]; p.peer_u = (const float*)d_in[23]; p.peer_v = (const float*)d_in[24];
  p.w_fada = (const float*)d_in[25]; p.b_fada = (const float*)d_in[26]; p.normf_g = (const float*)d_in[27];
  p.out = (float*)d_out;
  char* ws = (char*)d_ws;
  p.winT = (u16*)(ws + 0 * MB); p.wgrT = (u16*)(ws + 11 * MB); p.wgaT = (u16*)(ws + 13 * MB); p.wgbT = (u16*)(ws + 15 * MB);
  p.wglaT = (u16*)(ws + 17 * MB); p.wdiffT = (u16*)(ws + 19 * MB); p.woutT = (u16*)(ws + 21 * MB); p.wqT = (u16*)(ws + 23 * MB);
  p.subk = (u16*)(ws + 27 * MB); p.rope = (float*)(ws + 28 * MB);
  p.mod = (float*)(ws + 36 * MB); p.fmod = (float*)(ws + 36 * MB + 128 * 1024); p.lam = (float*)(ws + 36 * MB + 192 * 1024);
  p.counter = (int*)(ws + 36 * MB + 196 * 1024);
  p.kmax = (int*)(ws + 36 * MB + 200 * 1024);
  p.lr = (float*)(ws + 37 * MB); p.dec = (float*)(ws + 41 * MB); p.rstd = (float*)(ws + 43 * MB);
  char* slot[9];
  for (int i = 0; i < 7; ++i) slot[i] = ws + (44 + 64 * (size_t)i) * MB;
  slot[7] = (char*)d_out; slot[8] = (char*)d_out + 64 * MB;
  p.hA = (u16*)slot[0];
  p.gq = (u16*)slot[1]; p.gk = (u16*)(slot[1] + 32 * MB);
  p.gvT = (u16*)slot[2]; p.dq = (u16*)slot[3]; p.dk = (u16*)slot[4]; p.dvT = (u16*)slot[5];
  p.qe_fw = (u16*)slot[0]; p.ke_fw = (u16*)(slot[0] + 32 * MB);
  p.qe_bw = (u16*)slot[6]; p.ke_bw = (u16*)(slot[6] + 32 * MB);
  p.keT = (u16*)slot[7];
  p.o_fw = (u16*)slot[1]; p.o_bw = (u16*)slot[8];
  p.uB = (u16*)slot[6]; p.vB = (u16*)(slot[6] + 16 * MB);
  p.A1 = (u16*)slot[2]; p.merged = (u16*)slot[4];
  p.sga = (u16*)slot[5]; p.sgb = (u16*)slot[7];
  p.x1 = (float*)slot[0];
  p.h2 = (u16*)slot[2]; p.qp = (u16*)slot[3];
  p.us = (float*)(slot[6] + 32 * MB); p.vs = (float*)(slot[6] + 33 * MB);
  p.idx = (int*)slot[5]; p.g = (float*)(slot[5] + 16 * MB);
  void* args[] = {&p};
  hipError_t e = hipLaunchCooperativeKernel((void*)fwd_megakernel, dim3(grid_blocks), dim3(512), args, LDS_BYTES, stream);
  if (e != hipSuccess) fprintf(stderr, "cooperative launch failed: %s (grid %d)\n", hipGetErrorString(e), grid_blocks);
}
```

```cpp
#include <hip/hip_runtime.h>
#include <hip/hip_cooperative_groups.h>
#include <cstdio>
namespace cg = cooperative_groups;

#define DI __device__ __forceinline__
typedef unsigned short u16;
using bf16x8 = __attribute__((ext_vector_type(8))) short;
using f32x16 = __attribute__((ext_vector_type(16))) float;
using u32x4 = __attribute__((ext_vector_type(4))) unsigned;
using u32x2 = __attribute__((ext_vector_type(2))) unsigned;
typedef __bf16 bf16x2_t __attribute__((ext_vector_type(2)));
typedef float f32x2_t __attribute__((ext_vector_type(2)));

constexpr int T = 32768, D = 1024, S = 8192;
constexpr size_t MB = 1ull << 20;
constexpr float RMS_EPS = 1e-6f;
constexpr int LDS_BYTES = 144 * 1024;

#define MFMA(a, b, c) __builtin_amdgcn_mfma_f32_32x32x16_bf16((a), (b), (c), 0, 0, 0)

struct Params {
  const float *x, *c; const int* pos;
  const float *w_ada, *b_ada, *norm1_g, *w_in, *wa_fw, *ba_fw, *wa_bw, *ba_bw, *gla_norm_g;
  const float *lq1, *lk1, *lq2, *lk2, *diff_norm_g, *w_gla, *w_diff, *w_out, *norm2_g, *peer_wq, *subkeys, *peer_u, *peer_v;
  const float *w_fada, *b_fada, *normf_g;
  float* out;
  u16 *winT, *wgrT, *wgaT, *wgbT, *wglaT, *wdiffT, *woutT, *wqT, *subk;
  float* rope;
  float* mod;
  float* fmod;
  float* lam;
  int* counter;
  float* lr;
  float* dec;
  float* rstd;
  u16 *hA, *gq, *gk, *gvT, *dq, *dk, *dvT;
  u16 *qe_fw, *ke_fw, *qe_bw, *ke_bw, *keT;
  u16 *o_fw, *o_bw, *A1, *merged, *h2, *qp, *uB, *vB;
  float* x1;
  int* idx; float* g;
  float *us, *vs;
  u16 *sga, *sgb;
  int* kmax;
};

DI u16 f2bf(float x) { unsigned u = __float_as_uint(x); u += 0x7fffu + ((u >> 16) & 1u); return (u16)(u >> 16); }
DI float bf2f(u16 b) { return __uint_as_float(((unsigned)b) << 16); }
DI unsigned pack2(float a, float b) {
  f32x2_t v = {a, b};
  bf16x2_t r = __builtin_convertvector(v, bf16x2_t);
  return __builtin_bit_cast(unsigned, r);
}
DI float bflo(unsigned u) { return __uint_as_float(u << 16); }
DI float bfhi(unsigned u) { return __uint_as_float(u & 0xffff0000u); }
DI int crow(int i, int h) { return (i & 3) + 8 * (i >> 2) + 4 * h; }
DI bf16x8 pack_step(const f32x16& x, int s) {
  u32x4 p;
  p[0] = pack2(x[8 * s + 0], x[8 * s + 1]);
  p[1] = pack2(x[8 * s + 2], x[8 * s + 3]);
  p[2] = pack2(x[8 * s + 4], x[8 * s + 5]);
  p[3] = pack2(x[8 * s + 6], x[8 * s + 7]);
  return __builtin_bit_cast(bf16x8, p);
}
DI bf16x8 ld_frag16(const u16* p) { return __builtin_bit_cast(bf16x8, *(const u32x4*)p); }
DI bf16x8 ld_frag8x2(const u16* p) {
  u32x2 lo = *(const u32x2*)p; u32x2 hi = *(const u32x2*)(p + 8);
  u32x4 v = {lo[0], lo[1], hi[0], hi[1]};
  return __builtin_bit_cast(bf16x8, v);
}
DI void st_perm(u16* rowp, int ch, u32x4 v) {
  u16* d = rowp + (ch >> 1) * 16 + (ch & 1) * 4;
  u32x2 lo = {v[0], v[1]}, hi = {v[2], v[3]};
  *(u32x2*)d = lo;
  *(u32x2*)(d + 8) = hi;
}
DI float wave_sum(float v) {
#pragma unroll
  for (int o = 32; o >= 1; o >>= 1) v += __shfl_xor(v, o);
  return v;
}

template <int CTRL> DI float dpp_f(float v) { return __builtin_bit_cast(float, __builtin_amdgcn_update_dpp(0, __builtin_bit_cast(int, v), CTRL, 0xF, 0xF, false)); }
template <int CTRL> DI unsigned dpp_u(unsigned v) { return (unsigned)__builtin_amdgcn_update_dpp(0, (int)v, CTRL, 0xF, 0xF, false); }
DI float gsum16(float v) { v += dpp_f<0x121>(v); v += dpp_f<0x122>(v); v += dpp_f<0x124>(v); v += dpp_f<0x128>(v); return v; }
DI float gmaxf16(float v) { v = fmaxf(v, dpp_f<0x121>(v)); v = fmaxf(v, dpp_f<0x122>(v)); v = fmaxf(v, dpp_f<0x124>(v)); v = fmaxf(v, dpp_f<0x128>(v)); return v; }
DI unsigned gmax16(unsigned v) { v = max(v, dpp_u<0x121>(v)); v = max(v, dpp_u<0x122>(v)); v = max(v, dpp_u<0x124>(v)); v = max(v, dpp_u<0x128>(v)); return v; }
DI int opq(int x) { asm volatile("" : "+v"(x)); return x; }
DI f32x16 zero16() { f32x16 z; for (int i = 0; i < 16; ++i) z[i] = 0.f; return z; }

DI void tconv_tile(const float* src, int ld, int c0, int nc, u16* dst, int ct, int kt, float* sm, int tid) {
  __syncthreads();
  int cl = tid & 63, r0 = tid >> 6;
#pragma unroll
  for (int r = 0; r < 8; ++r) {
    int k = kt * 64 + r0 + 8 * r;
    int col = ct * 64 + cl;
    float v = (col < nc) ? src[(size_t)k * ld + c0 + col] : 0.f;
    sm[(r0 + 8 * r) * 65 + cl] = v;
  }
  __syncthreads();
#pragma unroll
  for (int r = 0; r < 8; ++r) {
    int col = r0 + 8 * r;
    int k = cl;
    dst[(size_t)(ct * 64 + col) * 1024 + kt * 64 + k] = f2bf(sm[k * 65 + col]);
  }
}

DI void phase_prep(const Params& p, char* smem, int tid) {
  float* sm = (float*)smem;
  const int nblk = gridDim.x, bid = blockIdx.x;
  const int NCT = 32 + 48 + 2 + 16 * 6 + 32;
  for (int it = bid; it < NCT * 16; it += nblk) {
    int ctg = it >> 4, kt = it & 15;
    const float* src; int ld, c0, nc; u16* dst; int ct;
    if (ctg < 32) { src = p.w_in; ld = 8224; c0 = 0; nc = 2048; dst = p.winT; ct = ctg; }
    else if (ctg < 80) { src = p.w_in; ld = 8224; c0 = 3104; nc = 3072; dst = p.winT + (size_t)2048 * 1024; ct = ctg - 32; }
    else if (ctg < 82) { src = p.w_in; ld = 8224; c0 = 3072; nc = 32; dst = p.winT + (size_t)5120 * 1024; ct = ctg - 80; }
    else if (ctg < 98) { src = p.w_in; ld = 8224; c0 = 2048; nc = 1024; dst = p.wgrT; ct = ctg - 82; }
    else if (ctg < 114) { src = p.w_in; ld = 8224; c0 = 6176; nc = 1024; dst = p.wgaT; ct = ctg - 98; }
    else if (ctg < 130) { src = p.w_in; ld = 8224; c0 = 7200; nc = 1024; dst = p.wgbT; ct = ctg - 114; }
    else if (ctg < 146) { src = p.w_gla; ld = 1024; c0 = 0; nc = 1024; dst = p.wglaT; ct = ctg - 130; }
    else if (ctg < 162) { src = p.w_diff; ld = 1024; c0 = 0; nc = 1024; dst = p.wdiffT; ct = ctg - 146; }
    else if (ctg < 178) { src = p.w_out; ld = 1024; c0 = 0; nc = 1024; dst = p.woutT; ct = ctg - 162; }
    else { src = p.peer_wq; ld = 2048; c0 = 0; nc = 2048; dst = p.wqT; ct = ctg - 178; }
    tconv_tile(src, ld, c0, nc, dst, ct, kt, sm, tid);
  }
  __syncthreads();
  const int gtid = bid * 512 + tid, gsz = nblk * 512;
  for (int i = gtid; i < 8 * 2 * 128 * 128; i += gsz) p.subk[i] = f2bf(p.subkeys[i]);
  for (int i = gtid; i < T * 32; i += gsz) {
    int t = i >> 5, d = i & 31;
    float inv = powf(10000.f, -(float)d / 32.f);
    float ang = (float)p.pos[t] * inv;
    double r = (double)ang * 0.15915494309189535;
    r -= rint(r);
    float rf = (float)r;
    p.rope[2 * i] = __builtin_amdgcn_cosf(rf);
    p.rope[2 * i + 1] = __builtin_amdgcn_sinf(rf);
  }
  if (gtid == 0) {
    float s1 = 0.f, s2 = 0.f;
    for (int i = 0; i < 64; ++i) { s1 += p.lq1[i] * p.lk1[i]; s2 += p.lq2[i] * p.lk2[i]; }
    p.lam[0] = expf(s1) - expf(s2) + 0.2f;
    for (int i = 0; i < 16; ++i) p.counter[i] = 0;
    for (int i = 0; i < 64; ++i) p.kmax[i] = 0;
  }
  {
    float* cact = sm;
    float* red = sm + 4096;
    __syncthreads();
    for (int i = tid; i < 4096; i += 512) { float v = p.c[i]; cact[i] = v / (1.f + __expf(-v)); }
    __syncthreads();
    int w = tid >> 6, lane = tid & 63;
    for (int it = bid; it < 128; it += nblk) {
      int col = it * 64 + lane;
      const float* W; int ld, cc;
      if (col < 6144) { W = p.w_ada; ld = 6144; cc = col; } else { W = p.w_fada; ld = 2048; cc = col - 6144; }
      float a0 = 0, a1 = 0, a2 = 0, a3 = 0;
#pragma unroll 8
      for (int k = w * 128; k < w * 128 + 128; ++k) {
        float wv = W[(size_t)k * ld + cc];
        a0 += cact[k] * wv; a1 += cact[1024 + k] * wv; a2 += cact[2048 + k] * wv; a3 += cact[3072 + k] * wv;
      }
      red[(w * 4 + 0) * 64 + lane] = a0; red[(w * 4 + 1) * 64 + lane] = a1;
      red[(w * 4 + 2) * 64 + lane] = a2; red[(w * 4 + 3) * 64 + lane] = a3;
      __syncthreads();
      if (tid < 256) {
        int b = w;
        float s = 0.f;
#pragma unroll
        for (int ww = 0; ww < 8; ++ww) s += red[(ww * 4 + b) * 64 + lane];
        if (col < 6144) p.mod[b * 6144 + cc] = s + p.b_ada[cc];
        else p.fmod[b * 2048 + cc] = s + p.b_fada[cc];
      }
      __syncthreads();
    }
  }
}

DI void phase_norm_mod(const float* src, const float* g, const float* mod, int sh_off, int sc_off, u16* dst, int tid) {
  int w = tid >> 6, lane = tid & 63;
  for (int row = blockIdx.x * 8 + w; row < T; row += gridDim.x * 8) {
    int b = row >> 13;
    const float* xr = src + (size_t)row * 1024;
    float4 v[4]; float ss = 0.f;
#pragma unroll
    for (int m = 0; m < 4; ++m) { v[m] = *(const float4*)(xr + (m * 64 + lane) * 4); ss += v[m].x * v[m].x + v[m].y * v[m].y + v[m].z * v[m].z + v[m].w * v[m].w; }
    ss = wave_sum(ss);
    float rstd = rsqrtf(ss * (1.f / 1024.f) + RMS_EPS);
#pragma unroll
    for (int m = 0; m < 4; ++m) {
      int col = (m * 64 + lane) * 4;
      float4 gg = *(const float4*)(g + col);
      float4 sh = *(const float4*)(mod + b * 6144 + sh_off + col);
      float4 sc = *(const float4*)(mod + b * 6144 + sc_off + col);
      float y0 = v[m].x * rstd * gg.x * (1.f + sc.x) + sh.x;
      float y1 = v[m].y * rstd * gg.y * (1.f + sc.y) + sh.y;
      float y2 = v[m].z * rstd * gg.z * (1.f + sc.z) + sh.z;
      float y3 = v[m].w * rstd * gg.w * (1.f + sc.w) + sh.w;
      u32x2 o = {pack2(y0, y1), pack2(y2, y3)};
      *(u32x2*)(dst + (size_t)row * 1024 + col) = o;
    }
  }
}

constexpr int GLD = 72;
constexpr int GSTAGE = (256 + 128) * GLD;
DI void gemm_kloop(const u16* A, int lda, const u16* Bt, int ldb, int K, f32x16 (&acc)[2][2], u16* smem, int tid) {
  const int w = tid >> 6, lane = tid & 63, c = lane & 31, hh = lane >> 5;
  const int wm = w >> 1, wn = w & 1;
  const int lrow = tid >> 3, lcol = (tid & 7) * 8;
  u32x4 ra[4], rb[2];
  const int nk = K >> 6;
#pragma unroll
  for (int r = 0; r < 4; ++r) ra[r] = *(const u32x4*)(A + (size_t)(r * 64 + lrow) * lda + lcol);
#pragma unroll
  for (int r = 0; r < 2; ++r) rb[r] = *(const u32x4*)(Bt + (size_t)(r * 64 + lrow) * ldb + lcol);
  __syncthreads();
  {
    u16* sA = smem; u16* sB = smem + 256 * GLD;
#pragma unroll
    for (int r = 0; r < 4; ++r) *(u32x4*)(sA + (r * 64 + lrow) * GLD + lcol) = ra[r];
#pragma unroll
    for (int r = 0; r < 2; ++r) *(u32x4*)(sB + (r * 64 + lrow) * GLD + lcol) = rb[r];
  }
  if (nk > 1) {
#pragma unroll
    for (int r = 0; r < 4; ++r) ra[r] = *(const u32x4*)(A + (size_t)(r * 64 + lrow) * lda + 64 + lcol);
#pragma unroll
    for (int r = 0; r < 2; ++r) rb[r] = *(const u32x4*)(Bt + (size_t)(r * 64 + lrow) * ldb + 64 + lcol);
  }
  __syncthreads();
  for (int kt = 0; kt < nk; ++kt) {
    const u16* sA = smem + (kt & 1) * GSTAGE; const u16* sB = sA + 256 * GLD;
    if (kt + 1 < nk) {
      u16* nA = smem + ((kt + 1) & 1) * GSTAGE; u16* nB = nA + 256 * GLD;
#pragma unroll
      for (int r = 0; r < 4; ++r) *(u32x4*)(nA + (r * 64 + lrow) * GLD + lcol) = ra[r];
#pragma unroll
      for (int r = 0; r < 2; ++r) *(u32x4*)(nB + (r * 64 + lrow) * GLD + lcol) = rb[r];
      if (kt + 2 < nk) {
#pragma unroll
        for (int r = 0; r < 4; ++r) ra[r] = *(const u32x4*)(A + (size_t)(r * 64 + lrow) * lda + (kt + 2) * 64 + lcol);
#pragma unroll
        for (int r = 0; r < 2; ++r) rb[r] = *(const u32x4*)(Bt + (size_t)(r * 64 + lrow) * ldb + (kt + 2) * 64 + lcol);
      }
    }
    bf16x8 fr[2][4];
#define GLOADF(set, s) { fr[set][0] = ld_frag16(sA + (wm * 64 + c) * GLD + (s) * 16 + hh * 8); fr[set][1] = ld_frag16(sA + (wm * 64 + 32 + c) * GLD + (s) * 16 + hh * 8); \
                         fr[set][2] = ld_frag16(sB + (wn * 64 + c) * GLD + (s) * 16 + hh * 8); fr[set][3] = ld_frag16(sB + (wn * 64 + 32 + c) * GLD + (s) * 16 + hh * 8); }
#define GMM(set) { acc[0][0] = MFMA(fr[set][0], fr[set][2], acc[0][0]); acc[0][1] = MFMA(fr[set][0], fr[set][3], acc[0][1]); \
                   acc[1][0] = MFMA(fr[set][1], fr[set][2], acc[1][0]); acc[1][1] = MFMA(fr[set][1], fr[set][3], acc[1][1]); }
    GLOADF(0, 0);
    __builtin_amdgcn_sched_barrier(0);
    GLOADF(1, 1); GMM(0);
    __builtin_amdgcn_sched_barrier(0);
    GLOADF(0, 2); GMM(1);
    __builtin_amdgcn_sched_barrier(0);
    GLOADF(1, 3); GMM(0);
    __builtin_amdgcn_sched_barrier(0);
    GMM(1);
#undef GLOADF
#undef GMM
    __syncthreads();
  }
}
DI void zero_acc(f32x16 (&acc)[2][2]) {
#pragma unroll
  for (int a = 0; a < 2; ++a)
#pragma unroll
    for (int b = 0; b < 2; ++b) acc[a][b] = zero16();
}


constexpr int EPS = 68, EPT = 65;
DI float* wave_stage(char* smem, int w) { return (float*)smem + w * (64 * EPS); }
template <int STR> DI void stage_acc(const f32x16 (&acc)[2][2], float* wl, int c, int hh) {
#pragma unroll
  for (int mi = 0; mi < 2; ++mi)
#pragma unroll
    for (int ni = 0; ni < 2; ++ni)
#pragma unroll
      for (int i = 0; i < 16; ++i) wl[(mi * 32 + crow(i, hh)) * STR + ni * 32 + c] = acc[mi][ni][i];
}
DI void st_bf16x8(u16* dst, const float (&v)[8]) {
  u32x4 o = {pack2(v[0], v[1]), pack2(v[2], v[3]), pack2(v[4], v[5]), pack2(v[6], v[7])};
  *(u32x4*)dst = o;
}
DI void ld_bf16x8(const u16* srcp, float (&v)[8]) {
  u32x4 o = *(const u32x4*)srcp;
#pragma unroll
  for (int i = 0; i < 4; ++i) { v[2 * i] = bflo(o[i]); v[2 * i + 1] = bfhi(o[i]); }
}
template <class F> DI void epi_rows(const float* wl, int lane, F f) {
#pragma unroll
  for (int ps = 0; ps < 8; ++ps) {
    const int r = (lane >> 3) + 8 * ps, cc = (lane & 7) * 8;
    float4 v0 = *(const float4*)(wl + r * EPS + cc), v1 = *(const float4*)(wl + r * EPS + cc + 4);
    float v[8] = {v0.x, v0.y, v0.z, v0.w, v1.x, v1.y, v1.z, v1.w};
    f(r, cc, v);
  }
}
DI void epi_cols_bf16(const float* wl, int lane, u16* dstT, size_t ldt) {
#pragma unroll
  for (int ps = 0; ps < 8; ++ps) {
    const int col = (lane >> 3) + 8 * ps, r0 = (lane & 7) * 8;
    float v[8];
#pragma unroll
    for (int j = 0; j < 8; ++j) v[j] = wl[(r0 + j) * EPT + col];
    st_bf16x8(dstT + (size_t)col * ldt + r0, v);
  }
}

DI void phase_proj(const Params& p, char* smem, int tid) {
  const int w = tid >> 6, lane = tid & 63, c_inv = lane & 31, hh_inv = lane >> 5;
  const int wm = w >> 1, wn = w & 1;
  float* wl = wave_stage(smem, w);
  const int NT = 41;
  for (int id = blockIdx.x; id < 128 * NT; id += gridDim.x) {
    int mt = id / NT, nt = id - mt * NT;
    int m0 = mt * 256, n0 = nt * 128;
    f32x16 acc[2][2]; zero_acc(acc);
    gemm_kloop(p.hA + (size_t)m0 * 1024, 1024, p.winT + (size_t)n0 * 1024, 1024, 1024, acc, (u16*)smem, tid);
    const int c = opq(c_inv), hh = opq(hh_inv);
    const int rb = m0 + wm * 64, cb = n0 + wn * 64;
    if (n0 < 1024) {
      const float sc = (n0 < 512) ? 0.08838834764831845f : 1.f;
      u16* dst = ((n0 < 512) ? p.gq : p.gk) + (size_t)rb * 512 + (cb & 511);
      stage_acc<EPS>(acc, wl, c, hh);
      epi_rows(wl, lane, [&](int r, int cc, float (&v)[8]) {
#pragma unroll
        for (int j = 0; j < 8; ++j) v[j] *= sc;
        st_bf16x8(dst + (size_t)r * 512 + cc, v);
      });
    } else if (n0 < 2048 || (n0 >= 4096 && n0 < 5120)) {
      const bool isg = n0 < 2048;
      const int b = rb >> 13;
      u16* dstT;
      if (isg) { int cc0 = cb - 1024; dstT = p.gvT + ((size_t)(b * 4 + (cc0 >> 8)) * 256 + (cc0 & 255)) * 8192 + (rb & 8191); }
      else { int cc0 = cb - 4096; dstT = p.dvT + ((size_t)(b * 8 + (cc0 >> 7)) * 128 + (cc0 & 127)) * 8192 + (rb & 8191); }
      stage_acc<EPT>(acc, wl, c, hh);
      epi_cols_bf16(wl, lane, dstT, 8192);
    } else if (n0 < 4096) {
      const bool isq = n0 < 3072;
      const float sc = isq ? (0.125f * 1.4426950408889634f) : 1.f;
      const int cbb = cb - (isq ? 2048 : 3072);
      float knmax = 0.f;
#pragma unroll
      for (int mi = 0; mi < 2; ++mi)
#pragma unroll
        for (int i = 0; i < 16; ++i) {
          int row = rb + mi * 32 + crow(i, hh);
          float2 cs = *(const float2*)(p.rope + ((size_t)row * 32 + c) * 2);
          float x1 = acc[mi][0][i], x2 = acc[mi][1][i];
          float o1 = (x1 * cs.x - x2 * cs.y) * sc;
          float o2 = (x2 * cs.x + x1 * cs.y) * sc;
          acc[mi][0][i] = o1; acc[mi][1][i] = o2;
          if (!isq) {
            float ssq = o1 * o1 + o2 * o2;
            ssq += __shfl_xor(ssq, 1); ssq += __shfl_xor(ssq, 2); ssq += __shfl_xor(ssq, 4); ssq += __shfl_xor(ssq, 8); ssq += __shfl_xor(ssq, 16);
            knmax = fmaxf(knmax, ssq);
          }
        }
      if (!isq && c == 0) atomicMax(p.kmax + ((rb >> 13) * 8 + (cbb >> 7)) * 2 + ((cbb >> 6) & 1), __float_as_int(knmax));
      u16* dst = (isq ? p.dq : p.dk) + (size_t)rb * 1024 + cbb;
      stage_acc<EPS>(acc, wl, c, hh);
      epi_rows(wl, lane, [&](int r, int cc, float (&v)[8]) { st_bf16x8(dst + (size_t)r * 1024 + cc, v); });
    } else {
      if (wn == 0) {
#pragma unroll
        for (int mi = 0; mi < 2; ++mi)
#pragma unroll
          for (int i = 0; i < 16; ++i) {
            int row = rb + mi * 32 + crow(i, hh);
            p.lr[(size_t)row * 32 + c] = acc[mi][0][i];
          }
      }
    }
  }
}

DI float logsig(float x) { return fminf(x, 0.f) - __logf(1.f + __expf(-fabsf(x))); }

DI void phase_gla_pre(const Params& p, char* smem, int tid) {
  float* slr = (float*)smem;
  for (int it = blockIdx.x; it < 1024; it += gridDim.x) {
    const int dir = it & 1, ch = (it >> 1) & 127, b = it >> 8;
    const size_t t0 = (size_t)b * 8192 + ch * 64;
    __syncthreads();
    for (int i = tid; i < 1024; i += 512) slr[i] = p.lr[t0 * 32 + (i >> 4) * 32 + dir * 16 + (i & 15)];
    __syncthreads();
    const int j = tid;
    const int h = j >> 7, d = j & 127;
    const float* wa = dir ? p.wa_bw : p.wa_fw;
    float wr[16];
#pragma unroll
    for (int r = 0; r < 16; ++r) wr[r] = wa[r * 512 + j];
    const float ba = (dir ? p.ba_bw : p.ba_fw)[j];
    u16* qe = (dir ? p.qe_bw : p.qe_fw) + t0 * 512 + j;
    u16* ke = (dir ? p.ke_bw : p.ke_fw) + t0 * 512 + j;
    const u16* gq = p.gq + t0 * 512 + j;
    const u16* gk = p.gk + t0 * 512 + j;
    u16* keT = p.keT + (size_t)dir * (16ull * 128 * 8192) + ((size_t)(b * 4 + h) * 128 + d) * 8192 + ch * 64;
    float bsum = 0.f;
#pragma unroll 1
    for (int g8 = 0; g8 < 8; ++g8) {
      u16 qraw[8], kraw[8];
#pragma unroll
      for (int u = 0; u < 8; ++u) {
        const int tt = g8 * 8 + u;
        const int t = dir ? 63 - tt : tt;
        qraw[u] = gq[t * 512]; kraw[u] = gk[t * 512];
      }
      unsigned kk[8];
#pragma unroll
      for (int u = 0; u < 8; ++u) {
        const int tt = g8 * 8 + u;
        const int t = dir ? 63 - tt : tt;
        float pre = ba;
#pragma unroll
        for (int r = 0; r < 16; ++r) pre += slr[t * 16 + r] * wr[r];
        bsum += logsig(pre) * (1.f / 16.f);
        const float eb = __expf(bsum);
        const u16 qo = f2bf(bf2f(qraw[u]) * eb);
        const u16 ko = f2bf(bf2f(kraw[u]) * __expf(-bsum));
        qe[t * 512] = qo;
        ke[t * 512] = ko;
        kk[u] = ko;
      }
      u32x4 v;
      if (!dir) {
        v[0] = kk[0] | (kk[1] << 16); v[1] = kk[2] | (kk[3] << 16); v[2] = kk[4] | (kk[5] << 16); v[3] = kk[6] | (kk[7] << 16);
        *(u32x4*)(keT + g8 * 8) = v;
      } else {
        v[0] = kk[7] | (kk[6] << 16); v[1] = kk[5] | (kk[4] << 16); v[2] = kk[3] | (kk[2] << 16); v[3] = kk[1] | (kk[0] << 16);
        *(u32x4*)(keT + (56 - g8 * 8)) = v;
      }
    }
    p.dec[((size_t)(dir * 4 + b) * 128 + ch) * 512 + j] = __expf(bsum);
  }
}

constexpr int QLD = 136, TLD = 72;
DI void gla_scan_block(const Params& p, int g, char* smem, int tid) {
  const int dir = g & 1, bh = g >> 1;
  const int b = bh >> 2, h = bh & 3;
  const int w = tid >> 6, lane = tid & 63, c = lane & 31, hh = lane >> 5;
  const int slice = w;
  u16* sQ = (u16*)smem;
  u16* sK = sQ + 64 * QLD;
  u16* sKT = sK + 64 * QLD;
  u16* sVT = sKT + 128 * TLD;
  const u16* qe = (dir ? p.qe_bw : p.qe_fw) + (size_t)b * 8192 * 512 + h * 128;
  const u16* ke = (dir ? p.ke_bw : p.ke_fw) + (size_t)b * 8192 * 512 + h * 128;
  const u16* keT = p.keT + (size_t)dir * (16ull * 128 * 8192) + (size_t)bh * 128 * 8192;
  const u16* vT = p.gvT + (size_t)bh * 256 * 8192;
  const float* dec = p.dec + ((size_t)(dir * 4 + b) * 128) * 512 + h * 128;
  u16* o = dir ? p.o_bw : p.o_fw;
  f32x16 st[4];
#pragma unroll
  for (int i = 0; i < 4; ++i) st[i] = zero16();
  u32x4 rq[2], rk[2], rt[2];
  unsigned offq[2], offt[2];
#pragma unroll
  for (int r = 0; r < 2; ++r) {
    int id = tid + 512 * r;
    offq[r] = (unsigned)(((id >> 4) * 512 + (id & 15) * 8) * 2);
    offt[r] = (unsigned)(((id >> 3) * 8192 + (id & 7) * 8) * 2);
  }
  const unsigned offv = (unsigned)(((w * 32 + c) * 8192 + 4 * hh) * 2);
  {
    const int ch = dir ? 127 : 0;
#pragma unroll
    for (int r = 0; r < 2; ++r) {
      int id = tid + 512 * r;
      rq[r] = *(const u32x4*)((const char*)(qe + (size_t)ch * 64 * 512) + offq[r]);
      rk[r] = *(const u32x4*)((const char*)(ke + (size_t)ch * 64 * 512) + offq[r]);
      rt[r] = *(const u32x4*)((const char*)(keT + ch * 64) + offt[r]);
    }
  }
#pragma unroll 1
  for (int ci = 0; ci < 128; ++ci) {
    const int ch = dir ? 127 - ci : ci;
    const size_t t0 = (size_t)b * 8192 + ch * 64;
    __syncthreads();
#pragma unroll
    for (int r = 0; r < 2; ++r) {
      int id = tid + 512 * r;
      st_perm(sQ + (id >> 4) * QLD, id & 15, rq[r]);
      st_perm(sK + (id >> 4) * QLD, id & 15, rk[r]);
      st_perm(sKT + (id >> 3) * TLD, id & 7, rt[r]);
    }
    __syncthreads();
    if (ci + 1 < 128) {
      const int chn = dir ? ch - 1 : ch + 1;
#pragma unroll
      for (int r = 0; r < 2; ++r) {
        int id = tid + 512 * r;
        rq[r] = *(const u32x4*)((const char*)(qe + (size_t)chn * 64 * 512) + offq[r]);
        rk[r] = *(const u32x4*)((const char*)(ke + (size_t)chn * 64 * 512) + offq[r]);
        rt[r] = *(const u32x4*)((const char*)(keT + chn * 64) + offt[r]);
      }
    }
    bf16x8 vf[4];
#pragma unroll
    for (int k4 = 0; k4 < 4; ++k4) vf[k4] = ld_frag8x2((const u16*)((const char*)(vT + ch * 64 + 16 * k4) + offv));
#pragma unroll 1
    for (int qt = 0; qt < 2; ++qt) {
      f32x16 oacc = zero16();
#pragma unroll
      for (int ks = 0; ks < 8; ++ks) {
        bf16x8 sf = pack_step(st[ks >> 1], ks & 1);
        bf16x8 q0 = ld_frag16(sQ + (qt * 32 + c) * QLD + ks * 16 + 8 * hh);
        oacc = MFMA(q0, sf, oacc);
        if (ks & 1) __builtin_amdgcn_sched_barrier(0);
      }
#pragma unroll
      for (int kt = 0; kt < 2; ++kt) {
        bool skip = dir ? (kt < qt) : (kt > qt);
        if (skip) continue;
        f32x16 X = zero16();
#pragma unroll 1
        for (int ks = 0; ks < 8; ++ks) {
          bf16x8 kf = ld_frag16(sK + (kt * 32 + c) * QLD + ks * 16 + 8 * hh);
          bf16x8 qf = ld_frag16(sQ + (qt * 32 + c) * QLD + ks * 16 + 8 * hh);
          X = MFMA(kf, qf, X);
        }
        if (kt == qt) {
#pragma unroll
          for (int i = 0; i < 16; ++i) {
            int key = crow(i, hh);
            bool keep = dir ? (key >= c) : (key <= c);
            X[i] = keep ? X[i] : 0.f;
          }
        }
        oacc = MFMA(pack_step(X, 0), vf[kt * 2 + 0], oacc);
        oacc = MFMA(pack_step(X, 1), vf[kt * 2 + 1], oacc);
        __builtin_amdgcn_sched_barrier(0);
      }
#pragma unroll
      for (int i = 0; i < 16; ++i)
        o[(t0 + qt * 32 + crow(i, hh)) * 1024 + h * 256 + slice * 32 + c] = f2bf(oacc[i]);
      __builtin_amdgcn_sched_barrier(0);
    }
#pragma unroll
    for (int dt = 0; dt < 4; ++dt) {
#pragma unroll
      for (int k4 = 0; k4 < 4; ++k4) {
        bf16x8 kt_f = ld_frag16(sKT + (dt * 32 + c) * TLD + 16 * k4 + 8 * hh);
        st[dt] = MFMA(kt_f, vf[k4], st[dt]);
      }
#pragma unroll
      for (int gg = 0; gg < 4; ++gg) {
        float4 dv = *(const float4*)(dec + (size_t)ch * 512 + dt * 32 + 8 * gg + 4 * hh);
        st[dt][4 * gg + 0] *= dv.x; st[dt][4 * gg + 1] *= dv.y; st[dt][4 * gg + 2] *= dv.z; st[dt][4 * gg + 3] *= dv.w;
      }
      __builtin_amdgcn_sched_barrier(0);
    }
  }
}

constexpr int KLD = 136, VLD = 72;
constexpr int ATT_BUF = 64 * KLD + 128 * VLD;
DI void attn_item(const Params& p, int item, char* smem, int tid) {
  const int qb = item & 63, bh = item >> 6;
  const int b = bh >> 3, h = bh & 7;
  const int w = tid >> 6, lane = tid & 63, c = lane & 31, hh = lane >> 5;
  const int qg = w & 3, mp = w >> 2;
  u16* sbase = (u16*)smem;
  float* sex = (float*)(smem + 2 * ATT_BUF * 2);
  const size_t tq = (size_t)b * 8192 + qb * 128 + qg * 32 + c;
  bf16x8 qf[4];
#pragma unroll
  for (int s = 0; s < 4; ++s) qf[s] = ld_frag16(p.dq + tq * 1024 + h * 128 + mp * 64 + 16 * s + 8 * hh);
  f32x16 O[4];
#pragma unroll
  for (int dt = 0; dt < 4; ++dt) O[dt] = zero16();
  float lrun = 0.f;
  float negmb;
  {
    float qn = 0.f;
#pragma unroll
    for (int s = 0; s < 4; ++s) {
      u32x4 qq = __builtin_bit_cast(u32x4, qf[s]);
#pragma unroll
      for (int i = 0; i < 4; ++i) { float x0 = bflo(qq[i]), x1 = bfhi(qq[i]); qn += x0 * x0 + x1 * x1; }
    }
    qn += __shfl_xor(qn, 32);
    float kn = __int_as_float(p.kmax[(b * 8 + h) * 2 + mp]);
    float mb = sqrtf(qn * kn) * 1.01f + 1e-3f;
    negmb = -mb;
  }
  const u16* Kg = p.dk + (size_t)b * 8192 * 1024 + h * 128;
  const u16* Vg = p.dvT + (size_t)bh * 128 * 8192;
  u32x4 rk[2], rv[2];
#pragma unroll
  for (int r = 0; r < 2; ++r) {
    int id = tid + 512 * r;
    rk[r] = *(const u32x4*)(Kg + (size_t)(id >> 4) * 1024 + (id & 15) * 8);
    rv[r] = *(const u32x4*)(Vg + (size_t)(id >> 3) * 8192 + (id & 7) * 8);
  }
  __syncthreads();
#pragma unroll
  for (int r = 0; r < 2; ++r) {
    int id = tid + 512 * r;
    *(u32x4*)(sbase + (id >> 4) * KLD + (id & 15) * 8) = rk[r];
    st_perm(sbase + 64 * KLD + (id >> 3) * VLD, id & 7, rv[r]);
  }
#pragma unroll
  for (int r = 0; r < 2; ++r) {
    int id = tid + 512 * r;
    rk[r] = *(const u32x4*)(Kg + (size_t)(64 + (id >> 4)) * 1024 + (id & 15) * 8);
    rv[r] = *(const u32x4*)(Vg + (size_t)(id >> 3) * 8192 + 64 + (id & 7) * 8);
  }
  __syncthreads();
#pragma unroll 1
  for (int kt = 0; kt < 128; ++kt) {
    const u16* sK = sbase + (kt & 1) * ATT_BUF;
    const u16* sV = sK + 64 * KLD;
    if (kt + 1 < 128) {
      u16* nK = sbase + ((kt + 1) & 1) * ATT_BUF;
      u16* nV = nK + 64 * KLD;
#pragma unroll
      for (int r = 0; r < 2; ++r) {
        int id = tid + 512 * r;
        *(u32x4*)(nK + (id >> 4) * KLD + (id & 15) * 8) = rk[r];
        st_perm(nV + (id >> 3) * VLD, id & 7, rv[r]);
      }
      if (kt + 2 < 128) {
#pragma unroll
        for (int r = 0; r < 2; ++r) {
          int id = tid + 512 * r;
          rk[r] = *(const u32x4*)(Kg + (size_t)((kt + 2) * 64 + (id >> 4)) * 1024 + (id & 15) * 8);
          rv[r] = *(const u32x4*)(Vg + (size_t)(id >> 3) * 8192 + (kt + 2) * 64 + (id & 7) * 8);
        }
      }
    }
    f32x16 sacc[2];
    bf16x8 kf[8];
#pragma unroll
    for (int s = 0; s < 4; ++s)
#pragma unroll
      for (int k2 = 0; k2 < 2; ++k2) kf[s * 2 + k2] = ld_frag16(sK + (k2 * 32 + c) * KLD + mp * 64 + 16 * s + 8 * hh);
    __builtin_amdgcn_sched_barrier(0);
#pragma unroll
    for (int i = 0; i < 16; ++i) { sacc[0][i] = negmb; sacc[1][i] = negmb; }
#pragma unroll
    for (int s = 0; s < 4; ++s) {
      sacc[0] = MFMA(kf[s * 2 + 0], qf[s], sacc[0]);
      sacc[1] = MFMA(kf[s * 2 + 1], qf[s], sacc[1]);
    }
    bf16x8 vfA[4], vfB[4];
#define VLOAD(dst, k2, s2) { _Pragma("unroll") for (int dt = 0; dt < 4; ++dt) dst[dt] = ld_frag16(sV + (dt * 32 + c) * VLD + (k2) * 32 + (s2) * 16 + 8 * hh); }
#define PVMM(vf, pf) { _Pragma("unroll") for (int dt = 0; dt < 4; ++dt) O[dt] = MFMA(vf[dt], pf, O[dt]); }
#define EXPS(k2) { _Pragma("unroll") for (int i = 0; i < 8; ++i) { \
        float e0 = __builtin_amdgcn_exp2f(sacc[k2][2 * i]), e1 = __builtin_amdgcn_exp2f(sacc[k2][2 * i + 1]); \
        sacc[k2][2 * i] = e0; sacc[k2][2 * i + 1] = e1; f32x2_t ev = {e0, e1}; ls2 += ev; } }
    VLOAD(vfA, 0, 0);
    __builtin_amdgcn_sched_barrier(0);
    f32x2_t ls2 = {0.f, 0.f};
    EXPS(0);
    bf16x8 p0 = pack_step(sacc[0], 0), p1 = pack_step(sacc[0], 1);
    __builtin_amdgcn_sched_barrier(0);
    VLOAD(vfB, 0, 1);
    PVMM(vfA, p0);
    __builtin_amdgcn_sched_barrier(0);
    VLOAD(vfA, 1, 0);
    PVMM(vfB, p1);
    __builtin_amdgcn_sched_barrier(0);
    EXPS(1);
    p0 = pack_step(sacc[1], 0); p1 = pack_step(sacc[1], 1);
    __builtin_amdgcn_sched_barrier(0);
    VLOAD(vfB, 1, 1);
    PVMM(vfA, p0);
    __builtin_amdgcn_sched_barrier(0);
    PVMM(vfB, p1);
    lrun += ls2[0] + ls2[1];
#undef VLOAD
#undef PVMM
#undef EXPS
    __syncthreads();
  }
  float ltot = lrun + __shfl_xor(lrun, 32);
  if (mp == 1) {
    float sc = p.lam[0] / ltot;
#pragma unroll
    for (int dt = 0; dt < 4; ++dt)
#pragma unroll
      for (int i = 0; i < 16; ++i) sex[(qg * 64 + dt * 16 + i) * 64 + lane] = O[dt][i] * sc;
  }
  __syncthreads();
  if (mp == 0) {
    float i0 = 1.f / ltot;
    float ss = 0.f;
#pragma unroll
    for (int dt = 0; dt < 4; ++dt)
#pragma unroll
      for (int i = 0; i < 16; ++i) { float v = O[dt][i] * i0 - sex[(qg * 64 + dt * 16 + i) * 64 + lane]; O[dt][i] = v; ss += v * v; }
    ss += __shfl_xor(ss, 32);
    float rstd = rsqrtf(ss * (1.f / 128.f) + RMS_EPS) * 0.8f;
#pragma unroll
    for (int dt = 0; dt < 4; ++dt)
#pragma unroll
      for (int g = 0; g < 4; ++g) {
        int dv = dt * 32 + 8 * g + 4 * hh;
        float4 gg = *(const float4*)(p.diff_norm_g + h * 128 + dv);
        u32x2 v = {pack2(O[dt][4 * g] * rstd * gg.x, O[dt][4 * g + 1] * rstd * gg.y),
                   pack2(O[dt][4 * g + 2] * rstd * gg.z, O[dt][4 * g + 3] * rstd * gg.w)};
        *(u32x2*)(p.dq + tq * 1024 + h * 128 + dv) = v;
      }
  }
}

DI void phase_mixers(const Params& p, char* smem, int tid) {
  int* sitem = (int*)(smem + 143 * 1024);
  if (blockIdx.x < 32) gla_scan_block(p, blockIdx.x, smem, opq(tid));
  for (;;) {
    __syncthreads();
    if (tid == 0) *sitem = atomicAdd(p.counter, 1);
    __syncthreads();
    int item = *sitem;
    if (item >= 2048) break;
    attn_item(p, item, smem, opq(tid));
  }
}

DI void phase_post_mixers(const Params& p, int tid) {
  int w = tid >> 6, lane = tid & 63;
  for (int row = blockIdx.x * 8 + w; row < T; row += gridDim.x * 8) {
#pragma unroll
    for (int hd = 0; hd < 4; ++hd) {
      u32x2 a = *(const u32x2*)(p.o_fw + (size_t)row * 1024 + hd * 256 + lane * 4);
      u32x2 bq = *(const u32x2*)(p.o_bw + (size_t)row * 1024 + hd * 256 + lane * 4);
      float v0 = bflo(a[0]) + bflo(bq[0]), v1 = bfhi(a[0]) + bfhi(bq[0]), v2 = bflo(a[1]) + bflo(bq[1]), v3 = bfhi(a[1]) + bfhi(bq[1]);
      float ss = wave_sum(v0 * v0 + v1 * v1 + v2 * v2 + v3 * v3);
      if (lane == 0) p.rstd[row * 4 + hd] = rsqrtf(ss * (1.f / 256.f) + RMS_EPS);
    }
  }
  phase_norm_mod(p.x, p.norm1_g, p.mod, 0, 1024, p.hA, tid);
  for (int row = blockIdx.x * 8 + w; row < 32768; row += gridDim.x * 8) {
    const bool isv = row >= 16384;
    const int r = row & 16383;
    const float* srcp = (isv ? p.peer_v : p.peer_u) + (size_t)r * 1024 + lane * 16;
    float4 a0 = *(const float4*)(srcp), a1 = *(const float4*)(srcp + 4), a2 = *(const float4*)(srcp + 8), a3 = *(const float4*)(srcp + 12);
    float am = fmaxf(fmaxf(fmaxf(fabsf(a0.x), fabsf(a0.y)), fmaxf(fabsf(a0.z), fabsf(a0.w))), fmaxf(fmaxf(fabsf(a1.x), fabsf(a1.y)), fmaxf(fabsf(a1.z), fabsf(a1.w))));
    am = fmaxf(am, fmaxf(fmaxf(fmaxf(fabsf(a2.x), fabsf(a2.y)), fmaxf(fabsf(a2.z), fabsf(a2.w))), fmaxf(fmaxf(fabsf(a3.x), fabsf(a3.y)), fmaxf(fabsf(a3.z), fabsf(a3.w)))));
#pragma unroll
    for (int o = 32; o >= 1; o >>= 1) am = fmaxf(am, __shfl_xor(am, o));
    am = fmaxf(am, 1e-30f);
    const float sc = 256.f / am;
    u32x4 v;
    int t0 = __builtin_amdgcn_cvt_pk_fp8_f32(a0.x * sc, a0.y * sc, 0, false); t0 = __builtin_amdgcn_cvt_pk_fp8_f32(a0.z * sc, a0.w * sc, t0, true);
    int t1 = __builtin_amdgcn_cvt_pk_fp8_f32(a1.x * sc, a1.y * sc, 0, false); t1 = __builtin_amdgcn_cvt_pk_fp8_f32(a1.z * sc, a1.w * sc, t1, true);
    int t2 = __builtin_amdgcn_cvt_pk_fp8_f32(a2.x * sc, a2.y * sc, 0, false); t2 = __builtin_amdgcn_cvt_pk_fp8_f32(a2.z * sc, a2.w * sc, t2, true);
    int t3 = __builtin_amdgcn_cvt_pk_fp8_f32(a3.x * sc, a3.y * sc, 0, false); t3 = __builtin_amdgcn_cvt_pk_fp8_f32(a3.z * sc, a3.w * sc, t3, true);
    v[0] = (unsigned)t0; v[1] = (unsigned)t1; v[2] = (unsigned)t2; v[3] = (unsigned)t3;
    unsigned char* dst = (unsigned char*)(isv ? p.vB : p.uB) + (size_t)r * 1024 + lane * 16;
    *(u32x4*)dst = v;
    if (lane == 0) (isv ? p.vs : p.us)[r] = am * (1.f / 256.f);
  }
}

DI void phase_gr(const Params& p, char* smem, int tid) {
  const int w = tid >> 6, lane = tid & 63, c_inv = lane & 31, hh_inv = lane >> 5;
  const int wm = w >> 1, wn = w & 1;
  float* wl = wave_stage(smem, w);
  for (int id = blockIdx.x; id < 128 * 24; id += gridDim.x) {
    int mt = id / 24, nt = id - mt * 24;
    int m0 = mt * 256, n0 = nt * 128;
    f32x16 acc[2][2]; zero_acc(acc);
    gemm_kloop(p.hA + (size_t)m0 * 1024, 1024, p.wgrT + (size_t)n0 * 1024, 1024, 1024, acc, (u16*)smem, tid);
    const int c = opq(c_inv), hh = opq(hh_inv);
    const int rb = m0 + wm * 64;
    stage_acc<EPS>(acc, wl, c, hh);
    if (n0 < 1024) {
      const int cb = n0 + wn * 64;
      epi_rows(wl, lane, [&](int r, int cc, float (&v)[8]) {
        const size_t off = (size_t)(rb + r) * 1024 + cb + cc;
        float of[8], ob[8];
        ld_bf16x8(p.o_fw + off, of); ld_bf16x8(p.o_bw + off, ob);
        const float rs = p.rstd[(rb + r) * 4 + ((cb + cc) >> 8)];
        float4 g0 = *(const float4*)(p.gla_norm_g + cb + cc), g1 = *(const float4*)(p.gla_norm_g + cb + cc + 4);
        const float gg[8] = {g0.x, g0.y, g0.z, g0.w, g1.x, g1.y, g1.z, g1.w};
#pragma unroll
        for (int j = 0; j < 8; ++j) { float a = v[j]; v[j] = (of[j] + ob[j]) * rs * gg[j] * (a / (1.f + __expf(-a))); }
        st_bf16x8(p.A1 + off, v);
      });
    } else {
      u16* dst = ((n0 < 2048) ? p.sga : p.sgb) + (size_t)rb * 1024 + (n0 & 1023) + wn * 64;
      epi_rows(wl, lane, [&](int r, int cc, float (&v)[8]) {
#pragma unroll
        for (int j = 0; j < 8; ++j) v[j] = 1.f / (1.f + __expf(-v[j]));
        st_bf16x8(dst + (size_t)r * 1024 + cc, v);
      });
    }
  }
}

DI void phase_merge(const Params& p, char* smem, int tid) {
  const int w = tid >> 6, lane = tid & 63, c_inv = lane & 31, hh_inv = lane >> 5;
  const int wm = w >> 1, wn = w & 1;
  float* wl = wave_stage(smem, w);
  for (int id = blockIdx.x; id < 128 * 8; id += gridDim.x) {
    int mt = id >> 3, nt = id & 7;
    int m0 = mt * 256, n0 = nt * 128;
    const size_t tb = (size_t)(m0 + wm * 64) * 1024 + n0 + wn * 64;
    f32x16 acc[2][2];
    zero_acc(acc);
    gemm_kloop(p.A1 + (size_t)m0 * 1024, 1024, p.wglaT + (size_t)n0 * 1024, 1024, 1024, acc, (u16*)smem, tid);
    {
      const int c = opq(c_inv), hh = opq(hh_inv);
      stage_acc<EPS>(acc, wl, c, hh);
      epi_rows(wl, lane, [&](int r, int cc, float (&v)[8]) {
        float gv[8];
        ld_bf16x8(p.sga + tb + (size_t)r * 1024 + cc, gv);
#pragma unroll
        for (int j = 0; j < 8; ++j) v[j] *= gv[j];
        st_bf16x8(p.sga + tb + (size_t)r * 1024 + cc, v);
      });
    }
    zero_acc(acc);
    gemm_kloop(p.dq + (size_t)m0 * 1024, 1024, p.wdiffT + (size_t)n0 * 1024, 1024, 1024, acc, (u16*)smem, tid);
    {
      const int c = opq(c_inv), hh = opq(hh_inv);
      stage_acc<EPS>(acc, wl, c, hh);
      epi_rows(wl, lane, [&](int r, int cc, float (&v)[8]) {
        float gv[8], mv[8];
        ld_bf16x8(p.sgb + tb + (size_t)r * 1024 + cc, gv);
        ld_bf16x8(p.sga + tb + (size_t)r * 1024 + cc, mv);
#pragma unroll
        for (int j = 0; j < 8; ++j) v[j] = mv[j] + v[j] * gv[j];
        st_bf16x8(p.merged + tb + (size_t)r * 1024 + cc, v);
      });
    }
  }
}

DI void phase_out(const Params& p, char* smem, int tid) {
  const int w = tid >> 6, lane = tid & 63, c_inv = lane & 31, hh_inv = lane >> 5;
  const int wm = w >> 1, wn = w & 1;
  float* wl = wave_stage(smem, w);
  for (int id = blockIdx.x; id < 128 * 8; id += gridDim.x) {
    int mt = id >> 3, nt = id & 7;
    int m0 = mt * 256, n0 = nt * 128;
    f32x16 acc[2][2]; zero_acc(acc);
    gemm_kloop(p.merged + (size_t)m0 * 1024, 1024, p.woutT + (size_t)n0 * 1024, 1024, 1024, acc, (u16*)smem, tid);
    const int c = opq(c_inv), hh = opq(hh_inv);
    const int b = m0 >> 13;
    const int cb = n0 + wn * 64;
    const size_t tb = (size_t)(m0 + wm * 64) * 1024 + cb;
    stage_acc<EPS>(acc, wl, c, hh);
    epi_rows(wl, lane, [&](int r, int cc, float (&v)[8]) {
      const float* xp = p.x + tb + (size_t)r * 1024 + cc;
      const float* gp = p.mod + b * 6144 + 2048 + cb + cc;
      float4 x0 = *(const float4*)xp, x1v = *(const float4*)(xp + 4);
      float4 g0 = *(const float4*)gp, g1 = *(const float4*)(gp + 4);
      float4 o0 = {x0.x + g0.x * v[0], x0.y + g0.y * v[1], x0.z + g0.z * v[2], x0.w + g0.w * v[3]};
      float4 o1 = {x1v.x + g1.x * v[4], x1v.y + g1.y * v[5], x1v.z + g1.z * v[6], x1v.w + g1.w * v[7]};
      float* op = p.x1 + tb + (size_t)r * 1024 + cc;
      *(float4*)op = o0; *(float4*)(op + 4) = o1;
    });
  }
}

DI void phase_peerq(const Params& p, char* smem, int tid) {
  const int w = tid >> 6, lane = tid & 63, c_inv = lane & 31, hh_inv = lane >> 5;
  const int wm = w >> 1, wn = w & 1;
  float* wl = wave_stage(smem, w);
  for (int id = blockIdx.x; id < 128 * 16; id += gridDim.x) {
    int mt = id >> 4, nt = id & 15;
    int m0 = mt * 256, n0 = nt * 128;
    f32x16 acc[2][2]; zero_acc(acc);
    gemm_kloop(p.h2 + (size_t)m0 * 1024, 1024, p.wqT + (size_t)n0 * 1024, 1024, 1024, acc, (u16*)smem, tid);
    const int c = opq(c_inv), hh = opq(hh_inv);
    u16* dst = p.qp + (size_t)(m0 + wm * 64) * 2048 + n0 + wn * 64;
    stage_acc<EPS>(acc, wl, c, hh);
    epi_rows(wl, lane, [&](int r, int cc, float (&v)[8]) { st_bf16x8(dst + (size_t)r * 2048 + cc, v); });
  }
}

DI unsigned fkey(float f) { unsigned u = __float_as_uint(f); return (u & 0x80000000u) ? ~u : (u | 0x80000000u); }
DI void phase_topk(const Params& p, char* smem, int tid) {
  float* sc = (float*)smem;
  float* ts = sc + 64 * 132;
  int* ti = (int*)(ts + 64 * 32);
  const int w = tid >> 6, lane = tid & 63, c = lane & 31, hh = lane >> 5;
  const int l16 = tid & 15, grp = tid >> 4;
  const int nt = w & 3, mt = w >> 2;
  bf16x8 af[8], bfq[8];
#define TK_LOAD(item_, pp_) { const int h_ = (item_) & 7; const u16* Aq_ = p.qp + (size_t)((item_) >> 3) * 64 * 2048 + h_ * 256 + (pp_) * 128; \
    const u16* Bk_ = p.subk + (size_t)(h_ * 2 + (pp_)) * 128 * 128; \
    _Pragma("unroll") for (int s = 0; s < 8; ++s) { bfq[s] = ld_frag16(Bk_ + (32 * nt + c) * 128 + 16 * s + 8 * hh); af[s] = ld_frag16(Aq_ + (size_t)(32 * mt + c) * 2048 + 16 * s + 8 * hh); } }
  if (blockIdx.x < 4096) TK_LOAD(blockIdx.x, 0);
  for (int item = blockIdx.x; item < 4096; item += gridDim.x) {
    const int h = item & 7;
    const size_t t0 = (size_t)(item >> 3) * 64;
#pragma unroll 1
    for (int pp = 0; pp < 2; ++pp) {
      f32x16 acc = zero16();
      {
        f32x16 acc2 = zero16();
#pragma unroll
        for (int s = 0; s < 8; s += 2) { acc = MFMA(af[s], bfq[s], acc); acc2 = MFMA(af[s + 1], bfq[s + 1], acc2); }
#pragma unroll
        for (int i = 0; i < 16; ++i) acc[i] += acc2[i];
      }
      if (pp == 0) { TK_LOAD(item, 1); }
      else { const int nitem = item + gridDim.x; if (nitem < 4096) TK_LOAD(nitem, 0); }
      __syncthreads();
#pragma unroll
      for (int i = 0; i < 16; ++i) sc[(mt * 32 + crow(i, hh)) * 132 + 32 * nt + c] = acc[i];
      __syncthreads();
      unsigned k[2][8], sel[2];
#pragma unroll
      for (int rr = 0; rr < 2; ++rr) {
        sel[rr] = 0;
#pragma unroll
        for (int m = 0; m < 8; ++m) { int n = l16 + 16 * m; k[rr][m] = (fkey(sc[(grp + 32 * rr) * 132 + n]) & ~127u) | (unsigned)(127 - n); }
      }
#pragma unroll 1
      for (int round = 0; round < 16; ++round) {
#pragma unroll
        for (int rr = 0; rr < 2; ++rr) {
          unsigned mx = max(max(max(k[rr][0], k[rr][1]), max(k[rr][2], k[rr][3])), max(max(k[rr][4], k[rr][5]), max(k[rr][6], k[rr][7])));
          mx = gmax16(mx);
          sel[rr] = (l16 == round) ? mx : sel[rr];
#pragma unroll
          for (int m = 0; m < 8; ++m) k[rr][m] = (k[rr][m] == mx) ? 0u : k[rr][m];
        }
      }
#pragma unroll
      for (int rr = 0; rr < 2; ++rr) {
        const int row = grp + 32 * rr;
        int n = 127 - (int)(sel[rr] & 127u);
        ti[(row * 2 + pp) * 16 + l16] = n;
        ts[(row * 2 + pp) * 16 + l16] = sc[row * 132 + n];
      }
    }
    __syncthreads();
    {
      float s0v[2]; int ptr[2]; unsigned selk[2];
#pragma unroll
      for (int rr = 0; rr < 2; ++rr) { s0v[rr] = ts[((grp + 32 * rr) * 2) * 16 + l16]; ptr[rr] = 0; selk[rr] = 0; }
#pragma unroll 1
      for (int round = 0; round < 16; ++round) {
#pragma unroll
        for (int rr = 0; rr < 2; ++rr) {
          const int row = grp + 32 * rr;
          float v = s0v[rr] + ts[(row * 2 + 1) * 16 + (ptr[rr] & 15)];
          unsigned key = (ptr[rr] < 16) ? ((fkey(v) & ~255u) | (unsigned)(255 - (l16 * 16 + ptr[rr]))) : 0u;
          unsigned mx = gmax16(key);
          selk[rr] = (l16 == round) ? mx : selk[rr];
          int aw = (255 - (int)(mx & 255u)) >> 4;
          ptr[rr] += (l16 == aw) ? 1 : 0;
        }
      }
#pragma unroll
      for (int rr = 0; rr < 2; ++rr) {
        const int row = grp + 32 * rr;
        int flat = 255 - (int)(selk[rr] & 255u);
        int aw = flat >> 4, bw = flat & 15;
        int my_idx = ti[(row * 2) * 16 + aw] * 128 + ti[(row * 2 + 1) * 16 + bw];
        float my_s = ts[(row * 2) * 16 + aw] + ts[(row * 2 + 1) * 16 + bw];
        float mxs = gmaxf16(my_s);
        float e = __expf(my_s - mxs);
        float sum = gsum16(e);
        p.idx[(t0 + row) * 128 + h * 16 + l16] = my_idx;
        p.g[(t0 + row) * 128 + h * 16 + l16] = e / sum;
      }
    }
    __syncthreads();
  }
#undef TK_LOAD
}

DI void peer_load_batch(const unsigned char* tab, const float* rsc, int ireg, int ebase, int q, int gq, u32x4 (&buf)[4], float (&scl)[1]) {
#pragma unroll
  for (int rr = 0; rr < 1; ++rr) {
    int e = ebase + 4 * rr + gq;
    int row = __shfl(ireg, e & 63);
    const unsigned char* rp = tab + (size_t)row * 1024 + q * 16;
#pragma unroll
    for (int j = 0; j < 4; ++j) buf[rr * 4 + j] = *(const u32x4*)(rp + j * 256);
    scl[rr] = rsc[row];
  }
}
DI void peer_u_compute(const u32x4 (&buf)[4], const float (&scl)[1], const float (&hf)[64], float* wl, int ebase, int q, int gq) {
#pragma unroll
  for (int rr = 0; rr < 1; ++rr) {
    float acc = 0.f;
#pragma unroll
    for (int j = 0; j < 4; ++j)
#pragma unroll
      for (int i = 0; i < 4; ++i) {
        f32x2_t lo = __builtin_amdgcn_cvt_pk_f32_fp8((int)buf[rr * 4 + j][i], false);
        f32x2_t hi = __builtin_amdgcn_cvt_pk_f32_fp8((int)buf[rr * 4 + j][i], true);
        acc += lo[0] * hf[j * 16 + 4 * i] + lo[1] * hf[j * 16 + 4 * i + 1] + hi[0] * hf[j * 16 + 4 * i + 2] + hi[1] * hf[j * 16 + 4 * i + 3];
      }
    acc = gsum16(acc) * scl[rr];
    float act = 0.5f * acc * (1.f + erff(acc * 0.7071067811865476f));
    if (q == 0) wl[ebase + 4 * rr + gq] = act;
  }
}
DI void peer_v_compute(const u32x4 (&buf)[4], const float (&scl)[1], float (&o)[64], const float* wl, float greg, int ebase, int gq) {
#pragma unroll
  for (int rr = 0; rr < 1; ++rr) {
    const int e = ebase + 4 * rr + gq;
    float ge = __shfl(greg, e & 63);
    float wg = wl[e] * ge * scl[rr];
#pragma unroll
    for (int j = 0; j < 4; ++j)
#pragma unroll
      for (int i = 0; i < 4; ++i) {
        f32x2_t lo = __builtin_amdgcn_cvt_pk_f32_fp8((int)buf[rr * 4 + j][i], false);
        f32x2_t hi = __builtin_amdgcn_cvt_pk_f32_fp8((int)buf[rr * 4 + j][i], true);
        o[j * 16 + 4 * i] += wg * lo[0]; o[j * 16 + 4 * i + 1] += wg * lo[1];
        o[j * 16 + 4 * i + 2] += wg * hi[0]; o[j * 16 + 4 * i + 3] += wg * hi[1];
      }
  }
}
DI void phase_peer_final(const Params& p, char* smem, int tid) {
  const int w = tid >> 6, lane = tid & 63, q = lane & 15, gq = lane >> 4;
  float* wl = (float*)smem + w * 128;
  const unsigned char* U8 = (const unsigned char*)p.uB;
  const unsigned char* V8 = (const unsigned char*)p.vB;
  for (int item = blockIdx.x; item < T / 8; item += gridDim.x) {
    const size_t t = (size_t)item * 8 + w;
    const int b = (int)(t >> 13);
    float hf[64];
#pragma unroll
    for (int j = 0; j < 4; ++j) {
      u32x4 ha = *(const u32x4*)(p.h2 + t * 1024 + (q + 16 * j) * 16);
      u32x4 hb = *(const u32x4*)(p.h2 + t * 1024 + (q + 16 * j) * 16 + 8);
#pragma unroll
      for (int i = 0; i < 4; ++i) { hf[j * 16 + 2 * i] = bflo(ha[i]); hf[j * 16 + 2 * i + 1] = bfhi(ha[i]); hf[j * 16 + 8 + 2 * i] = bflo(hb[i]); hf[j * 16 + 8 + 2 * i + 1] = bfhi(hb[i]); }
    }
    const int i0 = p.idx[t * 128 + lane], i1 = p.idx[t * 128 + 64 + lane];
    const float g0 = p.g[t * 128 + lane], g1 = p.g[t * 128 + 64 + lane];
    u32x4 bA[4], bB[4]; float sA[1], sB[1];
    peer_load_batch(U8, p.us, i0, 0, q, gq, bA, sA);
#pragma unroll 1
    for (int it = 0; it < 16; ++it) {
      const int e0 = 8 * it;
      peer_load_batch(U8, p.us, (e0 & 64) ? i1 : i0, e0 + 4, q, gq, bB, sB);
      peer_u_compute(bA, sA, hf, wl, e0, q, gq);
      if (it < 15) peer_load_batch(U8, p.us, ((e0 + 8) & 64) ? i1 : i0, e0 + 8, q, gq, bA, sA);
      else peer_load_batch(V8, p.vs, i0, 0, q, gq, bA, sA);
      peer_u_compute(bB, sB, hf, wl, e0 + 4, q, gq);
    }
    __syncthreads();
    float o[64];
#pragma unroll
    for (int i = 0; i < 64; ++i) o[i] = 0.f;
#pragma unroll 1
    for (int it = 0; it < 16; ++it) {
      const int e0 = 8 * it;
      peer_load_batch(V8, p.vs, (e0 & 64) ? i1 : i0, e0 + 4, q, gq, bB, sB);
      peer_v_compute(bA, sA, o, wl, (e0 & 64) ? g1 : g0, e0, gq);
      if (it < 15) peer_load_batch(V8, p.vs, ((e0 + 8) & 64) ? i1 : i0, e0 + 8, q, gq, bA, sA);
      peer_v_compute(bB, sB, o, wl, (e0 & 64) ? g1 : g0, e0 + 4, gq);
    }
    float h1[32];
#pragma unroll
    for (int i = 0; i < 32; ++i) {
      float send = (gq < 2) ? o[32 + i] : o[i];
      float keep = (gq < 2) ? o[i] : o[32 + i];
      h1[i] = keep + __shfl_xor(send, 32);
    }
    float fin[16];
#pragma unroll
    for (int i = 0; i < 16; ++i) {
      float send = (gq & 1) ? h1[i] : h1[16 + i];
      float keep = (gq & 1) ? h1[16 + i] : h1[i];
      fin[i] = keep + __shfl_xor(send, 16);
    }
    const int colb = (q + 16 * gq) * 16;
    float ss = 0.f;
#pragma unroll
    for (int i4 = 0; i4 < 4; ++i4) {
      float4 xa = *(const float4*)(p.x1 + t * 1024 + colb + 4 * i4);
      float4 ga = *(const float4*)(p.mod + b * 6144 + 5120 + colb + 4 * i4);
      fin[4 * i4 + 0] = xa.x + ga.x * fin[4 * i4 + 0]; fin[4 * i4 + 1] = xa.y + ga.y * fin[4 * i4 + 1];
      fin[4 * i4 + 2] = xa.z + ga.z * fin[4 * i4 + 2]; fin[4 * i4 + 3] = xa.w + ga.w * fin[4 * i4 + 3];
      ss += fin[4 * i4] * fin[4 * i4] + fin[4 * i4 + 1] * fin[4 * i4 + 1] + fin[4 * i4 + 2] * fin[4 * i4 + 2] + fin[4 * i4 + 3] * fin[4 * i4 + 3];
    }
    ss = wave_sum(ss);
    const float rstd = rsqrtf(ss * (1.f / 1024.f) + RMS_EPS);
#pragma unroll
    for (int i4 = 0; i4 < 4; ++i4) {
      int col = colb + 4 * i4;
      float4 gg = *(const float4*)(p.normf_g + col);
      float4 sh = *(const float4*)(p.fmod + b * 2048 + col);
      float4 sc = *(const float4*)(p.fmod + b * 2048 + 1024 + col);
      float4 r;
      r.x = fin[4 * i4 + 0] * rstd * gg.x * (1.f + sc.x) + sh.x;
      r.y = fin[4 * i4 + 1] * rstd * gg.y * (1.f + sc.y) + sh.y;
      r.z = fin[4 * i4 + 2] * rstd * gg.z * (1.f + sc.z) + sh.z;
      r.w = fin[4 * i4 + 3] * rstd * gg.w * (1.f + sc.w) + sh.w;
      *(float4*)(p.out + t * 1024 + col) = r;
    }
    __syncthreads();
  }
}

__global__ void __launch_bounds__(512) fwd_megakernel(Params p) {
  cg::grid_group grid = cg::this_grid();
  extern __shared__ __attribute__((aligned(16))) char smem[];
  const int tid = threadIdx.x;
  phase_prep(p, smem, opq(tid));
  grid.sync();
  phase_norm_mod(p.x, p.norm1_g, p.mod, 0, 1024, p.hA, opq(tid));
  grid.sync();
  phase_proj(p, smem, opq(tid));
  grid.sync();
  phase_gla_pre(p, smem, opq(tid));
  grid.sync();
  phase_mixers(p, smem, opq(tid));
  grid.sync();
  phase_post_mixers(p, opq(tid));
  grid.sync();
  phase_gr(p, smem, opq(tid));
  grid.sync();
  phase_merge(p, smem, opq(tid));
  grid.sync();
  phase_out(p, smem, opq(tid));
  grid.sync();
  phase_norm_mod(p.x1, p.norm2_g, p.mod, 3072, 4096, p.h2, opq(tid));
  grid.sync();
  phase_peerq(p, smem, opq(tid));
  grid.sync();
  phase_topk(p, smem, opq(tid));
  grid.sync();
  phase_peer_final(p, smem, opq(tid));
}

extern "C" void kernel_launch(void* const* d_in, const int* in_sizes, int n_in, void* d_out, int out_size, void* d_ws,
                              size_t ws_size, hipStream_t stream) {
  static int grid_blocks = 0;
  if (!grid_blocks) {
    int dev = 0, cus = 0, per_cu = 0;
    hipGetDevice(&dev);
    hipDeviceGetAttribute(&cus, hipDeviceAttributeMultiprocessorCount, dev);
    if (hipFuncSetAttribute((const void*)fwd_megakernel, hipFuncAttributeMaxDynamicSharedMemorySize, LDS_BYTES) != hipSuccess) { fprintf(stderr, "hipFuncSetAttribute failed\n"); }
    hipOccupancyMaxActiveBlocksPerMultiprocessor(&per_cu, fwd_megakernel, 512, LDS_BYTES);
    if (per_cu < 1) per_cu = 1;
    grid_blocks = cus * per_cu;
  }
  if (ws_size < 492 * MB) { fprintf(stderr, "ws too small: %zu\n", ws_size); return; }
  Params p{};
  p.x = (const float*)d_in[0]; p.c = (const float*)d_in[1]; p.pos = (const int*)d_in[2];
  p.w_ada = (const float*)d_in[3]; p.b_ada = (const float*)d_in[4]; p.norm1_g = (const float*)d_in[5];
  p.w_in = (const float*)d_in[6]; p.wa_fw = (const float*)d_in[7]; p.ba_fw = (const float*)d_in[8];
  p.wa_bw = (const float*)d_in[9]; p.ba_bw = (const float*)d_in[10]; p.gla_norm_g = (const float*)d_in[11];
  p.lq1 = (const float*)d_in[12]; p.lk1 = (const float*)d_in[13]; p.lq2 = (const float*)d_in[14]; p.lk2 = (const float*)d_in[15];
  p.diff_norm_g = (const float*)d_in[16]; p.w_gla = (const float*)d_in[17]; p.w_diff = (const float*)d_in[18];
  p.w_out = (const float*)d_in[19]; p.norm2_g = (const float*)d_in[20]; p.peer_wq = (const float*)d_in[21];
  p.subkeys = (const float*)d_in[22]; p.peer_u = (const float*)d_in[23]; p.peer_v = (const float*)d_in[24];
  p.w_fada = (const float*)d_in[25]; p.b_fada = (const float*)d_in[26]; p.normf_g = (const float*)d_in[27];
  p.out = (float*)d_out;
  char* ws = (char*)d_ws;
  p.winT = (u16*)(ws + 0 * MB); p.wgrT = (u16*)(ws + 11 * MB); p.wgaT = (u16*)(ws + 13 * MB); p.wgbT = (u16*)(ws + 15 * MB);
  p.wglaT = (u16*)(ws + 17 * MB); p.wdiffT = (u16*)(ws + 19 * MB); p.woutT = (u16*)(ws + 21 * MB); p.wqT = (u16*)(ws + 23 * MB);
  p.subk = (u16*)(ws + 27 * MB); p.rope = (float*)(ws + 28 * MB);
  p.mod = (float*)(ws + 36 * MB); p.fmod = (float*)(ws + 36 * MB + 128 * 1024); p.lam = (float*)(ws + 36 * MB + 192 * 1024);
  p.counter = (int*)(ws + 36 * MB + 196 * 1024);
  p.kmax = (int*)(ws + 36 * MB + 200 * 1024);
  p.lr = (float*)(ws + 37 * MB); p.dec = (float*)(ws + 41 * MB); p.rstd = (float*)(ws + 43 * MB);
  char* slot[9];
  for (int i = 0; i < 7; ++i) slot[i] = ws + (44 + 64 * (size_t)i) * MB;
  slot[7] = (char*)d_out; slot[8] = (char*)d_out + 64 * MB;
  p.hA = (u16*)slot[0];
  p.gq = (u16*)slot[1]; p.gk = (u16*)(slot[1] + 32 * MB);
  p.gvT = (u16*)slot[2]; p.dq = (u16*)slot[3]; p.dk = (u16*)slot[4]; p.dvT = (u16*)slot[5];
  p.qe_fw = (u16*)slot[0]; p.ke_fw = (u16*)(slot[0] + 32 * MB);
  p.qe_bw = (u16*)slot[6]; p.ke_bw = (u16*)(slot[6] + 32 * MB);
  p.keT = (u16*)slot[7];
  p.o_fw = (u16*)slot[1]; p.o_bw = (u16*)slot[8];
  p.uB = (u16*)slot[6]; p.vB = (u16*)(slot[6] + 16 * MB);
  p.A1 = (u16*)slot[2]; p.merged = (u16*)slot[4];
  p.sga = (u16*)slot[5]; p.sgb = (u16*)slot[7];
  p.x1 = (float*)slot[0];
  p.h2 = (u16*)slot[2]; p.qp = (u16*)slot[3];
  p.us = (float*)(slot[6] + 32 * MB); p.vs = (float*)(slot[6] + 33 * MB);
  p.idx = (int*)slot[5]; p.g = (float*)(slot[5] + 16 * MB);
  void* args[] = {&p};
  hipError_t e = hipLaunchCooperativeKernel((void*)fwd_megakernel, dim3(grid_blocks), dim3(512), args, LDS_BYTES, stream);
  if (e != hipSuccess) fprintf(stderr, "cooperative launch failed: %s (grid %d)\n", hipGetErrorString(e), grid_blocks);
}
```

```cpp
#include <hip/hip_runtime.h>
#include <hip/hip_cooperative_groups.h>
#include <cstdio>
namespace cg = cooperative_groups;

#define DI __device__ __forceinline__
typedef unsigned short u16;
using bf16x8 = __attribute__((ext_vector_type(8))) short;
using f32x16 = __attribute__((ext_vector_type(16))) float;
using u32x4 = __attribute__((ext_vector_type(4))) unsigned;
using u32x2 = __attribute__((ext_vector_type(2))) unsigned;
typedef __bf16 bf16x2_t __attribute__((ext_vector_type(2)));
typedef float f32x2_t __attribute__((ext_vector_type(2)));

constexpr int T = 32768, D = 1024, S = 8192;
constexpr size_t MB = 1ull << 20;
constexpr float RMS_EPS = 1e-6f;
constexpr int LDS_BYTES = 144 * 1024;

#define MFMA(a, b, c) __builtin_amdgcn_mfma_f32_32x32x16_bf16((a), (b), (c), 0, 0, 0)

struct Params {
  const float *x, *c; const int* pos;
  const float *w_ada, *b_ada, *norm1_g, *w_in, *wa_fw, *ba_fw, *wa_bw, *ba_bw, *gla_norm_g;
  const float *lq1, *lk1, *lq2, *lk2, *diff_norm_g, *w_gla, *w_diff, *w_out, *norm2_g, *peer_wq, *subkeys, *peer_u, *peer_v;
  const float *w_fada, *b_fada, *normf_g;
  float* out;
  u16 *winT, *wgrT, *wgaT, *wgbT, *wglaT, *wdiffT, *woutT, *wqT, *subk;
  float* rope;
  float* mod;
  float* fmod;
  float* lam;
  int* counter;
  float* lr;
  float* dec;
  float* rstd;
  u16 *hA, *gq, *gk, *gvT, *dq, *dk, *dvT;
  u16 *qe_fw, *ke_fw, *qe_bw, *ke_bw, *keT;
  u16 *o_fw, *o_bw, *A1, *merged, *h2, *qp, *uB, *vB;
  float* x1;
  int* idx; float* g;
  float *us, *vs;
  u16 *sga, *sgb;
  unsigned* bar;
  int* kmax;
};

DI u16 f2bf(float x) { unsigned u = __float_as_uint(x); u += 0x7fffu + ((u >> 16) & 1u); return (u16)(u >> 16); }
DI float bf2f(u16 b) { return __uint_as_float(((unsigned)b) << 16); }
DI unsigned pack2(float a, float b) {
  f32x2_t v = {a, b};
  bf16x2_t r = __builtin_convertvector(v, bf16x2_t);
  return __builtin_bit_cast(unsigned, r);
}
DI float bflo(unsigned u) { return __uint_as_float(u << 16); }
DI float bfhi(unsigned u) { return __uint_as_float(u & 0xffff0000u); }
DI int crow(int i, int h) { return (i & 3) + 8 * (i >> 2) + 4 * h; }
DI bf16x8 pack_step(const f32x16& x, int s) {
  u32x4 p;
  p[0] = pack2(x[8 * s + 0], x[8 * s + 1]);
  p[1] = pack2(x[8 * s + 2], x[8 * s + 3]);
  p[2] = pack2(x[8 * s + 4], x[8 * s + 5]);
  p[3] = pack2(x[8 * s + 6], x[8 * s + 7]);
  return __builtin_bit_cast(bf16x8, p);
}
DI bf16x8 ld_frag16(const u16* p) { return __builtin_bit_cast(bf16x8, *(const u32x4*)p); }
DI bf16x8 ld_frag8x2(const u16* p) {
  u32x2 lo = *(const u32x2*)p; u32x2 hi = *(const u32x2*)(p + 8);
  u32x4 v = {lo[0], lo[1], hi[0], hi[1]};
  return __builtin_bit_cast(bf16x8, v);
}
DI void st_perm(u16* rowp, int ch, u32x4 v) {
  u16* d = rowp + (ch >> 1) * 16 + (ch & 1) * 4;
  u32x2 lo = {v[0], v[1]}, hi = {v[2], v[3]};
  *(u32x2*)d = lo;
  *(u32x2*)(d + 8) = hi;
}
DI float wave_sum(float v) {
#pragma unroll
  for (int o = 32; o >= 1; o >>= 1) v += __shfl_xor(v, o);
  return v;
}

template <int CTRL> DI float dpp_f(float v) { return __builtin_bit_cast(float, __builtin_amdgcn_update_dpp(0, __builtin_bit_cast(int, v), CTRL, 0xF, 0xF, false)); }
template <int CTRL> DI unsigned dpp_u(unsigned v) { return (unsigned)__builtin_amdgcn_update_dpp(0, (int)v, CTRL, 0xF, 0xF, false); }
DI float gsum16(float v) { v += dpp_f<0x121>(v); v += dpp_f<0x122>(v); v += dpp_f<0x124>(v); v += dpp_f<0x128>(v); return v; }
DI float gmaxf16(float v) { v = fmaxf(v, dpp_f<0x121>(v)); v = fmaxf(v, dpp_f<0x122>(v)); v = fmaxf(v, dpp_f<0x124>(v)); v = fmaxf(v, dpp_f<0x128>(v)); return v; }
DI unsigned gmax16(unsigned v) { v = max(v, dpp_u<0x121>(v)); v = max(v, dpp_u<0x122>(v)); v = max(v, dpp_u<0x124>(v)); v = max(v, dpp_u<0x128>(v)); return v; }
DI int opq(int x) { asm volatile("" : "+v"(x)); return x; }
DI f32x16 zero16() { f32x16 z; for (int i = 0; i < 16; ++i) z[i] = 0.f; return z; }

DI void tconv_tile(const float* src, int ld, int c0, int nc, u16* dst, int ct, int kt, float* sm, int tid) {
  __syncthreads();
  int cl = tid & 63, r0 = tid >> 6;
#pragma unroll
  for (int r = 0; r < 8; ++r) {
    int k = kt * 64 + r0 + 8 * r;
    int col = ct * 64 + cl;
    float v = (col < nc) ? src[(size_t)k * ld + c0 + col] : 0.f;
    sm[(r0 + 8 * r) * 65 + cl] = v;
  }
  __syncthreads();
#pragma unroll
  for (int r = 0; r < 8; ++r) {
    int col = r0 + 8 * r;
    int k = cl;
    dst[(size_t)(ct * 64 + col) * 1024 + kt * 64 + k] = f2bf(sm[k * 65 + col]);
  }
}

DI void phase_prep(const Params& p, char* smem, int tid) {
  float* sm = (float*)smem;
  const int nblk = gridDim.x, bid = blockIdx.x;
  const int NCT = 32 + 48 + 2 + 16 * 6 + 32;
  for (int it = bid; it < NCT * 16; it += nblk) {
    int ctg = it >> 4, kt = it & 15;
    const float* src; int ld, c0, nc; u16* dst; int ct;
    if (ctg < 32) { src = p.w_in; ld = 8224; c0 = 0; nc = 2048; dst = p.winT; ct = ctg; }
    else if (ctg < 80) { src = p.w_in; ld = 8224; c0 = 3104; nc = 3072; dst = p.winT + (size_t)2048 * 1024; ct = ctg - 32; }
    else if (ctg < 82) { src = p.w_in; ld = 8224; c0 = 3072; nc = 32; dst = p.winT + (size_t)5120 * 1024; ct = ctg - 80; }
    else if (ctg < 98) { src = p.w_in; ld = 8224; c0 = 2048; nc = 1024; dst = p.wgrT; ct = ctg - 82; }
    else if (ctg < 114) { src = p.w_in; ld = 8224; c0 = 6176; nc = 1024; dst = p.wgaT; ct = ctg - 98; }
    else if (ctg < 130) { src = p.w_in; ld = 8224; c0 = 7200; nc = 1024; dst = p.wgbT; ct = ctg - 114; }
    else if (ctg < 146) { src = p.w_gla; ld = 1024; c0 = 0; nc = 1024; dst = p.wglaT; ct = ctg - 130; }
    else if (ctg < 162) { src = p.w_diff; ld = 1024; c0 = 0; nc = 1024; dst = p.wdiffT; ct = ctg - 146; }
    else if (ctg < 178) { src = p.w_out; ld = 1024; c0 = 0; nc = 1024; dst = p.woutT; ct = ctg - 162; }
    else { src = p.peer_wq; ld = 2048; c0 = 0; nc = 2048; dst = p.wqT; ct = ctg - 178; }
    tconv_tile(src, ld, c0, nc, dst, ct, kt, sm, tid);
  }
  __syncthreads();
  const int gtid = bid * 512 + tid, gsz = nblk * 512;
  for (int i = gtid; i < 8 * 2 * 128 * 128; i += gsz) p.subk[i] = f2bf(p.subkeys[i]);
  for (int i = gtid; i < T * 32; i += gsz) {
    int t = i >> 5, d = i & 31;
    float inv = powf(10000.f, -(float)d / 32.f);
    float ang = (float)p.pos[t] * inv;
    double r = (double)ang * 0.15915494309189535;
    r -= rint(r);
    float rf = (float)r;
    p.rope[2 * i] = __builtin_amdgcn_cosf(rf);
    p.rope[2 * i + 1] = __builtin_amdgcn_sinf(rf);
  }
  if (gtid == 0) {
    float s1 = 0.f, s2 = 0.f;
    for (int i = 0; i < 64; ++i) { s1 += p.lq1[i] * p.lk1[i]; s2 += p.lq2[i] * p.lk2[i]; }
    p.lam[0] = expf(s1) - expf(s2) + 0.2f;
    for (int i = 0; i < 16; ++i) p.counter[i] = 0;
    for (int i = 0; i < 64; ++i) p.kmax[i] = 0;
  }
  {
    float* cact = sm;
    float* red = sm + 4096;
    __syncthreads();
    for (int i = tid; i < 4096; i += 512) { float v = p.c[i]; cact[i] = v / (1.f + __expf(-v)); }
    __syncthreads();
    int w = tid >> 6, lane = tid & 63;
    for (int it = bid; it < 128; it += nblk) {
      int col = it * 64 + lane;
      const float* W; int ld, cc;
      if (col < 6144) { W = p.w_ada; ld = 6144; cc = col; } else { W = p.w_fada; ld = 2048; cc = col - 6144; }
      float a0 = 0, a1 = 0, a2 = 0, a3 = 0;
#pragma unroll 8
      for (int k = w * 128; k < w * 128 + 128; ++k) {
        float wv = W[(size_t)k * ld + cc];
        a0 += cact[k] * wv; a1 += cact[1024 + k] * wv; a2 += cact[2048 + k] * wv; a3 += cact[3072 + k] * wv;
      }
      red[(w * 4 + 0) * 64 + lane] = a0; red[(w * 4 + 1) * 64 + lane] = a1;
      red[(w * 4 + 2) * 64 + lane] = a2; red[(w * 4 + 3) * 64 + lane] = a3;
      __syncthreads();
      if (tid < 256) {
        int b = w;
        float s = 0.f;
#pragma unroll
        for (int ww = 0; ww < 8; ++ww) s += red[(ww * 4 + b) * 64 + lane];
        if (col < 6144) p.mod[b * 6144 + cc] = s + p.b_ada[cc];
        else p.fmod[b * 2048 + cc] = s + p.b_fada[cc];
      }
      __syncthreads();
    }
  }
}

DI void phase_norm_mod(const float* src, const float* g, const float* mod, int sh_off, int sc_off, u16* dst, int tid) {
  int w = tid >> 6, lane = tid & 63;
  for (int row = blockIdx.x * 8 + w; row < T; row += gridDim.x * 8) {
    int b = row >> 13;
    const float* xr = src + (size_t)row * 1024;
    float4 v[4]; float ss = 0.f;
#pragma unroll
    for (int m = 0; m < 4; ++m) { v[m] = *(const float4*)(xr + (m * 64 + lane) * 4); ss += v[m].x * v[m].x + v[m].y * v[m].y + v[m].z * v[m].z + v[m].w * v[m].w; }
    ss = wave_sum(ss);
    float rstd = rsqrtf(ss * (1.f / 1024.f) + RMS_EPS);
#pragma unroll
    for (int m = 0; m < 4; ++m) {
      int col = (m * 64 + lane) * 4;
      float4 gg = *(const float4*)(g + col);
      float4 sh = *(const float4*)(mod + b * 6144 + sh_off + col);
      float4 sc = *(const float4*)(mod + b * 6144 + sc_off + col);
      float y0 = v[m].x * rstd * gg.x * (1.f + sc.x) + sh.x;
      float y1 = v[m].y * rstd * gg.y * (1.f + sc.y) + sh.y;
      float y2 = v[m].z * rstd * gg.z * (1.f + sc.z) + sh.z;
      float y3 = v[m].w * rstd * gg.w * (1.f + sc.w) + sh.w;
      u32x2 o = {pack2(y0, y1), pack2(y2, y3)};
      *(u32x2*)(dst + (size_t)row * 1024 + col) = o;
    }
  }
}

constexpr int GLD = 72;
constexpr int GSTAGE = (256 + 128) * GLD;
DI void gemm_kloop(const u16* A, int lda, const u16* Bt, int ldb, int K, f32x16 (&acc)[2][2], u16* smem, int tid) {
  const int w = tid >> 6, lane = tid & 63, c = lane & 31, hh = lane >> 5;
  const int wm = w >> 1, wn = w & 1;
  const int lrow = tid >> 3, lcol = (tid & 7) * 8;
  u32x4 ra[4], rb[2];
  const int nk = K >> 6;
#pragma unroll
  for (int r = 0; r < 4; ++r) ra[r] = *(const u32x4*)(A + (size_t)(r * 64 + lrow) * lda + lcol);
#pragma unroll
  for (int r = 0; r < 2; ++r) rb[r] = *(const u32x4*)(Bt + (size_t)(r * 64 + lrow) * ldb + lcol);
  __syncthreads();
  {
    u16* sA = smem; u16* sB = smem + 256 * GLD;
#pragma unroll
    for (int r = 0; r < 4; ++r) *(u32x4*)(sA + (r * 64 + lrow) * GLD + lcol) = ra[r];
#pragma unroll
    for (int r = 0; r < 2; ++r) *(u32x4*)(sB + (r * 64 + lrow) * GLD + lcol) = rb[r];
  }
  if (nk > 1) {
#pragma unroll
    for (int r = 0; r < 4; ++r) ra[r] = *(const u32x4*)(A + (size_t)(r * 64 + lrow) * lda + 64 + lcol);
#pragma unroll
    for (int r = 0; r < 2; ++r) rb[r] = *(const u32x4*)(Bt + (size_t)(r * 64 + lrow) * ldb + 64 + lcol);
  }
  __syncthreads();
  for (int kt = 0; kt < nk; ++kt) {
    const u16* sA = smem + (kt & 1) * GSTAGE; const u16* sB = sA + 256 * GLD;
    if (kt + 1 < nk) {
      u16* nA = smem + ((kt + 1) & 1) * GSTAGE; u16* nB = nA + 256 * GLD;
#pragma unroll
      for (int r = 0; r < 4; ++r) *(u32x4*)(nA + (r * 64 + lrow) * GLD + lcol) = ra[r];
#pragma unroll
      for (int r = 0; r < 2; ++r) *(u32x4*)(nB + (r * 64 + lrow) * GLD + lcol) = rb[r];
      if (kt + 2 < nk) {
#pragma unroll
        for (int r = 0; r < 4; ++r) ra[r] = *(const u32x4*)(A + (size_t)(r * 64 + lrow) * lda + (kt + 2) * 64 + lcol);
#pragma unroll
        for (int r = 0; r < 2; ++r) rb[r] = *(const u32x4*)(Bt + (size_t)(r * 64 + lrow) * ldb + (kt + 2) * 64 + lcol);
      }
    }
    bf16x8 fr[2][4];
#define GLOADF(set, s) { fr[set][0] = ld_frag16(sA + (wm * 64 + c) * GLD + (s) * 16 + hh * 8); fr[set][1] = ld_frag16(sA + (wm * 64 + 32 + c) * GLD + (s) * 16 + hh * 8); \
                         fr[set][2] = ld_frag16(sB + (wn * 64 + c) * GLD + (s) * 16 + hh * 8); fr[set][3] = ld_frag16(sB + (wn * 64 + 32 + c) * GLD + (s) * 16 + hh * 8); }
#define GMM(set) { acc[0][0] = MFMA(fr[set][0], fr[set][2], acc[0][0]); acc[0][1] = MFMA(fr[set][0], fr[set][3], acc[0][1]); \
                   acc[1][0] = MFMA(fr[set][1], fr[set][2], acc[1][0]); acc[1][1] = MFMA(fr[set][1], fr[set][3], acc[1][1]); }
    GLOADF(0, 0);
    __builtin_amdgcn_sched_barrier(0);
    GLOADF(1, 1); GMM(0);
    __builtin_amdgcn_sched_barrier(0);
    GLOADF(0, 2); GMM(1);
    __builtin_amdgcn_sched_barrier(0);
    GLOADF(1, 3); GMM(0);
    __builtin_amdgcn_sched_barrier(0);
    GMM(1);
#undef GLOADF
#undef GMM
    __syncthreads();
  }
}
DI void zero_acc(f32x16 (&acc)[2][2]) {
#pragma unroll
  for (int a = 0; a < 2; ++a)
#pragma unroll
    for (int b = 0; b < 2; ++b) acc[a][b] = zero16();
}


constexpr int EPS = 68, EPT = 65;
DI float* wave_stage(char* smem, int w) { return (float*)smem + w * (64 * EPS); }
template <int STR> DI void stage_acc(const f32x16 (&acc)[2][2], float* wl, int c, int hh) {
#pragma unroll
  for (int mi = 0; mi < 2; ++mi)
#pragma unroll
    for (int ni = 0; ni < 2; ++ni)
#pragma unroll
      for (int i = 0; i < 16; ++i) wl[(mi * 32 + crow(i, hh)) * STR + ni * 32 + c] = acc[mi][ni][i];
}
DI void st_bf16x8(u16* dst, const float (&v)[8]) {
  u32x4 o = {pack2(v[0], v[1]), pack2(v[2], v[3]), pack2(v[4], v[5]), pack2(v[6], v[7])};
  *(u32x4*)dst = o;
}
DI void ld_bf16x8(const u16* srcp, float (&v)[8]) {
  u32x4 o = *(const u32x4*)srcp;
#pragma unroll
  for (int i = 0; i < 4; ++i) { v[2 * i] = bflo(o[i]); v[2 * i + 1] = bfhi(o[i]); }
}
template <class F> DI void epi_rows(const float* wl, int lane, F f) {
#pragma unroll
  for (int ps = 0; ps < 8; ++ps) {
    const int r = (lane >> 3) + 8 * ps, cc = (lane & 7) * 8;
    float4 v0 = *(const float4*)(wl + r * EPS + cc), v1 = *(const float4*)(wl + r * EPS + cc + 4);
    float v[8] = {v0.x, v0.y, v0.z, v0.w, v1.x, v1.y, v1.z, v1.w};
    f(r, cc, v);
  }
}
DI void epi_cols_bf16(const float* wl, int lane, u16* dstT, size_t ldt) {
#pragma unroll
  for (int ps = 0; ps < 8; ++ps) {
    const int col = (lane >> 3) + 8 * ps, r0 = (lane & 7) * 8;
    float v[8];
#pragma unroll
    for (int j = 0; j < 8; ++j) v[j] = wl[(r0 + j) * EPT + col];
    st_bf16x8(dstT + (size_t)col * ldt + r0, v);
  }
}

DI void phase_proj(const Params& p, char* smem, int tid) {
  const int w = tid >> 6, lane = tid & 63, c_inv = lane & 31, hh_inv = lane >> 5;
  const int wm = w >> 1, wn = w & 1;
  float* wl = wave_stage(smem, w);
  const int NT = 41;
  for (int id = blockIdx.x; id < 128 * NT; id += gridDim.x) {
    int mt = id / NT, nt = id - mt * NT;
    int m0 = mt * 256, n0 = nt * 128;
    f32x16 acc[2][2]; zero_acc(acc);
    gemm_kloop(p.hA + (size_t)m0 * 1024, 1024, p.winT + (size_t)n0 * 1024, 1024, 1024, acc, (u16*)smem, tid);
    const int c = opq(c_inv), hh = opq(hh_inv);
    const int rb = m0 + wm * 64, cb = n0 + wn * 64;
    if (n0 < 1024) {
      const float sc = (n0 < 512) ? 0.08838834764831845f : 1.f;
      u16* dst = ((n0 < 512) ? p.gq : p.gk) + (size_t)rb * 512 + (cb & 511);
      stage_acc<EPS>(acc, wl, c, hh);
      epi_rows(wl, lane, [&](int r, int cc, float (&v)[8]) {
#pragma unroll
        for (int j = 0; j < 8; ++j) v[j] *= sc;
        st_bf16x8(dst + (size_t)r * 512 + cc, v);
      });
    } else if (n0 < 2048 || (n0 >= 4096 && n0 < 5120)) {
      const bool isg = n0 < 2048;
      const int b = rb >> 13;
      u16* dstT;
      if (isg) { int cc0 = cb - 1024; dstT = p.gvT + ((size_t)(b * 4 + (cc0 >> 8)) * 256 + (cc0 & 255)) * 8192 + (rb & 8191); }
      else { int cc0 = cb - 4096; dstT = p.dvT + ((size_t)(b * 8 + (cc0 >> 7)) * 128 + (cc0 & 127)) * 8192 + (rb & 8191); }
      stage_acc<EPT>(acc, wl, c, hh);
      epi_cols_bf16(wl, lane, dstT, 8192);
    } else if (n0 < 4096) {
      const bool isq = n0 < 3072;
      const float sc = isq ? (0.125f * 1.4426950408889634f) : 1.f;
      const int cbb = cb - (isq ? 2048 : 3072);
      float knmax = 0.f;
#pragma unroll
      for (int mi = 0; mi < 2; ++mi)
#pragma unroll
        for (int i = 0; i < 16; ++i) {
          int row = rb + mi * 32 + crow(i, hh);
          float2 cs = *(const float2*)(p.rope + ((size_t)row * 32 + c) * 2);
          float x1 = acc[mi][0][i], x2 = acc[mi][1][i];
          float o1 = (x1 * cs.x - x2 * cs.y) * sc;
          float o2 = (x2 * cs.x + x1 * cs.y) * sc;
          acc[mi][0][i] = o1; acc[mi][1][i] = o2;
          if (!isq) {
            float ssq = o1 * o1 + o2 * o2;
            ssq += __shfl_xor(ssq, 1); ssq += __shfl_xor(ssq, 2); ssq += __shfl_xor(ssq, 4); ssq += __shfl_xor(ssq, 8); ssq += __shfl_xor(ssq, 16);
            knmax = fmaxf(knmax, ssq);
          }
        }
      if (!isq && c == 0) atomicMax(p.kmax + ((rb >> 13) * 8 + (cbb >> 7)) * 2 + ((cbb >> 6) & 1), __float_as_int(knmax));
      u16* dst = (isq ? p.dq : p.dk) + (size_t)rb * 1024 + cbb;
      stage_acc<EPS>(acc, wl, c, hh);
      epi_rows(wl, lane, [&](int r, int cc, float (&v)[8]) { st_bf16x8(dst + (size_t)r * 1024 + cc, v); });
    } else {
      if (wn == 0) {
#pragma unroll
        for (int mi = 0; mi < 2; ++mi)
#pragma unroll
          for (int i = 0; i < 16; ++i) {
            int row = rb + mi * 32 + crow(i, hh);
            p.lr[(size_t)row * 32 + c] = acc[mi][0][i];
          }
      }
    }
  }
}

DI float logsig(float x) { return fminf(x, 0.f) - __logf(1.f + __expf(-fabsf(x))); }

DI void phase_gla_pre(const Params& p, char* smem, int tid) {
  float* slr = (float*)smem;
  for (int it = blockIdx.x; it < 1024; it += gridDim.x) {
    const int dir = it & 1, ch = (it >> 1) & 127, b = it >> 8;
    const size_t t0 = (size_t)b * 8192 + ch * 64;
    __syncthreads();
    for (int i = tid; i < 1024; i += 512) slr[i] = p.lr[t0 * 32 + (i >> 4) * 32 + dir * 16 + (i & 15)];
    __syncthreads();
    const int j = tid;
    const int h = j >> 7, d = j & 127;
    const float* wa = dir ? p.wa_bw : p.wa_fw;
    float wr[16];
#pragma unroll
    for (int r = 0; r < 16; ++r) wr[r] = wa[r * 512 + j];
    const float ba = (dir ? p.ba_bw : p.ba_fw)[j];
    u16* qe = (dir ? p.qe_bw : p.qe_fw) + t0 * 512 + j;
    u16* ke = (dir ? p.ke_bw : p.ke_fw) + t0 * 512 + j;
    const u16* gq = p.gq + t0 * 512 + j;
    const u16* gk = p.gk + t0 * 512 + j;
    u16* keT = p.keT + (size_t)dir * (16ull * 128 * 8192) + ((size_t)(b * 4 + h) * 128 + d) * 8192 + ch * 64;
    float bsum = 0.f;
#pragma unroll 1
    for (int g8 = 0; g8 < 8; ++g8) {
      u16 qraw[8], kraw[8];
#pragma unroll
      for (int u = 0; u < 8; ++u) {
        const int tt = g8 * 8 + u;
        const int t = dir ? 63 - tt : tt;
        qraw[u] = gq[t * 512]; kraw[u] = gk[t * 512];
      }
      unsigned kk[8];
#pragma unroll
      for (int u = 0; u < 8; ++u) {
        const int tt = g8 * 8 + u;
        const int t = dir ? 63 - tt : tt;
        float pre = ba;
#pragma unroll
        for (int r = 0; r < 16; ++r) pre += slr[t * 16 + r] * wr[r];
        bsum += logsig(pre) * (1.f / 16.f);
        const float eb = __expf(bsum);
        const u16 qo = f2bf(bf2f(qraw[u]) * eb);
        const u16 ko = f2bf(bf2f(kraw[u]) * __expf(-bsum));
        qe[t * 512] = qo;
        ke[t * 512] = ko;
        kk[u] = ko;
      }
      u32x4 v;
      if (!dir) {
        v[0] = kk[0] | (kk[1] << 16); v[1] = kk[2] | (kk[3] << 16); v[2] = kk[4] | (kk[5] << 16); v[3] = kk[6] | (kk[7] << 16);
        *(u32x4*)(keT + g8 * 8) = v;
      } else {
        v[0] = kk[7] | (kk[6] << 16); v[1] = kk[5] | (kk[4] << 16); v[2] = kk[3] | (kk[2] << 16); v[3] = kk[1] | (kk[0] << 16);
        *(u32x4*)(keT + (56 - g8 * 8)) = v;
      }
    }
    p.dec[((size_t)(dir * 4 + b) * 128 + ch) * 512 + j] = __expf(bsum);
  }
}

constexpr int QLD = 136, TLD = 72;
DI void gla_scan_block(const Params& p, int g, char* smem, int tid) {
  const int dir = g & 1, bh = g >> 1;
  const int b = bh >> 2, h = bh & 3;
  const int w = tid >> 6, lane = tid & 63, c = lane & 31, hh = lane >> 5;
  const int slice = w;
  u16* sQ = (u16*)smem;
  u16* sK = sQ + 64 * QLD;
  u16* sKT = sK + 64 * QLD;
  u16* sVT = sKT + 128 * TLD;
  const u16* qe = (dir ? p.qe_bw : p.qe_fw) + (size_t)b * 8192 * 512 + h * 128;
  const u16* ke = (dir ? p.ke_bw : p.ke_fw) + (size_t)b * 8192 * 512 + h * 128;
  const u16* keT = p.keT + (size_t)dir * (16ull * 128 * 8192) + (size_t)bh * 128 * 8192;
  const u16* vT = p.gvT + (size_t)bh * 256 * 8192;
  const float* dec = p.dec + ((size_t)(dir * 4 + b) * 128) * 512 + h * 128;
  u16* o = dir ? p.o_bw : p.o_fw;
  f32x16 st[4];
#pragma unroll
  for (int i = 0; i < 4; ++i) st[i] = zero16();
  u32x4 rq[2], rk[2], rt[2];
  unsigned offq[2], offt[2];
#pragma unroll
  for (int r = 0; r < 2; ++r) {
    int id = tid + 512 * r;
    offq[r] = (unsigned)(((id >> 4) * 512 + (id & 15) * 8) * 2);
    offt[r] = (unsigned)(((id >> 3) * 8192 + (id & 7) * 8) * 2);
  }
  const unsigned offv = (unsigned)(((w * 32 + c) * 8192 + 4 * hh) * 2);
  {
    const int ch = dir ? 127 : 0;
#pragma unroll
    for (int r = 0; r < 2; ++r) {
      int id = tid + 512 * r;
      rq[r] = *(const u32x4*)((const char*)(qe + (size_t)ch * 64 * 512) + offq[r]);
      rk[r] = *(const u32x4*)((const char*)(ke + (size_t)ch * 64 * 512) + offq[r]);
      rt[r] = *(const u32x4*)((const char*)(keT + ch * 64) + offt[r]);
    }
  }
#pragma unroll 1
  for (int ci = 0; ci < 128; ++ci) {
    const int ch = dir ? 127 - ci : ci;
    const size_t t0 = (size_t)b * 8192 + ch * 64;
    __syncthreads();
#pragma unroll
    for (int r = 0; r < 2; ++r) {
      int id = tid + 512 * r;
      st_perm(sQ + (id >> 4) * QLD, id & 15, rq[r]);
      st_perm(sK + (id >> 4) * QLD, id & 15, rk[r]);
      st_perm(sKT + (id >> 3) * TLD, id & 7, rt[r]);
    }
    __syncthreads();
    if (ci + 1 < 128) {
      const int chn = dir ? ch - 1 : ch + 1;
#pragma unroll
      for (int r = 0; r < 2; ++r) {
        int id = tid + 512 * r;
        rq[r] = *(const u32x4*)((const char*)(qe + (size_t)chn * 64 * 512) + offq[r]);
        rk[r] = *(const u32x4*)((const char*)(ke + (size_t)chn * 64 * 512) + offq[r]);
        rt[r] = *(const u32x4*)((const char*)(keT + chn * 64) + offt[r]);
      }
    }
    bf16x8 vf[4];
#pragma unroll
    for (int k4 = 0; k4 < 4; ++k4) vf[k4] = ld_frag8x2((const u16*)((const char*)(vT + ch * 64 + 16 * k4) + offv));
#pragma unroll 1
    for (int qt = 0; qt < 2; ++qt) {
      f32x16 oacc = zero16();
#pragma unroll
      for (int ks = 0; ks < 8; ++ks) {
        bf16x8 sf = pack_step(st[ks >> 1], ks & 1);
        bf16x8 q0 = ld_frag16(sQ + (qt * 32 + c) * QLD + ks * 16 + 8 * hh);
        oacc = MFMA(q0, sf, oacc);
        if (ks & 1) __builtin_amdgcn_sched_barrier(0);
      }
#pragma unroll
      for (int kt = 0; kt < 2; ++kt) {
        bool skip = dir ? (kt < qt) : (kt > qt);
        if (skip) continue;
        f32x16 X = zero16();
#pragma unroll 1
        for (int ks = 0; ks < 8; ++ks) {
          bf16x8 kf = ld_frag16(sK + (kt * 32 + c) * QLD + ks * 16 + 8 * hh);
          bf16x8 qf = ld_frag16(sQ + (qt * 32 + c) * QLD + ks * 16 + 8 * hh);
          X = MFMA(kf, qf, X);
        }
        if (kt == qt) {
#pragma unroll
          for (int i = 0; i < 16; ++i) {
            int key = crow(i, hh);
            bool keep = dir ? (key >= c) : (key <= c);
            X[i] = keep ? X[i] : 0.f;
          }
        }
        oacc = MFMA(pack_step(X, 0), vf[kt * 2 + 0], oacc);
        oacc = MFMA(pack_step(X, 1), vf[kt * 2 + 1], oacc);
        __builtin_amdgcn_sched_barrier(0);
      }
#pragma unroll
      for (int i = 0; i < 16; ++i)
        o[(t0 + qt * 32 + crow(i, hh)) * 1024 + h * 256 + slice * 32 + c] = f2bf(oacc[i]);
      __builtin_amdgcn_sched_barrier(0);
    }
#pragma unroll
    for (int dt = 0; dt < 4; ++dt) {
#pragma unroll
      for (int k4 = 0; k4 < 4; ++k4) {
        bf16x8 kt_f = ld_frag16(sKT + (dt * 32 + c) * TLD + 16 * k4 + 8 * hh);
        st[dt] = MFMA(kt_f, vf[k4], st[dt]);
      }
#pragma unroll
      for (int gg = 0; gg < 4; ++gg) {
        float4 dv = *(const float4*)(dec + (size_t)ch * 512 + dt * 32 + 8 * gg + 4 * hh);
        st[dt][4 * gg + 0] *= dv.x; st[dt][4 * gg + 1] *= dv.y; st[dt][4 * gg + 2] *= dv.z; st[dt][4 * gg + 3] *= dv.w;
      }
      __builtin_amdgcn_sched_barrier(0);
    }
  }
}

constexpr int KLD = 136, VLD = 72;
constexpr int ATT_BUF = 64 * KLD + 128 * VLD;
DI void attn_item(const Params& p, int item, char* smem, int tid) {
  const int qb = item & 63, bh = item >> 6;
  const int b = bh >> 3, h = bh & 7;
  const int w = tid >> 6, lane = tid & 63, c = lane & 31, hh = lane >> 5;
  const int qg = w & 3, mp = w >> 2;
  u16* sbase = (u16*)smem;
  float* sex = (float*)(smem + 2 * ATT_BUF * 2);
  const size_t tq = (size_t)b * 8192 + qb * 128 + qg * 32 + c;
  bf16x8 qf[4];
#pragma unroll
  for (int s = 0; s < 4; ++s) qf[s] = ld_frag16(p.dq + tq * 1024 + h * 128 + mp * 64 + 16 * s + 8 * hh);
  f32x16 O[4];
#pragma unroll
  for (int dt = 0; dt < 4; ++dt) O[dt] = zero16();
  float lrun = 0.f;
  float negmb;
  {
    float qn = 0.f;
#pragma unroll
    for (int s = 0; s < 4; ++s) {
      u32x4 qq = __builtin_bit_cast(u32x4, qf[s]);
#pragma unroll
      for (int i = 0; i < 4; ++i) { float x0 = bflo(qq[i]), x1 = bfhi(qq[i]); qn += x0 * x0 + x1 * x1; }
    }
    qn += __shfl_xor(qn, 32);
    float kn = __int_as_float(p.kmax[(b * 8 + h) * 2 + mp]);
    float mb = sqrtf(qn * kn) * 1.01f + 1e-3f;
    negmb = -mb;
  }
  const u16* Kg = p.dk + (size_t)b * 8192 * 1024 + h * 128;
  const u16* Vg = p.dvT + (size_t)bh * 128 * 8192;
  u32x4 rk[2], rv[2];
#pragma unroll
  for (int r = 0; r < 2; ++r) {
    int id = tid + 512 * r;
    rk[r] = *(const u32x4*)(Kg + (size_t)(id >> 4) * 1024 + (id & 15) * 8);
    rv[r] = *(const u32x4*)(Vg + (size_t)(id >> 3) * 8192 + (id & 7) * 8);
  }
  __syncthreads();
#pragma unroll
  for (int r = 0; r < 2; ++r) {
    int id = tid + 512 * r;
    *(u32x4*)(sbase + (id >> 4) * KLD + (id & 15) * 8) = rk[r];
    st_perm(sbase + 64 * KLD + (id >> 3) * VLD, id & 7, rv[r]);
  }
#pragma unroll
  for (int r = 0; r < 2; ++r) {
    int id = tid + 512 * r;
    rk[r] = *(const u32x4*)(Kg + (size_t)(64 + (id >> 4)) * 1024 + (id & 15) * 8);
    rv[r] = *(const u32x4*)(Vg + (size_t)(id >> 3) * 8192 + 64 + (id & 7) * 8);
  }
  __syncthreads();
#pragma unroll 1
  for (int kt = 0; kt < 128; ++kt) {
    const u16* sK = sbase + (kt & 1) * ATT_BUF;
    const u16* sV = sK + 64 * KLD;
    if (kt + 1 < 128) {
      u16* nK = sbase + ((kt + 1) & 1) * ATT_BUF;
      u16* nV = nK + 64 * KLD;
#pragma unroll
      for (int r = 0; r < 2; ++r) {
        int id = tid + 512 * r;
        *(u32x4*)(nK + (id >> 4) * KLD + (id & 15) * 8) = rk[r];
        st_perm(nV + (id >> 3) * VLD, id & 7, rv[r]);
      }
      if (kt + 2 < 128) {
#pragma unroll
        for (int r = 0; r < 2; ++r) {
          int id = tid + 512 * r;
          rk[r] = *(const u32x4*)(Kg + (size_t)((kt + 2) * 64 + (id >> 4)) * 1024 + (id & 15) * 8);
          rv[r] = *(const u32x4*)(Vg + (size_t)(id >> 3) * 8192 + (kt + 2) * 64 + (id & 7) * 8);
        }
      }
    }
    f32x16 sacc[2];
    bf16x8 kf[8];
#pragma unroll
    for (int s = 0; s < 4; ++s)
#pragma unroll
      for (int k2 = 0; k2 < 2; ++k2) kf[s * 2 + k2] = ld_frag16(sK + (k2 * 32 + c) * KLD + mp * 64 + 16 * s + 8 * hh);
    __builtin_amdgcn_sched_barrier(0);
#pragma unroll
    for (int i = 0; i < 16; ++i) { sacc[0][i] = negmb; sacc[1][i] = negmb; }
#pragma unroll
    for (int s = 0; s < 4; ++s) {
      sacc[0] = MFMA(kf[s * 2 + 0], qf[s], sacc[0]);
      sacc[1] = MFMA(kf[s * 2 + 1], qf[s], sacc[1]);
    }
    bf16x8 vfA[4], vfB[4];
#define VLOAD(dst, k2, s2) { _Pragma("unroll") for (int dt = 0; dt < 4; ++dt) dst[dt] = ld_frag16(sV + (dt * 32 + c) * VLD + (k2) * 32 + (s2) * 16 + 8 * hh); }
#define PVMM(vf, pf) { _Pragma("unroll") for (int dt = 0; dt < 4; ++dt) O[dt] = MFMA(vf[dt], pf, O[dt]); }
#define EXPS(k2) { _Pragma("unroll") for (int i = 0; i < 8; ++i) { \
        float e0 = __builtin_amdgcn_exp2f(sacc[k2][2 * i]), e1 = __builtin_amdgcn_exp2f(sacc[k2][2 * i + 1]); \
        sacc[k2][2 * i] = e0; sacc[k2][2 * i + 1] = e1; f32x2_t ev = {e0, e1}; ls2 += ev; } }
    VLOAD(vfA, 0, 0);
    __builtin_amdgcn_sched_barrier(0);
    f32x2_t ls2 = {0.f, 0.f};
    EXPS(0);
    bf16x8 p0 = pack_step(sacc[0], 0), p1 = pack_step(sacc[0], 1);
    __builtin_amdgcn_sched_barrier(0);
    VLOAD(vfB, 0, 1);
    PVMM(vfA, p0);
    __builtin_amdgcn_sched_barrier(0);
    VLOAD(vfA, 1, 0);
    PVMM(vfB, p1);
    __builtin_amdgcn_sched_barrier(0);
    EXPS(1);
    p0 = pack_step(sacc[1], 0); p1 = pack_step(sacc[1], 1);
    __builtin_amdgcn_sched_barrier(0);
    VLOAD(vfB, 1, 1);
    PVMM(vfA, p0);
    __builtin_amdgcn_sched_barrier(0);
    PVMM(vfB, p1);
    lrun += ls2[0] + ls2[1];
#undef VLOAD
#undef PVMM
#undef EXPS
    __syncthreads();
  }
  float ltot = lrun + __shfl_xor(lrun, 32);
  if (mp == 1) {
    float sc = p.lam[0] / ltot;
#pragma unroll
    for (int dt = 0; dt < 4; ++dt)
#pragma unroll
      for (int i = 0; i < 16; ++i) sex[(qg * 64 + dt * 16 + i) * 64 + lane] = O[dt][i] * sc;
  }
  __syncthreads();
  if (mp == 0) {
    float i0 = 1.f / ltot;
    float ss = 0.f;
#pragma unroll
    for (int dt = 0; dt < 4; ++dt)
#pragma unroll
      for (int i = 0; i < 16; ++i) { float v = O[dt][i] * i0 - sex[(qg * 64 + dt * 16 + i) * 64 + lane]; O[dt][i] = v; ss += v * v; }
    ss += __shfl_xor(ss, 32);
    float rstd = rsqrtf(ss * (1.f / 128.f) + RMS_EPS) * 0.8f;
#pragma unroll
    for (int dt = 0; dt < 4; ++dt)
#pragma unroll
      for (int g = 0; g < 4; ++g) {
        int dv = dt * 32 + 8 * g + 4 * hh;
        float4 gg = *(const float4*)(p.diff_norm_g + h * 128 + dv);
        u32x2 v = {pack2(O[dt][4 * g] * rstd * gg.x, O[dt][4 * g + 1] * rstd * gg.y),
                   pack2(O[dt][4 * g + 2] * rstd * gg.z, O[dt][4 * g + 3] * rstd * gg.w)};
        *(u32x2*)(p.dq + tq * 1024 + h * 128 + dv) = v;
      }
  }
}

DI void phase_mixers(const Params& p, char* smem, int tid) {
  int* sitem = (int*)(smem + 143 * 1024);
  if (blockIdx.x < 32) gla_scan_block(p, blockIdx.x, smem, opq(tid));
  for (;;) {
    __syncthreads();
    if (tid == 0) *sitem = atomicAdd(p.counter, 1);
    __syncthreads();
    int item = *sitem;
    if (item >= 2048) break;
    attn_item(p, item, smem, opq(tid));
  }
}

DI void phase_post_mixers(const Params& p, int tid) {
  int w = tid >> 6, lane = tid & 63;
  for (int row = blockIdx.x * 8 + w; row < T; row += gridDim.x * 8) {
#pragma unroll
    for (int hd = 0; hd < 4; ++hd) {
      u32x2 a = *(const u32x2*)(p.o_fw + (size_t)row * 1024 + hd * 256 + lane * 4);
      u32x2 bq = *(const u32x2*)(p.o_bw + (size_t)row * 1024 + hd * 256 + lane * 4);
      float v0 = bflo(a[0]) + bflo(bq[0]), v1 = bfhi(a[0]) + bfhi(bq[0]), v2 = bflo(a[1]) + bflo(bq[1]), v3 = bfhi(a[1]) + bfhi(bq[1]);
      float ss = wave_sum(v0 * v0 + v1 * v1 + v2 * v2 + v3 * v3);
      if (lane == 0) p.rstd[row * 4 + hd] = rsqrtf(ss * (1.f / 256.f) + RMS_EPS);
    }
  }
  phase_norm_mod(p.x, p.norm1_g, p.mod, 0, 1024, p.hA, tid);
  for (int row = blockIdx.x * 8 + w; row < 32768; row += gridDim.x * 8) {
    const bool isv = row >= 16384;
    const int r = row & 16383;
    const float* srcp = (isv ? p.peer_v : p.peer_u) + (size_t)r * 1024 + lane * 16;
    float4 a0 = *(const float4*)(srcp), a1 = *(const float4*)(srcp + 4), a2 = *(const float4*)(srcp + 8), a3 = *(const float4*)(srcp + 12);
    float am = fmaxf(fmaxf(fmaxf(fabsf(a0.x), fabsf(a0.y)), fmaxf(fabsf(a0.z), fabsf(a0.w))), fmaxf(fmaxf(fabsf(a1.x), fabsf(a1.y)), fmaxf(fabsf(a1.z), fabsf(a1.w))));
    am = fmaxf(am, fmaxf(fmaxf(fmaxf(fabsf(a2.x), fabsf(a2.y)), fmaxf(fabsf(a2.z), fabsf(a2.w))), fmaxf(fmaxf(fabsf(a3.x), fabsf(a3.y)), fmaxf(fabsf(a3.z), fabsf(a3.w)))));
#pragma unroll
    for (int o = 32; o >= 1; o >>= 1) am = fmaxf(am, __shfl_xor(am, o));
    am = fmaxf(am, 1e-30f);
    const float sc = 256.f / am;
    u32x4 v;
    int t0 = __builtin_amdgcn_cvt_pk_fp8_f32(a0.x * sc, a0.y * sc, 0, false); t0 = __builtin_amdgcn_cvt_pk_fp8_f32(a0.z * sc, a0.w * sc, t0, true);
    int t1 = __builtin_amdgcn_cvt_pk_fp8_f32(a1.x * sc, a1.y * sc, 0, false); t1 = __builtin_amdgcn_cvt_pk_fp8_f32(a1.z * sc, a1.w * sc, t1, true);
    int t2 = __builtin_amdgcn_cvt_pk_fp8_f32(a2.x * sc, a2.y * sc, 0, false); t2 = __builtin_amdgcn_cvt_pk_fp8_f32(a2.z * sc, a2.w * sc, t2, true);
    int t3 = __builtin_amdgcn_cvt_pk_fp8_f32(a3.x * sc, a3.y * sc, 0, false); t3 = __builtin_amdgcn_cvt_pk_fp8_f32(a3.z * sc, a3.w * sc, t3, true);
    v[0] = (unsigned)t0; v[1] = (unsigned)t1; v[2] = (unsigned)t2; v[3] = (unsigned)t3;
    unsigned char* dst = (unsigned char*)(isv ? p.vB : p.uB) + (size_t)r * 1024 + lane * 16;
    *(u32x4*)dst = v;
    if (lane == 0) (isv ? p.vs : p.us)[r] = am * (1.f / 256.f);
  }
}

DI void phase_gr(const Params& p, char* smem, int tid) {
  const int w = tid >> 6, lane = tid & 63, c_inv = lane & 31, hh_inv = lane >> 5;
  const int wm = w >> 1, wn = w & 1;
  float* wl = wave_stage(smem, w);
  for (int id = blockIdx.x; id < 128 * 24; id += gridDim.x) {
    int mt = id / 24, nt = id - mt * 24;
    int m0 = mt * 256, n0 = nt * 128;
    f32x16 acc[2][2]; zero_acc(acc);
    gemm_kloop(p.hA + (size_t)m0 * 1024, 1024, p.wgrT + (size_t)n0 * 1024, 1024, 1024, acc, (u16*)smem, tid);
    const int c = opq(c_inv), hh = opq(hh_inv);
    const int rb = m0 + wm * 64;
    stage_acc<EPS>(acc, wl, c, hh);
    if (n0 < 1024) {
      const int cb = n0 + wn * 64;
      epi_rows(wl, lane, [&](int r, int cc, float (&v)[8]) {
        const size_t off = (size_t)(rb + r) * 1024 + cb + cc;
        float of[8], ob[8];
        ld_bf16x8(p.o_fw + off, of); ld_bf16x8(p.o_bw + off, ob);
        const float rs = p.rstd[(rb + r) * 4 + ((cb + cc) >> 8)];
        float4 g0 = *(const float4*)(p.gla_norm_g + cb + cc), g1 = *(const float4*)(p.gla_norm_g + cb + cc + 4);
        const float gg[8] = {g0.x, g0.y, g0.z, g0.w, g1.x, g1.y, g1.z, g1.w};
#pragma unroll
        for (int j = 0; j < 8; ++j) { float a = v[j]; v[j] = (of[j] + ob[j]) * rs * gg[j] * (a / (1.f + __expf(-a))); }
        st_bf16x8(p.A1 + off, v);
      });
    } else {
      u16* dst = ((n0 < 2048) ? p.sga : p.sgb) + (size_t)rb * 1024 + (n0 & 1023) + wn * 64;
      epi_rows(wl, lane, [&](int r, int cc, float (&v)[8]) {
#pragma unroll
        for (int j = 0; j < 8; ++j) v[j] = 1.f / (1.f + __expf(-v[j]));
        st_bf16x8(dst + (size_t)r * 1024 + cc, v);
      });
    }
  }
}

DI void phase_merge(const Params& p, char* smem, int tid) {
  const int w = tid >> 6, lane = tid & 63, c_inv = lane & 31, hh_inv = lane >> 5;
  const int wm = w >> 1, wn = w & 1;
  float* wl = wave_stage(smem, w);
  for (int id = blockIdx.x; id < 128 * 8; id += gridDim.x) {
    int mt = id >> 3, nt = id & 7;
    int m0 = mt * 256, n0 = nt * 128;
    const size_t tb = (size_t)(m0 + wm * 64) * 1024 + n0 + wn * 64;
    f32x16 acc[2][2];
    zero_acc(acc);
    gemm_kloop(p.A1 + (size_t)m0 * 1024, 1024, p.wglaT + (size_t)n0 * 1024, 1024, 1024, acc, (u16*)smem, tid);
    {
      const int c = opq(c_inv), hh = opq(hh_inv);
      stage_acc<EPS>(acc, wl, c, hh);
      epi_rows(wl, lane, [&](int r, int cc, float (&v)[8]) {
        float gv[8];
        ld_bf16x8(p.sga + tb + (size_t)r * 1024 + cc, gv);
#pragma unroll
        for (int j = 0; j < 8; ++j) v[j] *= gv[j];
        st_bf16x8(p.sga + tb + (size_t)r * 1024 + cc, v);
      });
    }
    zero_acc(acc);
    gemm_kloop(p.dq + (size_t)m0 * 1024, 1024, p.wdiffT + (size_t)n0 * 1024, 1024, 1024, acc, (u16*)smem, tid);
    {
      const int c = opq(c_inv), hh = opq(hh_inv);
      stage_acc<EPS>(acc, wl, c, hh);
      epi_rows(wl, lane, [&](int r, int cc, float (&v)[8]) {
        float gv[8], mv[8];
        ld_bf16x8(p.sgb + tb + (size_t)r * 1024 + cc, gv);
        ld_bf16x8(p.sga + tb + (size_t)r * 1024 + cc, mv);
#pragma unroll
        for (int j = 0; j < 8; ++j) v[j] = mv[j] + v[j] * gv[j];
        st_bf16x8(p.merged + tb + (size_t)r * 1024 + cc, v);
      });
    }
  }
}

DI void phase_out(const Params& p, char* smem, int tid) {
  const int w = tid >> 6, lane = tid & 63, c_inv = lane & 31, hh_inv = lane >> 5;
  const int wm = w >> 1, wn = w & 1;
  float* wl = wave_stage(smem, w);
  for (int id = blockIdx.x; id < 128 * 8; id += gridDim.x) {
    int mt = id >> 3, nt = id & 7;
    int m0 = mt * 256, n0 = nt * 128;
    f32x16 acc[2][2]; zero_acc(acc);
    gemm_kloop(p.merged + (size_t)m0 * 1024, 1024, p.woutT + (size_t)n0 * 1024, 1024, 1024, acc, (u16*)smem, tid);
    const int c = opq(c_inv), hh = opq(hh_inv);
    const int b = m0 >> 13;
    const int cb = n0 + wn * 64;
    const size_t tb = (size_t)(m0 + wm * 64) * 1024 + cb;
    stage_acc<EPS>(acc, wl, c, hh);
    epi_rows(wl, lane, [&](int r, int cc, float (&v)[8]) {
      const float* xp = p.x + tb + (size_t)r * 1024 + cc;
      const float* gp = p.mod + b * 6144 + 2048 + cb + cc;
      float4 x0 = *(const float4*)xp, x1v = *(const float4*)(xp + 4);
      float4 g0 = *(const float4*)gp, g1 = *(const float4*)(gp + 4);
      float4 o0 = {x0.x + g0.x * v[0], x0.y + g0.y * v[1], x0.z + g0.z * v[2], x0.w + g0.w * v[3]};
      float4 o1 = {x1v.x + g1.x * v[4], x1v.y + g1.y * v[5], x1v.z + g1.z * v[6], x1v.w + g1.w * v[7]};
      float* op = p.x1 + tb + (size_t)r * 1024 + cc;
      *(float4*)op = o0; *(float4*)(op + 4) = o1;
    });
  }
}

DI void phase_peerq(const Params& p, char* smem, int tid) {
  const int w = tid >> 6, lane = tid & 63, c_inv = lane & 31, hh_inv = lane >> 5;
  const int wm = w >> 1, wn = w & 1;
  float* wl = wave_stage(smem, w);
  for (int id = blockIdx.x; id < 128 * 16; id += gridDim.x) {
    int mt = id >> 4, nt = id & 15;
    int m0 = mt * 256, n0 = nt * 128;
    f32x16 acc[2][2]; zero_acc(acc);
    gemm_kloop(p.h2 + (size_t)m0 * 1024, 1024, p.wqT + (size_t)n0 * 1024, 1024, 1024, acc, (u16*)smem, tid);
    const int c = opq(c_inv), hh = opq(hh_inv);
    u16* dst = p.qp + (size_t)(m0 + wm * 64) * 2048 + n0 + wn * 64;
    stage_acc<EPS>(acc, wl, c, hh);
    epi_rows(wl, lane, [&](int r, int cc, float (&v)[8]) { st_bf16x8(dst + (size_t)r * 2048 + cc, v); });
  }
}

DI unsigned fkey(float f) { unsigned u = __float_as_uint(f); return (u & 0x80000000u) ? ~u : (u | 0x80000000u); }
DI void phase_topk(const Params& p, char* smem, int tid) {
  float* sc = (float*)smem;
  float* ts = sc + 64 * 132;
  int* ti = (int*)(ts + 64 * 32);
  const int w = tid >> 6, lane = tid & 63, c = lane & 31, hh = lane >> 5;
  const int l16 = tid & 15, grp = tid >> 4;
  const int nt = w & 3, mt = w >> 2;
  bf16x8 af[8], bfq[8];
#define TK_LOAD(item_, pp_) { const int h_ = (item_) & 7; const u16* Aq_ = p.qp + (size_t)((item_) >> 3) * 64 * 2048 + h_ * 256 + (pp_) * 128; \
    const u16* Bk_ = p.subk + (size_t)(h_ * 2 + (pp_)) * 128 * 128; \
    _Pragma("unroll") for (int s = 0; s < 8; ++s) { bfq[s] = ld_frag16(Bk_ + (32 * nt + c) * 128 + 16 * s + 8 * hh); af[s] = ld_frag16(Aq_ + (size_t)(32 * mt + c) * 2048 + 16 * s + 8 * hh); } }
  if (blockIdx.x < 4096) TK_LOAD(blockIdx.x, 0);
  for (int item = blockIdx.x; item < 4096; item += gridDim.x) {
    const int h = item & 7;
    const size_t t0 = (size_t)(item >> 3) * 64;
#pragma unroll 1
    for (int pp = 0; pp < 2; ++pp) {
      f32x16 acc = zero16();
      {
        f32x16 acc2 = zero16();
#pragma unroll
        for (int s = 0; s < 8; s += 2) { acc = MFMA(af[s], bfq[s], acc); acc2 = MFMA(af[s + 1], bfq[s + 1], acc2); }
#pragma unroll
        for (int i = 0; i < 16; ++i) acc[i] += acc2[i];
      }
      if (pp == 0) { TK_LOAD(item, 1); }
      else { const int nitem = item + gridDim.x; if (nitem < 4096) TK_LOAD(nitem, 0); }
      __syncthreads();
#pragma unroll
      for (int i = 0; i < 16; ++i) sc[(mt * 32 + crow(i, hh)) * 132 + 32 * nt + c] = acc[i];
      __syncthreads();
      unsigned k[2][8], sel[2];
#pragma unroll
      for (int rr = 0; rr < 2; ++rr) {
        sel[rr] = 0;
#pragma unroll
        for (int m = 0; m < 8; ++m) { int n = l16 + 16 * m; k[rr][m] = (fkey(sc[(grp + 32 * rr) * 132 + n]) & ~127u) | (unsigned)(127 - n); }
      }
#pragma unroll 1
      for (int round = 0; round < 16; ++round) {
#pragma unroll
        for (int rr = 0; rr < 2; ++rr) {
          unsigned mx = max(max(max(k[rr][0], k[rr][1]), max(k[rr][2], k[rr][3])), max(max(k[rr][4], k[rr][5]), max(k[rr][6], k[rr][7])));
          mx = gmax16(mx);
          sel[rr] = (l16 == round) ? mx : sel[rr];
#pragma unroll
          for (int m = 0; m < 8; ++m) k[rr][m] = (k[rr][m] == mx) ? 0u : k[rr][m];
        }
      }
#pragma unroll
      for (int rr = 0; rr < 2; ++rr) {
        const int row = grp + 32 * rr;
        int n = 127 - (int)(sel[rr] & 127u);
        ti[(row * 2 + pp) * 16 + l16] = n;
        ts[(row * 2 + pp) * 16 + l16] = sc[row * 132 + n];
      }
    }
    __syncthreads();
    {
      float s0v[2]; int ptr[2]; unsigned selk[2];
#pragma unroll
      for (int rr = 0; rr < 2; ++rr) { s0v[rr] = ts[((grp + 32 * rr) * 2) * 16 + l16]; ptr[rr] = 0; selk[rr] = 0; }
#pragma unroll 1
      for (int round = 0; round < 16; ++round) {
#pragma unroll
        for (int rr = 0; rr < 2; ++rr) {
          const int row = grp + 32 * rr;
          float v = s0v[rr] + ts[(row * 2 + 1) * 16 + (ptr[rr] & 15)];
          unsigned key = (ptr[rr] < 16) ? ((fkey(v) & ~255u) | (unsigned)(255 - (l16 * 16 + ptr[rr]))) : 0u;
          unsigned mx = gmax16(key);
          selk[rr] = (l16 == round) ? mx : selk[rr];
          int aw = (255 - (int)(mx & 255u)) >> 4;
          ptr[rr] += (l16 == aw) ? 1 : 0;
        }
      }
#pragma unroll
      for (int rr = 0; rr < 2; ++rr) {
        const int row = grp + 32 * rr;
        int flat = 255 - (int)(selk[rr] & 255u);
        int aw = flat >> 4, bw = flat & 15;
        int my_idx = ti[(row * 2) * 16 + aw] * 128 + ti[(row * 2 + 1) * 16 + bw];
        float my_s = ts[(row * 2) * 16 + aw] + ts[(row * 2 + 1) * 16 + bw];
        float mxs = gmaxf16(my_s);
        float e = __expf(my_s - mxs);
        float sum = gsum16(e);
        p.idx[(t0 + row) * 128 + h * 16 + l16] = my_idx;
        p.g[(t0 + row) * 128 + h * 16 + l16] = e / sum;
      }
    }
    __syncthreads();
  }
#undef TK_LOAD
}

DI void peer_load_batch(const unsigned char* tab, const float* rsc, int ireg, int ebase, int q, int gq, u32x4 (&buf)[4], float (&scl)[1]) {
#pragma unroll
  for (int rr = 0; rr < 1; ++rr) {
    int e = ebase + 4 * rr + gq;
    int row = __shfl(ireg, e & 63);
    const unsigned char* rp = tab + (size_t)row * 1024 + q * 16;
#pragma unroll
    for (int j = 0; j < 4; ++j) buf[rr * 4 + j] = *(const u32x4*)(rp + j * 256);
    scl[rr] = rsc[row];
  }
}
DI void peer_u_compute(const u32x4 (&buf)[4], const float (&scl)[1], const float (&hf)[64], float* wl, int ebase, int q, int gq) {
#pragma unroll
  for (int rr = 0; rr < 1; ++rr) {
    float acc = 0.f;
#pragma unroll
    for (int j = 0; j < 4; ++j)
#pragma unroll
      for (int i = 0; i < 4; ++i) {
        f32x2_t lo = __builtin_amdgcn_cvt_pk_f32_fp8((int)buf[rr * 4 + j][i], false);
        f32x2_t hi = __builtin_amdgcn_cvt_pk_f32_fp8((int)buf[rr * 4 + j][i], true);
        acc += lo[0] * hf[j * 16 + 4 * i] + lo[1] * hf[j * 16 + 4 * i + 1] + hi[0] * hf[j * 16 + 4 * i + 2] + hi[1] * hf[j * 16 + 4 * i + 3];
      }
    acc = gsum16(acc) * scl[rr];
    float act = 0.5f * acc * (1.f + erff(acc * 0.7071067811865476f));
    if (q == 0) wl[ebase + 4 * rr + gq] = act;
  }
}
DI void peer_v_compute(const u32x4 (&buf)[4], const float (&scl)[1], float (&o)[64], const float* wl, float greg, int ebase, int gq) {
#pragma unroll
  for (int rr = 0; rr < 1; ++rr) {
    const int e = ebase + 4 * rr + gq;
    float ge = __shfl(greg, e & 63);
    float wg = wl[e] * ge * scl[rr];
#pragma unroll
    for (int j = 0; j < 4; ++j)
#pragma unroll
      for (int i = 0; i < 4; ++i) {
        f32x2_t lo = __builtin_amdgcn_cvt_pk_f32_fp8((int)buf[rr * 4 + j][i], false);
        f32x2_t hi = __builtin_amdgcn_cvt_pk_f32_fp8((int)buf[rr * 4 + j][i], true);
        o[j * 16 + 4 * i] += wg * lo[0]; o[j * 16 + 4 * i + 1] += wg * lo[1];
        o[j * 16 + 4 * i + 2] += wg * hi[0]; o[j * 16 + 4 * i + 3] += wg * hi[1];
      }
  }
}
DI void phase_peer_final(const Params& p, char* smem, int tid) {
  const int w = tid >> 6, lane = tid & 63, q = lane & 15, gq = lane >> 4;
  float* wl = (float*)smem + w * 128;
  const unsigned char* U8 = (const unsigned char*)p.uB;
  const unsigned char* V8 = (const unsigned char*)p.vB;
  for (int item = blockIdx.x; item < T / 8; item += gridDim.x) {
    const size_t t = (size_t)item * 8 + w;
    const int b = (int)(t >> 13);
    float hf[64];
#pragma unroll
    for (int j = 0; j < 4; ++j) {
      u32x4 ha = *(const u32x4*)(p.h2 + t * 1024 + (q + 16 * j) * 16);
      u32x4 hb = *(const u32x4*)(p.h2 + t * 1024 + (q + 16 * j) * 16 + 8);
#pragma unroll
      for (int i = 0; i < 4; ++i) { hf[j * 16 + 2 * i] = bflo(ha[i]); hf[j * 16 + 2 * i + 1] = bfhi(ha[i]); hf[j * 16 + 8 + 2 * i] = bflo(hb[i]); hf[j * 16 + 8 + 2 * i + 1] = bfhi(hb[i]); }
    }
    const int i0 = p.idx[t * 128 + lane], i1 = p.idx[t * 128 + 64 + lane];
    const float g0 = p.g[t * 128 + lane], g1 = p.g[t * 128 + 64 + lane];
    u32x4 bA[4], bB[4]; float sA[1], sB[1];
    peer_load_batch(U8, p.us, i0, 0, q, gq, bA, sA);
#pragma unroll 1
    for (int it = 0; it < 16; ++it) {
      const int e0 = 8 * it;
      peer_load_batch(U8, p.us, (e0 & 64) ? i1 : i0, e0 + 4, q, gq, bB, sB);
      peer_u_compute(bA, sA, hf, wl, e0, q, gq);
      if (it < 15) peer_load_batch(U8, p.us, ((e0 + 8) & 64) ? i1 : i0, e0 + 8, q, gq, bA, sA);
      else peer_load_batch(V8, p.vs, i0, 0, q, gq, bA, sA);
      peer_u_compute(bB, sB, hf, wl, e0 + 4, q, gq);
    }
    __syncthreads();
    float o[64];
#pragma unroll
    for (int i = 0; i < 64; ++i) o[i] = 0.f;
#pragma unroll 1
    for (int it = 0; it < 16; ++it) {
      const int e0 = 8 * it;
      peer_load_batch(V8, p.vs, (e0 & 64) ? i1 : i0, e0 + 4, q, gq, bB, sB);
      peer_v_compute(bA, sA, o, wl, (e0 & 64) ? g1 : g0, e0, gq);
      if (it < 15) peer_load_batch(V8, p.vs, ((e0 + 8) & 64) ? i1 : i0, e0 + 8, q, gq, bA, sA);
      peer_v_compute(bB, sB, o, wl, (e0 & 64) ? g1 : g0, e0 + 4, gq);
    }
    float h1[32];
#pragma unroll
    for (int i = 0; i < 32; ++i) {
      float send = (gq < 2) ? o[32 + i] : o[i];
      float keep = (gq < 2) ? o[i] : o[32 + i];
      h1[i] = keep + __shfl_xor(send, 32);
    }
    float fin[16];
#pragma unroll
    for (int i = 0; i < 16; ++i) {
      float send = (gq & 1) ? h1[i] : h1[16 + i];
      float keep = (gq & 1) ? h1[16 + i] : h1[i];
      fin[i] = keep + __shfl_xor(send, 16);
    }
    const int colb = (q + 16 * gq) * 16;
    float ss = 0.f;
#pragma unroll
    for (int i4 = 0; i4 < 4; ++i4) {
      float4 xa = *(const float4*)(p.x1 + t * 1024 + colb + 4 * i4);
      float4 ga = *(const float4*)(p.mod + b * 6144 + 5120 + colb + 4 * i4);
      fin[4 * i4 + 0] = xa.x + ga.x * fin[4 * i4 + 0]; fin[4 * i4 + 1] = xa.y + ga.y * fin[4 * i4 + 1];
      fin[4 * i4 + 2] = xa.z + ga.z * fin[4 * i4 + 2]; fin[4 * i4 + 3] = xa.w + ga.w * fin[4 * i4 + 3];
      ss += fin[4 * i4] * fin[4 * i4] + fin[4 * i4 + 1] * fin[4 * i4 + 1] + fin[4 * i4 + 2] * fin[4 * i4 + 2] + fin[4 * i4 + 3] * fin[4 * i4 + 3];
    }
    ss = wave_sum(ss);
    const float rstd = rsqrtf(ss * (1.f / 1024.f) + RMS_EPS);
#pragma unroll
    for (int i4 = 0; i4 < 4; ++i4) {
      int col = colb + 4 * i4;
      float4 gg = *(const float4*)(p.normf_g + col);
      float4 sh = *(const float4*)(p.fmod + b * 2048 + col);
      float4 sc = *(const float4*)(p.fmod + b * 2048 + 1024 + col);
      float4 r;
      r.x = fin[4 * i4 + 0] * rstd * gg.x * (1.f + sc.x) + sh.x;
      r.y = fin[4 * i4 + 1] * rstd * gg.y * (1.f + sc.y) + sh.y;
      r.z = fin[4 * i4 + 2] * rstd * gg.z * (1.f + sc.z) + sh.z;
      r.w = fin[4 * i4 + 3] * rstd * gg.w * (1.f + sc.w) + sh.w;
      *(float4*)(p.out + t * 1024 + col) = r;
    }
    __syncthreads();
  }
}

#define XB_TMO      128
#define XB_XCNT(j)  (256  + 64 * (j))
#define XB_XSUB(j)  (1280 + 64 * (j))
#define XB_XGEN(j)  (2304 + 64 * (j))
#define XB_TOP      3328
#define XB_TOPGEN   3392
#define XCD_BAR_WORDS 3456
#define XB_SPIN_CAP (1u << 18)
#define LAS __attribute__((address_space(3)))

__device__ __forceinline__ unsigned xb_ld(unsigned* p)              { return __hip_atomic_load(p, __ATOMIC_RELAXED, __HIP_MEMORY_SCOPE_AGENT); }
__device__ __forceinline__ unsigned xb_add(unsigned* p, unsigned v) { return __hip_atomic_fetch_add(p, v, __ATOMIC_RELAXED, __HIP_MEMORY_SCOPE_AGENT); }
__device__ __forceinline__ unsigned xb_xcc_id() { return (unsigned)__builtin_amdgcn_s_getreg((3 << 11) | 20) & 0xFu; }
#define XB_SPIN(cond, bar) do { unsigned _sp = 0; while (cond) { __builtin_amdgcn_s_sleep(1); \
    if ((++_sp & 255u) == 0u) { if (xb_ld(&(bar)[XB_TMO])) break; if (_sp > XB_SPIN_CAP) { atomicAdd(&(bar)[XB_TMO], 1u); break; } } } } while (0)

struct XcdBarrier {
    unsigned* bar; unsigned x;
    volatile LAS unsigned* st;
};

__device__ __forceinline__ XcdBarrier xcd_barrier_post(unsigned* bar, volatile LAS unsigned* st) {
    XcdBarrier b; b.bar = bar; b.x = xb_xcc_id(); b.st = st;
    if (threadIdx.x == 0) (void)xb_add(&bar[XB_XCNT(b.x)], 1u);
    return b;
}
__device__ __forceinline__ void xcd_barrier_complete(unsigned* bar, unsigned x, unsigned& nloc, unsigned& nx) {
    const unsigned G = gridDim.x * gridDim.y * gridDim.z;
    unsigned sum, cnt, mine, sp = 0u;
    for (;;) {
        sum = 0u; cnt = 0u; mine = 0u;
#pragma unroll
        for (unsigned j = 0; j < 16; ++j) { const unsigned c = xb_ld(&bar[XB_XCNT(j)]); sum += c; cnt += (c > 0u) ? 1u : 0u; mine = (j == x) ? c : mine; }
        if (sum == G) break;
        __builtin_amdgcn_s_sleep(1);
        if ((++sp & 255u) == 0u) { if (xb_ld(&bar[XB_TMO])) break; if (sp > XB_SPIN_CAP) { atomicAdd(&bar[XB_TMO], 1u); break; } }
    }
    nloc = mine > 0u ? mine : 1u; nx = cnt > 0u ? cnt : 1u;
}

__device__ __forceinline__ void xcd_barrier(const XcdBarrier& b) {
    asm volatile("s_waitcnt vmcnt(0)" ::: "memory");
    __syncthreads();
    if (threadIdx.x == 0) {
        unsigned* bar = b.bar;
        __builtin_amdgcn_s_waitcnt(0);
        unsigned nloc = b.st[0], nx = b.st[1];
        if (nloc == 0u) { xcd_barrier_complete(bar, b.x, nloc, nx); b.st[0] = nloc; b.st[1] = nx; }
        const unsigned old = xb_add(&bar[XB_XSUB(b.x)], 1u);
        const unsigned gen = old / nloc;
        if (old + 1u == (gen + 1u) * nloc) {
            __builtin_amdgcn_fence(__ATOMIC_RELEASE, "agent");
            asm volatile("s_waitcnt vmcnt(0)" ::: "memory");
            const unsigned og = xb_add(&bar[XB_TOP], 1u);
            const unsigned tg = og / nx;
            if (og + 1u == (tg + 1u) * nx) xb_add(&bar[XB_TOPGEN], 1u);
            else XB_SPIN(xb_ld(&bar[XB_TOPGEN]) == tg, bar);
            __builtin_amdgcn_fence(__ATOMIC_ACQUIRE, "agent");
            xb_add(&bar[XB_XGEN(b.x)], 1u);
            asm volatile("s_waitcnt vmcnt(0)" ::: "memory");
        } else {
            XB_SPIN(xb_ld(&bar[XB_XGEN(b.x)]) == gen, bar);
            __builtin_amdgcn_fence(__ATOMIC_ACQUIRE, "agent");
            asm volatile("s_waitcnt vmcnt(0)" ::: "memory");
        }
    }
    __syncthreads();
}

__global__ void __launch_bounds__(512) fwd_megakernel(Params p) {
  cg::grid_group grid = cg::this_grid();
  extern __shared__ __attribute__((aligned(16))) char smem[];
  const int tid = threadIdx.x;
  volatile LAS unsigned* xst = (volatile LAS unsigned*)(smem + LDS_BYTES - 16);
  if (tid == 0) { xst[0] = 0u; xst[1] = 0u; }
  __syncthreads();
  XcdBarrier xb = xcd_barrier_post(p.bar, xst);
  phase_prep(p, smem, opq(tid));
  grid.sync();
  phase_norm_mod(p.x, p.norm1_g, p.mod, 0, 1024, p.hA, opq(tid));
  xcd_barrier(xb);
  phase_proj(p, smem, opq(tid));
  xcd_barrier(xb);
  phase_gla_pre(p, smem, opq(tid));
  xcd_barrier(xb);
  phase_mixers(p, smem, opq(tid));
  xcd_barrier(xb);
  phase_post_mixers(p, opq(tid));
  xcd_barrier(xb);
  phase_gr(p, smem, opq(tid));
  xcd_barrier(xb);
  phase_merge(p, smem, opq(tid));
  xcd_barrier(xb);
  phase_out(p, smem, opq(tid));
  xcd_barrier(xb);
  phase_norm_mod(p.x1, p.norm2_g, p.mod, 3072, 4096, p.h2, opq(tid));
  xcd_barrier(xb);
  phase_peerq(p, smem, opq(tid));
  xcd_barrier(xb);
  phase_topk(p, smem, opq(tid));
  xcd_barrier(xb);
  phase_peer_final(p, smem, opq(tid));
}

extern "C" void kernel_launch(void* const* d_in, const int* in_sizes, int n_in, void* d_out, int out_size, void* d_ws,
                              size_t ws_size, hipStream_t stream) {
  static int grid_blocks = 0;
  if (!grid_blocks) {
    int dev = 0, cus = 0, per_cu = 0;
    hipGetDevice(&dev);
    hipDeviceGetAttribute(&cus, hipDeviceAttributeMultiprocessorCount, dev);
    if (hipFuncSetAttribute((const void*)fwd_megakernel, hipFuncAttributeMaxDynamicSharedMemorySize, LDS_BYTES) != hipSuccess) { fprintf(stderr, "hipFuncSetAttribute failed\n"); }
    hipOccupancyMaxActiveBlocksPerMultiprocessor(&per_cu, fwd_megakernel, 512, LDS_BYTES);
    if (per_cu < 1) per_cu = 1;
    grid_blocks = cus * per_cu;
  }
  if (ws_size < 492 * MB) { fprintf(stderr, "ws too small: %zu\n", ws_size); return; }
  Params p{};
  p.x = (const float*)d_in[0]; p.c = (const float*)d_in[1]; p.pos = (const int*)d_in[2];
  p.w_ada = (const float*)d_in[3]; p.b_ada = (const float*)d_in[4]; p.norm1_g = (const float*)d_in[5];
  p.w_in = (const float*)d_in[6]; p.wa_fw = (const float*)d_in[7]; p.ba_fw = (const float*)d_in[8];
  p.wa_bw = (const float*)d_in[9]; p.ba_bw = (const float*)d_in[10]; p.gla_norm_g = (const float*)d_in[11];
  p.lq1 = (const float*)d_in[12]; p.lk1 = (const float*)d_in[13]; p.lq2 = (const float*)d_in[14]; p.lk2 = (const float*)d_in[15];
  p.diff_norm_g = (const float*)d_in[16]; p.w_gla = (const float*)d_in[17]; p.w_diff = (const float*)d_in[18];
  p.w_out = (const float*)d_in[19]; p.norm2_g = (const float*)d_in[20]; p.peer_wq = (const float*)d_in[21];
  p.subkeys = (const float*)d_in[22]; p.peer_u = (const float*)d_in[23]; p.peer_v = (const float*)d_in[24];
  p.w_fada = (const float*)d_in[25]; p.b_fada = (const float*)d_in[26]; p.normf_g = (const float*)d_in[27];
  p.out = (float*)d_out;
  char* ws = (char*)d_ws;
  p.winT = (u16*)(ws + 0 * MB); p.wgrT = (u16*)(ws + 11 * MB); p.wgaT = (u16*)(ws + 13 * MB); p.wgbT = (u16*)(ws + 15 * MB);
  p.wglaT = (u16*)(ws + 17 * MB); p.wdiffT = (u16*)(ws + 19 * MB); p.woutT = (u16*)(ws + 21 * MB); p.wqT = (u16*)(ws + 23 * MB);
  p.subk = (u16*)(ws + 27 * MB); p.rope = (float*)(ws + 28 * MB);
  p.mod = (float*)(ws + 36 * MB); p.fmod = (float*)(ws + 36 * MB + 128 * 1024); p.lam = (float*)(ws + 36 * MB + 192 * 1024);
  p.counter = (int*)(ws + 36 * MB + 196 * 1024);
  p.kmax = (int*)(ws + 36 * MB + 200 * 1024);
  p.bar = (unsigned*)(ws + 36 * MB + 256 * 1024);
  hipMemsetAsync(p.bar, 0, XCD_BAR_WORDS * sizeof(unsigned), stream);
  p.lr = (float*)(ws + 37 * MB); p.dec = (float*)(ws + 41 * MB); p.rstd = (float*)(ws + 43 * MB);
  char* slot[9];
  for (int i = 0; i < 7; ++i) slot[i] = ws + (44 + 64 * (size_t)i) * MB;
  slot[7] = (char*)d_out; slot[8] = (char*)d_out + 64 * MB;
  p.hA = (u16*)slot[0];
  p.gq = (u16*)slot[1]; p.gk = (u16*)(slot[1] + 32 * MB);
  p.gvT = (u16*)slot[2]; p.dq = (u16*)slot[3]; p.dk = (u16*)slot[4]; p.dvT = (u16*)slot[5];
  p.qe_fw = (u16*)slot[0]; p.ke_fw = (u16*)(slot[0] + 32 * MB);
  p.qe_bw = (u16*)slot[6]; p.ke_bw = (u16*)(slot[6] + 32 * MB);
  p.keT = (u16*)slot[7];
  p.o_fw = (u16*)slot[1]; p.o_bw = (u16*)slot[8];
  p.uB = (u16*)slot[6]; p.vB = (u16*)(slot[6] + 16 * MB);
  p.A1 = (u16*)slot[2]; p.merged = (u16*)slot[4];
  p.sga = (u16*)slot[5]; p.sgb = (u16*)slot[7];
  p.x1 = (float*)slot[0];
  p.h2 = (u16*)slot[2]; p.qp = (u16*)slot[3];
  p.us = (float*)(slot[6] + 32 * MB); p.vs = (float*)(slot[6] + 33 * MB);
  p.idx = (int*)slot[5]; p.g = (float*)(slot[5] + 16 * MB);
  void* args[] = {&p};
  hipError_t e = hipLaunchCooperativeKernel((void*)fwd_megakernel, dim3(grid_blocks), dim3(512), args, LDS_BYTES, stream);
  if (e != hipSuccess) fprintf(stderr, "cooperative launch failed: %s (grid %d)\n", hipGetErrorString(e), grid_blocks);
}
```

```cpp
#include <hip/hip_runtime.h>
#include <hip/hip_cooperative_groups.h>
#include <cstdio>
namespace cg = cooperative_groups;

#define DI __device__ __forceinline__
typedef unsigned short u16;
using bf16x8 = __attribute__((ext_vector_type(8))) short;
using f32x16 = __attribute__((ext_vector_type(16))) float;
using u32x4 = __attribute__((ext_vector_type(4))) unsigned;
using u32x2 = __attribute__((ext_vector_type(2))) unsigned;
typedef __bf16 bf16x2_t __attribute__((ext_vector_type(2)));
typedef float f32x2_t __attribute__((ext_vector_type(2)));

constexpr int T = 32768, D = 1024, S = 8192;
constexpr size_t MB = 1ull << 20;
constexpr float RMS_EPS = 1e-6f;
constexpr int LDS_BYTES = 144 * 1024;

#define MFMA(a, b, c) __builtin_amdgcn_mfma_f32_32x32x16_bf16((a), (b), (c), 0, 0, 0)

struct Params {
  const float *x, *c; const int* pos;
  const float *w_ada, *b_ada, *norm1_g, *w_in, *wa_fw, *ba_fw, *wa_bw, *ba_bw, *gla_norm_g;
  const float *lq1, *lk1, *lq2, *lk2, *diff_norm_g, *w_gla, *w_diff, *w_out, *norm2_g, *peer_wq, *subkeys, *peer_u, *peer_v;
  const float *w_fada, *b_fada, *normf_g;
  float* out;
  u16 *winT, *wgrT, *wgaT, *wgbT, *wglaT, *wdiffT, *woutT, *wqT, *subk;
  float* rope;
  float* mod;
  float* fmod;
  float* lam;
  int* counter;
  float* lr;
  float* dec;
  float* rstd;
  u16 *hA, *gq, *gk, *gvT, *dq, *dk, *dvT;
  u16 *qe_fw, *ke_fw, *qe_bw, *ke_bw, *keT;
  u16 *o_fw, *o_bw, *A1, *merged, *h2, *qp, *uB, *vB;
  float* x1;
  int* idx; float* g;
  float *us, *vs;
  u16 *sga, *sgb;
  unsigned* bar;
  int* kmax;
};

DI u16 f2bf(float x) { unsigned u = __float_as_uint(x); u += 0x7fffu + ((u >> 16) & 1u); return (u16)(u >> 16); }
DI float bf2f(u16 b) { return __uint_as_float(((unsigned)b) << 16); }
DI unsigned pack2(float a, float b) {
  f32x2_t v = {a, b};
  bf16x2_t r = __builtin_convertvector(v, bf16x2_t);
  return __builtin_bit_cast(unsigned, r);
}
DI float bflo(unsigned u) { return __uint_as_float(u << 16); }
DI float bfhi(unsigned u) { return __uint_as_float(u & 0xffff0000u); }
DI int crow(int i, int h) { return (i & 3) + 8 * (i >> 2) + 4 * h; }
DI bf16x8 pack_step(const f32x16& x, int s) {
  u32x4 p;
  p[0] = pack2(x[8 * s + 0], x[8 * s + 1]);
  p[1] = pack2(x[8 * s + 2], x[8 * s + 3]);
  p[2] = pack2(x[8 * s + 4], x[8 * s + 5]);
  p[3] = pack2(x[8 * s + 6], x[8 * s + 7]);
  return __builtin_bit_cast(bf16x8, p);
}
DI bf16x8 ld_frag16(const u16* p) { return __builtin_bit_cast(bf16x8, *(const u32x4*)p); }
DI bf16x8 ld_frag8x2(const u16* p) {
  u32x2 lo = *(const u32x2*)p; u32x2 hi = *(const u32x2*)(p + 8);
  u32x4 v = {lo[0], lo[1], hi[0], hi[1]};
  return __builtin_bit_cast(bf16x8, v);
}
DI void st_perm(u16* rowp, int ch, u32x4 v) {
  u16* d = rowp + (ch >> 1) * 16 + (ch & 1) * 4;
  u32x2 lo = {v[0], v[1]}, hi = {v[2], v[3]};
  *(u32x2*)d = lo;
  *(u32x2*)(d + 8) = hi;
}
DI float wave_sum(float v) {
#pragma unroll
  for (int o = 32; o >= 1; o >>= 1) v += __shfl_xor(v, o);
  return v;
}

template <int CTRL> DI float dpp_f(float v) { return __builtin_bit_cast(float, __builtin_amdgcn_update_dpp(0, __builtin_bit_cast(int, v), CTRL, 0xF, 0xF, false)); }
template <int CTRL> DI unsigned dpp_u(unsigned v) { return (unsigned)__builtin_amdgcn_update_dpp(0, (int)v, CTRL, 0xF, 0xF, false); }
DI float gsum16(float v) { v += dpp_f<0x121>(v); v += dpp_f<0x122>(v); v += dpp_f<0x124>(v); v += dpp_f<0x128>(v); return v; }
DI float gmaxf16(float v) { v = fmaxf(v, dpp_f<0x121>(v)); v = fmaxf(v, dpp_f<0x122>(v)); v = fmaxf(v, dpp_f<0x124>(v)); v = fmaxf(v, dpp_f<0x128>(v)); return v; }
DI unsigned gmax16(unsigned v) { v = max(v, dpp_u<0x121>(v)); v = max(v, dpp_u<0x122>(v)); v = max(v, dpp_u<0x124>(v)); v = max(v, dpp_u<0x128>(v)); return v; }
DI int opq(int x) { asm volatile("" : "+v"(x)); return x; }
DI f32x16 zero16() { f32x16 z; for (int i = 0; i < 16; ++i) z[i] = 0.f; return z; }

DI void tconv_tile(const float* src, int ld, int c0, int nc, u16* dst, int ct, int kt, float* sm, int tid) {
  __syncthreads();
  int cl = tid & 63, r0 = tid >> 6;
#pragma unroll
  for (int r = 0; r < 8; ++r) {
    int k = kt * 64 + r0 + 8 * r;
    int col = ct * 64 + cl;
    float v = (col < nc) ? src[(size_t)k * ld + c0 + col] : 0.f;
    sm[(r0 + 8 * r) * 65 + cl] = v;
  }
  __syncthreads();
#pragma unroll
  for (int r = 0; r < 8; ++r) {
    int col = r0 + 8 * r;
    int k = cl;
    dst[(size_t)(ct * 64 + col) * 1024 + kt * 64 + k] = f2bf(sm[k * 65 + col]);
  }
}

DI void phase_prep(const Params& p, char* smem, int tid) {
  float* sm = (float*)smem;
  const int nblk = gridDim.x, bid = blockIdx.x;
  const int NCT = 32 + 48 + 2 + 16 * 6 + 32;
  for (int it = bid; it < NCT * 16; it += nblk) {
    int ctg = it >> 4, kt = it & 15;
    const float* src; int ld, c0, nc; u16* dst; int ct;
    if (ctg < 32) { src = p.w_in; ld = 8224; c0 = 0; nc = 2048; dst = p.winT; ct = ctg; }
    else if (ctg < 80) { src = p.w_in; ld = 8224; c0 = 3104; nc = 3072; dst = p.winT + (size_t)2048 * 1024; ct = ctg - 32; }
    else if (ctg < 82) { src = p.w_in; ld = 8224; c0 = 3072; nc = 32; dst = p.winT + (size_t)5120 * 1024; ct = ctg - 80; }
    else if (ctg < 98) { src = p.w_in; ld = 8224; c0 = 2048; nc = 1024; dst = p.wgrT; ct = ctg - 82; }
    else if (ctg < 114) { src = p.w_in; ld = 8224; c0 = 6176; nc = 1024; dst = p.wgaT; ct = ctg - 98; }
    else if (ctg < 130) { src = p.w_in; ld = 8224; c0 = 7200; nc = 1024; dst = p.wgbT; ct = ctg - 114; }
    else if (ctg < 146) { src = p.w_gla; ld = 1024; c0 = 0; nc = 1024; dst = p.wglaT; ct = ctg - 130; }
    else if (ctg < 162) { src = p.w_diff; ld = 1024; c0 = 0; nc = 1024; dst = p.wdiffT; ct = ctg - 146; }
    else if (ctg < 178) { src = p.w_out; ld = 1024; c0 = 0; nc = 1024; dst = p.woutT; ct = ctg - 162; }
    else { src = p.peer_wq; ld = 2048; c0 = 0; nc = 2048; dst = p.wqT; ct = ctg - 178; }
    tconv_tile(src, ld, c0, nc, dst, ct, kt, sm, tid);
  }
  __syncthreads();
  const int gtid = bid * 512 + tid, gsz = nblk * 512;
  for (int i = gtid; i < 8 * 2 * 128 * 128; i += gsz) p.subk[i] = f2bf(p.subkeys[i]);
  for (int i = gtid; i < T * 32; i += gsz) {
    int t = i >> 5, d = i & 31;
    float inv = powf(10000.f, -(float)d / 32.f);
    float ang = (float)p.pos[t] * inv;
    double r = (double)ang * 0.15915494309189535;
    r -= rint(r);
    float rf = (float)r;
    p.rope[2 * i] = __builtin_amdgcn_cosf(rf);
    p.rope[2 * i + 1] = __builtin_amdgcn_sinf(rf);
  }
  if (gtid == 0) {
    float s1 = 0.f, s2 = 0.f;
    for (int i = 0; i < 64; ++i) { s1 += p.lq1[i] * p.lk1[i]; s2 += p.lq2[i] * p.lk2[i]; }
    p.lam[0] = expf(s1) - expf(s2) + 0.2f;
    for (int i = 0; i < 128; ++i) p.counter[i] = 0;
    for (int i = 0; i < 64; ++i) p.kmax[i] = 0;
  }
  {
    float* cact = sm;
    float* red = sm + 4096;
    __syncthreads();
    for (int i = tid; i < 4096; i += 512) { float v = p.c[i]; cact[i] = v / (1.f + __expf(-v)); }
    __syncthreads();
    int w = tid >> 6, lane = tid & 63;
    for (int it = bid; it < 128; it += nblk) {
      int col = it * 64 + lane;
      const float* W; int ld, cc;
      if (col < 6144) { W = p.w_ada; ld = 6144; cc = col; } else { W = p.w_fada; ld = 2048; cc = col - 6144; }
      float a0 = 0, a1 = 0, a2 = 0, a3 = 0;
#pragma unroll 8
      for (int k = w * 128; k < w * 128 + 128; ++k) {
        float wv = W[(size_t)k * ld + cc];
        a0 += cact[k] * wv; a1 += cact[1024 + k] * wv; a2 += cact[2048 + k] * wv; a3 += cact[3072 + k] * wv;
      }
      red[(w * 4 + 0) * 64 + lane] = a0; red[(w * 4 + 1) * 64 + lane] = a1;
      red[(w * 4 + 2) * 64 + lane] = a2; red[(w * 4 + 3) * 64 + lane] = a3;
      __syncthreads();
      if (tid < 256) {
        int b = w;
        float s = 0.f;
#pragma unroll
        for (int ww = 0; ww < 8; ++ww) s += red[(ww * 4 + b) * 64 + lane];
        if (col < 6144) p.mod[b * 6144 + cc] = s + p.b_ada[cc];
        else p.fmod[b * 2048 + cc] = s + p.b_fada[cc];
      }
      __syncthreads();
    }
  }
}

DI void phase_norm_mod(const float* src, const float* g, const float* mod, int sh_off, int sc_off, u16* dst, int tid) {
  int w = tid >> 6, lane = tid & 63;
  for (int row = blockIdx.x * 8 + w; row < T; row += gridDim.x * 8) {
    int b = row >> 13;
    const float* xr = src + (size_t)row * 1024;
    float4 v[4]; float ss = 0.f;
#pragma unroll
    for (int m = 0; m < 4; ++m) { v[m] = *(const float4*)(xr + (m * 64 + lane) * 4); ss += v[m].x * v[m].x + v[m].y * v[m].y + v[m].z * v[m].z + v[m].w * v[m].w; }
    ss = wave_sum(ss);
    float rstd = rsqrtf(ss * (1.f / 1024.f) + RMS_EPS);
#pragma unroll
    for (int m = 0; m < 4; ++m) {
      int col = (m * 64 + lane) * 4;
      float4 gg = *(const float4*)(g + col);
      float4 sh = *(const float4*)(mod + b * 6144 + sh_off + col);
      float4 sc = *(const float4*)(mod + b * 6144 + sc_off + col);
      float y0 = v[m].x * rstd * gg.x * (1.f + sc.x) + sh.x;
      float y1 = v[m].y * rstd * gg.y * (1.f + sc.y) + sh.y;
      float y2 = v[m].z * rstd * gg.z * (1.f + sc.z) + sh.z;
      float y3 = v[m].w * rstd * gg.w * (1.f + sc.w) + sh.w;
      u32x2 o = {pack2(y0, y1), pack2(y2, y3)};
      *(u32x2*)(dst + (size_t)row * 1024 + col) = o;
    }
  }
}

constexpr int GLD = 72;
constexpr int GSTAGE = (256 + 128) * GLD;
DI void gemm_kloop(const u16* A, int lda, const u16* Bt, int ldb, int K, f32x16 (&acc)[2][2], u16* smem, int tid) {
  const int w = tid >> 6, lane = tid & 63, c = lane & 31, hh = lane >> 5;
  const int wm = w >> 1, wn = w & 1;
  const int lrow = tid >> 3, lcol = (tid & 7) * 8;
  u32x4 ra[4], rb[2];
  const int nk = K >> 6;
#pragma unroll
  for (int r = 0; r < 4; ++r) ra[r] = *(const u32x4*)(A + (size_t)(r * 64 + lrow) * lda + lcol);
#pragma unroll
  for (int r = 0; r < 2; ++r) rb[r] = *(const u32x4*)(Bt + (size_t)(r * 64 + lrow) * ldb + lcol);
  __syncthreads();
  {
    u16* sA = smem; u16* sB = smem + 256 * GLD;
#pragma unroll
    for (int r = 0; r < 4; ++r) *(u32x4*)(sA + (r * 64 + lrow) * GLD + lcol) = ra[r];
#pragma unroll
    for (int r = 0; r < 2; ++r) *(u32x4*)(sB + (r * 64 + lrow) * GLD + lcol) = rb[r];
  }
  if (nk > 1) {
#pragma unroll
    for (int r = 0; r < 4; ++r) ra[r] = *(const u32x4*)(A + (size_t)(r * 64 + lrow) * lda + 64 + lcol);
#pragma unroll
    for (int r = 0; r < 2; ++r) rb[r] = *(const u32x4*)(Bt + (size_t)(r * 64 + lrow) * ldb + 64 + lcol);
  }
  __syncthreads();
  for (int kt = 0; kt < nk; ++kt) {
    const u16* sA = smem + (kt & 1) * GSTAGE; const u16* sB = sA + 256 * GLD;
    if (kt + 1 < nk) {
      u16* nA = smem + ((kt + 1) & 1) * GSTAGE; u16* nB = nA + 256 * GLD;
#pragma unroll
      for (int r = 0; r < 4; ++r) *(u32x4*)(nA + (r * 64 + lrow) * GLD + lcol) = ra[r];
#pragma unroll
      for (int r = 0; r < 2; ++r) *(u32x4*)(nB + (r * 64 + lrow) * GLD + lcol) = rb[r];
      if (kt + 2 < nk) {
#pragma unroll
        for (int r = 0; r < 4; ++r) ra[r] = *(const u32x4*)(A + (size_t)(r * 64 + lrow) * lda + (kt + 2) * 64 + lcol);
#pragma unroll
        for (int r = 0; r < 2; ++r) rb[r] = *(const u32x4*)(Bt + (size_t)(r * 64 + lrow) * ldb + (kt + 2) * 64 + lcol);
      }
    }
    bf16x8 fr[2][4];
#define GLOADF(set, s) { fr[set][0] = ld_frag16(sA + (wm * 64 + c) * GLD + (s) * 16 + hh * 8); fr[set][1] = ld_frag16(sA + (wm * 64 + 32 + c) * GLD + (s) * 16 + hh * 8); \
                         fr[set][2] = ld_frag16(sB + (wn * 64 + c) * GLD + (s) * 16 + hh * 8); fr[set][3] = ld_frag16(sB + (wn * 64 + 32 + c) * GLD + (s) * 16 + hh * 8); }
#define GMM(set) { acc[0][0] = MFMA(fr[set][0], fr[set][2], acc[0][0]); acc[0][1] = MFMA(fr[set][0], fr[set][3], acc[0][1]); \
                   acc[1][0] = MFMA(fr[set][1], fr[set][2], acc[1][0]); acc[1][1] = MFMA(fr[set][1], fr[set][3], acc[1][1]); }
    GLOADF(0, 0);
    __builtin_amdgcn_sched_barrier(0);
    GLOADF(1, 1); GMM(0);
    __builtin_amdgcn_sched_barrier(0);
    GLOADF(0, 2); GMM(1);
    __builtin_amdgcn_sched_barrier(0);
    GLOADF(1, 3); GMM(0);
    __builtin_amdgcn_sched_barrier(0);
    GMM(1);
#undef GLOADF
#undef GMM
    __syncthreads();
  }
}
DI void zero_acc(f32x16 (&acc)[2][2]) {
#pragma unroll
  for (int a = 0; a < 2; ++a)
#pragma unroll
    for (int b = 0; b < 2; ++b) acc[a][b] = zero16();
}


constexpr int EPS = 68, EPT = 65;
__device__ __forceinline__ unsigned xb_xcc_id();

template <class F> DI void xcd_queue(int* counters, int per_xcd, char* smem, int tid, F f) {
  int* sitem = (int*)(smem + 143 * 1024);
  const int myx = (int)xb_xcc_id() & 7;
  for (int qi = 0; qi < 8; ++qi) {
    const int xq = (myx + qi) & 7;
    for (;;) {
      __syncthreads();
      if (tid == 0) *sitem = atomicAdd(counters + xq, 1);
      __syncthreads();
      const int qn = *sitem;
      if (qn >= per_xcd) break;
      f(xq, qn);
    }
  }
}

template <class F> DI void xcd_static(const Params& p, int per_xcd, char* smem, F f) {
  const int myx = (int)xb_xcc_id() & 7;
  const int rank = (int)((volatile unsigned*)(smem + LDS_BYTES - 16))[2];
  const int nloc = (int)__hip_atomic_load(p.bar + 3600 + myx * 16, __ATOMIC_RELAXED, __HIP_MEMORY_SCOPE_AGENT);
  for (int qn = rank; qn < per_xcd; qn += nloc) f(myx, qn);
}
DI float* wave_stage(char* smem, int w) { return (float*)smem + w * (64 * EPS); }
template <int STR> DI void stage_acc(const f32x16 (&acc)[2][2], float* wl, int c, int hh) {
#pragma unroll
  for (int mi = 0; mi < 2; ++mi)
#pragma unroll
    for (int ni = 0; ni < 2; ++ni)
#pragma unroll
      for (int i = 0; i < 16; ++i) wl[(mi * 32 + crow(i, hh)) * STR + ni * 32 + c] = acc[mi][ni][i];
}
DI void st_bf16x8(u16* dst, const float (&v)[8]) {
  u32x4 o = {pack2(v[0], v[1]), pack2(v[2], v[3]), pack2(v[4], v[5]), pack2(v[6], v[7])};
  *(u32x4*)dst = o;
}
DI void ld_bf16x8(const u16* srcp, float (&v)[8]) {
  u32x4 o = *(const u32x4*)srcp;
#pragma unroll
  for (int i = 0; i < 4; ++i) { v[2 * i] = bflo(o[i]); v[2 * i + 1] = bfhi(o[i]); }
}
template <class F> DI void epi_rows(const float* wl, int lane, F f) {
#pragma unroll
  for (int ps = 0; ps < 8; ++ps) {
    const int r = (lane >> 3) + 8 * ps, cc = (lane & 7) * 8;
    float4 v0 = *(const float4*)(wl + r * EPS + cc), v1 = *(const float4*)(wl + r * EPS + cc + 4);
    float v[8] = {v0.x, v0.y, v0.z, v0.w, v1.x, v1.y, v1.z, v1.w};
    f(r, cc, v);
  }
}
DI void epi_cols_bf16(const float* wl, int lane, u16* dstT, size_t ldt) {
#pragma unroll
  for (int ps = 0; ps < 8; ++ps) {
    const int col = (lane >> 3) + 8 * ps, r0 = (lane & 7) * 8;
    float v[8];
#pragma unroll
    for (int j = 0; j < 8; ++j) v[j] = wl[(r0 + j) * EPT + col];
    st_bf16x8(dstT + (size_t)col * ldt + r0, v);
  }
}

DI void phase_proj(const Params& p, char* smem, int tid) {
  const int w = tid >> 6, lane = tid & 63, c_inv = lane & 31, hh_inv = lane >> 5;
  const int wm = w >> 1, wn = w & 1;
  float* wl = wave_stage(smem, w);
  const int NT = 41;
  xcd_static(p, 16 * NT, smem, [&](int xq, int qn) {
    int mt = xq + 8 * (qn / NT), nt = qn % NT;
    int m0 = mt * 256, n0 = nt * 128;
    f32x16 acc[2][2]; zero_acc(acc);
    gemm_kloop(p.hA + (size_t)m0 * 1024, 1024, p.winT + (size_t)n0 * 1024, 1024, 1024, acc, (u16*)smem, tid);
    const int c = opq(c_inv), hh = opq(hh_inv);
    const int rb = m0 + wm * 64, cb = n0 + wn * 64;
    if (n0 < 1024) {
      const float sc = (n0 < 512) ? 0.08838834764831845f : 1.f;
      u16* dst = ((n0 < 512) ? p.gq : p.gk) + (size_t)rb * 512 + (cb & 511);
      stage_acc<EPS>(acc, wl, c, hh);
      epi_rows(wl, lane, [&](int r, int cc, float (&v)[8]) {
#pragma unroll
        for (int j = 0; j < 8; ++j) v[j] *= sc;
        st_bf16x8(dst + (size_t)r * 512 + cc, v);
      });
    } else if (n0 < 2048 || (n0 >= 4096 && n0 < 5120)) {
      const bool isg = n0 < 2048;
      const int b = rb >> 13;
      u16* dstT;
      if (isg) { int cc0 = cb - 1024; dstT = p.gvT + ((size_t)(b * 4 + (cc0 >> 8)) * 256 + (cc0 & 255)) * 8192 + (rb & 8191); }
      else { int cc0 = cb - 4096; dstT = p.dvT + ((size_t)(b * 8 + (cc0 >> 7)) * 128 + (cc0 & 127)) * 8192 + (rb & 8191); }
      stage_acc<EPT>(acc, wl, c, hh);
      epi_cols_bf16(wl, lane, dstT, 8192);
    } else if (n0 < 4096) {
      const bool isq = n0 < 3072;
      const float sc = isq ? (0.125f * 1.4426950408889634f) : 1.f;
      const int cbb = cb - (isq ? 2048 : 3072);
      float knmax = 0.f;
#pragma unroll
      for (int mi = 0; mi < 2; ++mi)
#pragma unroll
        for (int i = 0; i < 16; ++i) {
          int row = rb + mi * 32 + crow(i, hh);
          float2 cs = *(const float2*)(p.rope + ((size_t)row * 32 + c) * 2);
          float x1 = acc[mi][0][i], x2 = acc[mi][1][i];
          float o1 = (x1 * cs.x - x2 * cs.y) * sc;
          float o2 = (x2 * cs.x + x1 * cs.y) * sc;
          acc[mi][0][i] = o1; acc[mi][1][i] = o2;
          if (!isq) {
            float ssq = o1 * o1 + o2 * o2;
            ssq += __shfl_xor(ssq, 1); ssq += __shfl_xor(ssq, 2); ssq += __shfl_xor(ssq, 4); ssq += __shfl_xor(ssq, 8); ssq += __shfl_xor(ssq, 16);
            knmax = fmaxf(knmax, ssq);
          }
        }
      if (!isq && c == 0) atomicMax(p.kmax + ((rb >> 13) * 8 + (cbb >> 7)) * 2 + ((cbb >> 6) & 1), __float_as_int(knmax));
      u16* dst = (isq ? p.dq : p.dk) + (size_t)rb * 1024 + cbb;
      stage_acc<EPS>(acc, wl, c, hh);
      epi_rows(wl, lane, [&](int r, int cc, float (&v)[8]) { st_bf16x8(dst + (size_t)r * 1024 + cc, v); });
    } else {
      if (wn == 0) {
#pragma unroll
        for (int mi = 0; mi < 2; ++mi)
#pragma unroll
          for (int i = 0; i < 16; ++i) {
            int row = rb + mi * 32 + crow(i, hh);
            p.lr[(size_t)row * 32 + c] = acc[mi][0][i];
          }
      }
    }
  });
}

DI float logsig(float x) { return fminf(x, 0.f) - __logf(1.f + __expf(-fabsf(x))); }

DI void phase_gla_pre(const Params& p, char* smem, int tid) {
  float* slr = (float*)smem;
  for (int it = blockIdx.x; it < 1024; it += gridDim.x) {
    const int dir = it & 1, ch = (it >> 1) & 127, b = it >> 8;
    const size_t t0 = (size_t)b * 8192 + ch * 64;
    __syncthreads();
    for (int i = tid; i < 1024; i += 512) slr[i] = p.lr[t0 * 32 + (i >> 4) * 32 + dir * 16 + (i & 15)];
    __syncthreads();
    const int j = tid;
    const int h = j >> 7, d = j & 127;
    const float* wa = dir ? p.wa_bw : p.wa_fw;
    float wr[16];
#pragma unroll
    for (int r = 0; r < 16; ++r) wr[r] = wa[r * 512 + j];
    const float ba = (dir ? p.ba_bw : p.ba_fw)[j];
    u16* qe = (dir ? p.qe_bw : p.qe_fw) + t0 * 512 + j;
    u16* ke = (dir ? p.ke_bw : p.ke_fw) + t0 * 512 + j;
    const u16* gq = p.gq + t0 * 512 + j;
    const u16* gk = p.gk + t0 * 512 + j;
    u16* keT = p.keT + (size_t)dir * (16ull * 128 * 8192) + ((size_t)(b * 4 + h) * 128 + d) * 8192 + ch * 64;
    float bsum = 0.f;
#pragma unroll 1
    for (int g8 = 0; g8 < 8; ++g8) {
      u16 qraw[8], kraw[8];
#pragma unroll
      for (int u = 0; u < 8; ++u) {
        const int tt = g8 * 8 + u;
        const int t = dir ? 63 - tt : tt;
        qraw[u] = gq[t * 512]; kraw[u] = gk[t * 512];
      }
      unsigned kk[8];
#pragma unroll
      for (int u = 0; u < 8; ++u) {
        const int tt = g8 * 8 + u;
        const int t = dir ? 63 - tt : tt;
        float pre = ba;
#pragma unroll
        for (int r = 0; r < 16; ++r) pre += slr[t * 16 + r] * wr[r];
        bsum += logsig(pre) * (1.f / 16.f);
        const float eb = __expf(bsum);
        const u16 qo = f2bf(bf2f(qraw[u]) * eb);
        const u16 ko = f2bf(bf2f(kraw[u]) * __expf(-bsum));
        qe[t * 512] = qo;
        ke[t * 512] = ko;
        kk[u] = ko;
      }
      u32x4 v;
      if (!dir) {
        v[0] = kk[0] | (kk[1] << 16); v[1] = kk[2] | (kk[3] << 16); v[2] = kk[4] | (kk[5] << 16); v[3] = kk[6] | (kk[7] << 16);
        *(u32x4*)(keT + g8 * 8) = v;
      } else {
        v[0] = kk[7] | (kk[6] << 16); v[1] = kk[5] | (kk[4] << 16); v[2] = kk[3] | (kk[2] << 16); v[3] = kk[1] | (kk[0] << 16);
        *(u32x4*)(keT + (56 - g8 * 8)) = v;
      }
    }
    p.dec[((size_t)(dir * 4 + b) * 128 + ch) * 512 + j] = __expf(bsum);
  }
}

constexpr int QLD = 136, TLD = 72;
DI void gla_scan_block(const Params& p, int g, char* smem, int tid) {
  const int dir = g & 1, bh = g >> 1;
  const int b = bh >> 2, h = bh & 3;
  const int w = tid >> 6, lane = tid & 63, c = lane & 31, hh = lane >> 5;
  const int slice = w;
  u16* sQ = (u16*)smem;
  u16* sK = sQ + 64 * QLD;
  u16* sKT = sK + 64 * QLD;
  u16* sVT = sKT + 128 * TLD;
  const u16* qe = (dir ? p.qe_bw : p.qe_fw) + (size_t)b * 8192 * 512 + h * 128;
  const u16* ke = (dir ? p.ke_bw : p.ke_fw) + (size_t)b * 8192 * 512 + h * 128;
  const u16* keT = p.keT + (size_t)dir * (16ull * 128 * 8192) + (size_t)bh * 128 * 8192;
  const u16* vT = p.gvT + (size_t)bh * 256 * 8192;
  const float* dec = p.dec + ((size_t)(dir * 4 + b) * 128) * 512 + h * 128;
  u16* o = dir ? p.o_bw : p.o_fw;
  f32x16 st[4];
#pragma unroll
  for (int i = 0; i < 4; ++i) st[i] = zero16();
  u32x4 rq[2], rk[2], rt[2];
  unsigned offq[2], offt[2];
#pragma unroll
  for (int r = 0; r < 2; ++r) {
    int id = tid + 512 * r;
    offq[r] = (unsigned)(((id >> 4) * 512 + (id & 15) * 8) * 2);
    offt[r] = (unsigned)(((id >> 3) * 8192 + (id & 7) * 8) * 2);
  }
  const unsigned offv = (unsigned)(((w * 32 + c) * 8192 + 4 * hh) * 2);
  {
    const int ch = dir ? 127 : 0;
#pragma unroll
    for (int r = 0; r < 2; ++r) {
      int id = tid + 512 * r;
      rq[r] = *(const u32x4*)((const char*)(qe + (size_t)ch * 64 * 512) + offq[r]);
      rk[r] = *(const u32x4*)((const char*)(ke + (size_t)ch * 64 * 512) + offq[r]);
      rt[r] = *(const u32x4*)((const char*)(keT + ch * 64) + offt[r]);
    }
  }
#pragma unroll 1
  for (int ci = 0; ci < 128; ++ci) {
    const int ch = dir ? 127 - ci : ci;
    const size_t t0 = (size_t)b * 8192 + ch * 64;
    __syncthreads();
#pragma unroll
    for (int r = 0; r < 2; ++r) {
      int id = tid + 512 * r;
      st_perm(sQ + (id >> 4) * QLD, id & 15, rq[r]);
      st_perm(sK + (id >> 4) * QLD, id & 15, rk[r]);
      st_perm(sKT + (id >> 3) * TLD, id & 7, rt[r]);
    }
    __syncthreads();
    if (ci + 1 < 128) {
      const int chn = dir ? ch - 1 : ch + 1;
#pragma unroll
      for (int r = 0; r < 2; ++r) {
        int id = tid + 512 * r;
        rq[r] = *(const u32x4*)((const char*)(qe + (size_t)chn * 64 * 512) + offq[r]);
        rk[r] = *(const u32x4*)((const char*)(ke + (size_t)chn * 64 * 512) + offq[r]);
        rt[r] = *(const u32x4*)((const char*)(keT + chn * 64) + offt[r]);
      }
    }
    bf16x8 vf[4];
#pragma unroll
    for (int k4 = 0; k4 < 4; ++k4) vf[k4] = ld_frag8x2((const u16*)((const char*)(vT + ch * 64 + 16 * k4) + offv));
#pragma unroll 1
    for (int qt = 0; qt < 2; ++qt) {
      f32x16 oacc = zero16();
#pragma unroll
      for (int ks = 0; ks < 8; ++ks) {
        bf16x8 sf = pack_step(st[ks >> 1], ks & 1);
        bf16x8 q0 = ld_frag16(sQ + (qt * 32 + c) * QLD + ks * 16 + 8 * hh);
        oacc = MFMA(q0, sf, oacc);
        if (ks & 1) __builtin_amdgcn_sched_barrier(0);
      }
#pragma unroll
      for (int kt = 0; kt < 2; ++kt) {
        bool skip = dir ? (kt < qt) : (kt > qt);
        if (skip) continue;
        f32x16 X = zero16();
#pragma unroll 1
        for (int ks = 0; ks < 8; ++ks) {
          bf16x8 kf = ld_frag16(sK + (kt * 32 + c) * QLD + ks * 16 + 8 * hh);
          bf16x8 qf = ld_frag16(sQ + (qt * 32 + c) * QLD + ks * 16 + 8 * hh);
          X = MFMA(kf, qf, X);
        }
        if (kt == qt) {
#pragma unroll
          for (int i = 0; i < 16; ++i) {
            int key = crow(i, hh);
            bool keep = dir ? (key >= c) : (key <= c);
            X[i] = keep ? X[i] : 0.f;
          }
        }
        oacc = MFMA(pack_step(X, 0), vf[kt * 2 + 0], oacc);
        oacc = MFMA(pack_step(X, 1), vf[kt * 2 + 1], oacc);
        __builtin_amdgcn_sched_barrier(0);
      }
#pragma unroll
      for (int i = 0; i < 16; ++i)
        o[(t0 + qt * 32 + crow(i, hh)) * 1024 + h * 256 + slice * 32 + c] = f2bf(oacc[i]);
      __builtin_amdgcn_sched_barrier(0);
    }
#pragma unroll
    for (int dt = 0; dt < 4; ++dt) {
#pragma unroll
      for (int k4 = 0; k4 < 4; ++k4) {
        bf16x8 kt_f = ld_frag16(sKT + (dt * 32 + c) * TLD + 16 * k4 + 8 * hh);
        st[dt] = MFMA(kt_f, vf[k4], st[dt]);
      }
#pragma unroll
      for (int gg = 0; gg < 4; ++gg) {
        float4 dv = *(const float4*)(dec + (size_t)ch * 512 + dt * 32 + 8 * gg + 4 * hh);
        st[dt][4 * gg + 0] *= dv.x; st[dt][4 * gg + 1] *= dv.y; st[dt][4 * gg + 2] *= dv.z; st[dt][4 * gg + 3] *= dv.w;
      }
      __builtin_amdgcn_sched_barrier(0);
    }
  }
}

constexpr int KLD = 136, VLD = 72;
constexpr int ATT_BUF = 64 * KLD + 128 * VLD;
DI void attn_item(const Params& p, int item, char* smem, int tid) {
  const int qb = item & 63, bh = item >> 6;
  const int b = bh >> 3, h = bh & 7;
  const int w = tid >> 6, lane = tid & 63, c = lane & 31, hh = lane >> 5;
  const int qg = w & 3, mp = w >> 2;
  u16* sbase = (u16*)smem;
  float* sex = (float*)(smem + 2 * ATT_BUF * 2);
  const size_t tq = (size_t)b * 8192 + qb * 128 + qg * 32 + c;
  bf16x8 qf[4];
#pragma unroll
  for (int s = 0; s < 4; ++s) qf[s] = ld_frag16(p.dq + tq * 1024 + h * 128 + mp * 64 + 16 * s + 8 * hh);
  f32x16 O[4];
#pragma unroll
  for (int dt = 0; dt < 4; ++dt) O[dt] = zero16();
  float lrun = 0.f;
  float negmb;
  {
    float qn = 0.f;
#pragma unroll
    for (int s = 0; s < 4; ++s) {
      u32x4 qq = __builtin_bit_cast(u32x4, qf[s]);
#pragma unroll
      for (int i = 0; i < 4; ++i) { float x0 = bflo(qq[i]), x1 = bfhi(qq[i]); qn += x0 * x0 + x1 * x1; }
    }
    qn += __shfl_xor(qn, 32);
    float kn = __int_as_float(p.kmax[(b * 8 + h) * 2 + mp]);
    float mb = sqrtf(qn * kn) * 1.01f + 1e-3f;
    negmb = -mb;
  }
  const u16* Kg = p.dk + (size_t)b * 8192 * 1024 + h * 128;
  const u16* Vg = p.dvT + (size_t)bh * 128 * 8192;
  u32x4 rk[2], rv[2];
#pragma unroll
  for (int r = 0; r < 2; ++r) {
    int id = tid + 512 * r;
    rk[r] = *(const u32x4*)(Kg + (size_t)(id >> 4) * 1024 + (id & 15) * 8);
    rv[r] = *(const u32x4*)(Vg + (size_t)(id >> 3) * 8192 + (id & 7) * 8);
  }
  __syncthreads();
#pragma unroll
  for (int r = 0; r < 2; ++r) {
    int id = tid + 512 * r;
    *(u32x4*)(sbase + (id >> 4) * KLD + (id & 15) * 8) = rk[r];
    st_perm(sbase + 64 * KLD + (id >> 3) * VLD, id & 7, rv[r]);
  }
#pragma unroll
  for (int r = 0; r < 2; ++r) {
    int id = tid + 512 * r;
    rk[r] = *(const u32x4*)(Kg + (size_t)(64 + (id >> 4)) * 1024 + (id & 15) * 8);
    rv[r] = *(const u32x4*)(Vg + (size_t)(id >> 3) * 8192 + 64 + (id & 7) * 8);
  }
  __syncthreads();
#pragma unroll 1
  for (int kt = 0; kt < 128; ++kt) {
    const u16* sK = sbase + (kt & 1) * ATT_BUF;
    const u16* sV = sK + 64 * KLD;
    if (kt + 1 < 128) {
      u16* nK = sbase + ((kt + 1) & 1) * ATT_BUF;
      u16* nV = nK + 64 * KLD;
#pragma unroll
      for (int r = 0; r < 2; ++r) {
        int id = tid + 512 * r;
        *(u32x4*)(nK + (id >> 4) * KLD + (id & 15) * 8) = rk[r];
        st_perm(nV + (id >> 3) * VLD, id & 7, rv[r]);
      }
      if (kt + 2 < 128) {
#pragma unroll
        for (int r = 0; r < 2; ++r) {
          int id = tid + 512 * r;
          rk[r] = *(const u32x4*)(Kg + (size_t)((kt + 2) * 64 + (id >> 4)) * 1024 + (id & 15) * 8);
          rv[r] = *(const u32x4*)(Vg + (size_t)(id >> 3) * 8192 + (kt + 2) * 64 + (id & 7) * 8);
        }
      }
    }
    f32x16 sacc[2];
    bf16x8 kf[8];
#pragma unroll
    for (int s = 0; s < 4; ++s)
#pragma unroll
      for (int k2 = 0; k2 < 2; ++k2) kf[s * 2 + k2] = ld_frag16(sK + (k2 * 32 + c) * KLD + mp * 64 + 16 * s + 8 * hh);
    __builtin_amdgcn_sched_barrier(0);
#pragma unroll
    for (int i = 0; i < 16; ++i) { sacc[0][i] = negmb; sacc[1][i] = negmb; }
#pragma unroll
    for (int s = 0; s < 4; ++s) {
      sacc[0] = MFMA(kf[s * 2 + 0], qf[s], sacc[0]);
      sacc[1] = MFMA(kf[s * 2 + 1], qf[s], sacc[1]);
    }
    bf16x8 vfA[4], vfB[4];
#define VLOAD(dst, k2, s2) { _Pragma("unroll") for (int dt = 0; dt < 4; ++dt) dst[dt] = ld_frag16(sV + (dt * 32 + c) * VLD + (k2) * 32 + (s2) * 16 + 8 * hh); }
#define PVMM(vf, pf) { _Pragma("unroll") for (int dt = 0; dt < 4; ++dt) O[dt] = MFMA(vf[dt], pf, O[dt]); }
#define EXPS(k2) { _Pragma("unroll") for (int i = 0; i < 8; ++i) { \
        float e0 = __builtin_amdgcn_exp2f(sacc[k2][2 * i]), e1 = __builtin_amdgcn_exp2f(sacc[k2][2 * i + 1]); \
        sacc[k2][2 * i] = e0; sacc[k2][2 * i + 1] = e1; f32x2_t ev = {e0, e1}; ls2 += ev; } }
    VLOAD(vfA, 0, 0);
    __builtin_amdgcn_sched_barrier(0);
    f32x2_t ls2 = {0.f, 0.f};
    EXPS(0);
    bf16x8 p0 = pack_step(sacc[0], 0), p1 = pack_step(sacc[0], 1);
    __builtin_amdgcn_sched_barrier(0);
    VLOAD(vfB, 0, 1);
    PVMM(vfA, p0);
    __builtin_amdgcn_sched_barrier(0);
    VLOAD(vfA, 1, 0);
    PVMM(vfB, p1);
    __builtin_amdgcn_sched_barrier(0);
    EXPS(1);
    p0 = pack_step(sacc[1], 0); p1 = pack_step(sacc[1], 1);
    __builtin_amdgcn_sched_barrier(0);
    VLOAD(vfB, 1, 1);
    PVMM(vfA, p0);
    __builtin_amdgcn_sched_barrier(0);
    PVMM(vfB, p1);
    lrun += ls2[0] + ls2[1];
#undef VLOAD
#undef PVMM
#undef EXPS
    __syncthreads();
  }
  float ltot = lrun + __shfl_xor(lrun, 32);
  if (mp == 1) {
    float sc = p.lam[0] / ltot;
#pragma unroll
    for (int dt = 0; dt < 4; ++dt)
#pragma unroll
      for (int i = 0; i < 16; ++i) sex[(qg * 64 + dt * 16 + i) * 64 + lane] = O[dt][i] * sc;
  }
  __syncthreads();
  if (mp == 0) {
    float i0 = 1.f / ltot;
    float ss = 0.f;
#pragma unroll
    for (int dt = 0; dt < 4; ++dt)
#pragma unroll
      for (int i = 0; i < 16; ++i) { float v = O[dt][i] * i0 - sex[(qg * 64 + dt * 16 + i) * 64 + lane]; O[dt][i] = v; ss += v * v; }
    ss += __shfl_xor(ss, 32);
    float rstd = rsqrtf(ss * (1.f / 128.f) + RMS_EPS) * 0.8f;
#pragma unroll
    for (int dt = 0; dt < 4; ++dt)
#pragma unroll
      for (int g = 0; g < 4; ++g) {
        int dv = dt * 32 + 8 * g + 4 * hh;
        float4 gg = *(const float4*)(p.diff_norm_g + h * 128 + dv);
        u32x2 v = {pack2(O[dt][4 * g] * rstd * gg.x, O[dt][4 * g + 1] * rstd * gg.y),
                   pack2(O[dt][4 * g + 2] * rstd * gg.z, O[dt][4 * g + 3] * rstd * gg.w)};
        *(u32x2*)(p.dq + tq * 1024 + h * 128 + dv) = v;
      }
  }
}

DI void phase_mixers(const Params& p, char* smem, int tid) {
  if (blockIdx.x < 32) gla_scan_block(p, blockIdx.x, smem, opq(tid));
  xcd_queue(p.counter + 56, 256, smem, tid, [&](int xq, int qn) {
    const int bh = xq + 8 * (qn >> 6);
    attn_item(p, bh * 64 + (qn & 63), smem, opq(tid));
  });
}

DI void phase_post_mixers(const Params& p, int tid) {
  int w = tid >> 6, lane = tid & 63;
  for (int row = blockIdx.x * 8 + w; row < T; row += gridDim.x * 8) {
#pragma unroll
    for (int hd = 0; hd < 4; ++hd) {
      u32x2 a = *(const u32x2*)(p.o_fw + (size_t)row * 1024 + hd * 256 + lane * 4);
      u32x2 bq = *(const u32x2*)(p.o_bw + (size_t)row * 1024 + hd * 256 + lane * 4);
      float v0 = bflo(a[0]) + bflo(bq[0]), v1 = bfhi(a[0]) + bfhi(bq[0]), v2 = bflo(a[1]) + bflo(bq[1]), v3 = bfhi(a[1]) + bfhi(bq[1]);
      float ss = wave_sum(v0 * v0 + v1 * v1 + v2 * v2 + v3 * v3);
      if (lane == 0) p.rstd[row * 4 + hd] = rsqrtf(ss * (1.f / 256.f) + RMS_EPS);
    }
  }
  phase_norm_mod(p.x, p.norm1_g, p.mod, 0, 1024, p.hA, tid);
  for (int row = blockIdx.x * 8 + w; row < 32768; row += gridDim.x * 8) {
    const bool isv = row >= 16384;
    const int r = row & 16383;
    const float* srcp = (isv ? p.peer_v : p.peer_u) + (size_t)r * 1024 + lane * 16;
    float4 a0 = *(const float4*)(srcp), a1 = *(const float4*)(srcp + 4), a2 = *(const float4*)(srcp + 8), a3 = *(const float4*)(srcp + 12);
    float am = fmaxf(fmaxf(fmaxf(fabsf(a0.x), fabsf(a0.y)), fmaxf(fabsf(a0.z), fabsf(a0.w))), fmaxf(fmaxf(fabsf(a1.x), fabsf(a1.y)), fmaxf(fabsf(a1.z), fabsf(a1.w))));
    am = fmaxf(am, fmaxf(fmaxf(fmaxf(fabsf(a2.x), fabsf(a2.y)), fmaxf(fabsf(a2.z), fabsf(a2.w))), fmaxf(fmaxf(fabsf(a3.x), fabsf(a3.y)), fmaxf(fabsf(a3.z), fabsf(a3.w)))));
#pragma unroll
    for (int o = 32; o >= 1; o >>= 1) am = fmaxf(am, __shfl_xor(am, o));
    am = fmaxf(am, 1e-30f);
    const float sc = 256.f / am;
    u32x4 v;
    int t0 = __builtin_amdgcn_cvt_pk_fp8_f32(a0.x * sc, a0.y * sc, 0, false); t0 = __builtin_amdgcn_cvt_pk_fp8_f32(a0.z * sc, a0.w * sc, t0, true);
    int t1 = __builtin_amdgcn_cvt_pk_fp8_f32(a1.x * sc, a1.y * sc, 0, false); t1 = __builtin_amdgcn_cvt_pk_fp8_f32(a1.z * sc, a1.w * sc, t1, true);
    int t2 = __builtin_amdgcn_cvt_pk_fp8_f32(a2.x * sc, a2.y * sc, 0, false); t2 = __builtin_amdgcn_cvt_pk_fp8_f32(a2.z * sc, a2.w * sc, t2, true);
    int t3 = __builtin_amdgcn_cvt_pk_fp8_f32(a3.x * sc, a3.y * sc, 0, false); t3 = __builtin_amdgcn_cvt_pk_fp8_f32(a3.z * sc, a3.w * sc, t3, true);
    v[0] = (unsigned)t0; v[1] = (unsigned)t1; v[2] = (unsigned)t2; v[3] = (unsigned)t3;
    unsigned char* dst = (unsigned char*)(isv ? p.vB : p.uB) + (size_t)r * 1024 + lane * 16;
    *(u32x4*)dst = v;
    if (lane == 0) (isv ? p.vs : p.us)[r] = am * (1.f / 256.f);
  }
}

DI void phase_gr(const Params& p, char* smem, int tid) {
  const int w = tid >> 6, lane = tid & 63, c_inv = lane & 31, hh_inv = lane >> 5;
  const int wm = w >> 1, wn = w & 1;
  float* wl = wave_stage(smem, w);
  xcd_static(p, 16 * 24, smem, [&](int xq, int qn) {
    int mt = xq + 8 * (qn / 24), nt = qn % 24;
    int m0 = mt * 256, n0 = nt * 128;
    f32x16 acc[2][2]; zero_acc(acc);
    gemm_kloop(p.hA + (size_t)m0 * 1024, 1024, p.wgrT + (size_t)n0 * 1024, 1024, 1024, acc, (u16*)smem, tid);
    const int c = opq(c_inv), hh = opq(hh_inv);
    const int rb = m0 + wm * 64;
    stage_acc<EPS>(acc, wl, c, hh);
    if (n0 < 1024) {
      const int cb = n0 + wn * 64;
      epi_rows(wl, lane, [&](int r, int cc, float (&v)[8]) {
        const size_t off = (size_t)(rb + r) * 1024 + cb + cc;
        float of[8], ob[8];
        ld_bf16x8(p.o_fw + off, of); ld_bf16x8(p.o_bw + off, ob);
        const float rs = p.rstd[(rb + r) * 4 + ((cb + cc) >> 8)];
        float4 g0 = *(const float4*)(p.gla_norm_g + cb + cc), g1 = *(const float4*)(p.gla_norm_g + cb + cc + 4);
        const float gg[8] = {g0.x, g0.y, g0.z, g0.w, g1.x, g1.y, g1.z, g1.w};
#pragma unroll
        for (int j = 0; j < 8; ++j) { float a = v[j]; v[j] = (of[j] + ob[j]) * rs * gg[j] * (a / (1.f + __expf(-a))); }
        st_bf16x8(p.A1 + off, v);
      });
    } else {
      u16* dst = ((n0 < 2048) ? p.sga : p.sgb) + (size_t)rb * 1024 + (n0 & 1023) + wn * 64;
      epi_rows(wl, lane, [&](int r, int cc, float (&v)[8]) {
#pragma unroll
        for (int j = 0; j < 8; ++j) v[j] = 1.f / (1.f + __expf(-v[j]));
        st_bf16x8(dst + (size_t)r * 1024 + cc, v);
      });
    }
  });
}

DI void phase_merge(const Params& p, char* smem, int tid) {
  const int w = tid >> 6, lane = tid & 63, c_inv = lane & 31, hh_inv = lane >> 5;
  const int wm = w >> 1, wn = w & 1;
  float* wl = wave_stage(smem, w);
  xcd_static(p, 16 * 8, smem, [&](int xq, int qn) {
    int mt = xq + 8 * (qn >> 3), nt = qn & 7;
    int m0 = mt * 256, n0 = nt * 128;
    const size_t tb = (size_t)(m0 + wm * 64) * 1024 + n0 + wn * 64;
    f32x16 acc[2][2];
    zero_acc(acc);
    gemm_kloop(p.A1 + (size_t)m0 * 1024, 1024, p.wglaT + (size_t)n0 * 1024, 1024, 1024, acc, (u16*)smem, tid);
    {
      const int c = opq(c_inv), hh = opq(hh_inv);
      stage_acc<EPS>(acc, wl, c, hh);
      epi_rows(wl, lane, [&](int r, int cc, float (&v)[8]) {
        float gv[8];
        ld_bf16x8(p.sga + tb + (size_t)r * 1024 + cc, gv);
#pragma unroll
        for (int j = 0; j < 8; ++j) v[j] *= gv[j];
        st_bf16x8(p.sga + tb + (size_t)r * 1024 + cc, v);
      });
    }
    zero_acc(acc);
    gemm_kloop(p.dq + (size_t)m0 * 1024, 1024, p.wdiffT + (size_t)n0 * 1024, 1024, 1024, acc, (u16*)smem, tid);
    {
      const int c = opq(c_inv), hh = opq(hh_inv);
      stage_acc<EPS>(acc, wl, c, hh);
      epi_rows(wl, lane, [&](int r, int cc, float (&v)[8]) {
        float gv[8], mv[8];
        ld_bf16x8(p.sgb + tb + (size_t)r * 1024 + cc, gv);
        ld_bf16x8(p.sga + tb + (size_t)r * 1024 + cc, mv);
#pragma unroll
        for (int j = 0; j < 8; ++j) v[j] = mv[j] + v[j] * gv[j];
        st_bf16x8(p.merged + tb + (size_t)r * 1024 + cc, v);
      });
    }
  });
}

DI void phase_out(const Params& p, char* smem, int tid) {
  const int w = tid >> 6, lane = tid & 63, c_inv = lane & 31, hh_inv = lane >> 5;
  const int wm = w >> 1, wn = w & 1;
  float* wl = wave_stage(smem, w);
  xcd_static(p, 16 * 8, smem, [&](int xq, int qn) {
    int mt = xq + 8 * (qn >> 3), nt = qn & 7;
    int m0 = mt * 256, n0 = nt * 128;
    f32x16 acc[2][2]; zero_acc(acc);
    gemm_kloop(p.merged + (size_t)m0 * 1024, 1024, p.woutT + (size_t)n0 * 1024, 1024, 1024, acc, (u16*)smem, tid);
    const int c = opq(c_inv), hh = opq(hh_inv);
    const int b = m0 >> 13;
    const int cb = n0 + wn * 64;
    const size_t tb = (size_t)(m0 + wm * 64) * 1024 + cb;
    stage_acc<EPS>(acc, wl, c, hh);
    epi_rows(wl, lane, [&](int r, int cc, float (&v)[8]) {
      const float* xp = p.x + tb + (size_t)r * 1024 + cc;
      const float* gp = p.mod + b * 6144 + 2048 + cb + cc;
      float4 x0 = *(const float4*)xp, x1v = *(const float4*)(xp + 4);
      float4 g0 = *(const float4*)gp, g1 = *(const float4*)(gp + 4);
      float4 o0 = {x0.x + g0.x * v[0], x0.y + g0.y * v[1], x0.z + g0.z * v[2], x0.w + g0.w * v[3]};
      float4 o1 = {x1v.x + g1.x * v[4], x1v.y + g1.y * v[5], x1v.z + g1.z * v[6], x1v.w + g1.w * v[7]};
      float* op = p.x1 + tb + (size_t)r * 1024 + cc;
      *(float4*)op = o0; *(float4*)(op + 4) = o1;
    });
  });
}

DI void phase_peerq(const Params& p, char* smem, int tid) {
  const int w = tid >> 6, lane = tid & 63, c_inv = lane & 31, hh_inv = lane >> 5;
  const int wm = w >> 1, wn = w & 1;
  float* wl = wave_stage(smem, w);
  xcd_static(p, 16 * 16, smem, [&](int xq, int qn) {
    int mt = xq + 8 * (qn >> 4), nt = qn & 15;
    int m0 = mt * 256, n0 = nt * 128;
    f32x16 acc[2][2]; zero_acc(acc);
    gemm_kloop(p.h2 + (size_t)m0 * 1024, 1024, p.wqT + (size_t)n0 * 1024, 1024, 1024, acc, (u16*)smem, tid);
    const int c = opq(c_inv), hh = opq(hh_inv);
    u16* dst = p.qp + (size_t)(m0 + wm * 64) * 2048 + n0 + wn * 64;
    stage_acc<EPS>(acc, wl, c, hh);
    epi_rows(wl, lane, [&](int r, int cc, float (&v)[8]) { st_bf16x8(dst + (size_t)r * 2048 + cc, v); });
  });
}

DI unsigned fkey(float f) { unsigned u = __float_as_uint(f); return (u & 0x80000000u) ? ~u : (u | 0x80000000u); }
DI void phase_topk(const Params& p, char* smem, int tid) {
  float* sc = (float*)smem;
  float* ts = sc + 64 * 132;
  int* ti = (int*)(ts + 64 * 32);
  const int w = tid >> 6, lane = tid & 63, c = lane & 31, hh = lane >> 5;
  const int l16 = tid & 15, grp = tid >> 4;
  const int nt = w & 3, mt = w >> 2;
  bf16x8 af[8], bfq[8];
#define TK_LOAD(item_, pp_) { const int h_ = (item_) & 7; const u16* Aq_ = p.qp + (size_t)((item_) >> 3) * 64 * 2048 + h_ * 256 + (pp_) * 128; \
    const u16* Bk_ = p.subk + (size_t)(h_ * 2 + (pp_)) * 128 * 128; \
    _Pragma("unroll") for (int s = 0; s < 8; ++s) { bfq[s] = ld_frag16(Bk_ + (32 * nt + c) * 128 + 16 * s + 8 * hh); af[s] = ld_frag16(Aq_ + (size_t)(32 * mt + c) * 2048 + 16 * s + 8 * hh); } }
  if (blockIdx.x < 4096) TK_LOAD(blockIdx.x, 0);
  for (int item = blockIdx.x; item < 4096; item += gridDim.x) {
    const int h = item & 7;
    const size_t t0 = (size_t)(item >> 3) * 64;
#pragma unroll 1
    for (int pp = 0; pp < 2; ++pp) {
      f32x16 acc = zero16();
      {
        f32x16 acc2 = zero16();
#pragma unroll
        for (int s = 0; s < 8; s += 2) { acc = MFMA(af[s], bfq[s], acc); acc2 = MFMA(af[s + 1], bfq[s + 1], acc2); }
#pragma unroll
        for (int i = 0; i < 16; ++i) acc[i] += acc2[i];
      }
      if (pp == 0) { TK_LOAD(item, 1); }
      else { const int nitem = item + gridDim.x; if (nitem < 4096) TK_LOAD(nitem, 0); }
      __syncthreads();
#pragma unroll
      for (int i = 0; i < 16; ++i) sc[(mt * 32 + crow(i, hh)) * 132 + 32 * nt + c] = acc[i];
      __syncthreads();
      unsigned k[2][8], sel[2];
#pragma unroll
      for (int rr = 0; rr < 2; ++rr) {
        sel[rr] = 0;
#pragma unroll
        for (int m = 0; m < 8; ++m) { int n = l16 + 16 * m; k[rr][m] = (fkey(sc[(grp + 32 * rr) * 132 + n]) & ~127u) | (unsigned)(127 - n); }
      }
#pragma unroll 1
      for (int round = 0; round < 16; ++round) {
#pragma unroll
        for (int rr = 0; rr < 2; ++rr) {
          unsigned mx = max(max(max(k[rr][0], k[rr][1]), max(k[rr][2], k[rr][3])), max(max(k[rr][4], k[rr][5]), max(k[rr][6], k[rr][7])));
          mx = gmax16(mx);
          sel[rr] = (l16 == round) ? mx : sel[rr];
#pragma unroll
          for (int m = 0; m < 8; ++m) k[rr][m] = (k[rr][m] == mx) ? 0u : k[rr][m];
        }
      }
#pragma unroll
      for (int rr = 0; rr < 2; ++rr) {
        const int row = grp + 32 * rr;
        int n = 127 - (int)(sel[rr] & 127u);
        ti[(row * 2 + pp) * 16 + l16] = n;
        ts[(row * 2 + pp) * 16 + l16] = sc[row * 132 + n];
      }
    }
    __syncthreads();
    {
      float s0v[2]; int ptr[2]; unsigned selk[2];
#pragma unroll
      for (int rr = 0; rr < 2; ++rr) { s0v[rr] = ts[((grp + 32 * rr) * 2) * 16 + l16]; ptr[rr] = 0; selk[rr] = 0; }
#pragma unroll 1
      for (int round = 0; round < 16; ++round) {
#pragma unroll
        for (int rr = 0; rr < 2; ++rr) {
          const int row = grp + 32 * rr;
          float v = s0v[rr] + ts[(row * 2 + 1) * 16 + (ptr[rr] & 15)];
          unsigned key = (ptr[rr] < 16) ? ((fkey(v) & ~255u) | (unsigned)(255 - (l16 * 16 + ptr[rr]))) : 0u;
          unsigned mx = gmax16(key);
          selk[rr] = (l16 == round) ? mx : selk[rr];
          int aw = (255 - (int)(mx & 255u)) >> 4;
          ptr[rr] += (l16 == aw) ? 1 : 0;
        }
      }
#pragma unroll
      for (int rr = 0; rr < 2; ++rr) {
        const int row = grp + 32 * rr;
        int flat = 255 - (int)(selk[rr] & 255u);
        int aw = flat >> 4, bw = flat & 15;
        int my_idx = ti[(row * 2) * 16 + aw] * 128 + ti[(row * 2 + 1) * 16 + bw];
        float my_s = ts[(row * 2) * 16 + aw] + ts[(row * 2 + 1) * 16 + bw];
        float mxs = gmaxf16(my_s);
        float e = __expf(my_s - mxs);
        float sum = gsum16(e);
        p.idx[(t0 + row) * 128 + h * 16 + l16] = my_idx;
        p.g[(t0 + row) * 128 + h * 16 + l16] = e / sum;
      }
    }
    __syncthreads();
  }
#undef TK_LOAD
}

DI void peer_load_batch(const unsigned char* tab, const float* rsc, int ireg, int ebase, int q, int gq, u32x4 (&buf)[4], float (&scl)[1]) {
#pragma unroll
  for (int rr = 0; rr < 1; ++rr) {
    int e = ebase + 4 * rr + gq;
    int row = __shfl(ireg, e & 63);
    const unsigned char* rp = tab + (size_t)row * 1024 + q * 16;
#pragma unroll
    for (int j = 0; j < 4; ++j) buf[rr * 4 + j] = *(const u32x4*)(rp + j * 256);
    scl[rr] = rsc[row];
  }
}
DI void peer_u_compute(const u32x4 (&buf)[4], const float (&scl)[1], const float (&hf)[64], float* wl, int ebase, int q, int gq) {
#pragma unroll
  for (int rr = 0; rr < 1; ++rr) {
    float acc = 0.f;
#pragma unroll
    for (int j = 0; j < 4; ++j)
#pragma unroll
      for (int i = 0; i < 4; ++i) {
        f32x2_t lo = __builtin_amdgcn_cvt_pk_f32_fp8((int)buf[rr * 4 + j][i], false);
        f32x2_t hi = __builtin_amdgcn_cvt_pk_f32_fp8((int)buf[rr * 4 + j][i], true);
        acc += lo[0] * hf[j * 16 + 4 * i] + lo[1] * hf[j * 16 + 4 * i + 1] + hi[0] * hf[j * 16 + 4 * i + 2] + hi[1] * hf[j * 16 + 4 * i + 3];
      }
    acc = gsum16(acc) * scl[rr];
    float act = 0.5f * acc * (1.f + erff(acc * 0.7071067811865476f));
    if (q == 0) wl[ebase + 4 * rr + gq] = act;
  }
}
DI void peer_v_compute(const u32x4 (&buf)[4], const float (&scl)[1], float (&o)[64], const float* wl, float greg, int ebase, int gq) {
#pragma unroll
  for (int rr = 0; rr < 1; ++rr) {
    const int e = ebase + 4 * rr + gq;
    float ge = __shfl(greg, e & 63);
    float wg = wl[e] * ge * scl[rr];
#pragma unroll
    for (int j = 0; j < 4; ++j)
#pragma unroll
      for (int i = 0; i < 4; ++i) {
        f32x2_t lo = __builtin_amdgcn_cvt_pk_f32_fp8((int)buf[rr * 4 + j][i], false);
        f32x2_t hi = __builtin_amdgcn_cvt_pk_f32_fp8((int)buf[rr * 4 + j][i], true);
        o[j * 16 + 4 * i] += wg * lo[0]; o[j * 16 + 4 * i + 1] += wg * lo[1];
        o[j * 16 + 4 * i + 2] += wg * hi[0]; o[j * 16 + 4 * i + 3] += wg * hi[1];
      }
  }
}
DI void phase_peer_final(const Params& p, char* smem, int tid) {
  const int w = tid >> 6, lane = tid & 63, q = lane & 15, gq = lane >> 4;
  float* wl = (float*)smem + w * 128;
  const unsigned char* U8 = (const unsigned char*)p.uB;
  const unsigned char* V8 = (const unsigned char*)p.vB;
  for (int item = blockIdx.x; item < T / 8; item += gridDim.x) {
    const size_t t = (size_t)item * 8 + w;
    const int b = (int)(t >> 13);
    float hf[64];
#pragma unroll
    for (int j = 0; j < 4; ++j) {
      u32x4 ha = *(const u32x4*)(p.h2 + t * 1024 + (q + 16 * j) * 16);
      u32x4 hb = *(const u32x4*)(p.h2 + t * 1024 + (q + 16 * j) * 16 + 8);
#pragma unroll
      for (int i = 0; i < 4; ++i) { hf[j * 16 + 2 * i] = bflo(ha[i]); hf[j * 16 + 2 * i + 1] = bfhi(ha[i]); hf[j * 16 + 8 + 2 * i] = bflo(hb[i]); hf[j * 16 + 8 + 2 * i + 1] = bfhi(hb[i]); }
    }
    const int i0 = p.idx[t * 128 + lane], i1 = p.idx[t * 128 + 64 + lane];
    const float g0 = p.g[t * 128 + lane], g1 = p.g[t * 128 + 64 + lane];
    u32x4 bA[4], bB[4]; float sA[1], sB[1];
    peer_load_batch(U8, p.us, i0, 0, q, gq, bA, sA);
#pragma unroll 1
    for (int it = 0; it < 16; ++it) {
      const int e0 = 8 * it;
      peer_load_batch(U8, p.us, (e0 & 64) ? i1 : i0, e0 + 4, q, gq, bB, sB);
      peer_u_compute(bA, sA, hf, wl, e0, q, gq);
      if (it < 15) peer_load_batch(U8, p.us, ((e0 + 8) & 64) ? i1 : i0, e0 + 8, q, gq, bA, sA);
      else peer_load_batch(V8, p.vs, i0, 0, q, gq, bA, sA);
      peer_u_compute(bB, sB, hf, wl, e0 + 4, q, gq);
    }
    __syncthreads();
    float o[64];
#pragma unroll
    for (int i = 0; i < 64; ++i) o[i] = 0.f;
#pragma unroll 1
    for (int it = 0; it < 16; ++it) {
      const int e0 = 8 * it;
      peer_load_batch(V8, p.vs, (e0 & 64) ? i1 : i0, e0 + 4, q, gq, bB, sB);
      peer_v_compute(bA, sA, o, wl, (e0 & 64) ? g1 : g0, e0, gq);
      if (it < 15) peer_load_batch(V8, p.vs, ((e0 + 8) & 64) ? i1 : i0, e0 + 8, q, gq, bA, sA);
      peer_v_compute(bB, sB, o, wl, (e0 & 64) ? g1 : g0, e0 + 4, gq);
    }
    float h1[32];
#pragma unroll
    for (int i = 0; i < 32; ++i) {
      float send = (gq < 2) ? o[32 + i] : o[i];
      float keep = (gq < 2) ? o[i] : o[32 + i];
      h1[i] = keep + __shfl_xor(send, 32);
    }
    float fin[16];
#pragma unroll
    for (int i = 0; i < 16; ++i) {
      float send = (gq & 1) ? h1[i] : h1[16 + i];
      float keep = (gq & 1) ? h1[16 + i] : h1[i];
      fin[i] = keep + __shfl_xor(send, 16);
    }
    const int colb = (q + 16 * gq) * 16;
    float ss = 0.f;
#pragma unroll
    for (int i4 = 0; i4 < 4; ++i4) {
      float4 xa = *(const float4*)(p.x1 + t * 1024 + colb + 4 * i4);
      float4 ga = *(const float4*)(p.mod + b * 6144 + 5120 + colb + 4 * i4);
      fin[4 * i4 + 0] = xa.x + ga.x * fin[4 * i4 + 0]; fin[4 * i4 + 1] = xa.y + ga.y * fin[4 * i4 + 1];
      fin[4 * i4 + 2] = xa.z + ga.z * fin[4 * i4 + 2]; fin[4 * i4 + 3] = xa.w + ga.w * fin[4 * i4 + 3];
      ss += fin[4 * i4] * fin[4 * i4] + fin[4 * i4 + 1] * fin[4 * i4 + 1] + fin[4 * i4 + 2] * fin[4 * i4 + 2] + fin[4 * i4 + 3] * fin[4 * i4 + 3];
    }
    ss = wave_sum(ss);
    const float rstd = rsqrtf(ss * (1.f / 1024.f) + RMS_EPS);
#pragma unroll
    for (int i4 = 0; i4 < 4; ++i4) {
      int col = colb + 4 * i4;
      float4 gg = *(const float4*)(p.normf_g + col);
      float4 sh = *(const float4*)(p.fmod + b * 2048 + col);
      float4 sc = *(const float4*)(p.fmod + b * 2048 + 1024 + col);
      float4 r;
      r.x = fin[4 * i4 + 0] * rstd * gg.x * (1.f + sc.x) + sh.x;
      r.y = fin[4 * i4 + 1] * rstd * gg.y * (1.f + sc.y) + sh.y;
      r.z = fin[4 * i4 + 2] * rstd * gg.z * (1.f + sc.z) + sh.z;
      r.w = fin[4 * i4 + 3] * rstd * gg.w * (1.f + sc.w) + sh.w;
      *(float4*)(p.out + t * 1024 + col) = r;
    }
    __syncthreads();
  }
}

#define XB_TMO      128
#define XB_XCNT(j)  (256  + 64 * (j))
#define XB_XSUB(j)  (1280 + 64 * (j))
#define XB_XGEN(j)  (2304 + 64 * (j))
#define XB_TOP      3328
#define XB_TOPGEN   3392
#define XCD_BAR_WORDS 3456
#define XB_SPIN_CAP (1u << 18)
#define LAS __attribute__((address_space(3)))

__device__ __forceinline__ unsigned xb_ld(unsigned* p)              { return __hip_atomic_load(p, __ATOMIC_RELAXED, __HIP_MEMORY_SCOPE_AGENT); }
__device__ __forceinline__ unsigned xb_add(unsigned* p, unsigned v) { return __hip_atomic_fetch_add(p, v, __ATOMIC_RELAXED, __HIP_MEMORY_SCOPE_AGENT); }
__device__ __forceinline__ unsigned xb_xcc_id() { return (unsigned)__builtin_amdgcn_s_getreg((3 << 11) | 20) & 0xFu; }
#define XB_SPIN(cond, bar) do { unsigned _sp = 0; while (cond) { __builtin_amdgcn_s_sleep(1); \
    if ((++_sp & 255u) == 0u) { if (xb_ld(&(bar)[XB_TMO])) break; if (_sp > XB_SPIN_CAP) { atomicAdd(&(bar)[XB_TMO], 1u); break; } } } } while (0)

struct XcdBarrier {
    unsigned* bar; unsigned x;
    volatile LAS unsigned* st;
};

__device__ __forceinline__ XcdBarrier xcd_barrier_post(unsigned* bar, volatile LAS unsigned* st) {
    XcdBarrier b; b.bar = bar; b.x = xb_xcc_id(); b.st = st;
    if (threadIdx.x == 0) (void)xb_add(&bar[XB_XCNT(b.x)], 1u);
    return b;
}
__device__ __forceinline__ void xcd_barrier_complete(unsigned* bar, unsigned x, unsigned& nloc, unsigned& nx) {
    const unsigned G = gridDim.x * gridDim.y * gridDim.z;
    unsigned sum, cnt, mine, sp = 0u;
    for (;;) {
        sum = 0u; cnt = 0u; mine = 0u;
#pragma unroll
        for (unsigned j = 0; j < 16; ++j) { const unsigned c = xb_ld(&bar[XB_XCNT(j)]); sum += c; cnt += (c > 0u) ? 1u : 0u; mine = (j == x) ? c : mine; }
        if (sum == G) break;
        __builtin_amdgcn_s_sleep(1);
        if ((++sp & 255u) == 0u) { if (xb_ld(&bar[XB_TMO])) break; if (sp > XB_SPIN_CAP) { atomicAdd(&bar[XB_TMO], 1u); break; } }
    }
    nloc = mine > 0u ? mine : 1u; nx = cnt > 0u ? cnt : 1u;
}

__device__ __forceinline__ void xcd_barrier(const XcdBarrier& b) {
    asm volatile("s_waitcnt vmcnt(0)" ::: "memory");
    __syncthreads();
    if (threadIdx.x == 0) {
        unsigned* bar = b.bar;
        __builtin_amdgcn_s_waitcnt(0);
        unsigned nloc = b.st[0], nx = b.st[1];
        if (nloc == 0u) { xcd_barrier_complete(bar, b.x, nloc, nx); b.st[0] = nloc; b.st[1] = nx; }
        const unsigned old = xb_add(&bar[XB_XSUB(b.x)], 1u);
        const unsigned gen = old / nloc;
        if (old + 1u == (gen + 1u) * nloc) {
            __builtin_amdgcn_fence(__ATOMIC_RELEASE, "agent");
            asm volatile("s_waitcnt vmcnt(0)" ::: "memory");
            const unsigned og = xb_add(&bar[XB_TOP], 1u);
            const unsigned tg = og / nx;
            if (og + 1u == (tg + 1u) * nx) xb_add(&bar[XB_TOPGEN], 1u);
            else XB_SPIN(xb_ld(&bar[XB_TOPGEN]) == tg, bar);
            __builtin_amdgcn_fence(__ATOMIC_ACQUIRE, "agent");
            xb_add(&bar[XB_XGEN(b.x)], 1u);
            asm volatile("s_waitcnt vmcnt(0)" ::: "memory");
        } else {
            XB_SPIN(xb_ld(&bar[XB_XGEN(b.x)]) == gen, bar);
            __builtin_amdgcn_fence(__ATOMIC_ACQUIRE, "agent");
            asm volatile("s_waitcnt vmcnt(0)" ::: "memory");
        }
    }
    __syncthreads();
}

__global__ void __launch_bounds__(512) fwd_megakernel(Params p) {
  cg::grid_group grid = cg::this_grid();
  extern __shared__ __attribute__((aligned(16))) char smem[];
  const int tid = threadIdx.x;
  volatile LAS unsigned* xst = (volatile LAS unsigned*)(smem + LDS_BYTES - 16);
  if (tid == 0) { xst[0] = 0u; xst[1] = 0u; }
  __syncthreads();
  XcdBarrier xb = xcd_barrier_post(p.bar, xst);
  if (tid == 0) xst[2] = atomicAdd(p.bar + 3600 + (xb_xcc_id() & 7u) * 16, 1u);
  phase_prep(p, smem, opq(tid));
  grid.sync();
  phase_norm_mod(p.x, p.norm1_g, p.mod, 0, 1024, p.hA, opq(tid));
  xcd_barrier(xb);
  phase_proj(p, smem, opq(tid));
  xcd_barrier(xb);
  phase_gla_pre(p, smem, opq(tid));
  xcd_barrier(xb);
  phase_mixers(p, smem, opq(tid));
  xcd_barrier(xb);
  phase_post_mixers(p, opq(tid));
  xcd_barrier(xb);
  phase_gr(p, smem, opq(tid));
  xcd_barrier(xb);
  phase_merge(p, smem, opq(tid));
  xcd_barrier(xb);
  phase_out(p, smem, opq(tid));
  xcd_barrier(xb);
  phase_norm_mod(p.x1, p.norm2_g, p.mod, 3072, 4096, p.h2, opq(tid));
  xcd_barrier(xb);
  phase_peerq(p, smem, opq(tid));
  xcd_barrier(xb);
  phase_topk(p, smem, opq(tid));
  xcd_barrier(xb);
  phase_peer_final(p, smem, opq(tid));
}

extern "C" void kernel_launch(void* const* d_in, const int* in_sizes, int n_in, void* d_out, int out_size, void* d_ws,
                              size_t ws_size, hipStream_t stream) {
  static int grid_blocks = 0;
  if (!grid_blocks) {
    int dev = 0, cus = 0, per_cu = 0;
    hipGetDevice(&dev);
    hipDeviceGetAttribute(&cus, hipDeviceAttributeMultiprocessorCount, dev);
    if (hipFuncSetAttribute((const void*)fwd_megakernel, hipFuncAttributeMaxDynamicSharedMemorySize, LDS_BYTES) != hipSuccess) { fprintf(stderr, "hipFuncSetAttribute failed\n"); }
    hipOccupancyMaxActiveBlocksPerMultiprocessor(&per_cu, fwd_megakernel, 512, LDS_BYTES);
    if (per_cu < 1) per_cu = 1;
    grid_blocks = cus * per_cu;
  }
  if (ws_size < 492 * MB) { fprintf(stderr, "ws too small: %zu\n", ws_size); return; }
  Params p{};
  p.x = (const float*)d_in[0]; p.c = (const float*)d_in[1]; p.pos = (const int*)d_in[2];
  p.w_ada = (const float*)d_in[3]; p.b_ada = (const float*)d_in[4]; p.norm1_g = (const float*)d_in[5];
  p.w_in = (const float*)d_in[6]; p.wa_fw = (const float*)d_in[7]; p.ba_fw = (const float*)d_in[8];
  p.wa_bw = (const float*)d_in[9]; p.ba_bw = (const float*)d_in[10]; p.gla_norm_g = (const float*)d_in[11];
  p.lq1 = (const float*)d_in[12]; p.lk1 = (const float*)d_in[13]; p.lq2 = (const float*)d_in[14]; p.lk2 = (const float*)d_in[15];
  p.diff_norm_g = (const float*)d_in[16]; p.w_gla = (const float*)d_in[17]; p.w_diff = (const float*)d_in[18];
  p.w_out = (const float*)d_in[19]; p.norm2_g = (const float*)d_in[20]; p.peer_wq = (const float*)d_in[21];
  p.subkeys = (const float*)d_in[22]; p.peer_u = (const float*)d_in[23]; p.peer_v = (const float*)d_in[24];
  p.w_fada = (const float*)d_in[25]; p.b_fada = (const float*)d_in[26]; p.normf_g = (const float*)d_in[27];
  p.out = (float*)d_out;
  char* ws = (char*)d_ws;
  p.winT = (u16*)(ws + 0 * MB); p.wgrT = (u16*)(ws + 11 * MB); p.wgaT = (u16*)(ws + 13 * MB); p.wgbT = (u16*)(ws + 15 * MB);
  p.wglaT = (u16*)(ws + 17 * MB); p.wdiffT = (u16*)(ws + 19 * MB); p.woutT = (u16*)(ws + 21 * MB); p.wqT = (u16*)(ws + 23 * MB);
  p.subk = (u16*)(ws + 27 * MB); p.rope = (float*)(ws + 28 * MB);
  p.mod = (float*)(ws + 36 * MB); p.fmod = (float*)(ws + 36 * MB + 128 * 1024); p.lam = (float*)(ws + 36 * MB + 192 * 1024);
  p.counter = (int*)(ws + 36 * MB + 196 * 1024);
  p.kmax = (int*)(ws + 36 * MB + 200 * 1024);
  p.bar = (unsigned*)(ws + 36 * MB + 256 * 1024);
  hipMemsetAsync(p.bar, 0, 4096 * sizeof(unsigned), stream);
  p.lr = (float*)(ws + 37 * MB); p.dec = (float*)(ws + 41 * MB); p.rstd = (float*)(ws + 43 * MB);
  char* slot[9];
  for (int i = 0; i < 7; ++i) slot[i] = ws + (44 + 64 * (size_t)i) * MB;
  slot[7] = (char*)d_out; slot[8] = (char*)d_out + 64 * MB;
  p.hA = (u16*)slot[0];
  p.gq = (u16*)slot[1]; p.gk = (u16*)(slot[1] + 32 * MB);
  p.gvT = (u16*)slot[2]; p.dq = (u16*)slot[3]; p.dk = (u16*)slot[4]; p.dvT = (u16*)slot[5];
  p.qe_fw = (u16*)slot[0]; p.ke_fw = (u16*)(slot[0] + 32 * MB);
  p.qe_bw = (u16*)slot[6]; p.ke_bw = (u16*)(slot[6] + 32 * MB);
  p.keT = (u16*)slot[7];
  p.o_fw = (u16*)slot[1]; p.o_bw = (u16*)slot[8];
  p.uB = (u16*)slot[6]; p.vB = (u16*)(slot[6] + 16 * MB);
  p.A1 = (u16*)slot[2]; p.merged = (u16*)slot[4];
  p.sga = (u16*)slot[5]; p.sgb = (u16*)slot[7];
  p.x1 = (float*)slot[0];
  p.h2 = (u16*)slot[2]; p.qp = (u16*)slot[3];
  p.us = (float*)(slot[6] + 32 * MB); p.vs = (float*)(slot[6] + 33 * MB);
  p.idx = (int*)slot[5]; p.g = (float*)(slot[5] + 16 * MB);
  void* args[] = {&p};
  hipError_t e = hipLaunchCooperativeKernel((void*)fwd_megakernel, dim3(grid_blocks), dim3(512), args, LDS_BYTES, stream);
  if (e != hipSuccess) fprintf(stderr, "cooperative launch failed: %s (grid %d)\n", hipGetErrorString(e), grid_blocks);
}
```

```cpp
#include <hip/hip_runtime.h>
#include <hip/hip_cooperative_groups.h>
#include <cstdio>
namespace cg = cooperative_groups;

#define DI __device__ __forceinline__
typedef unsigned short u16;
using bf16x8 = __attribute__((ext_vector_type(8))) short;
using f32x16 = __attribute__((ext_vector_type(16))) float;
using u32x4 = __attribute__((ext_vector_type(4))) unsigned;
using u32x2 = __attribute__((ext_vector_type(2))) unsigned;
typedef __bf16 bf16x2_t __attribute__((ext_vector_type(2)));
typedef float f32x2_t __attribute__((ext_vector_type(2)));

constexpr int T = 32768, D = 1024, S = 8192;
constexpr size_t MB = 1ull << 20;
constexpr float RMS_EPS = 1e-6f;
constexpr int LDS_BYTES = 160 * 1024;
constexpr int SITEM_OFF = 150 * 1024;

#define MFMA(a, b, c) __builtin_amdgcn_mfma_f32_32x32x16_bf16((a), (b), (c), 0, 0, 0)

struct Params {
  const float *x, *c; const int* pos;
  const float *w_ada, *b_ada, *norm1_g, *w_in, *wa_fw, *ba_fw, *wa_bw, *ba_bw, *gla_norm_g;
  const float *lq1, *lk1, *lq2, *lk2, *diff_norm_g, *w_gla, *w_diff, *w_out, *norm2_g, *peer_wq, *subkeys, *peer_u, *peer_v;
  const float *w_fada, *b_fada, *normf_g;
  float* out;
  u16 *winT, *wgrT, *wgaT, *wgbT, *wglaT, *wdiffT, *woutT, *wqT, *subk;
  float* rope;
  float* mod;
  float* fmod;
  float* lam;
  int* counter;
  float* lr;
  float* dec;
  float* rstd;
  u16 *hA, *gq, *gk, *gvT, *dq, *dk, *dvT;
  u16 *qe_fw, *ke_fw, *qe_bw, *ke_bw, *keT;
  u16 *o_fw, *o_bw, *A1, *merged, *h2, *qp, *uB, *vB;
  float* x1;
  int* idx; float* g;
  float *us, *vs;
  u16 *sga, *sgb;
  unsigned* bar;
  int* kmax;
};

DI u16 f2bf(float x) { unsigned u = __float_as_uint(x); u += 0x7fffu + ((u >> 16) & 1u); return (u16)(u >> 16); }
DI float bf2f(u16 b) { return __uint_as_float(((unsigned)b) << 16); }
DI unsigned pack2(float a, float b) {
  f32x2_t v = {a, b};
  bf16x2_t r = __builtin_convertvector(v, bf16x2_t);
  return __builtin_bit_cast(unsigned, r);
}
DI float bflo(unsigned u) { return __uint_as_float(u << 16); }
DI float bfhi(unsigned u) { return __uint_as_float(u & 0xffff0000u); }
DI int crow(int i, int h) { return (i & 3) + 8 * (i >> 2) + 4 * h; }
DI bf16x8 pack_step(const f32x16& x, int s) {
  u32x4 p;
  p[0] = pack2(x[8 * s + 0], x[8 * s + 1]);
  p[1] = pack2(x[8 * s + 2], x[8 * s + 3]);
  p[2] = pack2(x[8 * s + 4], x[8 * s + 5]);
  p[3] = pack2(x[8 * s + 6], x[8 * s + 7]);
  return __builtin_bit_cast(bf16x8, p);
}
DI bf16x8 ld_frag16(const u16* p) { return __builtin_bit_cast(bf16x8, *(const u32x4*)p); }
DI bf16x8 ld_frag8x2(const u16* p) {
  u32x2 lo = *(const u32x2*)p; u32x2 hi = *(const u32x2*)(p + 8);
  u32x4 v = {lo[0], lo[1], hi[0], hi[1]};
  return __builtin_bit_cast(bf16x8, v);
}
DI void st_perm(u16* rowp, int ch, u32x4 v) {
  u16* d = rowp + (ch >> 1) * 16 + (ch & 1) * 4;
  u32x2 lo = {v[0], v[1]}, hi = {v[2], v[3]};
  *(u32x2*)d = lo;
  *(u32x2*)(d + 8) = hi;
}
DI float wave_sum(float v) {
#pragma unroll
  for (int o = 32; o >= 1; o >>= 1) v += __shfl_xor(v, o);
  return v;
}

template <int CTRL> DI float dpp_f(float v) { return __builtin_bit_cast(float, __builtin_amdgcn_update_dpp(0, __builtin_bit_cast(int, v), CTRL, 0xF, 0xF, false)); }
template <int CTRL> DI unsigned dpp_u(unsigned v) { return (unsigned)__builtin_amdgcn_update_dpp(0, (int)v, CTRL, 0xF, 0xF, false); }
DI float gsum16(float v) { v += dpp_f<0x121>(v); v += dpp_f<0x122>(v); v += dpp_f<0x124>(v); v += dpp_f<0x128>(v); return v; }
DI float gmaxf16(float v) { v = fmaxf(v, dpp_f<0x121>(v)); v = fmaxf(v, dpp_f<0x122>(v)); v = fmaxf(v, dpp_f<0x124>(v)); v = fmaxf(v, dpp_f<0x128>(v)); return v; }
DI unsigned gmax16(unsigned v) { v = max(v, dpp_u<0x121>(v)); v = max(v, dpp_u<0x122>(v)); v = max(v, dpp_u<0x124>(v)); v = max(v, dpp_u<0x128>(v)); return v; }
DI int opq(int x) { asm volatile("" : "+v"(x)); return x; }
DI f32x16 zero16() { f32x16 z; for (int i = 0; i < 16; ++i) z[i] = 0.f; return z; }

DI void tconv_tile(const float* src, int ld, int c0, int nc, u16* dst, int ct, int kt, float* sm, int tid) {
  __syncthreads();
  int cl = tid & 63, r0 = tid >> 6;
#pragma unroll
  for (int r = 0; r < 8; ++r) {
    int k = kt * 64 + r0 + 8 * r;
    int col = ct * 64 + cl;
    float v = (col < nc) ? src[(size_t)k * ld + c0 + col] : 0.f;
    sm[(r0 + 8 * r) * 65 + cl] = v;
  }
  __syncthreads();
#pragma unroll
  for (int r = 0; r < 8; ++r) {
    int col = r0 + 8 * r;
    int k = cl;
    dst[(size_t)(ct * 64 + col) * 1024 + kt * 64 + k] = f2bf(sm[k * 65 + col]);
  }
}

DI void phase_prep(const Params& p, char* smem, int tid) {
  float* sm = (float*)smem;
  const int nblk = gridDim.x, bid = blockIdx.x;
  const int NCT = 32 + 48 + 2 + 16 * 6 + 32;
  for (int it = bid; it < NCT * 16; it += nblk) {
    int ctg = it >> 4, kt = it & 15;
    const float* src; int ld, c0, nc; u16* dst; int ct;
    if (ctg < 32) { src = p.w_in; ld = 8224; c0 = 0; nc = 2048; dst = p.winT; ct = ctg; }
    else if (ctg < 80) { src = p.w_in; ld = 8224; c0 = 3104; nc = 3072; dst = p.winT + (size_t)2048 * 1024; ct = ctg - 32; }
    else if (ctg < 82) { src = p.w_in; ld = 8224; c0 = 3072; nc = 32; dst = p.winT + (size_t)5120 * 1024; ct = ctg - 80; }
    else if (ctg < 98) { src = p.w_in; ld = 8224; c0 = 2048; nc = 1024; dst = p.wgrT; ct = ctg - 82; }
    else if (ctg < 114) { src = p.w_in; ld = 8224; c0 = 6176; nc = 1024; dst = p.wgaT; ct = ctg - 98; }
    else if (ctg < 130) { src = p.w_in; ld = 8224; c0 = 7200; nc = 1024; dst = p.wgbT; ct = ctg - 114; }
    else if (ctg < 146) { src = p.w_gla; ld = 1024; c0 = 0; nc = 1024; dst = p.wglaT; ct = ctg - 130; }
    else if (ctg < 162) { src = p.w_diff; ld = 1024; c0 = 0; nc = 1024; dst = p.wdiffT; ct = ctg - 146; }
    else if (ctg < 178) { src = p.w_out; ld = 1024; c0 = 0; nc = 1024; dst = p.woutT; ct = ctg - 162; }
    else { src = p.peer_wq; ld = 2048; c0 = 0; nc = 2048; dst = p.wqT; ct = ctg - 178; }
    tconv_tile(src, ld, c0, nc, dst, ct, kt, sm, tid);
  }
  __syncthreads();
  const int gtid = bid * 512 + tid, gsz = nblk * 512;
  for (int i = gtid; i < 8 * 2 * 128 * 128; i += gsz) p.subk[i] = f2bf(p.subkeys[i]);
  for (int i = gtid; i < 128 * 1024 / 2; i += gsz) ((unsigned*)(p.winT + (size_t)5248 * 1024))[i] = 0u;
  for (int i = gtid; i < T * 32; i += gsz) {
    int t = i >> 5, d = i & 31;
    float inv = powf(10000.f, -(float)d / 32.f);
    float ang = (float)p.pos[t] * inv;
    double r = (double)ang * 0.15915494309189535;
    r -= rint(r);
    float rf = (float)r;
    p.rope[2 * i] = __builtin_amdgcn_cosf(rf);
    p.rope[2 * i + 1] = __builtin_amdgcn_sinf(rf);
  }
  if (gtid == 0) {
    float s1 = 0.f, s2 = 0.f;
    for (int i = 0; i < 64; ++i) { s1 += p.lq1[i] * p.lk1[i]; s2 += p.lq2[i] * p.lk2[i]; }
    p.lam[0] = expf(s1) - expf(s2) + 0.2f;
    for (int i = 0; i < 128; ++i) p.counter[i] = 0;
    for (int i = 0; i < 64; ++i) p.kmax[i] = 0;
  }
  {
    float* cact = sm;
    float* red = sm + 4096;
    __syncthreads();
    for (int i = tid; i < 4096; i += 512) { float v = p.c[i]; cact[i] = v / (1.f + __expf(-v)); }
    __syncthreads();
    int w = tid >> 6, lane = tid & 63;
    for (int it = bid; it < 128; it += nblk) {
      int col = it * 64 + lane;
      const float* W; int ld, cc;
      if (col < 6144) { W = p.w_ada; ld = 6144; cc = col; } else { W = p.w_fada; ld = 2048; cc = col - 6144; }
      float a0 = 0, a1 = 0, a2 = 0, a3 = 0;
#pragma unroll 8
      for (int k = w * 128; k < w * 128 + 128; ++k) {
        float wv = W[(size_t)k * ld + cc];
        a0 += cact[k] * wv; a1 += cact[1024 + k] * wv; a2 += cact[2048 + k] * wv; a3 += cact[3072 + k] * wv;
      }
      red[(w * 4 + 0) * 64 + lane] = a0; red[(w * 4 + 1) * 64 + lane] = a1;
      red[(w * 4 + 2) * 64 + lane] = a2; red[(w * 4 + 3) * 64 + lane] = a3;
      __syncthreads();
      if (tid < 256) {
        int b = w;
        float s = 0.f;
#pragma unroll
        for (int ww = 0; ww < 8; ++ww) s += red[(ww * 4 + b) * 64 + lane];
        if (col < 6144) p.mod[b * 6144 + cc] = s + p.b_ada[cc];
        else p.fmod[b * 2048 + cc] = s + p.b_fada[cc];
      }
      __syncthreads();
    }
  }
}

DI void phase_norm_mod(const float* src, const float* g, const float* mod, int sh_off, int sc_off, u16* dst, int tid) {
  int w = tid >> 6, lane = tid & 63;
  for (int row = blockIdx.x * 8 + w; row < T; row += gridDim.x * 8) {
    int b = row >> 13;
    const float* xr = src + (size_t)row * 1024;
    float4 v[4]; float ss = 0.f;
#pragma unroll
    for (int m = 0; m < 4; ++m) { v[m] = *(const float4*)(xr + (m * 64 + lane) * 4); ss += v[m].x * v[m].x + v[m].y * v[m].y + v[m].z * v[m].z + v[m].w * v[m].w; }
    ss = wave_sum(ss);
    float rstd = rsqrtf(ss * (1.f / 1024.f) + RMS_EPS);
#pragma unroll
    for (int m = 0; m < 4; ++m) {
      int col = (m * 64 + lane) * 4;
      float4 gg = *(const float4*)(g + col);
      float4 sh = *(const float4*)(mod + b * 6144 + sh_off + col);
      float4 sc = *(const float4*)(mod + b * 6144 + sc_off + col);
      float y0 = v[m].x * rstd * gg.x * (1.f + sc.x) + sh.x;
      float y1 = v[m].y * rstd * gg.y * (1.f + sc.y) + sh.y;
      float y2 = v[m].z * rstd * gg.z * (1.f + sc.z) + sh.z;
      float y3 = v[m].w * rstd * gg.w * (1.f + sc.w) + sh.w;
      u32x2 o = {pack2(y0, y1), pack2(y2, y3)};
      *(u32x2*)(dst + (size_t)row * 1024 + col) = o;
    }
  }
}

constexpr int GLD = 72;
constexpr int GSTAGE = (256 + 256) * GLD;
DI void gemm_kloop(const u16* A, int lda, const u16* Bt, int ldb, int K, f32x16 (&acc)[4][2], u16* smem, int tid) {
  const int w = tid >> 6, lane = tid & 63, c = lane & 31, hh = lane >> 5;
  const int wm = w >> 2, wn = w & 3;
  const int lrow = tid >> 3, lcol = (tid & 7) * 8;
  u32x4 ra[4], rb[4];
  const int nk = K >> 6;
#pragma unroll
  for (int r = 0; r < 4; ++r) { ra[r] = *(const u32x4*)(A + (size_t)(r * 64 + lrow) * lda + lcol); rb[r] = *(const u32x4*)(Bt + (size_t)(r * 64 + lrow) * ldb + lcol); }
  __syncthreads();
  {
    u16* sA = smem; u16* sB = smem + 256 * GLD;
#pragma unroll
    for (int r = 0; r < 4; ++r) { *(u32x4*)(sA + (r * 64 + lrow) * GLD + lcol) = ra[r]; *(u32x4*)(sB + (r * 64 + lrow) * GLD + lcol) = rb[r]; }
  }
#pragma unroll
  for (int r = 0; r < 4; ++r) { ra[r] = *(const u32x4*)(A + (size_t)(r * 64 + lrow) * lda + 64 + lcol); rb[r] = *(const u32x4*)(Bt + (size_t)(r * 64 + lrow) * ldb + 64 + lcol); }
  __syncthreads();
  for (int kt = 0; kt < nk; ++kt) {
    const u16* sA = smem + (kt & 1) * GSTAGE; const u16* sB = sA + 256 * GLD;
    if (kt + 1 < nk) {
      u16* nA = smem + ((kt + 1) & 1) * GSTAGE; u16* nB = nA + 256 * GLD;
#pragma unroll
      for (int r = 0; r < 4; ++r) { *(u32x4*)(nA + (r * 64 + lrow) * GLD + lcol) = ra[r]; *(u32x4*)(nB + (r * 64 + lrow) * GLD + lcol) = rb[r]; }
      if (kt + 2 < nk) {
#pragma unroll
        for (int r = 0; r < 4; ++r) { ra[r] = *(const u32x4*)(A + (size_t)(r * 64 + lrow) * lda + (kt + 2) * 64 + lcol); rb[r] = *(const u32x4*)(Bt + (size_t)(r * 64 + lrow) * ldb + (kt + 2) * 64 + lcol); }
      }
    }
    bf16x8 fr[1][6];
#define GLOADF(set, s) { _Pragma("unroll") for (int mi = 0; mi < 4; ++mi) fr[set][mi] = ld_frag16(sA + (wm * 128 + mi * 32 + c) * GLD + (s) * 16 + hh * 8); \
                         _Pragma("unroll") for (int ni = 0; ni < 2; ++ni) fr[set][4 + ni] = ld_frag16(sB + (wn * 64 + ni * 32 + c) * GLD + (s) * 16 + hh * 8); }
#define GMM(set) { _Pragma("unroll") for (int mi = 0; mi < 4; ++mi) _Pragma("unroll") for (int ni = 0; ni < 2; ++ni) acc[mi][ni] = MFMA(fr[set][mi], fr[set][4 + ni], acc[mi][ni]); }
#pragma unroll
    for (int s = 0; s < 4; ++s) {
      GLOADF(0, s);
      __builtin_amdgcn_sched_barrier(0);
      GMM(0);
      __builtin_amdgcn_sched_barrier(0);
    }
#undef GLOADF
#undef GMM
    __syncthreads();
  }
}
DI void zero_acc(f32x16 (&acc)[4][2]) {
#pragma unroll
  for (int a = 0; a < 4; ++a)
#pragma unroll
    for (int b = 0; b < 2; ++b) acc[a][b] = zero16();
}

constexpr int EPS = 68, EPT = 65;
__device__ __forceinline__ unsigned xb_xcc_id();

template <class F> DI void xcd_queue(int* counters, int per_xcd, char* smem, int tid, F f) {
  int* sitem = (int*)(smem + SITEM_OFF);
  const int myx = (int)xb_xcc_id() & 7;
  for (int qi = 0; qi < 8; ++qi) {
    const int xq = (myx + qi) & 7;
    for (;;) {
      __syncthreads();
      if (tid == 0) *sitem = atomicAdd(counters + xq, 1);
      __syncthreads();
      const int qn = *sitem;
      if (qn >= per_xcd) break;
      f(xq, qn);
    }
  }
}

template <class F> DI void xcd_static(const Params& p, int per_xcd, char* smem, F f) {
  const int myx = (int)xb_xcc_id() & 7;
  const int rank = (int)((volatile unsigned*)(smem + LDS_BYTES - 16))[2];
  const int nloc = (int)__hip_atomic_load(p.bar + 3600 + myx * 16, __ATOMIC_RELAXED, __HIP_MEMORY_SCOPE_AGENT);
  for (int qn = rank; qn < per_xcd; qn += nloc) f(myx, qn);
}
DI float* wave_stage(char* smem, int w) { return (float*)smem + w * (64 * EPS); }
template <int STR> DI void stage_acc(const f32x16 (&acc)[4][2], int half, float* wl, int c, int hh) {
#pragma unroll
  for (int mi = 0; mi < 2; ++mi)
#pragma unroll
    for (int ni = 0; ni < 2; ++ni)
#pragma unroll
      for (int i = 0; i < 16; ++i) wl[(mi * 32 + crow(i, hh)) * STR + ni * 32 + c] = (half ? acc[2 + mi][ni][i] : acc[mi][ni][i]);
}
DI void st_bf16x8(u16* dst, const float (&v)[8]) {
  u32x4 o = {pack2(v[0], v[1]), pack2(v[2], v[3]), pack2(v[4], v[5]), pack2(v[6], v[7])};
  *(u32x4*)dst = o;
}
DI void ld_bf16x8(const u16* srcp, float (&v)[8]) {
  u32x4 o = *(const u32x4*)srcp;
#pragma unroll
  for (int i = 0; i < 4; ++i) { v[2 * i] = bflo(o[i]); v[2 * i + 1] = bfhi(o[i]); }
}
template <class F> DI void epi_rows(const float* wl, int lane, F f) {
#pragma unroll
  for (int ps = 0; ps < 8; ++ps) {
    const int r = (lane >> 3) + 8 * ps, cc = (lane & 7) * 8;
    float4 v0 = *(const float4*)(wl + r * EPS + cc), v1 = *(const float4*)(wl + r * EPS + cc + 4);
    float v[8] = {v0.x, v0.y, v0.z, v0.w, v1.x, v1.y, v1.z, v1.w};
    f(r, cc, v);
  }
}
DI void epi_cols_bf16(const float* wl, int lane, u16* dstT, size_t ldt) {
#pragma unroll
  for (int ps = 0; ps < 8; ++ps) {
    const int col = (lane >> 3) + 8 * ps, r0 = (lane & 7) * 8;
    float v[8];
#pragma unroll
    for (int j = 0; j < 8; ++j) v[j] = wl[(r0 + j) * EPT + col];
    st_bf16x8(dstT + (size_t)col * ldt + r0, v);
  }
}

DI void phase_proj(const Params& p, char* smem, int tid) {
  const int w = tid >> 6, lane_inv = tid & 63;
  const int wm = w >> 2, wn = w & 3;
  float* wl = wave_stage(smem, w);
  const int NT = 21;
  xcd_static(p, 16 * NT, smem, [&](int xq, int qn) {
    int mt = xq + 8 * (qn / NT), nt = qn % NT;
    int m0 = mt * 256, n0 = nt * 256;
    f32x16 acc[4][2]; zero_acc(acc);
    gemm_kloop(p.hA + (size_t)m0 * 1024, 1024, p.winT + (size_t)n0 * 1024, 1024, 1024, acc, (u16*)smem, opq(tid));
    const int lane = opq(lane_inv);
    const int c = lane & 31, hh = lane >> 5;
    const int cb = n0 + wn * 64;
#pragma unroll
    for (int half = 0; half < 2; ++half) {
      const int rb = m0 + wm * 128 + half * 64;
      if (n0 < 1024) {
        const float sc = (n0 < 512) ? 0.08838834764831845f : 1.f;
        u16* dst = ((n0 < 512) ? p.gq : p.gk) + (size_t)rb * 512 + (cb & 511);
        stage_acc<EPS>(acc, half, wl, c, hh);
        epi_rows(wl, lane, [&](int r, int cc, float (&v)[8]) {
#pragma unroll
          for (int j = 0; j < 8; ++j) v[j] *= sc;
          st_bf16x8(dst + (size_t)r * 512 + cc, v);
        });
      } else if (n0 < 2048 || (n0 >= 4096 && n0 < 5120)) {
        const bool isg = n0 < 2048;
        const int b = rb >> 13;
        u16* dstT;
        if (isg) { int cc0 = cb - 1024; dstT = p.gvT + ((size_t)(b * 4 + (cc0 >> 8)) * 256 + (cc0 & 255)) * 8192 + (rb & 8191); }
        else { int cc0 = cb - 4096; dstT = p.dvT + ((size_t)(b * 8 + (cc0 >> 7)) * 128 + (cc0 & 127)) * 8192 + (rb & 8191); }
        stage_acc<EPT>(acc, half, wl, c, hh);
        epi_cols_bf16(wl, lane, dstT, 8192);
      } else if (n0 < 4096) {
        const bool isq = n0 < 3072;
        const float sc = isq ? (0.125f * 1.4426950408889634f) : 1.f;
        const int cbb = cb - (isq ? 2048 : 3072);
        float knmax = 0.f;
#pragma unroll
        for (int mi = 0; mi < 2; ++mi)
#pragma unroll
          for (int i = 0; i < 16; ++i) {
            int row = rb + mi * 32 + crow(i, hh);
            float2 cs = *(const float2*)(p.rope + ((size_t)row * 32 + c) * 2);
            float x1 = half ? acc[2 + mi][0][i] : acc[mi][0][i], x2 = half ? acc[2 + mi][1][i] : acc[mi][1][i];
            float o1 = (x1 * cs.x - x2 * cs.y) * sc;
            float o2 = (x2 * cs.x + x1 * cs.y) * sc;
            wl[(mi * 32 + crow(i, hh)) * EPS + c] = o1;
            wl[(mi * 32 + crow(i, hh)) * EPS + 32 + c] = o2;
            if (!isq) {
              float ssq = o1 * o1 + o2 * o2;
              ssq += __shfl_xor(ssq, 1); ssq += __shfl_xor(ssq, 2); ssq += __shfl_xor(ssq, 4); ssq += __shfl_xor(ssq, 8); ssq += __shfl_xor(ssq, 16);
              knmax = fmaxf(knmax, ssq);
            }
            if ((i & 3) == 3) __builtin_amdgcn_sched_barrier(0);
          }
        if (!isq && c == 0) atomicMax(p.kmax + ((rb >> 13) * 8 + (cbb >> 7)) * 2 + ((cbb >> 6) & 1), __float_as_int(knmax));
        u16* dst = (isq ? p.dq : p.dk) + (size_t)rb * 1024 + cbb;
        epi_rows(wl, lane, [&](int r, int cc, float (&v)[8]) { st_bf16x8(dst + (size_t)r * 1024 + cc, v); });
      } else {
        if (wn == 0) {
#pragma unroll
          for (int mi = 0; mi < 2; ++mi)
#pragma unroll
            for (int i = 0; i < 16; ++i) {
              int row = rb + mi * 32 + crow(i, hh);
              p.lr[(size_t)row * 32 + c] = half ? acc[2 + mi][0][i] : acc[mi][0][i];
            }
        }
      }
    }
  });
}

DI float logsig(float x) { return fminf(x, 0.f) - __logf(1.f + __expf(-fabsf(x))); }

DI void phase_gla_pre(const Params& p, char* smem, int tid) {
  float* slr = (float*)smem;
  for (int it = blockIdx.x; it < 1024; it += gridDim.x) {
    const int dir = it & 1, ch = (it >> 1) & 127, b = it >> 8;
    const size_t t0 = (size_t)b * 8192 + ch * 64;
    __syncthreads();
    for (int i = tid; i < 1024; i += 512) slr[i] = p.lr[t0 * 32 + (i >> 4) * 32 + dir * 16 + (i & 15)];
    __syncthreads();
    const int j = tid;
    const int h = j >> 7, d = j & 127;
    const float* wa = dir ? p.wa_bw : p.wa_fw;
    float wr[16];
#pragma unroll
    for (int r = 0; r < 16; ++r) wr[r] = wa[r * 512 + j];
    const float ba = (dir ? p.ba_bw : p.ba_fw)[j];
    u16* qe = (dir ? p.qe_bw : p.qe_fw) + t0 * 512 + j;
    u16* ke = (dir ? p.ke_bw : p.ke_fw) + t0 * 512 + j;
    const u16* gq = p.gq + t0 * 512 + j;
    const u16* gk = p.gk + t0 * 512 + j;
    u16* keT = p.keT + (size_t)dir * (16ull * 128 * 8192) + ((size_t)(b * 4 + h) * 128 + d) * 8192 + ch * 64;
    float bsum = 0.f;
#pragma unroll 1
    for (int g8 = 0; g8 < 8; ++g8) {
      u16 qraw[8], kraw[8];
#pragma unroll
      for (int u = 0; u < 8; ++u) {
        const int tt = g8 * 8 + u;
        const int t = dir ? 63 - tt : tt;
        qraw[u] = gq[t * 512]; kraw[u] = gk[t * 512];
      }
      unsigned kk[8];
#pragma unroll
      for (int u = 0; u < 8; ++u) {
        const int tt = g8 * 8 + u;
        const int t = dir ? 63 - tt : tt;
        float pre = ba;
#pragma unroll
        for (int r = 0; r < 16; ++r) pre += slr[t * 16 + r] * wr[r];
        bsum += logsig(pre) * (1.f / 16.f);
        const float eb = __expf(bsum);
        const u16 qo = f2bf(bf2f(qraw[u]) * eb);
        const u16 ko = f2bf(bf2f(kraw[u]) * __expf(-bsum));
        qe[t * 512] = qo;
        ke[t * 512] = ko;
        kk[u] = ko;
      }
      u32x4 v;
      if (!dir) {
        v[0] = kk[0] | (kk[1] << 16); v[1] = kk[2] | (kk[3] << 16); v[2] = kk[4] | (kk[5] << 16); v[3] = kk[6] | (kk[7] << 16);
        *(u32x4*)(keT + g8 * 8) = v;
      } else {
        v[0] = kk[7] | (kk[6] << 16); v[1] = kk[5] | (kk[4] << 16); v[2] = kk[3] | (kk[2] << 16); v[3] = kk[1] | (kk[0] << 16);
        *(u32x4*)(keT + (56 - g8 * 8)) = v;
      }
    }
    p.dec[((size_t)(dir * 4 + b) * 128 + ch) * 512 + j] = __expf(bsum);
  }
}

constexpr int QLD = 136, TLD = 72;
DI void gla_scan_block(const Params& p, int g, char* smem, int tid) {
  const int dir = g & 1, bh = g >> 1;
  const int b = bh >> 2, h = bh & 3;
  const int w = tid >> 6, lane = tid & 63, c = lane & 31, hh = lane >> 5;
  const int slice = w;
  u16* sQ = (u16*)smem;
  u16* sK = sQ + 64 * QLD;
  u16* sKT = sK + 64 * QLD;
  u16* sVT = sKT + 128 * TLD;
  const u16* qe = (dir ? p.qe_bw : p.qe_fw) + (size_t)b * 8192 * 512 + h * 128;
  const u16* ke = (dir ? p.ke_bw : p.ke_fw) + (size_t)b * 8192 * 512 + h * 128;
  const u16* keT = p.keT + (size_t)dir * (16ull * 128 * 8192) + (size_t)bh * 128 * 8192;
  const u16* vT = p.gvT + (size_t)bh * 256 * 8192;
  const float* dec = p.dec + ((size_t)(dir * 4 + b) * 128) * 512 + h * 128;
  u16* o = dir ? p.o_bw : p.o_fw;
  f32x16 st[4];
#pragma unroll
  for (int i = 0; i < 4; ++i) st[i] = zero16();
  u32x4 rq[2], rk[2], rt[2];
  unsigned offq[2], offt[2];
#pragma unroll
  for (int r = 0; r < 2; ++r) {
    int id = tid + 512 * r;
    offq[r] = (unsigned)(((id >> 4) * 512 + (id & 15) * 8) * 2);
    offt[r] = (unsigned)(((id >> 3) * 8192 + (id & 7) * 8) * 2);
  }
  const unsigned offv = (unsigned)(((w * 32 + c) * 8192 + 4 * hh) * 2);
  {
    const int ch = dir ? 127 : 0;
#pragma unroll
    for (int r = 0; r < 2; ++r) {
      int id = tid + 512 * r;
      rq[r] = *(const u32x4*)((const char*)(qe + (size_t)ch * 64 * 512) + offq[r]);
      rk[r] = *(const u32x4*)((const char*)(ke + (size_t)ch * 64 * 512) + offq[r]);
      rt[r] = *(const u32x4*)((const char*)(keT + ch * 64) + offt[r]);
    }
  }
#pragma unroll 1
  for (int ci = 0; ci < 128; ++ci) {
    const int ch = dir ? 127 - ci : ci;
    const size_t t0 = (size_t)b * 8192 + ch * 64;
    __syncthreads();
#pragma unroll
    for (int r = 0; r < 2; ++r) {
      int id = tid + 512 * r;
      st_perm(sQ + (id >> 4) * QLD, id & 15, rq[r]);
      st_perm(sK + (id >> 4) * QLD, id & 15, rk[r]);
      st_perm(sKT + (id >> 3) * TLD, id & 7, rt[r]);
    }
    __syncthreads();
    if (ci + 1 < 128) {
      const int chn = dir ? ch - 1 : ch + 1;
#pragma unroll
      for (int r = 0; r < 2; ++r) {
        int id = tid + 512 * r;
        rq[r] = *(const u32x4*)((const char*)(qe + (size_t)chn * 64 * 512) + offq[r]);
        rk[r] = *(const u32x4*)((const char*)(ke + (size_t)chn * 64 * 512) + offq[r]);
        rt[r] = *(const u32x4*)((const char*)(keT + chn * 64) + offt[r]);
      }
    }
    bf16x8 vf[4];
#pragma unroll
    for (int k4 = 0; k4 < 4; ++k4) vf[k4] = ld_frag8x2((const u16*)((const char*)(vT + ch * 64 + 16 * k4) + offv));
#pragma unroll 1
    for (int qt = 0; qt < 2; ++qt) {
      f32x16 oacc = zero16();
#pragma unroll
      for (int ks = 0; ks < 8; ++ks) {
        bf16x8 sf = pack_step(st[ks >> 1], ks & 1);
        bf16x8 q0 = ld_frag16(sQ + (qt * 32 + c) * QLD + ks * 16 + 8 * hh);
        oacc = MFMA(q0, sf, oacc);
        if (ks & 1) __builtin_amdgcn_sched_barrier(0);
      }
#pragma unroll
      for (int kt = 0; kt < 2; ++kt) {
        bool skip = dir ? (kt < qt) : (kt > qt);
        if (skip) continue;
        f32x16 X = zero16();
#pragma unroll 1
        for (int ks = 0; ks < 8; ++ks) {
          bf16x8 kf = ld_frag16(sK + (kt * 32 + c) * QLD + ks * 16 + 8 * hh);
          bf16x8 qf = ld_frag16(sQ + (qt * 32 + c) * QLD + ks * 16 + 8 * hh);
          X = MFMA(kf, qf, X);
        }
        if (kt == qt) {
#pragma unroll
          for (int i = 0; i < 16; ++i) {
            int key = crow(i, hh);
            bool keep = dir ? (key >= c) : (key <= c);
            X[i] = keep ? X[i] : 0.f;
          }
        }
        oacc = MFMA(pack_step(X, 0), vf[kt * 2 + 0], oacc);
        oacc = MFMA(pack_step(X, 1), vf[kt * 2 + 1], oacc);
        __builtin_amdgcn_sched_barrier(0);
      }
#pragma unroll
      for (int i = 0; i < 16; ++i)
        o[(t0 + qt * 32 + crow(i, hh)) * 1024 + h * 256 + slice * 32 + c] = f2bf(oacc[i]);
      __builtin_amdgcn_sched_barrier(0);
    }
#pragma unroll
    for (int dt = 0; dt < 4; ++dt) {
#pragma unroll
      for (int k4 = 0; k4 < 4; ++k4) {
        bf16x8 kt_f = ld_frag16(sKT + (dt * 32 + c) * TLD + 16 * k4 + 8 * hh);
        st[dt] = MFMA(kt_f, vf[k4], st[dt]);
      }
#pragma unroll
      for (int gg = 0; gg < 4; ++gg) {
        float4 dv = *(const float4*)(dec + (size_t)ch * 512 + dt * 32 + 8 * gg + 4 * hh);
        st[dt][4 * gg + 0] *= dv.x; st[dt][4 * gg + 1] *= dv.y; st[dt][4 * gg + 2] *= dv.z; st[dt][4 * gg + 3] *= dv.w;
      }
      __builtin_amdgcn_sched_barrier(0);
    }
  }
}

constexpr int KLD = 136, VLD = 72;
constexpr int ATT_BUF = 64 * KLD + 128 * VLD;
DI void attn_item(const Params& p, int item, char* smem, int tid) {
  const int qb = item & 63, bh = item >> 6;
  const int b = bh >> 3, h = bh & 7;
  const int w = tid >> 6, lane = tid & 63, c = lane & 31, hh = lane >> 5;
  const int qg = w & 3, mp = w >> 2;
  u16* sbase = (u16*)smem;
  float* sex = (float*)(smem + 2 * ATT_BUF * 2);
  const size_t tq = (size_t)b * 8192 + qb * 128 + qg * 32 + c;
  bf16x8 qf[4];
#pragma unroll
  for (int s = 0; s < 4; ++s) qf[s] = ld_frag16(p.dq + tq * 1024 + h * 128 + mp * 64 + 16 * s + 8 * hh);
  f32x16 O[4];
#pragma unroll
  for (int dt = 0; dt < 4; ++dt) O[dt] = zero16();
  float lrun = 0.f;
  float negmb;
  {
    float qn = 0.f;
#pragma unroll
    for (int s = 0; s < 4; ++s) {
      u32x4 qq = __builtin_bit_cast(u32x4, qf[s]);
#pragma unroll
      for (int i = 0; i < 4; ++i) { float x0 = bflo(qq[i]), x1 = bfhi(qq[i]); qn += x0 * x0 + x1 * x1; }
    }
    qn += __shfl_xor(qn, 32);
    float kn = __int_as_float(p.kmax[(b * 8 + h) * 2 + mp]);
    float mb = sqrtf(qn * kn) * 1.01f + 1e-3f;
    negmb = -mb;
  }
  const u16* Kg = p.dk + (size_t)b * 8192 * 1024 + h * 128;
  const u16* Vg = p.dvT + (size_t)bh * 128 * 8192;
  u32x4 rk[2], rv[2];
#pragma unroll
  for (int r = 0; r < 2; ++r) {
    int id = tid + 512 * r;
    rk[r] = *(const u32x4*)(Kg + (size_t)(id >> 4) * 1024 + (id & 15) * 8);
    rv[r] = *(const u32x4*)(Vg + (size_t)(id >> 3) * 8192 + (id & 7) * 8);
  }
  __syncthreads();
#pragma unroll
  for (int r = 0; r < 2; ++r) {
    int id = tid + 512 * r;
    *(u32x4*)(sbase + (id >> 4) * KLD + (id & 15) * 8) = rk[r];
    st_perm(sbase + 64 * KLD + (id >> 3) * VLD, id & 7, rv[r]);
  }
#pragma unroll
  for (int r = 0; r < 2; ++r) {
    int id = tid + 512 * r;
    rk[r] = *(const u32x4*)(Kg + (size_t)(64 + (id >> 4)) * 1024 + (id & 15) * 8);
    rv[r] = *(const u32x4*)(Vg + (size_t)(id >> 3) * 8192 + 64 + (id & 7) * 8);
  }
  __syncthreads();
#pragma unroll 1
  for (int kt = 0; kt < 128; ++kt) {
    const u16* sK = sbase + (kt & 1) * ATT_BUF;
    const u16* sV = sK + 64 * KLD;
    if (kt + 1 < 128) {
      u16* nK = sbase + ((kt + 1) & 1) * ATT_BUF;
      u16* nV = nK + 64 * KLD;
#pragma unroll
      for (int r = 0; r < 2; ++r) {
        int id = tid + 512 * r;
        *(u32x4*)(nK + (id >> 4) * KLD + (id & 15) * 8) = rk[r];
        st_perm(nV + (id >> 3) * VLD, id & 7, rv[r]);
      }
      if (kt + 2 < 128) {
#pragma unroll
        for (int r = 0; r < 2; ++r) {
          int id = tid + 512 * r;
          rk[r] = *(const u32x4*)(Kg + (size_t)((kt + 2) * 64 + (id >> 4)) * 1024 + (id & 15) * 8);
          rv[r] = *(const u32x4*)(Vg + (size_t)(id >> 3) * 8192 + (kt + 2) * 64 + (id & 7) * 8);
        }
      }
    }
    f32x16 sacc[2];
    bf16x8 kf[8];
#pragma unroll
    for (int s = 0; s < 4; ++s)
#pragma unroll
      for (int k2 = 0; k2 < 2; ++k2) kf[s * 2 + k2] = ld_frag16(sK + (k2 * 32 + c) * KLD + mp * 64 + 16 * s + 8 * hh);
    __builtin_amdgcn_sched_barrier(0);
#pragma unroll
    for (int i = 0; i < 16; ++i) { sacc[0][i] = negmb; sacc[1][i] = negmb; }
#pragma unroll
    for (int s = 0; s < 4; ++s) {
      sacc[0] = MFMA(kf[s * 2 + 0], qf[s], sacc[0]);
      sacc[1] = MFMA(kf[s * 2 + 1], qf[s], sacc[1]);
    }
    bf16x8 vfA[4], vfB[4];
#define VLOAD(dst, k2, s2) { _Pragma("unroll") for (int dt = 0; dt < 4; ++dt) dst[dt] = ld_frag16(sV + (dt * 32 + c) * VLD + (k2) * 32 + (s2) * 16 + 8 * hh); }
#define PVMM(vf, pf) { _Pragma("unroll") for (int dt = 0; dt < 4; ++dt) O[dt] = MFMA(vf[dt], pf, O[dt]); }
#define EXPS(k2) { _Pragma("unroll") for (int i = 0; i < 8; ++i) { \
        float e0 = __builtin_amdgcn_exp2f(sacc[k2][2 * i]), e1 = __builtin_amdgcn_exp2f(sacc[k2][2 * i + 1]); \
        sacc[k2][2 * i] = e0; sacc[k2][2 * i + 1] = e1; f32x2_t ev = {e0, e1}; ls2 += ev; } }
    VLOAD(vfA, 0, 0);
    __builtin_amdgcn_sched_barrier(0);
    f32x2_t ls2 = {0.f, 0.f};
    EXPS(0);
    bf16x8 p0 = pack_step(sacc[0], 0), p1 = pack_step(sacc[0], 1);
    __builtin_amdgcn_sched_barrier(0);
    VLOAD(vfB, 0, 1);
    PVMM(vfA, p0);
    __builtin_amdgcn_sched_barrier(0);
    VLOAD(vfA, 1, 0);
    PVMM(vfB, p1);
    __builtin_amdgcn_sched_barrier(0);
    EXPS(1);
    p0 = pack_step(sacc[1], 0); p1 = pack_step(sacc[1], 1);
    __builtin_amdgcn_sched_barrier(0);
    VLOAD(vfB, 1, 1);
    PVMM(vfA, p0);
    __builtin_amdgcn_sched_barrier(0);
    PVMM(vfB, p1);
    lrun += ls2[0] + ls2[1];
#undef VLOAD
#undef PVMM
#undef EXPS
    __syncthreads();
  }
  float ltot = lrun + __shfl_xor(lrun, 32);
  if (mp == 1) {
    float sc = p.lam[0] / ltot;
#pragma unroll
    for (int dt = 0; dt < 4; ++dt)
#pragma unroll
      for (int i = 0; i < 16; ++i) sex[(qg * 64 + dt * 16 + i) * 64 + lane] = O[dt][i] * sc;
  }
  __syncthreads();
  if (mp == 0) {
    float i0 = 1.f / ltot;
    float ss = 0.f;
#pragma unroll
    for (int dt = 0; dt < 4; ++dt)
#pragma unroll
      for (int i = 0; i < 16; ++i) { float v = O[dt][i] * i0 - sex[(qg * 64 + dt * 16 + i) * 64 + lane]; O[dt][i] = v; ss += v * v; }
    ss += __shfl_xor(ss, 32);
    float rstd = rsqrtf(ss * (1.f / 128.f) + RMS_EPS) * 0.8f;
#pragma unroll
    for (int dt = 0; dt < 4; ++dt)
#pragma unroll
      for (int g = 0; g < 4; ++g) {
        int dv = dt * 32 + 8 * g + 4 * hh;
        float4 gg = *(const float4*)(p.diff_norm_g + h * 128 + dv);
        u32x2 v = {pack2(O[dt][4 * g] * rstd * gg.x, O[dt][4 * g + 1] * rstd * gg.y),
                   pack2(O[dt][4 * g + 2] * rstd * gg.z, O[dt][4 * g + 3] * rstd * gg.w)};
        *(u32x2*)(p.dq + tq * 1024 + h * 128 + dv) = v;
      }
  }
}

DI void phase_mixers(const Params& p, char* smem, int tid) {
  if (blockIdx.x < 32) gla_scan_block(p, blockIdx.x, smem, opq(tid));
  xcd_queue(p.counter + 56, 256, smem, tid, [&](int xq, int qn) {
    const int bh = xq + 8 * (qn >> 6);
    attn_item(p, bh * 64 + (qn & 63), smem, opq(tid));
  });
}

DI void phase_post_mixers(const Params& p, int tid) {
  int w = tid >> 6, lane = tid & 63;
  for (int row = blockIdx.x * 8 + w; row < T; row += gridDim.x * 8) {
#pragma unroll
    for (int hd = 0; hd < 4; ++hd) {
      u32x2 a = *(const u32x2*)(p.o_fw + (size_t)row * 1024 + hd * 256 + lane * 4);
      u32x2 bq = *(const u32x2*)(p.o_bw + (size_t)row * 1024 + hd * 256 + lane * 4);
      float v0 = bflo(a[0]) + bflo(bq[0]), v1 = bfhi(a[0]) + bfhi(bq[0]), v2 = bflo(a[1]) + bflo(bq[1]), v3 = bfhi(a[1]) + bfhi(bq[1]);
      float ss = wave_sum(v0 * v0 + v1 * v1 + v2 * v2 + v3 * v3);
      if (lane == 0) p.rstd[row * 4 + hd] = rsqrtf(ss * (1.f / 256.f) + RMS_EPS);
    }
  }
  phase_norm_mod(p.x, p.norm1_g, p.mod, 0, 1024, p.hA, tid);
  for (int row = blockIdx.x * 8 + w; row < 32768; row += gridDim.x * 8) {
    const bool isv = row >= 16384;
    const int r = row & 16383;
    const float* srcp = (isv ? p.peer_v : p.peer_u) + (size_t)r * 1024 + lane * 16;
    float4 a0 = *(const float4*)(srcp), a1 = *(const float4*)(srcp + 4), a2 = *(const float4*)(srcp + 8), a3 = *(const float4*)(srcp + 12);
    float am = fmaxf(fmaxf(fmaxf(fabsf(a0.x), fabsf(a0.y)), fmaxf(fabsf(a0.z), fabsf(a0.w))), fmaxf(fmaxf(fabsf(a1.x), fabsf(a1.y)), fmaxf(fabsf(a1.z), fabsf(a1.w))));
    am = fmaxf(am, fmaxf(fmaxf(fmaxf(fabsf(a2.x), fabsf(a2.y)), fmaxf(fabsf(a2.z), fabsf(a2.w))), fmaxf(fmaxf(fabsf(a3.x), fabsf(a3.y)), fmaxf(fabsf(a3.z), fabsf(a3.w)))));
#pragma unroll
    for (int o = 32; o >= 1; o >>= 1) am = fmaxf(am, __shfl_xor(am, o));
    am = fmaxf(am, 1e-30f);
    const float sc = 256.f / am;
    u32x4 v;
    int t0 = __builtin_amdgcn_cvt_pk_fp8_f32(a0.x * sc, a0.y * sc, 0, false); t0 = __builtin_amdgcn_cvt_pk_fp8_f32(a0.z * sc, a0.w * sc, t0, true);
    int t1 = __builtin_amdgcn_cvt_pk_fp8_f32(a1.x * sc, a1.y * sc, 0, false); t1 = __builtin_amdgcn_cvt_pk_fp8_f32(a1.z * sc, a1.w * sc, t1, true);
    int t2 = __builtin_amdgcn_cvt_pk_fp8_f32(a2.x * sc, a2.y * sc, 0, false); t2 = __builtin_amdgcn_cvt_pk_fp8_f32(a2.z * sc, a2.w * sc, t2, true);
    int t3 = __builtin_amdgcn_cvt_pk_fp8_f32(a3.x * sc, a3.y * sc, 0, false); t3 = __builtin_amdgcn_cvt_pk_fp8_f32(a3.z * sc, a3.w * sc, t3, true);
    v[0] = (unsigned)t0; v[1] = (unsigned)t1; v[2] = (unsigned)t2; v[3] = (unsigned)t3;
    unsigned char* dst = (unsigned char*)(isv ? p.vB : p.uB) + (size_t)r * 1024 + lane * 16;
    *(u32x4*)dst = v;
    if (lane == 0) (isv ? p.vs : p.us)[r] = am * (1.f / 256.f);
  }
}

DI void phase_gr(const Params& p, char* smem, int tid) {
  const int w = tid >> 6, lane_inv = tid & 63;
  const int wm = w >> 2, wn = w & 3;
  float* wl = wave_stage(smem, w);
  xcd_static(p, 16 * 12, smem, [&](int xq, int qn) {
    int mt = xq + 8 * (qn / 12), nt = qn % 12;
    int m0 = mt * 256, n0 = nt * 256;
    f32x16 acc[4][2]; zero_acc(acc);
    gemm_kloop(p.hA + (size_t)m0 * 1024, 1024, p.wgrT + (size_t)n0 * 1024, 1024, 1024, acc, (u16*)smem, opq(tid));
    const int lane = opq(lane_inv);
    const int c = lane & 31, hh = lane >> 5;
#pragma unroll
    for (int half = 0; half < 2; ++half) {
      const int rb = m0 + wm * 128 + half * 64;
      stage_acc<EPS>(acc, half, wl, c, hh);
      if (n0 < 1024) {
        const int cb = n0 + wn * 64;
        epi_rows(wl, lane, [&](int r, int cc, float (&v)[8]) {
          const size_t off = (size_t)(rb + r) * 1024 + cb + cc;
          float of[8], ob[8];
          ld_bf16x8(p.o_fw + off, of); ld_bf16x8(p.o_bw + off, ob);
          const float rs = p.rstd[(rb + r) * 4 + ((cb + cc) >> 8)];
          float4 g0 = *(const float4*)(p.gla_norm_g + cb + cc), g1 = *(const float4*)(p.gla_norm_g + cb + cc + 4);
          const float gg[8] = {g0.x, g0.y, g0.z, g0.w, g1.x, g1.y, g1.z, g1.w};
#pragma unroll
          for (int j = 0; j < 8; ++j) { float a = v[j]; v[j] = (of[j] + ob[j]) * rs * gg[j] * (a / (1.f + __expf(-a))); }
          st_bf16x8(p.A1 + off, v);
        });
      } else {
        u16* dst = ((n0 < 2048) ? p.sga : p.sgb) + (size_t)rb * 1024 + (n0 & 1023) + wn * 64;
        epi_rows(wl, lane, [&](int r, int cc, float (&v)[8]) {
#pragma unroll
          for (int j = 0; j < 8; ++j) v[j] = 1.f / (1.f + __expf(-v[j]));
          st_bf16x8(dst + (size_t)r * 1024 + cc, v);
        });
      }
    }
  });
}

DI void phase_merge(const Params& p, char* smem, int tid) {
  const int w = tid >> 6, lane_inv = tid & 63;
  const int wm = w >> 2, wn = w & 3;
  float* wl = wave_stage(smem, w);
  xcd_static(p, 16 * 4, smem, [&](int xq, int qn) {
    int mt = xq + 8 * (qn >> 2), nt = qn & 3;
    int m0 = mt * 256, n0 = nt * 256;
    f32x16 acc[4][2];
    zero_acc(acc);
    gemm_kloop(p.A1 + (size_t)m0 * 1024, 1024, p.wglaT + (size_t)n0 * 1024, 1024, 1024, acc, (u16*)smem, opq(tid));
    {
      const int lane = opq(lane_inv);
      const int c = lane & 31, hh = lane >> 5;
#pragma unroll
      for (int half = 0; half < 2; ++half) {
        const size_t tb = (size_t)(m0 + wm * 128 + half * 64) * 1024 + n0 + wn * 64;
        stage_acc<EPS>(acc, half, wl, c, hh);
        epi_rows(wl, lane, [&](int r, int cc, float (&v)[8]) {
          float gv[8];
          ld_bf16x8(p.sga + tb + (size_t)r * 1024 + cc, gv);
#pragma unroll
          for (int j = 0; j < 8; ++j) v[j] *= gv[j];
          st_bf16x8(p.sga + tb + (size_t)r * 1024 + cc, v);
        });
      }
    }
    zero_acc(acc);
    gemm_kloop(p.dq + (size_t)m0 * 1024, 1024, p.wdiffT + (size_t)n0 * 1024, 1024, 1024, acc, (u16*)smem, opq(tid));
    {
      const int lane = opq(lane_inv);
      const int c = lane & 31, hh = lane >> 5;
#pragma unroll
      for (int half = 0; half < 2; ++half) {
        const size_t tb = (size_t)(m0 + wm * 128 + half * 64) * 1024 + n0 + wn * 64;
        stage_acc<EPS>(acc, half, wl, c, hh);
        epi_rows(wl, lane, [&](int r, int cc, float (&v)[8]) {
          float gv[8], mv[8];
          ld_bf16x8(p.sgb + tb + (size_t)r * 1024 + cc, gv);
          ld_bf16x8(p.sga + tb + (size_t)r * 1024 + cc, mv);
#pragma unroll
          for (int j = 0; j < 8; ++j) v[j] = mv[j] + v[j] * gv[j];
          st_bf16x8(p.merged + tb + (size_t)r * 1024 + cc, v);
        });
      }
    }
  });
}

DI void phase_out(const Params& p, char* smem, int tid) {
  const int w = tid >> 6, lane_inv = tid & 63;
  const int wm = w >> 2, wn = w & 3;
  float* wl = wave_stage(smem, w);
  xcd_static(p, 16 * 4, smem, [&](int xq, int qn) {
    int mt = xq + 8 * (qn >> 2), nt = qn & 3;
    int m0 = mt * 256, n0 = nt * 256;
    f32x16 acc[4][2]; zero_acc(acc);
    gemm_kloop(p.merged + (size_t)m0 * 1024, 1024, p.woutT + (size_t)n0 * 1024, 1024, 1024, acc, (u16*)smem, opq(tid));
    const int lane = opq(lane_inv);
    const int c = lane & 31, hh = lane >> 5;
    const int b = m0 >> 13;
    const int cb = n0 + wn * 64;
#pragma unroll
    for (int half = 0; half < 2; ++half) {
      const size_t tb = (size_t)(m0 + wm * 128 + half * 64) * 1024 + cb;
      stage_acc<EPS>(acc, half, wl, c, hh);
      epi_rows(wl, lane, [&](int r, int cc, float (&v)[8]) {
        const float* xp = p.x + tb + (size_t)r * 1024 + cc;
        const float* gp = p.mod + b * 6144 + 2048 + cb + cc;
        float4 x0 = *(const float4*)xp, x1v = *(const float4*)(xp + 4);
        float4 g0 = *(const float4*)gp, g1 = *(const float4*)(gp + 4);
        float4 o0 = {x0.x + g0.x * v[0], x0.y + g0.y * v[1], x0.z + g0.z * v[2], x0.w + g0.w * v[3]};
        float4 o1 = {x1v.x + g1.x * v[4], x1v.y + g1.y * v[5], x1v.z + g1.z * v[6], x1v.w + g1.w * v[7]};
        float* op = p.x1 + tb + (size_t)r * 1024 + cc;
        *(float4*)op = o0; *(float4*)(op + 4) = o1;
      });
    }
  });
}

DI void phase_peerq(const Params& p, char* smem, int tid) {
  const int w = tid >> 6, lane_inv = tid & 63;
  const int wm = w >> 2, wn = w & 3;
  float* wl = wave_stage(smem, w);
  xcd_static(p, 16 * 8, smem, [&](int xq, int qn) {
    int mt = xq + 8 * (qn >> 3), nt = qn & 7;
    int m0 = mt * 256, n0 = nt * 256;
    f32x16 acc[4][2]; zero_acc(acc);
    gemm_kloop(p.h2 + (size_t)m0 * 1024, 1024, p.wqT + (size_t)n0 * 1024, 1024, 1024, acc, (u16*)smem, opq(tid));
    const int lane = opq(lane_inv);
    const int c = lane & 31, hh = lane >> 5;
#pragma unroll
    for (int half = 0; half < 2; ++half) {
      u16* dst = p.qp + (size_t)(m0 + wm * 128 + half * 64) * 2048 + n0 + wn * 64;
      stage_acc<EPS>(acc, half, wl, c, hh);
      epi_rows(wl, lane, [&](int r, int cc, float (&v)[8]) { st_bf16x8(dst + (size_t)r * 2048 + cc, v); });
    }
  });
}

DI unsigned fkey(float f) { unsigned u = __float_as_uint(f); return (u & 0x80000000u) ? ~u : (u | 0x80000000u); }
DI void phase_topk(const Params& p, char* smem, int tid) {
  float* sc = (float*)smem;
  float* ts = sc + 64 * 132;
  int* ti = (int*)(ts + 64 * 32);
  const int w = tid >> 6, lane = tid & 63, c = lane & 31, hh = lane >> 5;
  const int l16 = tid & 15, grp = tid >> 4;
  const int nt = w & 3, mt = w >> 2;
  bf16x8 af[8], bfq[8];
#define TK_LOAD(item_, pp_) { const int h_ = (item_) & 7; const u16* Aq_ = p.qp + (size_t)((item_) >> 3) * 64 * 2048 + h_ * 256 + (pp_) * 128; \
    const u16* Bk_ = p.subk + (size_t)(h_ * 2 + (pp_)) * 128 * 128; \
    _Pragma("unroll") for (int s = 0; s < 8; ++s) { bfq[s] = ld_frag16(Bk_ + (32 * nt + c) * 128 + 16 * s + 8 * hh); af[s] = ld_frag16(Aq_ + (size_t)(32 * mt + c) * 2048 + 16 * s + 8 * hh); } }
  if (blockIdx.x < 4096) TK_LOAD(blockIdx.x, 0);
  for (int item = blockIdx.x; item < 4096; item += gridDim.x) {
    const int h = item & 7;
    const size_t t0 = (size_t)(item >> 3) * 64;
#pragma unroll 1
    for (int pp = 0; pp < 2; ++pp) {
      f32x16 acc = zero16();
      {
        f32x16 acc2 = zero16();
#pragma unroll
        for (int s = 0; s < 8; s += 2) { acc = MFMA(af[s], bfq[s], acc); acc2 = MFMA(af[s + 1], bfq[s + 1], acc2); }
#pragma unroll
        for (int i = 0; i < 16; ++i) acc[i] += acc2[i];
      }
      if (pp == 0) { TK_LOAD(item, 1); }
      else { const int nitem = item + gridDim.x; if (nitem < 4096) TK_LOAD(nitem, 0); }
      __syncthreads();
#pragma unroll
      for (int i = 0; i < 16; ++i) sc[(mt * 32 + crow(i, hh)) * 132 + 32 * nt + c] = acc[i];
      __syncthreads();
      unsigned k[2][8], sel[2];
#pragma unroll
      for (int rr = 0; rr < 2; ++rr) {
        sel[rr] = 0;
#pragma unroll
        for (int m = 0; m < 8; ++m) { int n = l16 + 16 * m; k[rr][m] = (fkey(sc[(grp + 32 * rr) * 132 + n]) & ~127u) | (unsigned)(127 - n); }
      }
#pragma unroll 1
      for (int round = 0; round < 16; ++round) {
#pragma unroll
        for (int rr = 0; rr < 2; ++rr) {
          unsigned mx = max(max(max(k[rr][0], k[rr][1]), max(k[rr][2], k[rr][3])), max(max(k[rr][4], k[rr][5]), max(k[rr][6], k[rr][7])));
          mx = gmax16(mx);
          sel[rr] = (l16 == round) ? mx : sel[rr];
#pragma unroll
          for (int m = 0; m < 8; ++m) k[rr][m] = (k[rr][m] == mx) ? 0u : k[rr][m];
        }
      }
#pragma unroll
      for (int rr = 0; rr < 2; ++rr) {
        const int row = grp + 32 * rr;
        int n = 127 - (int)(sel[rr] & 127u);
        ti[(row * 2 + pp) * 16 + l16] = n;
        ts[(row * 2 + pp) * 16 + l16] = sc[row * 132 + n];
      }
    }
    __syncthreads();
    {
      float s0v[2]; int ptr[2]; unsigned selk[2];
#pragma unroll
      for (int rr = 0; rr < 2; ++rr) { s0v[rr] = ts[((grp + 32 * rr) * 2) * 16 + l16]; ptr[rr] = 0; selk[rr] = 0; }
#pragma unroll 1
      for (int round = 0; round < 16; ++round) {
#pragma unroll
        for (int rr = 0; rr < 2; ++rr) {
          const int row = grp + 32 * rr;
          float v = s0v[rr] + ts[(row * 2 + 1) * 16 + (ptr[rr] & 15)];
          unsigned key = (ptr[rr] < 16) ? ((fkey(v) & ~255u) | (unsigned)(255 - (l16 * 16 + ptr[rr]))) : 0u;
          unsigned mx = gmax16(key);
          selk[rr] = (l16 == round) ? mx : selk[rr];
          int aw = (255 - (int)(mx & 255u)) >> 4;
          ptr[rr] += (l16 == aw) ? 1 : 0;
        }
      }
#pragma unroll
      for (int rr = 0; rr < 2; ++rr) {
        const int row = grp + 32 * rr;
        int flat = 255 - (int)(selk[rr] & 255u);
        int aw = flat >> 4, bw = flat & 15;
        int my_idx = ti[(row * 2) * 16 + aw] * 128 + ti[(row * 2 + 1) * 16 + bw];
        float my_s = ts[(row * 2) * 16 + aw] + ts[(row * 2 + 1) * 16 + bw];
        float mxs = gmaxf16(my_s);
        float e = __expf(my_s - mxs);
        float sum = gsum16(e);
        p.idx[(t0 + row) * 128 + h * 16 + l16] = my_idx;
        p.g[(t0 + row) * 128 + h * 16 + l16] = e / sum;
      }
    }
    __syncthreads();
  }
#undef TK_LOAD
}

DI void peer_load_batch(const unsigned char* tab, const float* rsc, int ireg, int ebase, int q, int gq, u32x4 (&buf)[4], float (&scl)[1]) {
#pragma unroll
  for (int rr = 0; rr < 1; ++rr) {
    int e = ebase + 4 * rr + gq;
    int row = __shfl(ireg, e & 63);
    const unsigned char* rp = tab + (size_t)row * 1024 + q * 16;
#pragma unroll
    for (int j = 0; j < 4; ++j) buf[rr * 4 + j] = *(const u32x4*)(rp + j * 256);
    scl[rr] = rsc[row];
  }
}
DI void peer_u_compute(const u32x4 (&buf)[4], const float (&scl)[1], const float (&hf)[64], float* wl, int ebase, int q, int gq) {
#pragma unroll
  for (int rr = 0; rr < 1; ++rr) {
    float acc = 0.f;
#pragma unroll
    for (int j = 0; j < 4; ++j)
#pragma unroll
      for (int i = 0; i < 4; ++i) {
        f32x2_t lo = __builtin_amdgcn_cvt_pk_f32_fp8((int)buf[rr * 4 + j][i], false);
        f32x2_t hi = __builtin_amdgcn_cvt_pk_f32_fp8((int)buf[rr * 4 + j][i], true);
        acc += lo[0] * hf[j * 16 + 4 * i] + lo[1] * hf[j * 16 + 4 * i + 1] + hi[0] * hf[j * 16 + 4 * i + 2] + hi[1] * hf[j * 16 + 4 * i + 3];
      }
    acc = gsum16(acc) * scl[rr];
    float act = 0.5f * acc * (1.f + erff(acc * 0.7071067811865476f));
    if (q == 0) wl[ebase + 4 * rr + gq] = act;
  }
}
DI void peer_v_compute(const u32x4 (&buf)[4], const float (&scl)[1], float (&o)[64], const float* wl, float greg, int ebase, int gq) {
#pragma unroll
  for (int rr = 0; rr < 1; ++rr) {
    const int e = ebase + 4 * rr + gq;
    float ge = __shfl(greg, e & 63);
    float wg = wl[e] * ge * scl[rr];
#pragma unroll
    for (int j = 0; j < 4; ++j)
#pragma unroll
      for (int i = 0; i < 4; ++i) {
        f32x2_t lo = __builtin_amdgcn_cvt_pk_f32_fp8((int)buf[rr * 4 + j][i], false);
        f32x2_t hi = __builtin_amdgcn_cvt_pk_f32_fp8((int)buf[rr * 4 + j][i], true);
        o[j * 16 + 4 * i] += wg * lo[0]; o[j * 16 + 4 * i + 1] += wg * lo[1];
        o[j * 16 + 4 * i + 2] += wg * hi[0]; o[j * 16 + 4 * i + 3] += wg * hi[1];
      }
  }
}
DI void phase_peer_final(const Params& p, char* smem, int tid) {
  const int w = tid >> 6, lane = tid & 63, q = lane & 15, gq = lane >> 4;
  float* wl = (float*)smem + w * 128;
  const unsigned char* U8 = (const unsigned char*)p.uB;
  const unsigned char* V8 = (const unsigned char*)p.vB;
  for (int item = blockIdx.x; item < T / 8; item += gridDim.x) {
    const size_t t = (size_t)item * 8 + w;
    const int b = (int)(t >> 13);
    float hf[64];
#pragma unroll
    for (int j = 0; j < 4; ++j) {
      u32x4 ha = *(const u32x4*)(p.h2 + t * 1024 + (q + 16 * j) * 16);
      u32x4 hb = *(const u32x4*)(p.h2 + t * 1024 + (q + 16 * j) * 16 + 8);
#pragma unroll
      for (int i = 0; i < 4; ++i) { hf[j * 16 + 2 * i] = bflo(ha[i]); hf[j * 16 + 2 * i + 1] = bfhi(ha[i]); hf[j * 16 + 8 + 2 * i] = bflo(hb[i]); hf[j * 16 + 8 + 2 * i + 1] = bfhi(hb[i]); }
    }
    const int i0 = p.idx[t * 128 + lane], i1 = p.idx[t * 128 + 64 + lane];
    const float g0 = p.g[t * 128 + lane], g1 = p.g[t * 128 + 64 + lane];
    u32x4 bA[4], bB[4]; float sA[1], sB[1];
    peer_load_batch(U8, p.us, i0, 0, q, gq, bA, sA);
#pragma unroll 1
    for (int it = 0; it < 16; ++it) {
      const int e0 = 8 * it;
      peer_load_batch(U8, p.us, (e0 & 64) ? i1 : i0, e0 + 4, q, gq, bB, sB);
      peer_u_compute(bA, sA, hf, wl, e0, q, gq);
      if (it < 15) peer_load_batch(U8, p.us, ((e0 + 8) & 64) ? i1 : i0, e0 + 8, q, gq, bA, sA);
      else peer_load_batch(V8, p.vs, i0, 0, q, gq, bA, sA);
      peer_u_compute(bB, sB, hf, wl, e0 + 4, q, gq);
    }
    __syncthreads();
    float o[64];
#pragma unroll
    for (int i = 0; i < 64; ++i) o[i] = 0.f;
#pragma unroll 1
    for (int it = 0; it < 16; ++it) {
      const int e0 = 8 * it;
      peer_load_batch(V8, p.vs, (e0 & 64) ? i1 : i0, e0 + 4, q, gq, bB, sB);
      peer_v_compute(bA, sA, o, wl, (e0 & 64) ? g1 : g0, e0, gq);
      if (it < 15) peer_load_batch(V8, p.vs, ((e0 + 8) & 64) ? i1 : i0, e0 + 8, q, gq, bA, sA);
      peer_v_compute(bB, sB, o, wl, (e0 & 64) ? g1 : g0, e0 + 4, gq);
    }
    float h1[32];
#pragma unroll
    for (int i = 0; i < 32; ++i) {
      float send = (gq < 2) ? o[32 + i] : o[i];
      float keep = (gq < 2) ? o[i] : o[32 + i];
      h1[i] = keep + __shfl_xor(send, 32);
    }
    float fin[16];
#pragma unroll
    for (int i = 0; i < 16; ++i) {
      float send = (gq & 1) ? h1[i] : h1[16 + i];
      float keep = (gq & 1) ? h1[16 + i] : h1[i];
      fin[i] = keep + __shfl_xor(send, 16);
    }
    const int colb = (q + 16 * gq) * 16;
    float ss = 0.f;
#pragma unroll
    for (int i4 = 0; i4 < 4; ++i4) {
      float4 xa = *(const float4*)(p.x1 + t * 1024 + colb + 4 * i4);
      float4 ga = *(const float4*)(p.mod + b * 6144 + 5120 + colb + 4 * i4);
      fin[4 * i4 + 0] = xa.x + ga.x * fin[4 * i4 + 0]; fin[4 * i4 + 1] = xa.y + ga.y * fin[4 * i4 + 1];
      fin[4 * i4 + 2] = xa.z + ga.z * fin[4 * i4 + 2]; fin[4 * i4 + 3] = xa.w + ga.w * fin[4 * i4 + 3];
      ss += fin[4 * i4] * fin[4 * i4] + fin[4 * i4 + 1] * fin[4 * i4 + 1] + fin[4 * i4 + 2] * fin[4 * i4 + 2] + fin[4 * i4 + 3] * fin[4 * i4 + 3];
    }
    ss = wave_sum(ss);
    const float rstd = rsqrtf(ss * (1.f / 1024.f) + RMS_EPS);
#pragma unroll
    for (int i4 = 0; i4 < 4; ++i4) {
      int col = colb + 4 * i4;
      float4 gg = *(const float4*)(p.normf_g + col);
      float4 sh = *(const float4*)(p.fmod + b * 2048 + col);
      float4 sc = *(const float4*)(p.fmod + b * 2048 + 1024 + col);
      float4 r;
      r.x = fin[4 * i4 + 0] * rstd * gg.x * (1.f + sc.x) + sh.x;
      r.y = fin[4 * i4 + 1] * rstd * gg.y * (1.f + sc.y) + sh.y;
      r.z = fin[4 * i4 + 2] * rstd * gg.z * (1.f + sc.z) + sh.z;
      r.w = fin[4 * i4 + 3] * rstd * gg.w * (1.f + sc.w) + sh.w;
      *(float4*)(p.out + t * 1024 + col) = r;
    }
    __syncthreads();
  }
}

#define XB_TMO      128
#define XB_XCNT(j)  (256  + 64 * (j))
#define XB_XSUB(j)  (1280 + 64 * (j))
#define XB_XGEN(j)  (2304 + 64 * (j))
#define XB_TOP      3328
#define XB_TOPGEN   3392
#define XCD_BAR_WORDS 3456
#define XB_SPIN_CAP (1u << 18)
#define LAS __attribute__((address_space(3)))

__device__ __forceinline__ unsigned xb_ld(unsigned* p)              { return __hip_atomic_load(p, __ATOMIC_RELAXED, __HIP_MEMORY_SCOPE_AGENT); }
__device__ __forceinline__ unsigned xb_add(unsigned* p, unsigned v) { return __hip_atomic_fetch_add(p, v, __ATOMIC_RELAXED, __HIP_MEMORY_SCOPE_AGENT); }
__device__ __forceinline__ unsigned xb_xcc_id() { return (unsigned)__builtin_amdgcn_s_getreg((3 << 11) | 20) & 0xFu; }
#define XB_SPIN(cond, bar) do { unsigned _sp = 0; while (cond) { __builtin_amdgcn_s_sleep(1); \
    if ((++_sp & 255u) == 0u) { if (xb_ld(&(bar)[XB_TMO])) break; if (_sp > XB_SPIN_CAP) { atomicAdd(&(bar)[XB_TMO], 1u); break; } } } } while (0)

struct XcdBarrier {
    unsigned* bar; unsigned x;
    volatile LAS unsigned* st;
};

__device__ __forceinline__ XcdBarrier xcd_barrier_post(unsigned* bar, volatile LAS unsigned* st) {
    XcdBarrier b; b.bar = bar; b.x = xb_xcc_id(); b.st = st;
    if (threadIdx.x == 0) (void)xb_add(&bar[XB_XCNT(b.x)], 1u);
    return b;
}
__device__ __forceinline__ void xcd_barrier_complete(unsigned* bar, unsigned x, unsigned& nloc, unsigned& nx) {
    const unsigned G = gridDim.x * gridDim.y * gridDim.z;
    unsigned sum, cnt, mine, sp = 0u;
    for (;;) {
        sum = 0u; cnt = 0u; mine = 0u;
#pragma unroll
        for (unsigned j = 0; j < 16; ++j) { const unsigned c = xb_ld(&bar[XB_XCNT(j)]); sum += c; cnt += (c > 0u) ? 1u : 0u; mine = (j == x) ? c : mine; }
        if (sum == G) break;
        __builtin_amdgcn_s_sleep(1);
        if ((++sp & 255u) == 0u) { if (xb_ld(&bar[XB_TMO])) break; if (sp > XB_SPIN_CAP) { atomicAdd(&bar[XB_TMO], 1u); break; } }
    }
    nloc = mine > 0u ? mine : 1u; nx = cnt > 0u ? cnt : 1u;
}

__device__ __forceinline__ void xcd_barrier(const XcdBarrier& b) {
    asm volatile("s_waitcnt vmcnt(0)" ::: "memory");
    __syncthreads();
    if (threadIdx.x == 0) {
        unsigned* bar = b.bar;
        __builtin_amdgcn_s_waitcnt(0);
        unsigned nloc = b.st[0], nx = b.st[1];
        if (nloc == 0u) { xcd_barrier_complete(bar, b.x, nloc, nx); b.st[0] = nloc; b.st[1] = nx; }
        const unsigned old = xb_add(&bar[XB_XSUB(b.x)], 1u);
        const unsigned gen = old / nloc;
        if (old + 1u == (gen + 1u) * nloc) {
            __builtin_amdgcn_fence(__ATOMIC_RELEASE, "agent");
            asm volatile("s_waitcnt vmcnt(0)" ::: "memory");
            const unsigned og = xb_add(&bar[XB_TOP], 1u);
            const unsigned tg = og / nx;
            if (og + 1u == (tg + 1u) * nx) xb_add(&bar[XB_TOPGEN], 1u);
            else XB_SPIN(xb_ld(&bar[XB_TOPGEN]) == tg, bar);
            __builtin_amdgcn_fence(__ATOMIC_ACQUIRE, "agent");
            xb_add(&bar[XB_XGEN(b.x)], 1u);
            asm volatile("s_waitcnt vmcnt(0)" ::: "memory");
        } else {
            XB_SPIN(xb_ld(&bar[XB_XGEN(b.x)]) == gen, bar);
            __builtin_amdgcn_fence(__ATOMIC_ACQUIRE, "agent");
            asm volatile("s_waitcnt vmcnt(0)" ::: "memory");
        }
    }
    __syncthreads();
}

__global__ void __launch_bounds__(512) fwd_megakernel(Params p) {
  cg::grid_group grid = cg::this_grid();
  extern __shared__ __attribute__((aligned(16))) char smem[];
  const int tid = threadIdx.x;
  volatile LAS unsigned* xst = (volatile LAS unsigned*)(smem + LDS_BYTES - 16);
  if (tid == 0) { xst[0] = 0u; xst[1] = 0u; }
  __syncthreads();
  XcdBarrier xb = xcd_barrier_post(p.bar, xst);
  if (tid == 0) xst[2] = atomicAdd(p.bar + 3600 + (xb_xcc_id() & 7u) * 16, 1u);
  phase_prep(p, smem, opq(tid));
  grid.sync();
  phase_norm_mod(p.x, p.norm1_g, p.mod, 0, 1024, p.hA, opq(tid));
  xcd_barrier(xb);
  phase_proj(p, smem, opq(tid));
  xcd_barrier(xb);
  phase_gla_pre(p, smem, opq(tid));
  xcd_barrier(xb);
  phase_mixers(p, smem, opq(tid));
  xcd_barrier(xb);
  phase_post_mixers(p, opq(tid));
  xcd_barrier(xb);
  phase_gr(p, smem, opq(tid));
  xcd_barrier(xb);
  phase_merge(p, smem, opq(tid));
  xcd_barrier(xb);
  phase_out(p, smem, opq(tid));
  xcd_barrier(xb);
  phase_norm_mod(p.x1, p.norm2_g, p.mod, 3072, 4096, p.h2, opq(tid));
  xcd_barrier(xb);
  phase_peerq(p, smem, opq(tid));
  xcd_barrier(xb);
  phase_topk(p, smem, opq(tid));
  xcd_barrier(xb);
  phase_peer_final(p, smem, opq(tid));
}

extern "C" void kernel_launch(void* const* d_in, const int* in_sizes, int n_in, void* d_out, int out_size, void* d_ws,
                              size_t ws_size, hipStream_t stream) {
  static int grid_blocks = 0;
  if (!grid_blocks) {
    int dev = 0, cus = 0, per_cu = 0;
    hipGetDevice(&dev);
    hipDeviceGetAttribute(&cus, hipDeviceAttributeMultiprocessorCount, dev);
    if (hipFuncSetAttribute((const void*)fwd_megakernel, hipFuncAttributeMaxDynamicSharedMemorySize, LDS_BYTES) != hipSuccess) { fprintf(stderr, "hipFuncSetAttribute failed\n"); }
    hipOccupancyMaxActiveBlocksPerMultiprocessor(&per_cu, fwd_megakernel, 512, LDS_BYTES);
    if (per_cu < 1) per_cu = 1;
    grid_blocks = cus * per_cu;
  }
  if (ws_size < 492 * MB) { fprintf(stderr, "ws too small: %zu\n", ws_size); return; }
  Params p{};
  p.x = (const float*)d_in[0]; p.c = (const float*)d_in[1]; p.pos = (const int*)d_in[2];
  p.w_ada = (const float*)d_in[3]; p.b_ada = (const float*)d_in[4]; p.norm1_g = (const float*)d_in[5];
  p.w_in = (const float*)d_in[6]; p.wa_fw = (const float*)d_in[7]; p.ba_fw = (const float*)d_in[8];
  p.wa_bw = (const float*)d_in[9]; p.ba_bw = (const float*)d_in[10]; p.gla_norm_g = (const float*)d_in[11];
  p.lq1 = (const float*)d_in[12]; p.lk1 = (const float*)d_in[13]; p.lq2 = (const float*)d_in[14]; p.lk2 = (const float*)d_in[15];
  p.diff_norm_g = (const float*)d_in[16]; p.w_gla = (const float*)d_in[17]; p.w_diff = (const float*)d_in[18];
  p.w_out = (const float*)d_in[19]; p.norm2_g = (const float*)d_in[20]; p.peer_wq = (const float*)d_in[21];
  p.subkeys = (const float*)d_in[22]; p.peer_u = (const float*)d_in[23]; p.peer_v = (const float*)d_in[24];
  p.w_fada = (const float*)d_in[25]; p.b_fada = (const float*)d_in[26]; p.normf_g = (const float*)d_in[27];
  p.out = (float*)d_out;
  char* ws = (char*)d_ws;
  p.winT = (u16*)(ws + 0 * MB); p.wgrT = (u16*)(ws + 11 * MB); p.wgaT = (u16*)(ws + 13 * MB); p.wgbT = (u16*)(ws + 15 * MB);
  p.wglaT = (u16*)(ws + 17 * MB); p.wdiffT = (u16*)(ws + 19 * MB); p.woutT = (u16*)(ws + 21 * MB); p.wqT = (u16*)(ws + 23 * MB);
  p.subk = (u16*)(ws + 27 * MB); p.rope = (float*)(ws + 28 * MB);
  p.mod = (float*)(ws + 36 * MB); p.fmod = (float*)(ws + 36 * MB + 128 * 1024); p.lam = (float*)(ws + 36 * MB + 192 * 1024);
  p.counter = (int*)(ws + 36 * MB + 196 * 1024);
  p.kmax = (int*)(ws + 36 * MB + 200 * 1024);
  p.bar = (unsigned*)(ws + 36 * MB + 256 * 1024);
  hipMemsetAsync(p.bar, 0, 4096 * sizeof(unsigned), stream);
  p.lr = (float*)(ws + 37 * MB); p.dec = (float*)(ws + 41 * MB); p.rstd = (float*)(ws + 43 * MB);
  char* slot[9];
  for (int i = 0; i < 7; ++i) slot[i] = ws + (44 + 64 * (size_t)i) * MB;
  slot[7] = (char*)d_out; slot[8] = (char*)d_out + 64 * MB;
  p.hA = (u16*)slot[0];
  p.gq = (u16*)slot[1]; p.gk = (u16*)(slot[1] + 32 * MB);
  p.gvT = (u16*)slot[2]; p.dq = (u16*)slot[3]; p.dk = (u16*)slot[4]; p.dvT = (u16*)slot[5];
  p.qe_fw = (u16*)slot[0]; p.ke_fw = (u16*)(slot[0] + 32 * MB);
  p.qe_bw = (u16*)slot[6]; p.ke_bw = (u16*)(slot[6] + 32 * MB);
  p.keT = (u16*)slot[7];
  p.o_fw = (u16*)slot[1]; p.o_bw = (u16*)slot[8];
  p.uB = (u16*)slot[6]; p.vB = (u16*)(slot[6] + 16 * MB);
  p.A1 = (u16*)slot[2]; p.merged = (u16*)slot[4];
  p.sga = (u16*)slot[5]; p.sgb = (u16*)slot[7];
  p.x1 = (float*)slot[0];
  p.h2 = (u16*)slot[2]; p.qp = (u16*)slot[3];
  p.us = (float*)(slot[6] + 32 * MB); p.vs = (float*)(slot[6] + 33 * MB);
  p.idx = (int*)slot[5]; p.g = (float*)(slot[5] + 16 * MB);
  void* args[] = {&p};
  hipError_t e = hipLaunchCooperativeKernel((void*)fwd_megakernel, dim3(grid_blocks), dim3(512), args, LDS_BYTES, stream);
  if (e != hipSuccess) fprintf(stderr, "cooperative launch failed: %s (grid %d)\n", hipGetErrorString(e), grid_blocks);
}
```

```cpp
#include <hip/hip_runtime.h>
#include <hip/hip_cooperative_groups.h>
#include <cstdio>
namespace cg = cooperative_groups;

#define DI __device__ __forceinline__
typedef unsigned short u16;
using bf16x8 = __attribute__((ext_vector_type(8))) short;
using f32x16 = __attribute__((ext_vector_type(16))) float;
using u32x4 = __attribute__((ext_vector_type(4))) unsigned;
using u32x2 = __attribute__((ext_vector_type(2))) unsigned;
typedef __bf16 bf16x2_t __attribute__((ext_vector_type(2)));
typedef float f32x2_t __attribute__((ext_vector_type(2)));

constexpr int T = 32768, D = 1024, S = 8192;
constexpr size_t MB = 1ull << 20;
constexpr float RMS_EPS = 1e-6f;
constexpr int LDS_BYTES = 160 * 1024;
constexpr int SITEM_OFF = 150 * 1024;

#define MFMA(a, b, c) __builtin_amdgcn_mfma_f32_32x32x16_bf16((a), (b), (c), 0, 0, 0)

struct Params {
  const float *x, *c; const int* pos;
  const float *w_ada, *b_ada, *norm1_g, *w_in, *wa_fw, *ba_fw, *wa_bw, *ba_bw, *gla_norm_g;
  const float *lq1, *lk1, *lq2, *lk2, *diff_norm_g, *w_gla, *w_diff, *w_out, *norm2_g, *peer_wq, *subkeys, *peer_u, *peer_v;
  const float *w_fada, *b_fada, *normf_g;
  float* out;
  u16 *winT, *wgrT, *wgaT, *wgbT, *wglaT, *wdiffT, *woutT, *wqT, *subk;
  float* rope;
  float* mod;
  float* fmod;
  float* lam;
  int* counter;
  float* lr;
  float* dec;
  float* rstd;
  u16 *hA, *gq, *gk, *gvT, *dq, *dk, *dvT;
  u16 *qe_fw, *ke_fw, *qe_bw, *ke_bw, *keT;
  u16 *o_fw, *o_bw, *A1, *merged, *h2, *qp, *uB, *vB;
  float* x1;
  int* idx; float* g;
  float *us, *vs;
  u16 *sga, *sgb;
  unsigned* bar;
  int* kmax;
};

DI u16 f2bf(float x) { unsigned u = __float_as_uint(x); u += 0x7fffu + ((u >> 16) & 1u); return (u16)(u >> 16); }
DI float bf2f(u16 b) { return __uint_as_float(((unsigned)b) << 16); }
DI unsigned pack2(float a, float b) {
  f32x2_t v = {a, b};
  bf16x2_t r = __builtin_convertvector(v, bf16x2_t);
  return __builtin_bit_cast(unsigned, r);
}
DI float bflo(unsigned u) { return __uint_as_float(u << 16); }
DI float bfhi(unsigned u) { return __uint_as_float(u & 0xffff0000u); }
DI int crow(int i, int h) { return (i & 3) + 8 * (i >> 2) + 4 * h; }
DI bf16x8 pack_step(const f32x16& x, int s) {
  u32x4 p;
  p[0] = pack2(x[8 * s + 0], x[8 * s + 1]);
  p[1] = pack2(x[8 * s + 2], x[8 * s + 3]);
  p[2] = pack2(x[8 * s + 4], x[8 * s + 5]);
  p[3] = pack2(x[8 * s + 6], x[8 * s + 7]);
  return __builtin_bit_cast(bf16x8, p);
}
DI bf16x8 ld_frag16(const u16* p) { return __builtin_bit_cast(bf16x8, *(const u32x4*)p); }
DI bf16x8 ld_frag8x2(const u16* p) {
  u32x2 lo = *(const u32x2*)p; u32x2 hi = *(const u32x2*)(p + 8);
  u32x4 v = {lo[0], lo[1], hi[0], hi[1]};
  return __builtin_bit_cast(bf16x8, v);
}
DI void st_perm(u16* rowp, int ch, u32x4 v) {
  u16* d = rowp + (ch >> 1) * 16 + (ch & 1) * 4;
  u32x2 lo = {v[0], v[1]}, hi = {v[2], v[3]};
  *(u32x2*)d = lo;
  *(u32x2*)(d + 8) = hi;
}
DI float wave_sum(float v) {
#pragma unroll
  for (int o = 32; o >= 1; o >>= 1) v += __shfl_xor(v, o);
  return v;
}

template <int CTRL> DI float dpp_f(float v) { return __builtin_bit_cast(float, __builtin_amdgcn_update_dpp(0, __builtin_bit_cast(int, v), CTRL, 0xF, 0xF, false)); }
template <int CTRL> DI unsigned dpp_u(unsigned v) { return (unsigned)__builtin_amdgcn_update_dpp(0, (int)v, CTRL, 0xF, 0xF, false); }
DI float gsum16(float v) { v += dpp_f<0x121>(v); v += dpp_f<0x122>(v); v += dpp_f<0x124>(v); v += dpp_f<0x128>(v); return v; }
DI float gmaxf16(float v) { v = fmaxf(v, dpp_f<0x121>(v)); v = fmaxf(v, dpp_f<0x122>(v)); v = fmaxf(v, dpp_f<0x124>(v)); v = fmaxf(v, dpp_f<0x128>(v)); return v; }
DI unsigned gmax16(unsigned v) { v = max(v, dpp_u<0x121>(v)); v = max(v, dpp_u<0x122>(v)); v = max(v, dpp_u<0x124>(v)); v = max(v, dpp_u<0x128>(v)); return v; }
DI int opq(int x) { asm volatile("" : "+v"(x)); return x; }
DI f32x16 zero16() { f32x16 z; for (int i = 0; i < 16; ++i) z[i] = 0.f; return z; }

DI void tconv_tile(const float* src, int ld, int c0, int nc, u16* dst, int ct, int kt, float* sm, int tid) {
  __syncthreads();
  int cl = tid & 63, r0 = tid >> 6;
#pragma unroll
  for (int r = 0; r < 8; ++r) {
    int k = kt * 64 + r0 + 8 * r;
    int col = ct * 64 + cl;
    float v = (col < nc) ? src[(size_t)k * ld + c0 + col] : 0.f;
    sm[(r0 + 8 * r) * 65 + cl] = v;
  }
  __syncthreads();
#pragma unroll
  for (int r = 0; r < 8; ++r) {
    int col = r0 + 8 * r;
    int k = cl;
    dst[(size_t)(ct * 64 + col) * 1024 + kt * 64 + k] = f2bf(sm[k * 65 + col]);
  }
}

DI void phase_prep(const Params& p, char* smem, int tid) {
  float* sm = (float*)smem;
  const int nblk = gridDim.x, bid = blockIdx.x;
  const int NCT = 32 + 48 + 2 + 16 * 6 + 32;
  for (int it = bid; it < NCT * 16; it += nblk) {
    int ctg = it >> 4, kt = it & 15;
    const float* src; int ld, c0, nc; u16* dst; int ct;
    if (ctg < 32) { src = p.w_in; ld = 8224; c0 = 0; nc = 2048; dst = p.winT; ct = ctg; }
    else if (ctg < 80) { src = p.w_in; ld = 8224; c0 = 3104; nc = 3072; dst = p.winT + (size_t)2048 * 1024; ct = ctg - 32; }
    else if (ctg < 82) { src = p.w_in; ld = 8224; c0 = 3072; nc = 32; dst = p.winT + (size_t)5120 * 1024; ct = ctg - 80; }
    else if (ctg < 98) { src = p.w_in; ld = 8224; c0 = 2048; nc = 1024; dst = p.wgrT; ct = ctg - 82; }
    else if (ctg < 114) { src = p.w_in; ld = 8224; c0 = 6176; nc = 1024; dst = p.wgaT; ct = ctg - 98; }
    else if (ctg < 130) { src = p.w_in; ld = 8224; c0 = 7200; nc = 1024; dst = p.wgbT; ct = ctg - 114; }
    else if (ctg < 146) { src = p.w_gla; ld = 1024; c0 = 0; nc = 1024; dst = p.wglaT; ct = ctg - 130; }
    else if (ctg < 162) { src = p.w_diff; ld = 1024; c0 = 0; nc = 1024; dst = p.wdiffT; ct = ctg - 146; }
    else if (ctg < 178) { src = p.w_out; ld = 1024; c0 = 0; nc = 1024; dst = p.woutT; ct = ctg - 162; }
    else { src = p.peer_wq; ld = 2048; c0 = 0; nc = 2048; dst = p.wqT; ct = ctg - 178; }
    tconv_tile(src, ld, c0, nc, dst, ct, kt, sm, tid);
  }
  __syncthreads();
  const int gtid = bid * 512 + tid, gsz = nblk * 512;
  for (int i = gtid; i < 8 * 2 * 128 * 128; i += gsz) p.subk[i] = f2bf(p.subkeys[i]);
  for (int i = gtid; i < 128 * 1024 / 2; i += gsz) ((unsigned*)(p.winT + (size_t)5248 * 1024))[i] = 0u;
  for (int i = gtid; i < T * 32; i += gsz) {
    int t = i >> 5, d = i & 31;
    float inv = powf(10000.f, -(float)d / 32.f);
    float ang = (float)p.pos[t] * inv;
    double r = (double)ang * 0.15915494309189535;
    r -= rint(r);
    float rf = (float)r;
    p.rope[2 * i] = __builtin_amdgcn_cosf(rf);
    p.rope[2 * i + 1] = __builtin_amdgcn_sinf(rf);
  }
  if (gtid == 0) {
    float s1 = 0.f, s2 = 0.f;
    for (int i = 0; i < 64; ++i) { s1 += p.lq1[i] * p.lk1[i]; s2 += p.lq2[i] * p.lk2[i]; }
    p.lam[0] = expf(s1) - expf(s2) + 0.2f;
    for (int i = 0; i < 128; ++i) p.counter[i] = 0;
    for (int i = 0; i < 64; ++i) p.kmax[i] = 0;
  }
  {
    float* cact = sm;
    float* red = sm + 4096;
    __syncthreads();
    for (int i = tid; i < 4096; i += 512) { float v = p.c[i]; cact[i] = v / (1.f + __expf(-v)); }
    __syncthreads();
    int w = tid >> 6, lane = tid & 63;
    for (int it = bid; it < 128; it += nblk) {
      int col = it * 64 + lane;
      const float* W; int ld, cc;
      if (col < 6144) { W = p.w_ada; ld = 6144; cc = col; } else { W = p.w_fada; ld = 2048; cc = col - 6144; }
      float a0 = 0, a1 = 0, a2 = 0, a3 = 0;
#pragma unroll 8
      for (int k = w * 128; k < w * 128 + 128; ++k) {
        float wv = W[(size_t)k * ld + cc];
        a0 += cact[k] * wv; a1 += cact[1024 + k] * wv; a2 += cact[2048 + k] * wv; a3 += cact[3072 + k] * wv;
      }
      red[(w * 4 + 0) * 64 + lane] = a0; red[(w * 4 + 1) * 64 + lane] = a1;
      red[(w * 4 + 2) * 64 + lane] = a2; red[(w * 4 + 3) * 64 + lane] = a3;
      __syncthreads();
      if (tid < 256) {
        int b = w;
        float s = 0.f;
#pragma unroll
        for (int ww = 0; ww < 8; ++ww) s += red[(ww * 4 + b) * 64 + lane];
        if (col < 6144) p.mod[b * 6144 + cc] = s + p.b_ada[cc];
        else p.fmod[b * 2048 + cc] = s + p.b_fada[cc];
      }
      __syncthreads();
    }
  }
}

DI void phase_norm_mod(const float* src, const float* g, const float* mod, int sh_off, int sc_off, u16* dst, int tid) {
  int w = tid >> 6, lane = tid & 63;
  for (int row = blockIdx.x * 8 + w; row < T; row += gridDim.x * 8) {
    int b = row >> 13;
    const float* xr = src + (size_t)row * 1024;
    float4 v[4]; float ss = 0.f;
#pragma unroll
    for (int m = 0; m < 4; ++m) { v[m] = *(const float4*)(xr + (m * 64 + lane) * 4); ss += v[m].x * v[m].x + v[m].y * v[m].y + v[m].z * v[m].z + v[m].w * v[m].w; }
    ss = wave_sum(ss);
    float rstd = rsqrtf(ss * (1.f / 1024.f) + RMS_EPS);
#pragma unroll
    for (int m = 0; m < 4; ++m) {
      int col = (m * 64 + lane) * 4;
      float4 gg = *(const float4*)(g + col);
      float4 sh = *(const float4*)(mod + b * 6144 + sh_off + col);
      float4 sc = *(const float4*)(mod + b * 6144 + sc_off + col);
      float y0 = v[m].x * rstd * gg.x * (1.f + sc.x) + sh.x;
      float y1 = v[m].y * rstd * gg.y * (1.f + sc.y) + sh.y;
      float y2 = v[m].z * rstd * gg.z * (1.f + sc.z) + sh.z;
      float y3 = v[m].w * rstd * gg.w * (1.f + sc.w) + sh.w;
      u32x2 o = {pack2(y0, y1), pack2(y2, y3)};
      *(u32x2*)(dst + (size_t)row * 1024 + col) = o;
    }
  }
}

constexpr int GLD = 72;
constexpr int GSTAGE = (256 + 256) * GLD;
DI void gemm_kloop(const u16* A, int lda, const u16* Bt, int ldb, int K, f32x16 (&acc)[4][2], u16* smem, int tid) {
  const int w = tid >> 6, lane = tid & 63, c = lane & 31, hh = lane >> 5;
  const int wm = w >> 2, wn = w & 3;
  const int lrow = tid >> 3, lcol = (tid & 7) * 8;
  u32x4 ra[4], rb[4];
  const int nk = K >> 6;
#pragma unroll
  for (int r = 0; r < 4; ++r) { ra[r] = *(const u32x4*)(A + (size_t)(r * 64 + lrow) * lda + lcol); rb[r] = *(const u32x4*)(Bt + (size_t)(r * 64 + lrow) * ldb + lcol); }
  __syncthreads();
  {
    u16* sA = smem; u16* sB = smem + 256 * GLD;
#pragma unroll
    for (int r = 0; r < 4; ++r) { *(u32x4*)(sA + (r * 64 + lrow) * GLD + lcol) = ra[r]; *(u32x4*)(sB + (r * 64 + lrow) * GLD + lcol) = rb[r]; }
  }
#pragma unroll
  for (int r = 0; r < 4; ++r) { ra[r] = *(const u32x4*)(A + (size_t)(r * 64 + lrow) * lda + 64 + lcol); rb[r] = *(const u32x4*)(Bt + (size_t)(r * 64 + lrow) * ldb + 64 + lcol); }
  __syncthreads();
  for (int kt = 0; kt < nk; ++kt) {
    const u16* sA = smem + (kt & 1) * GSTAGE; const u16* sB = sA + 256 * GLD;
    if (kt + 1 < nk) {
      u16* nA = smem + ((kt + 1) & 1) * GSTAGE; u16* nB = nA + 256 * GLD;
#pragma unroll
      for (int r = 0; r < 4; ++r) { *(u32x4*)(nA + (r * 64 + lrow) * GLD + lcol) = ra[r]; *(u32x4*)(nB + (r * 64 + lrow) * GLD + lcol) = rb[r]; }
      if (kt + 2 < nk) {
#pragma unroll
        for (int r = 0; r < 4; ++r) { ra[r] = *(const u32x4*)(A + (size_t)(r * 64 + lrow) * lda + (kt + 2) * 64 + lcol); rb[r] = *(const u32x4*)(Bt + (size_t)(r * 64 + lrow) * ldb + (kt + 2) * 64 + lcol); }
      }
    }
    bf16x8 fr[1][6];
#define GLOADF(set, s) { _Pragma("unroll") for (int mi = 0; mi < 4; ++mi) fr[set][mi] = ld_frag16(sA + (wm * 128 + mi * 32 + c) * GLD + (s) * 16 + hh * 8); \
                         _Pragma("unroll") for (int ni = 0; ni < 2; ++ni) fr[set][4 + ni] = ld_frag16(sB + (wn * 64 + ni * 32 + c) * GLD + (s) * 16 + hh * 8); }
#define GMM(set) { _Pragma("unroll") for (int mi = 0; mi < 4; ++mi) _Pragma("unroll") for (int ni = 0; ni < 2; ++ni) acc[mi][ni] = MFMA(fr[set][mi], fr[set][4 + ni], acc[mi][ni]); }
#pragma unroll
    for (int s = 0; s < 4; ++s) {
      GLOADF(0, s);
      __builtin_amdgcn_sched_barrier(0);
      GMM(0);
      __builtin_amdgcn_sched_barrier(0);
    }
#undef GLOADF
#undef GMM
    __syncthreads();
  }
}
DI void zero_acc(f32x16 (&acc)[4][2]) {
#pragma unroll
  for (int a = 0; a < 4; ++a)
#pragma unroll
    for (int b = 0; b < 2; ++b) acc[a][b] = zero16();
}

constexpr int EPS = 68, EPT = 65;
__device__ __forceinline__ unsigned xb_xcc_id();

template <class F> DI void xcd_queue(int* counters, int per_xcd, char* smem, int tid, F f) {
  int* sitem = (int*)(smem + SITEM_OFF);
  const int myx = (int)xb_xcc_id() & 7;
  for (int qi = 0; qi < 8; ++qi) {
    const int xq = (myx + qi) & 7;
    for (;;) {
      __syncthreads();
      if (tid == 0) *sitem = atomicAdd(counters + xq, 1);
      __syncthreads();
      const int qn = *sitem;
      if (qn >= per_xcd) break;
      f(xq, qn);
    }
  }
}

template <class F> DI void xcd_static(const Params& p, int per_xcd, char* smem, F f) {
  const int myx = (int)xb_xcc_id() & 7;
  const int rank = (int)((volatile unsigned*)(smem + LDS_BYTES - 16))[2];
  const int nloc = (int)__hip_atomic_load(p.bar + 3600 + myx * 16, __ATOMIC_RELAXED, __HIP_MEMORY_SCOPE_AGENT);
  for (int qn = rank; qn < per_xcd; qn += nloc) f(myx, qn);
  for (int j = 0; j < 8; ++j) {
    const int nj = (int)__hip_atomic_load(p.bar + 3600 + j * 16, __ATOMIC_RELAXED, __HIP_MEMORY_SCOPE_AGENT);
    if (nj == 0) for (int qn = blockIdx.x; qn < per_xcd; qn += gridDim.x) f(j, qn);
  }
}
DI float* wave_stage(char* smem, int w) { return (float*)smem + w * (64 * EPS); }
template <int STR> DI void stage_acc(const f32x16 (&acc)[4][2], int half, float* wl, int c, int hh) {
#pragma unroll
  for (int mi = 0; mi < 2; ++mi)
#pragma unroll
    for (int ni = 0; ni < 2; ++ni)
#pragma unroll
      for (int i = 0; i < 16; ++i) wl[(mi * 32 + crow(i, hh)) * STR + ni * 32 + c] = (half ? acc[2 + mi][ni][i] : acc[mi][ni][i]);
}
DI void st_bf16x8(u16* dst, const float (&v)[8]) {
  u32x4 o = {pack2(v[0], v[1]), pack2(v[2], v[3]), pack2(v[4], v[5]), pack2(v[6], v[7])};
  *(u32x4*)dst = o;
}
DI void ld_bf16x8(const u16* srcp, float (&v)[8]) {
  u32x4 o = *(const u32x4*)srcp;
#pragma unroll
  for (int i = 0; i < 4; ++i) { v[2 * i] = bflo(o[i]); v[2 * i + 1] = bfhi(o[i]); }
}
template <class F> DI void epi_rows(const float* wl, int lane, F f) {
#pragma unroll
  for (int ps = 0; ps < 8; ++ps) {
    const int r = (lane >> 3) + 8 * ps, cc = (lane & 7) * 8;
    float4 v0 = *(const float4*)(wl + r * EPS + cc), v1 = *(const float4*)(wl + r * EPS + cc + 4);
    float v[8] = {v0.x, v0.y, v0.z, v0.w, v1.x, v1.y, v1.z, v1.w};
    f(r, cc, v);
  }
}
DI void epi_cols_bf16(const float* wl, int lane, u16* dstT, size_t ldt) {
#pragma unroll
  for (int ps = 0; ps < 8; ++ps) {
    const int col = (lane >> 3) + 8 * ps, r0 = (lane & 7) * 8;
    float v[8];
#pragma unroll
    for (int j = 0; j < 8; ++j) v[j] = wl[(r0 + j) * EPT + col];
    st_bf16x8(dstT + (size_t)col * ldt + r0, v);
  }
}

DI void phase_proj(const Params& p, char* smem, int tid) {
  const int w = tid >> 6, lane_inv = tid & 63;
  const int wm = w >> 2, wn = w & 3;
  float* wl = wave_stage(smem, w);
  const int NT = 21;
  xcd_static(p, 16 * NT, smem, [&](int xq, int qn) {
    int mt = xq + 8 * (qn / NT), nt = qn % NT;
    int m0 = mt * 256, n0 = nt * 256;
    f32x16 acc[4][2]; zero_acc(acc);
    gemm_kloop(p.hA + (size_t)m0 * 1024, 1024, p.winT + (size_t)n0 * 1024, 1024, 1024, acc, (u16*)smem, opq(tid));
    const int lane = opq(lane_inv);
    const int c = lane & 31, hh = lane >> 5;
    const int cb = n0 + wn * 64;
#pragma unroll
    for (int half = 0; half < 2; ++half) {
      const int rb = m0 + wm * 128 + half * 64;
      if (n0 < 1024) {
        const float sc = (n0 < 512) ? 0.08838834764831845f : 1.f;
        u16* dst = ((n0 < 512) ? p.gq : p.gk) + (size_t)rb * 512 + (cb & 511);
        stage_acc<EPS>(acc, half, wl, c, hh);
        epi_rows(wl, lane, [&](int r, int cc, float (&v)[8]) {
#pragma unroll
          for (int j = 0; j < 8; ++j) v[j] *= sc;
          st_bf16x8(dst + (size_t)r * 512 + cc, v);
        });
      } else if (n0 < 2048 || (n0 >= 4096 && n0 < 5120)) {
        const bool isg = n0 < 2048;
        const int b = rb >> 13;
        u16* dstT;
        if (isg) { int cc0 = cb - 1024; dstT = p.gvT + ((size_t)(b * 4 + (cc0 >> 8)) * 256 + (cc0 & 255)) * 8192 + (rb & 8191); }
        else { int cc0 = cb - 4096; dstT = p.dvT + ((size_t)(b * 8 + (cc0 >> 7)) * 128 + (cc0 & 127)) * 8192 + (rb & 8191); }
        stage_acc<EPT>(acc, half, wl, c, hh);
        epi_cols_bf16(wl, lane, dstT, 8192);
      } else if (n0 < 4096) {
        const bool isq = n0 < 3072;
        const float sc = isq ? (0.125f * 1.4426950408889634f) : 1.f;
        const int cbb = cb - (isq ? 2048 : 3072);
        float knmax = 0.f;
#pragma unroll
        for (int mi = 0; mi < 2; ++mi)
#pragma unroll
          for (int i = 0; i < 16; ++i) {
            int row = rb + mi * 32 + crow(i, hh);
            float2 cs = *(const float2*)(p.rope + ((size_t)row * 32 + c) * 2);
            float x1 = half ? acc[2 + mi][0][i] : acc[mi][0][i], x2 = half ? acc[2 + mi][1][i] : acc[mi][1][i];
            float o1 = (x1 * cs.x - x2 * cs.y) * sc;
            float o2 = (x2 * cs.x + x1 * cs.y) * sc;
            wl[(mi * 32 + crow(i, hh)) * EPS + c] = o1;
            wl[(mi * 32 + crow(i, hh)) * EPS + 32 + c] = o2;
            if (!isq) {
              float ssq = o1 * o1 + o2 * o2;
              ssq += __shfl_xor(ssq, 1); ssq += __shfl_xor(ssq, 2); ssq += __shfl_xor(ssq, 4); ssq += __shfl_xor(ssq, 8); ssq += __shfl_xor(ssq, 16);
              knmax = fmaxf(knmax, ssq);
            }
            if ((i & 3) == 3) __builtin_amdgcn_sched_barrier(0);
          }
        if (!isq && c == 0) atomicMax(p.kmax + ((rb >> 13) * 8 + (cbb >> 7)) * 2 + ((cbb >> 6) & 1), __float_as_int(knmax));
        u16* dst = (isq ? p.dq : p.dk) + (size_t)rb * 1024 + cbb;
        epi_rows(wl, lane, [&](int r, int cc, float (&v)[8]) { st_bf16x8(dst + (size_t)r * 1024 + cc, v); });
      } else {
        if (wn == 0) {
#pragma unroll
          for (int mi = 0; mi < 2; ++mi)
#pragma unroll
            for (int i = 0; i < 16; ++i) {
              int row = rb + mi * 32 + crow(i, hh);
              p.lr[(size_t)row * 32 + c] = half ? acc[2 + mi][0][i] : acc[mi][0][i];
            }
        }
      }
    }
  });
}

DI float logsig(float x) { return fminf(x, 0.f) - __logf(1.f + __expf(-fabsf(x))); }

DI void phase_gla_pre(const Params& p, char* smem, int tid) {
  float* slr = (float*)smem;
  for (int it = blockIdx.x; it < 1024; it += gridDim.x) {
    const int dir = it & 1, ch = (it >> 1) & 127, b = it >> 8;
    const size_t t0 = (size_t)b * 8192 + ch * 64;
    __syncthreads();
    for (int i = tid; i < 1024; i += 512) slr[i] = p.lr[t0 * 32 + (i >> 4) * 32 + dir * 16 + (i & 15)];
    __syncthreads();
    const int j = tid;
    const int h = j >> 7, d = j & 127;
    const float* wa = dir ? p.wa_bw : p.wa_fw;
    float wr[16];
#pragma unroll
    for (int r = 0; r < 16; ++r) wr[r] = wa[r * 512 + j];
    const float ba = (dir ? p.ba_bw : p.ba_fw)[j];
    u16* qe = (dir ? p.qe_bw : p.qe_fw) + t0 * 512 + j;
    u16* ke = (dir ? p.ke_bw : p.ke_fw) + t0 * 512 + j;
    const u16* gq = p.gq + t0 * 512 + j;
    const u16* gk = p.gk + t0 * 512 + j;
    u16* keT = p.keT + (size_t)dir * (16ull * 128 * 8192) + ((size_t)(b * 4 + h) * 128 + d) * 8192 + ch * 64;
    float bsum = 0.f;
#pragma unroll 1
    for (int g8 = 0; g8 < 8; ++g8) {
      u16 qraw[8], kraw[8];
#pragma unroll
      for (int u = 0; u < 8; ++u) {
        const int tt = g8 * 8 + u;
        const int t = dir ? 63 - tt : tt;
        qraw[u] = gq[t * 512]; kraw[u] = gk[t * 512];
      }
      unsigned kk[8];
#pragma unroll
      for (int u = 0; u < 8; ++u) {
        const int tt = g8 * 8 + u;
        const int t = dir ? 63 - tt : tt;
        float pre = ba;
#pragma unroll
        for (int r = 0; r < 16; ++r) pre += slr[t * 16 + r] * wr[r];
        bsum += logsig(pre) * (1.f / 16.f);
        const float eb = __expf(bsum);
        const u16 qo = f2bf(bf2f(qraw[u]) * eb);
        const u16 ko = f2bf(bf2f(kraw[u]) * __expf(-bsum));
        qe[t * 512] = qo;
        ke[t * 512] = ko;
        kk[u] = ko;
      }
      u32x4 v;
      if (!dir) {
        v[0] = kk[0] | (kk[1] << 16); v[1] = kk[2] | (kk[3] << 16); v[2] = kk[4] | (kk[5] << 16); v[3] = kk[6] | (kk[7] << 16);
        *(u32x4*)(keT + g8 * 8) = v;
      } else {
        v[0] = kk[7] | (kk[6] << 16); v[1] = kk[5] | (kk[4] << 16); v[2] = kk[3] | (kk[2] << 16); v[3] = kk[1] | (kk[0] << 16);
        *(u32x4*)(keT + (56 - g8 * 8)) = v;
      }
    }
    p.dec[((size_t)(dir * 4 + b) * 128 + ch) * 512 + j] = __expf(bsum);
  }
}

constexpr int QLD = 136, TLD = 72;
DI void gla_scan_block(const Params& p, int g, char* smem, int tid) {
  const int dir = g & 1, bh = g >> 1;
  const int b = bh >> 2, h = bh & 3;
  const int w = tid >> 6, lane = tid & 63, c = lane & 31, hh = lane >> 5;
  const int slice = w;
  u16* sQ = (u16*)smem;
  u16* sK = sQ + 64 * QLD;
  u16* sKT = sK + 64 * QLD;
  u16* sVT = sKT + 128 * TLD;
  const u16* qe = (dir ? p.qe_bw : p.qe_fw) + (size_t)b * 8192 * 512 + h * 128;
  const u16* ke = (dir ? p.ke_bw : p.ke_fw) + (size_t)b * 8192 * 512 + h * 128;
  const u16* keT = p.keT + (size_t)dir * (16ull * 128 * 8192) + (size_t)bh * 128 * 8192;
  const u16* vT = p.gvT + (size_t)bh * 256 * 8192;
  const float* dec = p.dec + ((size_t)(dir * 4 + b) * 128) * 512 + h * 128;
  u16* o = dir ? p.o_bw : p.o_fw;
  f32x16 st[4];
#pragma unroll
  for (int i = 0; i < 4; ++i) st[i] = zero16();
  u32x4 rq[2], rk[2], rt[2];
  unsigned offq[2], offt[2];
#pragma unroll
  for (int r = 0; r < 2; ++r) {
    int id = tid + 512 * r;
    offq[r] = (unsigned)(((id >> 4) * 512 + (id & 15) * 8) * 2);
    offt[r] = (unsigned)(((id >> 3) * 8192 + (id & 7) * 8) * 2);
  }
  const unsigned offv = (unsigned)(((w * 32 + c) * 8192 + 4 * hh) * 2);
  {
    const int ch = dir ? 127 : 0;
#pragma unroll
    for (int r = 0; r < 2; ++r) {
      int id = tid + 512 * r;
      rq[r] = *(const u32x4*)((const char*)(qe + (size_t)ch * 64 * 512) + offq[r]);
      rk[r] = *(const u32x4*)((const char*)(ke + (size_t)ch * 64 * 512) + offq[r]);
      rt[r] = *(const u32x4*)((const char*)(keT + ch * 64) + offt[r]);
    }
  }
#pragma unroll 1
  for (int ci = 0; ci < 128; ++ci) {
    const int ch = dir ? 127 - ci : ci;
    const size_t t0 = (size_t)b * 8192 + ch * 64;
    __syncthreads();
#pragma unroll
    for (int r = 0; r < 2; ++r) {
      int id = tid + 512 * r;
      st_perm(sQ + (id >> 4) * QLD, id & 15, rq[r]);
      st_perm(sK + (id >> 4) * QLD, id & 15, rk[r]);
      st_perm(sKT + (id >> 3) * TLD, id & 7, rt[r]);
    }
    __syncthreads();
    if (ci + 1 < 128) {
      const int chn = dir ? ch - 1 : ch + 1;
#pragma unroll
      for (int r = 0; r < 2; ++r) {
        int id = tid + 512 * r;
        rq[r] = *(const u32x4*)((const char*)(qe + (size_t)chn * 64 * 512) + offq[r]);
        rk[r] = *(const u32x4*)((const char*)(ke + (size_t)chn * 64 * 512) + offq[r]);
        rt[r] = *(const u32x4*)((const char*)(keT + chn * 64) + offt[r]);
      }
    }
    bf16x8 vf[4];
#pragma unroll
    for (int k4 = 0; k4 < 4; ++k4) vf[k4] = ld_frag8x2((const u16*)((const char*)(vT + ch * 64 + 16 * k4) + offv));
#pragma unroll 1
    for (int qt = 0; qt < 2; ++qt) {
      f32x16 oacc = zero16();
#pragma unroll
      for (int ks = 0; ks < 8; ++ks) {
        bf16x8 sf = pack_step(st[ks >> 1], ks & 1);
        bf16x8 q0 = ld_frag16(sQ + (qt * 32 + c) * QLD + ks * 16 + 8 * hh);
        oacc = MFMA(q0, sf, oacc);
        if (ks & 1) __builtin_amdgcn_sched_barrier(0);
      }
#pragma unroll
      for (int kt = 0; kt < 2; ++kt) {
        bool skip = dir ? (kt < qt) : (kt > qt);
        if (skip) continue;
        f32x16 X = zero16();
#pragma unroll 1
        for (int ks = 0; ks < 8; ++ks) {
          bf16x8 kf = ld_frag16(sK + (kt * 32 + c) * QLD + ks * 16 + 8 * hh);
          bf16x8 qf = ld_frag16(sQ + (qt * 32 + c) * QLD + ks * 16 + 8 * hh);
          X = MFMA(kf, qf, X);
        }
        if (kt == qt) {
#pragma unroll
          for (int i = 0; i < 16; ++i) {
            int key = crow(i, hh);
            bool keep = dir ? (key >= c) : (key <= c);
            X[i] = keep ? X[i] : 0.f;
          }
        }
        oacc = MFMA(pack_step(X, 0), vf[kt * 2 + 0], oacc);
        oacc = MFMA(pack_step(X, 1), vf[kt * 2 + 1], oacc);
        __builtin_amdgcn_sched_barrier(0);
      }
#pragma unroll
      for (int i = 0; i < 16; ++i)
        o[(t0 + qt * 32 + crow(i, hh)) * 1024 + h * 256 + slice * 32 + c] = f2bf(oacc[i]);
      __builtin_amdgcn_sched_barrier(0);
    }
#pragma unroll
    for (int dt = 0; dt < 4; ++dt) {
#pragma unroll
      for (int k4 = 0; k4 < 4; ++k4) {
        bf16x8 kt_f = ld_frag16(sKT + (dt * 32 + c) * TLD + 16 * k4 + 8 * hh);
        st[dt] = MFMA(kt_f, vf[k4], st[dt]);
      }
#pragma unroll
      for (int gg = 0; gg < 4; ++gg) {
        float4 dv = *(const float4*)(dec + (size_t)ch * 512 + dt * 32 + 8 * gg + 4 * hh);
        st[dt][4 * gg + 0] *= dv.x; st[dt][4 * gg + 1] *= dv.y; st[dt][4 * gg + 2] *= dv.z; st[dt][4 * gg + 3] *= dv.w;
      }
      __builtin_amdgcn_sched_barrier(0);
    }
  }
}

constexpr int KLD = 136, VLD = 72;
constexpr int ATT_BUF = 64 * KLD + 128 * VLD;
DI void attn_item(const Params& p, int item, char* smem, int tid) {
  const int qb = item & 63, bh = item >> 6;
  const int b = bh >> 3, h = bh & 7;
  const int w = tid >> 6, lane = tid & 63, c = lane & 31, hh = lane >> 5;
  const int qg = w & 3, mp = w >> 2;
  u16* sbase = (u16*)smem;
  float* sex = (float*)(smem + 2 * ATT_BUF * 2);
  const size_t tq = (size_t)b * 8192 + qb * 128 + qg * 32 + c;
  bf16x8 qf[4];
#pragma unroll
  for (int s = 0; s < 4; ++s) qf[s] = ld_frag16(p.dq + tq * 1024 + h * 128 + mp * 64 + 16 * s + 8 * hh);
  f32x16 O[4];
#pragma unroll
  for (int dt = 0; dt < 4; ++dt) O[dt] = zero16();
  float lrun = 0.f;
  float negmb;
  {
    float qn = 0.f;
#pragma unroll
    for (int s = 0; s < 4; ++s) {
      u32x4 qq = __builtin_bit_cast(u32x4, qf[s]);
#pragma unroll
      for (int i = 0; i < 4; ++i) { float x0 = bflo(qq[i]), x1 = bfhi(qq[i]); qn += x0 * x0 + x1 * x1; }
    }
    qn += __shfl_xor(qn, 32);
    float kn = __int_as_float(p.kmax[(b * 8 + h) * 2 + mp]);
    float mb = sqrtf(qn * kn) * 1.01f + 1e-3f;
    negmb = -mb;
  }
  const u16* Kg = p.dk + (size_t)b * 8192 * 1024 + h * 128;
  const u16* Vg = p.dvT + (size_t)bh * 128 * 8192;
  u32x4 rk[2], rv[2];
#pragma unroll
  for (int r = 0; r < 2; ++r) {
    int id = tid + 512 * r;
    rk[r] = *(const u32x4*)(Kg + (size_t)(id >> 4) * 1024 + (id & 15) * 8);
    rv[r] = *(const u32x4*)(Vg + (size_t)(id >> 3) * 8192 + (id & 7) * 8);
  }
  __syncthreads();
#pragma unroll
  for (int r = 0; r < 2; ++r) {
    int id = tid + 512 * r;
    *(u32x4*)(sbase + (id >> 4) * KLD + (id & 15) * 8) = rk[r];
    st_perm(sbase + 64 * KLD + (id >> 3) * VLD, id & 7, rv[r]);
  }
#pragma unroll
  for (int r = 0; r < 2; ++r) {
    int id = tid + 512 * r;
    rk[r] = *(const u32x4*)(Kg + (size_t)(64 + (id >> 4)) * 1024 + (id & 15) * 8);
    rv[r] = *(const u32x4*)(Vg + (size_t)(id >> 3) * 8192 + 64 + (id & 7) * 8);
  }
  __syncthreads();
#pragma unroll 1
  for (int kt = 0; kt < 128; ++kt) {
    const u16* sK = sbase + (kt & 1) * ATT_BUF;
    const u16* sV = sK + 64 * KLD;
    if (kt + 1 < 128) {
      u16* nK = sbase + ((kt + 1) & 1) * ATT_BUF;
      u16* nV = nK + 64 * KLD;
#pragma unroll
      for (int r = 0; r < 2; ++r) {
        int id = tid + 512 * r;
        *(u32x4*)(nK + (id >> 4) * KLD + (id & 15) * 8) = rk[r];
        st_perm(nV + (id >> 3) * VLD, id & 7, rv[r]);
      }
      if (kt + 2 < 128) {
#pragma unroll
        for (int r = 0; r < 2; ++r) {
          int id = tid + 512 * r;
          rk[r] = *(const u32x4*)(Kg + (size_t)((kt + 2) * 64 + (id >> 4)) * 1024 + (id & 15) * 8);
          rv[r] = *(const u32x4*)(Vg + (size_t)(id >> 3) * 8192 + (kt + 2) * 64 + (id & 7) * 8);
        }
      }
    }
    f32x16 sacc[2];
    bf16x8 kf[8];
#pragma unroll
    for (int s = 0; s < 4; ++s)
#pragma unroll
      for (int k2 = 0; k2 < 2; ++k2) kf[s * 2 + k2] = ld_frag16(sK + (k2 * 32 + c) * KLD + mp * 64 + 16 * s + 8 * hh);
    __builtin_amdgcn_sched_barrier(0);
#pragma unroll
    for (int i = 0; i < 16; ++i) { sacc[0][i] = negmb; sacc[1][i] = negmb; }
#pragma unroll
    for (int s = 0; s < 4; ++s) {
      sacc[0] = MFMA(kf[s * 2 + 0], qf[s], sacc[0]);
      sacc[1] = MFMA(kf[s * 2 + 1], qf[s], sacc[1]);
    }
    bf16x8 vfA[4], vfB[4];
#define VLOAD(dst, k2, s2) { _Pragma("unroll") for (int dt = 0; dt < 4; ++dt) dst[dt] = ld_frag16(sV + (dt * 32 + c) * VLD + (k2) * 32 + (s2) * 16 + 8 * hh); }
#define PVMM(vf, pf) { _Pragma("unroll") for (int dt = 0; dt < 4; ++dt) O[dt] = MFMA(vf[dt], pf, O[dt]); }
#define EXPS(k2) { _Pragma("unroll") for (int i = 0; i < 8; ++i) { \
        float e0 = __builtin_amdgcn_exp2f(sacc[k2][2 * i]), e1 = __builtin_amdgcn_exp2f(sacc[k2][2 * i + 1]); \
        sacc[k2][2 * i] = e0; sacc[k2][2 * i + 1] = e1; f32x2_t ev = {e0, e1}; ls2 += ev; } }
    VLOAD(vfA, 0, 0);
    __builtin_amdgcn_sched_barrier(0);
    f32x2_t ls2 = {0.f, 0.f};
    EXPS(0);
    bf16x8 p0 = pack_step(sacc[0], 0), p1 = pack_step(sacc[0], 1);
    __builtin_amdgcn_sched_barrier(0);
    VLOAD(vfB, 0, 1);
    PVMM(vfA, p0);
    __builtin_amdgcn_sched_barrier(0);
    VLOAD(vfA, 1, 0);
    PVMM(vfB, p1);
    __builtin_amdgcn_sched_barrier(0);
    EXPS(1);
    p0 = pack_step(sacc[1], 0); p1 = pack_step(sacc[1], 1);
    __builtin_amdgcn_sched_barrier(0);
    VLOAD(vfB, 1, 1);
    PVMM(vfA, p0);
    __builtin_amdgcn_sched_barrier(0);
    PVMM(vfB, p1);
    lrun += ls2[0] + ls2[1];
#undef VLOAD
#undef PVMM
#undef EXPS
    __syncthreads();
  }
  float ltot = lrun + __shfl_xor(lrun, 32);
  if (mp == 1) {
    float sc = p.lam[0] / ltot;
#pragma unroll
    for (int dt = 0; dt < 4; ++dt)
#pragma unroll
      for (int i = 0; i < 16; ++i) sex[(qg * 64 + dt * 16 + i) * 64 + lane] = O[dt][i] * sc;
  }
  __syncthreads();
  if (mp == 0) {
    float i0 = 1.f / ltot;
    float ss = 0.f;
#pragma unroll
    for (int dt = 0; dt < 4; ++dt)
#pragma unroll
      for (int i = 0; i < 16; ++i) { float v = O[dt][i] * i0 - sex[(qg * 64 + dt * 16 + i) * 64 + lane]; O[dt][i] = v; ss += v * v; }
    ss += __shfl_xor(ss, 32);
    float rstd = rsqrtf(ss * (1.f / 128.f) + RMS_EPS) * 0.8f;
#pragma unroll
    for (int dt = 0; dt < 4; ++dt)
#pragma unroll
      for (int g = 0; g < 4; ++g) {
        int dv = dt * 32 + 8 * g + 4 * hh;
        float4 gg = *(const float4*)(p.diff_norm_g + h * 128 + dv);
        u32x2 v = {pack2(O[dt][4 * g] * rstd * gg.x, O[dt][4 * g + 1] * rstd * gg.y),
                   pack2(O[dt][4 * g + 2] * rstd * gg.z, O[dt][4 * g + 3] * rstd * gg.w)};
        *(u32x2*)(p.dq + tq * 1024 + h * 128 + dv) = v;
      }
  }
}

DI void phase_mixers(const Params& p, char* smem, int tid) {
  if (blockIdx.x < 32) gla_scan_block(p, blockIdx.x, smem, opq(tid));
  xcd_queue(p.counter + 56, 256, smem, tid, [&](int xq, int qn) {
    const int bh = xq + 8 * (qn >> 6);
    attn_item(p, bh * 64 + (qn & 63), smem, opq(tid));
  });
}

DI void phase_post_mixers(const Params& p, int tid) {
  int w = tid >> 6, lane = tid & 63;
  for (int row = blockIdx.x * 8 + w; row < T; row += gridDim.x * 8) {
#pragma unroll
    for (int hd = 0; hd < 4; ++hd) {
      u32x2 a = *(const u32x2*)(p.o_fw + (size_t)row * 1024 + hd * 256 + lane * 4);
      u32x2 bq = *(const u32x2*)(p.o_bw + (size_t)row * 1024 + hd * 256 + lane * 4);
      float v0 = bflo(a[0]) + bflo(bq[0]), v1 = bfhi(a[0]) + bfhi(bq[0]), v2 = bflo(a[1]) + bflo(bq[1]), v3 = bfhi(a[1]) + bfhi(bq[1]);
      float ss = wave_sum(v0 * v0 + v1 * v1 + v2 * v2 + v3 * v3);
      if (lane == 0) p.rstd[row * 4 + hd] = rsqrtf(ss * (1.f / 256.f) + RMS_EPS);
    }
  }
  phase_norm_mod(p.x, p.norm1_g, p.mod, 0, 1024, p.hA, tid);
  for (int row = blockIdx.x * 8 + w; row < 32768; row += gridDim.x * 8) {
    const bool isv = row >= 16384;
    const int r = row & 16383;
    const float* srcp = (isv ? p.peer_v : p.peer_u) + (size_t)r * 1024 + lane * 16;
    float4 a0 = *(const float4*)(srcp), a1 = *(const float4*)(srcp + 4), a2 = *(const float4*)(srcp + 8), a3 = *(const float4*)(srcp + 12);
    float am = fmaxf(fmaxf(fmaxf(fabsf(a0.x), fabsf(a0.y)), fmaxf(fabsf(a0.z), fabsf(a0.w))), fmaxf(fmaxf(fabsf(a1.x), fabsf(a1.y)), fmaxf(fabsf(a1.z), fabsf(a1.w))));
    am = fmaxf(am, fmaxf(fmaxf(fmaxf(fabsf(a2.x), fabsf(a2.y)), fmaxf(fabsf(a2.z), fabsf(a2.w))), fmaxf(fmaxf(fabsf(a3.x), fabsf(a3.y)), fmaxf(fabsf(a3.z), fabsf(a3.w)))));
#pragma unroll
    for (int o = 32; o >= 1; o >>= 1) am = fmaxf(am, __shfl_xor(am, o));
    am = fmaxf(am, 1e-30f);
    const float sc = 256.f / am;
    u32x4 v;
    int t0 = __builtin_amdgcn_cvt_pk_fp8_f32(a0.x * sc, a0.y * sc, 0, false); t0 = __builtin_amdgcn_cvt_pk_fp8_f32(a0.z * sc, a0.w * sc, t0, true);
    int t1 = __builtin_amdgcn_cvt_pk_fp8_f32(a1.x * sc, a1.y * sc, 0, false); t1 = __builtin_amdgcn_cvt_pk_fp8_f32(a1.z * sc, a1.w * sc, t1, true);
    int t2 = __builtin_amdgcn_cvt_pk_fp8_f32(a2.x * sc, a2.y * sc, 0, false); t2 = __builtin_amdgcn_cvt_pk_fp8_f32(a2.z * sc, a2.w * sc, t2, true);
    int t3 = __builtin_amdgcn_cvt_pk_fp8_f32(a3.x * sc, a3.y * sc, 0, false); t3 = __builtin_amdgcn_cvt_pk_fp8_f32(a3.z * sc, a3.w * sc, t3, true);
    v[0] = (unsigned)t0; v[1] = (unsigned)t1; v[2] = (unsigned)t2; v[3] = (unsigned)t3;
    unsigned char* dst = (unsigned char*)(isv ? p.vB : p.uB) + (size_t)r * 1024 + lane * 16;
    *(u32x4*)dst = v;
    if (lane == 0) (isv ? p.vs : p.us)[r] = am * (1.f / 256.f);
  }
}

DI void phase_gr(const Params& p, char* smem, int tid) {
  const int w = tid >> 6, lane_inv = tid & 63;
  const int wm = w >> 2, wn = w & 3;
  float* wl = wave_stage(smem, w);
  xcd_static(p, 16 * 12, smem, [&](int xq, int qn) {
    int mt = xq + 8 * (qn / 12), nt = qn % 12;
    int m0 = mt * 256, n0 = nt * 256;
    f32x16 acc[4][2]; zero_acc(acc);
    gemm_kloop(p.hA + (size_t)m0 * 1024, 1024, p.wgrT + (size_t)n0 * 1024, 1024, 1024, acc, (u16*)smem, opq(tid));
    const int lane = opq(lane_inv);
    const int c = lane & 31, hh = lane >> 5;
#pragma unroll
    for (int half = 0; half < 2; ++half) {
      const int rb = m0 + wm * 128 + half * 64;
      stage_acc<EPS>(acc, half, wl, c, hh);
      if (n0 < 1024) {
        const int cb = n0 + wn * 64;
        epi_rows(wl, lane, [&](int r, int cc, float (&v)[8]) {
          const size_t off = (size_t)(rb + r) * 1024 + cb + cc;
          float of[8], ob[8];
          ld_bf16x8(p.o_fw + off, of); ld_bf16x8(p.o_bw + off, ob);
          const float rs = p.rstd[(rb + r) * 4 + ((cb + cc) >> 8)];
          float4 g0 = *(const float4*)(p.gla_norm_g + cb + cc), g1 = *(const float4*)(p.gla_norm_g + cb + cc + 4);
          const float gg[8] = {g0.x, g0.y, g0.z, g0.w, g1.x, g1.y, g1.z, g1.w};
#pragma unroll
          for (int j = 0; j < 8; ++j) { float a = v[j]; v[j] = (of[j] + ob[j]) * rs * gg[j] * (a / (1.f + __expf(-a))); }
          st_bf16x8(p.A1 + off, v);
        });
      } else {
        u16* dst = ((n0 < 2048) ? p.sga : p.sgb) + (size_t)rb * 1024 + (n0 & 1023) + wn * 64;
        epi_rows(wl, lane, [&](int r, int cc, float (&v)[8]) {
#pragma unroll
          for (int j = 0; j < 8; ++j) v[j] = 1.f / (1.f + __expf(-v[j]));
          st_bf16x8(dst + (size_t)r * 1024 + cc, v);
        });
      }
    }
  });
}

DI void phase_merge(const Params& p, char* smem, int tid) {
  const int w = tid >> 6, lane_inv = tid & 63;
  const int wm = w >> 2, wn = w & 3;
  float* wl = wave_stage(smem, w);
  xcd_static(p, 16 * 4, smem, [&](int xq, int qn) {
    int mt = xq + 8 * (qn >> 2), nt = qn & 3;
    int m0 = mt * 256, n0 = nt * 256;
    f32x16 acc[4][2];
    zero_acc(acc);
    gemm_kloop(p.A1 + (size_t)m0 * 1024, 1024, p.wglaT + (size_t)n0 * 1024, 1024, 1024, acc, (u16*)smem, opq(tid));
    {
      const int lane = opq(lane_inv);
      const int c = lane & 31, hh = lane >> 5;
#pragma unroll
      for (int half = 0; half < 2; ++half) {
        const size_t tb = (size_t)(m0 + wm * 128 + half * 64) * 1024 + n0 + wn * 64;
        stage_acc<EPS>(acc, half, wl, c, hh);
        epi_rows(wl, lane, [&](int r, int cc, float (&v)[8]) {
          float gv[8];
          ld_bf16x8(p.sga + tb + (size_t)r * 1024 + cc, gv);
#pragma unroll
          for (int j = 0; j < 8; ++j) v[j] *= gv[j];
          st_bf16x8(p.sga + tb + (size_t)r * 1024 + cc, v);
        });
      }
    }
    zero_acc(acc);
    gemm_kloop(p.dq + (size_t)m0 * 1024, 1024, p.wdiffT + (size_t)n0 * 1024, 1024, 1024, acc, (u16*)smem, opq(tid));
    {
      const int lane = opq(lane_inv);
      const int c = lane & 31, hh = lane >> 5;
#pragma unroll
      for (int half = 0; half < 2; ++half) {
        const size_t tb = (size_t)(m0 + wm * 128 + half * 64) * 1024 + n0 + wn * 64;
        stage_acc<EPS>(acc, half, wl, c, hh);
        epi_rows(wl, lane, [&](int r, int cc, float (&v)[8]) {
          float gv[8], mv[8];
          ld_bf16x8(p.sgb + tb + (size_t)r * 1024 + cc, gv);
          ld_bf16x8(p.sga + tb + (size_t)r * 1024 + cc, mv);
#pragma unroll
          for (int j = 0; j < 8; ++j) v[j] = mv[j] + v[j] * gv[j];
          st_bf16x8(p.merged + tb + (size_t)r * 1024 + cc, v);
        });
      }
    }
  });
}

DI void phase_out(const Params& p, char* smem, int tid) {
  const int w = tid >> 6, lane_inv = tid & 63;
  const int wm = w >> 2, wn = w & 3;
  float* wl = wave_stage(smem, w);
  xcd_static(p, 16 * 4, smem, [&](int xq, int qn) {
    int mt = xq + 8 * (qn >> 2), nt = qn & 3;
    int m0 = mt * 256, n0 = nt * 256;
    f32x16 acc[4][2]; zero_acc(acc);
    gemm_kloop(p.merged + (size_t)m0 * 1024, 1024, p.woutT + (size_t)n0 * 1024, 1024, 1024, acc, (u16*)smem, opq(tid));
    const int lane = opq(lane_inv);
    const int c = lane & 31, hh = lane >> 5;
    const int b = m0 >> 13;
    const int cb = n0 + wn * 64;
#pragma unroll
    for (int half = 0; half < 2; ++half) {
      const size_t tb = (size_t)(m0 + wm * 128 + half * 64) * 1024 + cb;
      stage_acc<EPS>(acc, half, wl, c, hh);
      epi_rows(wl, lane, [&](int r, int cc, float (&v)[8]) {
        const float* xp = p.x + tb + (size_t)r * 1024 + cc;
        const float* gp = p.mod + b * 6144 + 2048 + cb + cc;
        float4 x0 = *(const float4*)xp, x1v = *(const float4*)(xp + 4);
        float4 g0 = *(const float4*)gp, g1 = *(const float4*)(gp + 4);
        float4 o0 = {x0.x + g0.x * v[0], x0.y + g0.y * v[1], x0.z + g0.z * v[2], x0.w + g0.w * v[3]};
        float4 o1 = {x1v.x + g1.x * v[4], x1v.y + g1.y * v[5], x1v.z + g1.z * v[6], x1v.w + g1.w * v[7]};
        float* op = p.x1 + tb + (size_t)r * 1024 + cc;
        *(float4*)op = o0; *(float4*)(op + 4) = o1;
      });
    }
  });
}

DI void phase_peerq(const Params& p, char* smem, int tid) {
  const int w = tid >> 6, lane_inv = tid & 63;
  const int wm = w >> 2, wn = w & 3;
  float* wl = wave_stage(smem, w);
  xcd_static(p, 16 * 8, smem, [&](int xq, int qn) {
    int mt = xq + 8 * (qn >> 3), nt = qn & 7;
    int m0 = mt * 256, n0 = nt * 256;
    f32x16 acc[4][2]; zero_acc(acc);
    gemm_kloop(p.h2 + (size_t)m0 * 1024, 1024, p.wqT + (size_t)n0 * 1024, 1024, 1024, acc, (u16*)smem, opq(tid));
    const int lane = opq(lane_inv);
    const int c = lane & 31, hh = lane >> 5;
#pragma unroll
    for (int half = 0; half < 2; ++half) {
      u16* dst = p.qp + (size_t)(m0 + wm * 128 + half * 64) * 2048 + n0 + wn * 64;
      stage_acc<EPS>(acc, half, wl, c, hh);
      epi_rows(wl, lane, [&](int r, int cc, float (&v)[8]) { st_bf16x8(dst + (size_t)r * 2048 + cc, v); });
    }
  });
}

DI unsigned fkey(float f) { unsigned u = __float_as_uint(f); return (u & 0x80000000u) ? ~u : (u | 0x80000000u); }
DI void phase_topk(const Params& p, char* smem, int tid) {
  float* sc = (float*)smem;
  float* ts = sc + 64 * 132;
  int* ti = (int*)(ts + 64 * 32);
  const int w = tid >> 6, lane = tid & 63, c = lane & 31, hh = lane >> 5;
  const int l16 = tid & 15, grp = tid >> 4;
  const int nt = w & 3, mt = w >> 2;
  bf16x8 af[8], bfq[8];
#define TK_LOAD(item_, pp_) { const int h_ = (item_) & 7; const u16* Aq_ = p.qp + (size_t)((item_) >> 3) * 64 * 2048 + h_ * 256 + (pp_) * 128; \
    const u16* Bk_ = p.subk + (size_t)(h_ * 2 + (pp_)) * 128 * 128; \
    _Pragma("unroll") for (int s = 0; s < 8; ++s) { bfq[s] = ld_frag16(Bk_ + (32 * nt + c) * 128 + 16 * s + 8 * hh); af[s] = ld_frag16(Aq_ + (size_t)(32 * mt + c) * 2048 + 16 * s + 8 * hh); } }
  if (blockIdx.x < 4096) TK_LOAD(blockIdx.x, 0);
  for (int item = blockIdx.x; item < 4096; item += gridDim.x) {
    const int h = item & 7;
    const size_t t0 = (size_t)(item >> 3) * 64;
#pragma unroll 1
    for (int pp = 0; pp < 2; ++pp) {
      f32x16 acc = zero16();
      {
        f32x16 acc2 = zero16();
#pragma unroll
        for (int s = 0; s < 8; s += 2) { acc = MFMA(af[s], bfq[s], acc); acc2 = MFMA(af[s + 1], bfq[s + 1], acc2); }
#pragma unroll
        for (int i = 0; i < 16; ++i) acc[i] += acc2[i];
      }
      if (pp == 0) { TK_LOAD(item, 1); }
      else { const int nitem = item + gridDim.x; if (nitem < 4096) TK_LOAD(nitem, 0); }
      __syncthreads();
#pragma unroll
      for (int i = 0; i < 16; ++i) sc[(mt * 32 + crow(i, hh)) * 132 + 32 * nt + c] = acc[i];
      __syncthreads();
      unsigned k[2][8], sel[2];
#pragma unroll
      for (int rr = 0; rr < 2; ++rr) {
        sel[rr] = 0;
#pragma unroll
        for (int m = 0; m < 8; ++m) { int n = l16 + 16 * m; k[rr][m] = (fkey(sc[(grp + 32 * rr) * 132 + n]) & ~127u) | (unsigned)(127 - n); }
      }
#pragma unroll 1
      for (int round = 0; round < 16; ++round) {
#pragma unroll
        for (int rr = 0; rr < 2; ++rr) {
          unsigned mx = max(max(max(k[rr][0], k[rr][1]), max(k[rr][2], k[rr][3])), max(max(k[rr][4], k[rr][5]), max(k[rr][6], k[rr][7])));
          mx = gmax16(mx);
          sel[rr] = (l16 == round) ? mx : sel[rr];
#pragma unroll
          for (int m = 0; m < 8; ++m) k[rr][m] = (k[rr][m] == mx) ? 0u : k[rr][m];
        }
      }
#pragma unroll
      for (int rr = 0; rr < 2; ++rr) {
        const int row = grp + 32 * rr;
        int n = 127 - (int)(sel[rr] & 127u);
        ti[(row * 2 + pp) * 16 + l16] = n;
        ts[(row * 2 + pp) * 16 + l16] = sc[row * 132 + n];
      }
    }
    __syncthreads();
    {
      float s0v[2]; int ptr[2]; unsigned selk[2];
#pragma unroll
      for (int rr = 0; rr < 2; ++rr) { s0v[rr] = ts[((grp + 32 * rr) * 2) * 16 + l16]; ptr[rr] = 0; selk[rr] = 0; }
#pragma unroll 1
      for (int round = 0; round < 16; ++round) {
#pragma unroll
        for (int rr = 0; rr < 2; ++rr) {
          const int row = grp + 32 * rr;
          float v = s0v[rr] + ts[(row * 2 + 1) * 16 + (ptr[rr] & 15)];
          unsigned key = (ptr[rr] < 16) ? ((fkey(v) & ~255u) | (unsigned)(255 - (l16 * 16 + ptr[rr]))) : 0u;
          unsigned mx = gmax16(key);
          selk[rr] = (l16 == round) ? mx : selk[rr];
          int aw = (255 - (int)(mx & 255u)) >> 4;
          ptr[rr] += (l16 == aw) ? 1 : 0;
        }
      }
#pragma unroll
      for (int rr = 0; rr < 2; ++rr) {
        const int row = grp + 32 * rr;
        int flat = 255 - (int)(selk[rr] & 255u);
        int aw = flat >> 4, bw = flat & 15;
        int my_idx = ti[(row * 2) * 16 + aw] * 128 + ti[(row * 2 + 1) * 16 + bw];
        float my_s = ts[(row * 2) * 16 + aw] + ts[(row * 2 + 1) * 16 + bw];
        float mxs = gmaxf16(my_s);
        float e = __expf(my_s - mxs);
        float sum = gsum16(e);
        p.idx[(t0 + row) * 128 + h * 16 + l16] = my_idx;
        p.g[(t0 + row) * 128 + h * 16 + l16] = e / sum;
      }
    }
    __syncthreads();
  }
#undef TK_LOAD
}

DI void peer_load_batch(const unsigned char* tab, const float* rsc, int ireg, int ebase, int q, int gq, u32x4 (&buf)[4], float (&scl)[1]) {
#pragma unroll
  for (int rr = 0; rr < 1; ++rr) {
    int e = ebase + 4 * rr + gq;
    int row = __shfl(ireg, e & 63);
    const unsigned char* rp = tab + (size_t)row * 1024 + q * 16;
#pragma unroll
    for (int j = 0; j < 4; ++j) buf[rr * 4 + j] = *(const u32x4*)(rp + j * 256);
    scl[rr] = rsc[row];
  }
}
DI void peer_u_compute(const u32x4 (&buf)[4], const float (&scl)[1], const float (&hf)[64], float* wl, int ebase, int q, int gq) {
#pragma unroll
  for (int rr = 0; rr < 1; ++rr) {
    float acc = 0.f;
#pragma unroll
    for (int j = 0; j < 4; ++j)
#pragma unroll
      for (int i = 0; i < 4; ++i) {
        f32x2_t lo = __builtin_amdgcn_cvt_pk_f32_fp8((int)buf[rr * 4 + j][i], false);
        f32x2_t hi = __builtin_amdgcn_cvt_pk_f32_fp8((int)buf[rr * 4 + j][i], true);
        acc += lo[0] * hf[j * 16 + 4 * i] + lo[1] * hf[j * 16 + 4 * i + 1] + hi[0] * hf[j * 16 + 4 * i + 2] + hi[1] * hf[j * 16 + 4 * i + 3];
      }
    acc = gsum16(acc) * scl[rr];
    float act = 0.5f * acc * (1.f + erff(acc * 0.7071067811865476f));
    if (q == 0) wl[ebase + 4 * rr + gq] = act;
  }
}
DI void peer_v_compute(const u32x4 (&buf)[4], const float (&scl)[1], float (&o)[64], const float* wl, float greg, int ebase, int gq) {
#pragma unroll
  for (int rr = 0; rr < 1; ++rr) {
    const int e = ebase + 4 * rr + gq;
    float ge = __shfl(greg, e & 63);
    float wg = wl[e] * ge * scl[rr];
#pragma unroll
    for (int j = 0; j < 4; ++j)
#pragma unroll
      for (int i = 0; i < 4; ++i) {
        f32x2_t lo = __builtin_amdgcn_cvt_pk_f32_fp8((int)buf[rr * 4 + j][i], false);
        f32x2_t hi = __builtin_amdgcn_cvt_pk_f32_fp8((int)buf[rr * 4 + j][i], true);
        o[j * 16 + 4 * i] += wg * lo[0]; o[j * 16 + 4 * i + 1] += wg * lo[1];
        o[j * 16 + 4 * i + 2] += wg * hi[0]; o[j * 16 + 4 * i + 3] += wg * hi[1];
      }
  }
}
DI void phase_peer_final(const Params& p, char* smem, int tid) {
  const int w = tid >> 6, lane = tid & 63, q = lane & 15, gq = lane >> 4;
  float* wl = (float*)smem + w * 128;
  const unsigned char* U8 = (const unsigned char*)p.uB;
  const unsigned char* V8 = (const unsigned char*)p.vB;
  for (int item = blockIdx.x; item < T / 8; item += gridDim.x) {
    const size_t t = (size_t)item * 8 + w;
    const int b = (int)(t >> 13);
    float hf[64];
#pragma unroll
    for (int j = 0; j < 4; ++j) {
      u32x4 ha = *(const u32x4*)(p.h2 + t * 1024 + (q + 16 * j) * 16);
      u32x4 hb = *(const u32x4*)(p.h2 + t * 1024 + (q + 16 * j) * 16 + 8);
#pragma unroll
      for (int i = 0; i < 4; ++i) { hf[j * 16 + 2 * i] = bflo(ha[i]); hf[j * 16 + 2 * i + 1] = bfhi(ha[i]); hf[j * 16 + 8 + 2 * i] = bflo(hb[i]); hf[j * 16 + 8 + 2 * i + 1] = bfhi(hb[i]); }
    }
    const int i0 = p.idx[t * 128 + lane], i1 = p.idx[t * 128 + 64 + lane];
    const float g0 = p.g[t * 128 + lane], g1 = p.g[t * 128 + 64 + lane];
    u32x4 bA[4], bB[4]; float sA[1], sB[1];
    peer_load_batch(U8, p.us, i0, 0, q, gq, bA, sA);
#pragma unroll 1
    for (int it = 0; it < 16; ++it) {
      const int e0 = 8 * it;
      peer_load_batch(U8, p.us, (e0 & 64) ? i1 : i0, e0 + 4, q, gq, bB, sB);
      peer_u_compute(bA, sA, hf, wl, e0, q, gq);
      if (it < 15) peer_load_batch(U8, p.us, ((e0 + 8) & 64) ? i1 : i0, e0 + 8, q, gq, bA, sA);
      else peer_load_batch(V8, p.vs, i0, 0, q, gq, bA, sA);
      peer_u_compute(bB, sB, hf, wl, e0 + 4, q, gq);
    }
    __syncthreads();
    float o[64];
#pragma unroll
    for (int i = 0; i < 64; ++i) o[i] = 0.f;
#pragma unroll 1
    for (int it = 0; it < 16; ++it) {
      const int e0 = 8 * it;
      peer_load_batch(V8, p.vs, (e0 & 64) ? i1 : i0, e0 + 4, q, gq, bB, sB);
      peer_v_compute(bA, sA, o, wl, (e0 & 64) ? g1 : g0, e0, gq);
      if (it < 15) peer_load_batch(V8, p.vs, ((e0 + 8) & 64) ? i1 : i0, e0 + 8, q, gq, bA, sA);
      peer_v_compute(bB, sB, o, wl, (e0 & 64) ? g1 : g0, e0 + 4, gq);
    }
    float h1[32];
#pragma unroll
    for (int i = 0; i < 32; ++i) {
      float send = (gq < 2) ? o[32 + i] : o[i];
      float keep = (gq < 2) ? o[i] : o[32 + i];
      h1[i] = keep + __shfl_xor(send, 32);
    }
    float fin[16];
#pragma unroll
    for (int i = 0; i < 16; ++i) {
      float send = (gq & 1) ? h1[i] : h1[16 + i];
      float keep = (gq & 1) ? h1[16 + i] : h1[i];
      fin[i] = keep + __shfl_xor(send, 16);
    }
    const int colb = (q + 16 * gq) * 16;
    float ss = 0.f;
#pragma unroll
    for (int i4 = 0; i4 < 4; ++i4) {
      float4 xa = *(const float4*)(p.x1 + t * 1024 + colb + 4 * i4);
      float4 ga = *(const float4*)(p.mod + b * 6144 + 5120 + colb + 4 * i4);
      fin[4 * i4 + 0] = xa.x + ga.x * fin[4 * i4 + 0]; fin[4 * i4 + 1] = xa.y + ga.y * fin[4 * i4 + 1];
      fin[4 * i4 + 2] = xa.z + ga.z * fin[4 * i4 + 2]; fin[4 * i4 + 3] = xa.w + ga.w * fin[4 * i4 + 3];
      ss += fin[4 * i4] * fin[4 * i4] + fin[4 * i4 + 1] * fin[4 * i4 + 1] + fin[4 * i4 + 2] * fin[4 * i4 + 2] + fin[4 * i4 + 3] * fin[4 * i4 + 3];
    }
    ss = wave_sum(ss);
    const float rstd = rsqrtf(ss * (1.f / 1024.f) + RMS_EPS);
#pragma unroll
    for (int i4 = 0; i4 < 4; ++i4) {
      int col = colb + 4 * i4;
      float4 gg = *(const float4*)(p.normf_g + col);
      float4 sh = *(const float4*)(p.fmod + b * 2048 + col);
      float4 sc = *(const float4*)(p.fmod + b * 2048 + 1024 + col);
      float4 r;
      r.x = fin[4 * i4 + 0] * rstd * gg.x * (1.f + sc.x) + sh.x;
      r.y = fin[4 * i4 + 1] * rstd * gg.y * (1.f + sc.y) + sh.y;
      r.z = fin[4 * i4 + 2] * rstd * gg.z * (1.f + sc.z) + sh.z;
      r.w = fin[4 * i4 + 3] * rstd * gg.w * (1.f + sc.w) + sh.w;
      *(float4*)(p.out + t * 1024 + col) = r;
    }
    __syncthreads();
  }
}

#define XB_TMO      128
#define XB_XCNT(j)  (256  + 64 * (j))
#define XB_XSUB(j)  (1280 + 64 * (j))
#define XB_XGEN(j)  (2304 + 64 * (j))
#define XB_TOP      3328
#define XB_TOPGEN   3392
#define XCD_BAR_WORDS 3456
#define XB_SPIN_CAP (1u << 18)
#define LAS __attribute__((address_space(3)))

__device__ __forceinline__ unsigned xb_ld(unsigned* p)              { return __hip_atomic_load(p, __ATOMIC_RELAXED, __HIP_MEMORY_SCOPE_AGENT); }
__device__ __forceinline__ unsigned xb_add(unsigned* p, unsigned v) { return __hip_atomic_fetch_add(p, v, __ATOMIC_RELAXED, __HIP_MEMORY_SCOPE_AGENT); }
__device__ __forceinline__ unsigned xb_xcc_id() { return (unsigned)__builtin_amdgcn_s_getreg((3 << 11) | 20) & 0xFu; }
#define XB_SPIN(cond, bar) do { unsigned _sp = 0; while (cond) { __builtin_amdgcn_s_sleep(1); \
    if ((++_sp & 255u) == 0u) { if (xb_ld(&(bar)[XB_TMO])) break; if (_sp > XB_SPIN_CAP) { atomicAdd(&(bar)[XB_TMO], 1u); break; } } } } while (0)

struct XcdBarrier {
    unsigned* bar; unsigned x;
    volatile LAS unsigned* st;
};

__device__ __forceinline__ XcdBarrier xcd_barrier_post(unsigned* bar, volatile LAS unsigned* st) {
    XcdBarrier b; b.bar = bar; b.x = xb_xcc_id(); b.st = st;
    if (threadIdx.x == 0) (void)xb_add(&bar[XB_XCNT(b.x)], 1u);
    return b;
}
__device__ __forceinline__ void xcd_barrier_complete(unsigned* bar, unsigned x, unsigned& nloc, unsigned& nx) {
    const unsigned G = gridDim.x * gridDim.y * gridDim.z;
    unsigned sum, cnt, mine, sp = 0u;
    for (;;) {
        sum = 0u; cnt = 0u; mine = 0u;
#pragma unroll
        for (unsigned j = 0; j < 16; ++j) { const unsigned c = xb_ld(&bar[XB_XCNT(j)]); sum += c; cnt += (c > 0u) ? 1u : 0u; mine = (j == x) ? c : mine; }
        if (sum == G) break;
        __builtin_amdgcn_s_sleep(1);
        if ((++sp & 255u) == 0u) { if (xb_ld(&bar[XB_TMO])) break; if (sp > XB_SPIN_CAP) { atomicAdd(&bar[XB_TMO], 1u); break; } }
    }
    nloc = mine > 0u ? mine : 1u; nx = cnt > 0u ? cnt : 1u;
}

__device__ __forceinline__ void xcd_barrier(const XcdBarrier& b) {
    asm volatile("s_waitcnt vmcnt(0)" ::: "memory");
    __syncthreads();
    if (threadIdx.x == 0) {
        unsigned* bar = b.bar;
        __builtin_amdgcn_s_waitcnt(0);
        unsigned nloc = b.st[0], nx = b.st[1];
        if (nloc == 0u) { xcd_barrier_complete(bar, b.x, nloc, nx); b.st[0] = nloc; b.st[1] = nx; }
        const unsigned old = xb_add(&bar[XB_XSUB(b.x)], 1u);
        const unsigned gen = old / nloc;
        if (old + 1u == (gen + 1u) * nloc) {
            __builtin_amdgcn_fence(__ATOMIC_RELEASE, "agent");
            asm volatile("s_waitcnt vmcnt(0)" ::: "memory");
            const unsigned og = xb_add(&bar[XB_TOP], 1u);
            const unsigned tg = og / nx;
            if (og + 1u == (tg + 1u) * nx) xb_add(&bar[XB_TOPGEN], 1u);
            else XB_SPIN(xb_ld(&bar[XB_TOPGEN]) == tg, bar);
            __builtin_amdgcn_fence(__ATOMIC_ACQUIRE, "agent");
            xb_add(&bar[XB_XGEN(b.x)], 1u);
            asm volatile("s_waitcnt vmcnt(0)" ::: "memory");
        } else {
            XB_SPIN(xb_ld(&bar[XB_XGEN(b.x)]) == gen, bar);
            __builtin_amdgcn_fence(__ATOMIC_ACQUIRE, "agent");
            asm volatile("s_waitcnt vmcnt(0)" ::: "memory");
        }
    }
    __syncthreads();
}

__global__ void __launch_bounds__(512) fwd_megakernel(Params p) {
  cg::grid_group grid = cg::this_grid();
  extern __shared__ __attribute__((aligned(16))) char smem[];
  const int tid = threadIdx.x;
  volatile LAS unsigned* xst = (volatile LAS unsigned*)(smem + LDS_BYTES - 16);
  if (tid == 0) { xst[0] = 0u; xst[1] = 0u; }
  __syncthreads();
  XcdBarrier xb = xcd_barrier_post(p.bar, xst);
  if (tid == 0) xst[2] = atomicAdd(p.bar + 3600 + (xb_xcc_id() & 7u) * 16, 1u);
  phase_prep(p, smem, opq(tid));
  grid.sync();
  phase_norm_mod(p.x, p.norm1_g, p.mod, 0, 1024, p.hA, opq(tid));
  xcd_barrier(xb);
  phase_proj(p, smem, opq(tid));
  xcd_barrier(xb);
  phase_gla_pre(p, smem, opq(tid));
  xcd_barrier(xb);
  phase_mixers(p, smem, opq(tid));
  xcd_barrier(xb);
  phase_post_mixers(p, opq(tid));
  xcd_barrier(xb);
  phase_gr(p, smem, opq(tid));
  xcd_barrier(xb);
  phase_merge(p, smem, opq(tid));
  xcd_barrier(xb);
  phase_out(p, smem, opq(tid));
  xcd_barrier(xb);
  phase_norm_mod(p.x1, p.norm2_g, p.mod, 3072, 4096, p.h2, opq(tid));
  xcd_barrier(xb);
  phase_peerq(p, smem, opq(tid));
  xcd_barrier(xb);
  phase_topk(p, smem, opq(tid));
  xcd_barrier(xb);
  phase_peer_final(p, smem, opq(tid));
}

extern "C" void kernel_launch(void* const* d_in, const int* in_sizes, int n_in, void* d_out, int out_size, void* d_ws,
                              size_t ws_size, hipStream_t stream) {
  static int grid_blocks = 0;
  if (!grid_blocks) {
    int dev = 0, cus = 0, per_cu = 0;
    hipGetDevice(&dev);
    hipDeviceGetAttribute(&cus, hipDeviceAttributeMultiprocessorCount, dev);
    if (hipFuncSetAttribute((const void*)fwd_megakernel, hipFuncAttributeMaxDynamicSharedMemorySize, LDS_BYTES) != hipSuccess) { fprintf(stderr, "hipFuncSetAttribute failed\n"); }
    hipOccupancyMaxActiveBlocksPerMultiprocessor(&per_cu, fwd_megakernel, 512, LDS_BYTES);
    if (per_cu < 1) per_cu = 1;
    grid_blocks = cus * per_cu;
  }
  if (ws_size < 492 * MB) { fprintf(stderr, "ws too small: %zu\n", ws_size); return; }
  Params p{};
  p.x = (const float*)d_in[0]; p.c = (const float*)d_in[1]; p.pos = (const int*)d_in[2];
  p.w_ada = (const float*)d_in[3]; p.b_ada = (const float*)d_in[4]; p.norm1_g = (const float*)d_in[5];
  p.w_in = (const float*)d_in[6]; p.wa_fw = (const float*)d_in[7]; p.ba_fw = (const float*)d_in[8];
  p.wa_bw = (const float*)d_in[9]; p.ba_bw = (const float*)d_in[10]; p.gla_norm_g = (const float*)d_in[11];
  p.lq1 = (const float*)d_in[12]; p.lk1 = (const float*)d_in[13]; p.lq2 = (const float*)d_in[14]; p.lk2 = (const float*)d_in[15];
  p.diff_norm_g = (const float*)d_in[16]; p.w_gla = (const float*)d_in[17]; p.w_diff = (const float*)d_in[18];
  p.w_out = (const float*)d_in[19]; p.norm2_g = (const float*)d_in[20]; p.peer_wq = (const float*)d_in[21];
  p.subkeys = (const float*)d_in[22]; p.peer_u = (const float*)d_in[23]; p.peer_v = (const float*)d_in[24];
  p.w_fada = (const float*)d_in[25]; p.b_fada = (const float*)d_in[26]; p.normf_g = (const float*)d_in[27];
  p.out = (float*)d_out;
  char* ws = (char*)d_ws;
  p.winT = (u16*)(ws + 0 * MB); p.wgrT = (u16*)(ws + 11 * MB); p.wgaT = (u16*)(ws + 13 * MB); p.wgbT = (u16*)(ws + 15 * MB);
  p.wglaT = (u16*)(ws + 17 * MB); p.wdiffT = (u16*)(ws + 19 * MB); p.woutT = (u16*)(ws + 21 * MB); p.wqT = (u16*)(ws + 23 * MB);
  p.subk = (u16*)(ws + 27 * MB); p.rope = (float*)(ws + 28 * MB);
  p.mod = (float*)(ws + 36 * MB); p.fmod = (float*)(ws + 36 * MB + 128 * 1024); p.lam = (float*)(ws + 36 * MB + 192 * 1024);
  p.counter = (int*)(ws + 36 * MB + 196 * 1024);
  p.kmax = (int*)(ws + 36 * MB + 200 * 1024);
  p.bar = (unsigned*)(ws + 36 * MB + 256 * 1024);
  hipMemsetAsync(p.bar, 0, 4096 * sizeof(unsigned), stream);
  p.lr = (float*)(ws + 37 * MB); p.dec = (float*)(ws + 41 * MB); p.rstd = (float*)(ws + 43 * MB);
  char* slot[9];
  for (int i = 0; i < 7; ++i) slot[i] = ws + (44 + 64 * (size_t)i) * MB;
  slot[7] = (char*)d_out; slot[8] = (char*)d_out + 64 * MB;
  p.hA = (u16*)slot[0];
  p.gq = (u16*)slot[1]; p.gk = (u16*)(slot[1] + 32 * MB);
  p.gvT = (u16*)slot[2]; p.dq = (u16*)slot[3]; p.dk = (u16*)slot[4]; p.dvT = (u16*)slot[5];
  p.qe_fw = (u16*)slot[0]; p.ke_fw = (u16*)(slot[0] + 32 * MB);
  p.qe_bw = (u16*)slot[6]; p.ke_bw = (u16*)(slot[6] + 32 * MB);
  p.keT = (u16*)slot[7];
  p.o_fw = (u16*)slot[1]; p.o_bw = (u16*)slot[8];
  p.uB = (u16*)slot[6]; p.vB = (u16*)(slot[6] + 16 * MB);
  p.A1 = (u16*)slot[2]; p.merged = (u16*)slot[4];
  p.sga = (u16*)slot[5]; p.sgb = (u16*)slot[7];
  p.x1 = (float*)slot[0];
  p.h2 = (u16*)slot[2]; p.qp = (u16*)slot[3];
  p.us = (float*)(slot[6] + 32 * MB); p.vs = (float*)(slot[6] + 33 * MB);
  p.idx = (int*)slot[5]; p.g = (float*)(slot[5] + 16 * MB);
  void* args[] = {&p};
  hipError_t e = hipLaunchCooperativeKernel((void*)fwd_megakernel, dim3(grid_blocks), dim3(512), args, LDS_BYTES, stream);
  if (e != hipSuccess) fprintf(stderr, "cooperative launch failed: %s (grid %d)\n", hipGetErrorString(e), grid_blocks);
}
```

```cpp
#include <hip/hip_runtime.h>
#include <hip/hip_cooperative_groups.h>
#include <cstdio>
namespace cg = cooperative_groups;

#define DI __device__ __forceinline__
typedef unsigned short u16;
using bf16x8 = __attribute__((ext_vector_type(8))) short;
using f32x16 = __attribute__((ext_vector_type(16))) float;
using u32x4 = __attribute__((ext_vector_type(4))) unsigned;
using u32x2 = __attribute__((ext_vector_type(2))) unsigned;
typedef __bf16 bf16x2_t __attribute__((ext_vector_type(2)));
typedef float f32x2_t __attribute__((ext_vector_type(2)));

constexpr int T = 32768, D = 1024, S = 8192;
constexpr size_t MB = 1ull << 20;
constexpr float RMS_EPS = 1e-6f;
constexpr int LDS_BYTES = 160 * 1024;
constexpr int SITEM_OFF = 150 * 1024;

#define MFMA(a, b, c) __builtin_amdgcn_mfma_f32_32x32x16_bf16((a), (b), (c), 0, 0, 0)

struct Params {
  const float *x, *c; const int* pos;
  const float *w_ada, *b_ada, *norm1_g, *w_in, *wa_fw, *ba_fw, *wa_bw, *ba_bw, *gla_norm_g;
  const float *lq1, *lk1, *lq2, *lk2, *diff_norm_g, *w_gla, *w_diff, *w_out, *norm2_g, *peer_wq, *subkeys, *peer_u, *peer_v;
  const float *w_fada, *b_fada, *normf_g;
  float* out;
  u16 *winT, *wgrT, *wgaT, *wgbT, *wglaT, *wdiffT, *woutT, *wqT, *subk;
  float* rope;
  float* mod;
  float* fmod;
  float* lam;
  int* counter;
  float* lr;
  float* dec;
  float* rstd;
  u16 *hA, *gq, *gk, *gvT, *dq, *dk, *dvT;
  u16 *qe_fw, *ke_fw, *qe_bw, *ke_bw, *keT;
  u16 *o_fw, *o_bw, *A1, *merged, *h2, *qp, *uB, *vB;
  float* x1;
  int* idx; float* g;
  float *us, *vs;
  u16 *sga, *sgb;
  unsigned* bar;
  int* kmax;
};

DI u16 f2bf(float x) { unsigned u = __float_as_uint(x); u += 0x7fffu + ((u >> 16) & 1u); return (u16)(u >> 16); }
DI float bf2f(u16 b) { return __uint_as_float(((unsigned)b) << 16); }
DI unsigned pack2(float a, float b) {
  f32x2_t v = {a, b};
  bf16x2_t r = __builtin_convertvector(v, bf16x2_t);
  return __builtin_bit_cast(unsigned, r);
}
DI float bflo(unsigned u) { return __uint_as_float(u << 16); }
DI float bfhi(unsigned u) { return __uint_as_float(u & 0xffff0000u); }
DI int crow(int i, int h) { return (i & 3) + 8 * (i >> 2) + 4 * h; }
DI bf16x8 pack_step(const f32x16& x, int s) {
  u32x4 p;
  p[0] = pack2(x[8 * s + 0], x[8 * s + 1]);
  p[1] = pack2(x[8 * s + 2], x[8 * s + 3]);
  p[2] = pack2(x[8 * s + 4], x[8 * s + 5]);
  p[3] = pack2(x[8 * s + 6], x[8 * s + 7]);
  return __builtin_bit_cast(bf16x8, p);
}
DI bf16x8 ld_frag16(const u16* p) { return __builtin_bit_cast(bf16x8, *(const u32x4*)p); }
DI bf16x8 ld_frag8x2(const u16* p) {
  u32x2 lo = *(const u32x2*)p; u32x2 hi = *(const u32x2*)(p + 8);
  u32x4 v = {lo[0], lo[1], hi[0], hi[1]};
  return __builtin_bit_cast(bf16x8, v);
}
DI void st_perm(u16* rowp, int ch, u32x4 v) {
  u16* d = rowp + (ch >> 1) * 16 + (ch & 1) * 4;
  u32x2 lo = {v[0], v[1]}, hi = {v[2], v[3]};
  *(u32x2*)d = lo;
  *(u32x2*)(d + 8) = hi;
}
DI float wave_sum(float v) {
#pragma unroll
  for (int o = 32; o >= 1; o >>= 1) v += __shfl_xor(v, o);
  return v;
}

template <int CTRL> DI float dpp_f(float v) { return __builtin_bit_cast(float, __builtin_amdgcn_update_dpp(0, __builtin_bit_cast(int, v), CTRL, 0xF, 0xF, false)); }
template <int CTRL> DI unsigned dpp_u(unsigned v) { return (unsigned)__builtin_amdgcn_update_dpp(0, (int)v, CTRL, 0xF, 0xF, false); }
DI float gsum16(float v) { v += dpp_f<0x121>(v); v += dpp_f<0x122>(v); v += dpp_f<0x124>(v); v += dpp_f<0x128>(v); return v; }
DI float gmaxf16(float v) { v = fmaxf(v, dpp_f<0x121>(v)); v = fmaxf(v, dpp_f<0x122>(v)); v = fmaxf(v, dpp_f<0x124>(v)); v = fmaxf(v, dpp_f<0x128>(v)); return v; }
DI unsigned gmax16(unsigned v) { v = max(v, dpp_u<0x121>(v)); v = max(v, dpp_u<0x122>(v)); v = max(v, dpp_u<0x124>(v)); v = max(v, dpp_u<0x128>(v)); return v; }
DI int opq(int x) { asm volatile("" : "+v"(x)); return x; }
DI f32x16 zero16() { f32x16 z; for (int i = 0; i < 16; ++i) z[i] = 0.f; return z; }

DI void tconv_tile(const float* src, int ld, int c0, int nc, u16* dst, int ct, int kt, float* sm, int tid) {
  __syncthreads();
  int cl = tid & 63, r0 = tid >> 6;
#pragma unroll
  for (int r = 0; r < 8; ++r) {
    int k = kt * 64 + r0 + 8 * r;
    int col = ct * 64 + cl;
    float v = (col < nc) ? src[(size_t)k * ld + c0 + col] : 0.f;
    sm[(r0 + 8 * r) * 65 + cl] = v;
  }
  __syncthreads();
#pragma unroll
  for (int r = 0; r < 8; ++r) {
    int col = r0 + 8 * r;
    int k = cl;
    dst[(size_t)(ct * 64 + col) * 1024 + kt * 64 + k] = f2bf(sm[k * 65 + col]);
  }
}

DI void phase_prep(const Params& p, char* smem, int tid) {
  float* sm = (float*)smem;
  const int nblk = gridDim.x, bid = blockIdx.x;
  const int NCT = 32 + 48 + 2 + 16 * 6 + 32;
  for (int it = bid; it < NCT * 16; it += nblk) {
    int ctg = it >> 4, kt = it & 15;
    const float* src; int ld, c0, nc; u16* dst; int ct;
    if (ctg < 32) { src = p.w_in; ld = 8224; c0 = 0; nc = 2048; dst = p.winT; ct = ctg; }
    else if (ctg < 80) { src = p.w_in; ld = 8224; c0 = 3104; nc = 3072; dst = p.winT + (size_t)2048 * 1024; ct = ctg - 32; }
    else if (ctg < 82) { src = p.w_in; ld = 8224; c0 = 3072; nc = 32; dst = p.winT + (size_t)5120 * 1024; ct = ctg - 80; }
    else if (ctg < 98) { src = p.w_in; ld = 8224; c0 = 2048; nc = 1024; dst = p.wgrT; ct = ctg - 82; }
    else if (ctg < 114) { src = p.w_in; ld = 8224; c0 = 6176; nc = 1024; dst = p.wgaT; ct = ctg - 98; }
    else if (ctg < 130) { src = p.w_in; ld = 8224; c0 = 7200; nc = 1024; dst = p.wgbT; ct = ctg - 114; }
    else if (ctg < 146) { src = p.w_gla; ld = 1024; c0 = 0; nc = 1024; dst = p.wglaT; ct = ctg - 130; }
    else if (ctg < 162) { src = p.w_diff; ld = 1024; c0 = 0; nc = 1024; dst = p.wdiffT; ct = ctg - 146; }
    else if (ctg < 178) { src = p.w_out; ld = 1024; c0 = 0; nc = 1024; dst = p.woutT; ct = ctg - 162; }
    else { src = p.peer_wq; ld = 2048; c0 = 0; nc = 2048; dst = p.wqT; ct = ctg - 178; }
    tconv_tile(src, ld, c0, nc, dst, ct, kt, sm, tid);
  }
  __syncthreads();
  const int gtid = bid * 512 + tid, gsz = nblk * 512;
  for (int i = gtid; i < 8 * 2 * 128 * 128; i += gsz) p.subk[i] = f2bf(p.subkeys[i]);
  for (int i = gtid; i < 128 * 1024 / 2; i += gsz) ((unsigned*)(p.winT + (size_t)5248 * 1024))[i] = 0u;
  for (int i = gtid; i < T * 32; i += gsz) {
    int t = i >> 5, d = i & 31;
    float inv = powf(10000.f, -(float)d / 32.f);
    float ang = (float)p.pos[t] * inv;
    double r = (double)ang * 0.15915494309189535;
    r -= rint(r);
    float rf = (float)r;
    p.rope[2 * i] = __builtin_amdgcn_cosf(rf);
    p.rope[2 * i + 1] = __builtin_amdgcn_sinf(rf);
  }
  if (gtid == 0) {
    float s1 = 0.f, s2 = 0.f;
    for (int i = 0; i < 64; ++i) { s1 += p.lq1[i] * p.lk1[i]; s2 += p.lq2[i] * p.lk2[i]; }
    p.lam[0] = expf(s1) - expf(s2) + 0.2f;
    for (int i = 0; i < 128; ++i) p.counter[i] = 0;
    for (int i = 0; i < 64; ++i) p.kmax[i] = 0;
  }
  {
    float* cact = sm;
    float* red = sm + 4096;
    __syncthreads();
    for (int i = tid; i < 4096; i += 512) { float v = p.c[i]; cact[i] = v / (1.f + __expf(-v)); }
    __syncthreads();
    int w = tid >> 6, lane = tid & 63;
    for (int it = bid; it < 128; it += nblk) {
      int col = it * 64 + lane;
      const float* W; int ld, cc;
      if (col < 6144) { W = p.w_ada; ld = 6144; cc = col; } else { W = p.w_fada; ld = 2048; cc = col - 6144; }
      float a0 = 0, a1 = 0, a2 = 0, a3 = 0;
#pragma unroll 8
      for (int k = w * 128; k < w * 128 + 128; ++k) {
        float wv = W[(size_t)k * ld + cc];
        a0 += cact[k] * wv; a1 += cact[1024 + k] * wv; a2 += cact[2048 + k] * wv; a3 += cact[3072 + k] * wv;
      }
      red[(w * 4 + 0) * 64 + lane] = a0; red[(w * 4 + 1) * 64 + lane] = a1;
      red[(w * 4 + 2) * 64 + lane] = a2; red[(w * 4 + 3) * 64 + lane] = a3;
      __syncthreads();
      if (tid < 256) {
        int b = w;
        float s = 0.f;
#pragma unroll
        for (int ww = 0; ww < 8; ++ww) s += red[(ww * 4 + b) * 64 + lane];
        if (col < 6144) p.mod[b * 6144 + cc] = s + p.b_ada[cc];
        else p.fmod[b * 2048 + cc] = s + p.b_fada[cc];
      }
      __syncthreads();
    }
  }
}

DI void phase_norm_mod(const float* src, const float* g, const float* mod, int sh_off, int sc_off, u16* dst, int tid) {
  int w = tid >> 6, lane = tid & 63;
  for (int row = blockIdx.x * 8 + w; row < T; row += gridDim.x * 8) {
    int b = row >> 13;
    const float* xr = src + (size_t)row * 1024;
    float4 v[4]; float ss = 0.f;
#pragma unroll
    for (int m = 0; m < 4; ++m) { v[m] = *(const float4*)(xr + (m * 64 + lane) * 4); ss += v[m].x * v[m].x + v[m].y * v[m].y + v[m].z * v[m].z + v[m].w * v[m].w; }
    ss = wave_sum(ss);
    float rstd = rsqrtf(ss * (1.f / 1024.f) + RMS_EPS);
#pragma unroll
    for (int m = 0; m < 4; ++m) {
      int col = (m * 64 + lane) * 4;
      float4 gg = *(const float4*)(g + col);
      float4 sh = *(const float4*)(mod + b * 6144 + sh_off + col);
      float4 sc = *(const float4*)(mod + b * 6144 + sc_off + col);
      float y0 = v[m].x * rstd * gg.x * (1.f + sc.x) + sh.x;
      float y1 = v[m].y * rstd * gg.y * (1.f + sc.y) + sh.y;
      float y2 = v[m].z * rstd * gg.z * (1.f + sc.z) + sh.z;
      float y3 = v[m].w * rstd * gg.w * (1.f + sc.w) + sh.w;
      u32x2 o = {pack2(y0, y1), pack2(y2, y3)};
      *(u32x2*)(dst + (size_t)row * 1024 + col) = o;
    }
  }
}

constexpr int GLD = 72;
constexpr int GSTAGE = (256 + 256) * GLD;
DI void gemm_kloop(const u16* A, int lda, const u16* Bt, int ldb, int K, f32x16 (&acc)[4][2], u16* smem, int tid) {
  const int w = tid >> 6, lane = tid & 63, c = lane & 31, hh = lane >> 5;
  const int wm = w >> 2, wn = w & 3;
  const int lrow = tid >> 3, lcol = (tid & 7) * 8;
  u32x4 ra[4], rb[4];
  const int nk = K >> 6;
#pragma unroll
  for (int r = 0; r < 4; ++r) { ra[r] = *(const u32x4*)(A + (size_t)(r * 64 + lrow) * lda + lcol); rb[r] = *(const u32x4*)(Bt + (size_t)(r * 64 + lrow) * ldb + lcol); }
  __syncthreads();
  {
    u16* sA = smem; u16* sB = smem + 256 * GLD;
#pragma unroll
    for (int r = 0; r < 4; ++r) { *(u32x4*)(sA + (r * 64 + lrow) * GLD + lcol) = ra[r]; *(u32x4*)(sB + (r * 64 + lrow) * GLD + lcol) = rb[r]; }
  }
#pragma unroll
  for (int r = 0; r < 4; ++r) { ra[r] = *(const u32x4*)(A + (size_t)(r * 64 + lrow) * lda + 64 + lcol); rb[r] = *(const u32x4*)(Bt + (size_t)(r * 64 + lrow) * ldb + 64 + lcol); }
  __syncthreads();
  for (int kt = 0; kt < nk; ++kt) {
    const u16* sA = smem + (kt & 1) * GSTAGE; const u16* sB = sA + 256 * GLD;
    bf16x8 fr[1][6];
#define GLOADF(set, s) { _Pragma("unroll") for (int mi = 0; mi < 4; ++mi) fr[set][mi] = ld_frag16(sA + (wm * 128 + mi * 32 + c) * GLD + (s) * 16 + hh * 8); \
                         _Pragma("unroll") for (int ni = 0; ni < 2; ++ni) fr[set][4 + ni] = ld_frag16(sB + (wn * 64 + ni * 32 + c) * GLD + (s) * 16 + hh * 8); }
#define GMM(set) { _Pragma("unroll") for (int mi = 0; mi < 4; ++mi) _Pragma("unroll") for (int ni = 0; ni < 2; ++ni) acc[mi][ni] = MFMA(fr[set][mi], fr[set][4 + ni], acc[mi][ni]); }
    GLOADF(0, 0);
    __builtin_amdgcn_sched_barrier(0);
    GMM(0);
    __builtin_amdgcn_sched_barrier(0);
    GLOADF(0, 1);
    __builtin_amdgcn_sched_barrier(0);
    if (kt + 1 < nk) {
      u16* nA = smem + ((kt + 1) & 1) * GSTAGE; u16* nB = nA + 256 * GLD;
#pragma unroll
      for (int r = 0; r < 4; ++r) { *(u32x4*)(nA + (r * 64 + lrow) * GLD + lcol) = ra[r]; *(u32x4*)(nB + (r * 64 + lrow) * GLD + lcol) = rb[r]; }
      if (kt + 2 < nk) {
#pragma unroll
        for (int r = 0; r < 4; ++r) { ra[r] = *(const u32x4*)(A + (size_t)(r * 64 + lrow) * lda + (kt + 2) * 64 + lcol); rb[r] = *(const u32x4*)(Bt + (size_t)(r * 64 + lrow) * ldb + (kt + 2) * 64 + lcol); }
      }
    }
    __builtin_amdgcn_sched_barrier(0);
    GMM(0);
    __builtin_amdgcn_sched_barrier(0);
    GLOADF(0, 2);
    __builtin_amdgcn_sched_barrier(0);
    GMM(0);
    __builtin_amdgcn_sched_barrier(0);
    GLOADF(0, 3);
    __builtin_amdgcn_sched_barrier(0);
    GMM(0);
#undef GLOADF
#undef GMM
    __syncthreads();
  }
}
DI void zero_acc(f32x16 (&acc)[4][2]) {
#pragma unroll
  for (int a = 0; a < 4; ++a)
#pragma unroll
    for (int b = 0; b < 2; ++b) acc[a][b] = zero16();
}

constexpr int EPS = 68, EPT = 65;
__device__ __forceinline__ unsigned xb_xcc_id();

template <class F> DI void xcd_queue(int* counters, int per_xcd, char* smem, int tid, F f) {
  int* sitem = (int*)(smem + SITEM_OFF);
  const int myx = (int)xb_xcc_id() & 7;
  for (int qi = 0; qi < 8; ++qi) {
    const int xq = (myx + qi) & 7;
    for (;;) {
      __syncthreads();
      if (tid == 0) *sitem = atomicAdd(counters + xq, 1);
      __syncthreads();
      const int qn = *sitem;
      if (qn >= per_xcd) break;
      f(xq, qn);
    }
  }
}

template <class F> DI void xcd_static(const Params& p, int per_xcd, char* smem, F f) {
  const int myx = (int)xb_xcc_id() & 7;
  const int rank = (int)((volatile unsigned*)(smem + LDS_BYTES - 16))[2];
  const int nloc = (int)__hip_atomic_load(p.bar + 3600 + myx * 16, __ATOMIC_RELAXED, __HIP_MEMORY_SCOPE_AGENT);
  for (int qn = rank; qn < per_xcd; qn += nloc) f(myx, qn);
  for (int j = 0; j < 8; ++j) {
    const int nj = (int)__hip_atomic_load(p.bar + 3600 + j * 16, __ATOMIC_RELAXED, __HIP_MEMORY_SCOPE_AGENT);
    if (nj == 0) for (int qn = blockIdx.x; qn < per_xcd; qn += gridDim.x) f(j, qn);
  }
}
DI float* wave_stage(char* smem, int w) { return (float*)smem + w * (64 * EPS); }
template <int STR> DI void stage_acc(const f32x16 (&acc)[4][2], int half, float* wl, int c, int hh) {
#pragma unroll
  for (int mi = 0; mi < 2; ++mi)
#pragma unroll
    for (int ni = 0; ni < 2; ++ni)
#pragma unroll
      for (int i = 0; i < 16; ++i) wl[(mi * 32 + crow(i, hh)) * STR + ni * 32 + c] = (half ? acc[2 + mi][ni][i] : acc[mi][ni][i]);
}
DI void st_bf16x8(u16* dst, const float (&v)[8]) {
  u32x4 o = {pack2(v[0], v[1]), pack2(v[2], v[3]), pack2(v[4], v[5]), pack2(v[6], v[7])};
  *(u32x4*)dst = o;
}
DI void ld_bf16x8(const u16* srcp, float (&v)[8]) {
  u32x4 o = *(const u32x4*)srcp;
#pragma unroll
  for (int i = 0; i < 4; ++i) { v[2 * i] = bflo(o[i]); v[2 * i + 1] = bfhi(o[i]); }
}
template <class F> DI void epi_rows(const float* wl, int lane, F f) {
#pragma unroll
  for (int ps = 0; ps < 8; ++ps) {
    const int r = (lane >> 3) + 8 * ps, cc = (lane & 7) * 8;
    float4 v0 = *(const float4*)(wl + r * EPS + cc), v1 = *(const float4*)(wl + r * EPS + cc + 4);
    float v[8] = {v0.x, v0.y, v0.z, v0.w, v1.x, v1.y, v1.z, v1.w};
    f(r, cc, v);
  }
}
DI void epi_cols_bf16(const float* wl, int lane, u16* dstT, size_t ldt) {
#pragma unroll
  for (int ps = 0; ps < 8; ++ps) {
    const int col = (lane >> 3) + 8 * ps, r0 = (lane & 7) * 8;
    float v[8];
#pragma unroll
    for (int j = 0; j < 8; ++j) v[j] = wl[(r0 + j) * EPT + col];
    st_bf16x8(dstT + (size_t)col * ldt + r0, v);
  }
}

DI void phase_proj(const Params& p, char* smem, int tid) {
  const int w = tid >> 6, lane_inv = tid & 63;
  const int wm = w >> 2, wn = w & 3;
  float* wl = wave_stage(smem, w);
  const int NT = 21;
  xcd_static(p, 16 * NT, smem, [&](int xq, int qn) {
    int mt = xq + 8 * (qn / NT), nt = qn % NT;
    int m0 = mt * 256, n0 = nt * 256;
    f32x16 acc[4][2]; zero_acc(acc);
    gemm_kloop(p.hA + (size_t)m0 * 1024, 1024, p.winT + (size_t)n0 * 1024, 1024, 1024, acc, (u16*)smem, opq(tid));
    const int lane = opq(lane_inv);
    const int c = lane & 31, hh = lane >> 5;
    const int cb = n0 + wn * 64;
#pragma unroll
    for (int half = 0; half < 2; ++half) {
      const int rb = m0 + wm * 128 + half * 64;
      if (n0 < 1024) {
        const float sc = (n0 < 512) ? 0.08838834764831845f : 1.f;
        u16* dst = ((n0 < 512) ? p.gq : p.gk) + (size_t)rb * 512 + (cb & 511);
        stage_acc<EPS>(acc, half, wl, c, hh);
        epi_rows(wl, lane, [&](int r, int cc, float (&v)[8]) {
#pragma unroll
          for (int j = 0; j < 8; ++j) v[j] *= sc;
          st_bf16x8(dst + (size_t)r * 512 + cc, v);
        });
      } else if (n0 < 2048 || (n0 >= 4096 && n0 < 5120)) {
        const bool isg = n0 < 2048;
        const int b = rb >> 13;
        u16* dstT;
        if (isg) { int cc0 = cb - 1024; dstT = p.gvT + ((size_t)(b * 4 + (cc0 >> 8)) * 256 + (cc0 & 255)) * 8192 + (rb & 8191); }
        else { int cc0 = cb - 4096; dstT = p.dvT + ((size_t)(b * 8 + (cc0 >> 7)) * 128 + (cc0 & 127)) * 8192 + (rb & 8191); }
        stage_acc<EPT>(acc, half, wl, c, hh);
        epi_cols_bf16(wl, lane, dstT, 8192);
      } else if (n0 < 4096) {
        const bool isq = n0 < 3072;
        const float sc = isq ? (0.125f * 1.4426950408889634f) : 1.f;
        const int cbb = cb - (isq ? 2048 : 3072);
        float knmax = 0.f;
#pragma unroll
        for (int mi = 0; mi < 2; ++mi)
#pragma unroll
          for (int i = 0; i < 16; ++i) {
            int row = rb + mi * 32 + crow(i, hh);
            float2 cs = *(const float2*)(p.rope + ((size_t)row * 32 + c) * 2);
            float x1 = half ? acc[2 + mi][0][i] : acc[mi][0][i], x2 = half ? acc[2 + mi][1][i] : acc[mi][1][i];
            float o1 = (x1 * cs.x - x2 * cs.y) * sc;
            float o2 = (x2 * cs.x + x1 * cs.y) * sc;
            wl[(mi * 32 + crow(i, hh)) * EPS + c] = o1;
            wl[(mi * 32 + crow(i, hh)) * EPS + 32 + c] = o2;
            if (!isq) {
              float ssq = o1 * o1 + o2 * o2;
              ssq += __shfl_xor(ssq, 1); ssq += __shfl_xor(ssq, 2); ssq += __shfl_xor(ssq, 4); ssq += __shfl_xor(ssq, 8); ssq += __shfl_xor(ssq, 16);
              knmax = fmaxf(knmax, ssq);
            }
            if ((i & 3) == 3) __builtin_amdgcn_sched_barrier(0);
          }
        if (!isq && c == 0) atomicMax(p.kmax + ((rb >> 13) * 8 + (cbb >> 7)) * 2 + ((cbb >> 6) & 1), __float_as_int(knmax));
        u16* dst = (isq ? p.dq : p.dk) + (size_t)rb * 1024 + cbb;
        epi_rows(wl, lane, [&](int r, int cc, float (&v)[8]) { st_bf16x8(dst + (size_t)r * 1024 + cc, v); });
      } else {
        if (wn == 0) {
#pragma unroll
          for (int mi = 0; mi < 2; ++mi)
#pragma unroll
            for (int i = 0; i < 16; ++i) {
              int row = rb + mi * 32 + crow(i, hh);
              p.lr[(size_t)row * 32 + c] = half ? acc[2 + mi][0][i] : acc[mi][0][i];
            }
        }
      }
    }
  });
}

DI float logsig(float x) { return fminf(x, 0.f) - __logf(1.f + __expf(-fabsf(x))); }

DI void phase_gla_pre(const Params& p, char* smem, int tid) {
  float* slr = (float*)smem;
  for (int it = blockIdx.x; it < 1024; it += gridDim.x) {
    const int dir = it & 1, ch = (it >> 1) & 127, b = it >> 8;
    const size_t t0 = (size_t)b * 8192 + ch * 64;
    __syncthreads();
    for (int i = tid; i < 1024; i += 512) slr[i] = p.lr[t0 * 32 + (i >> 4) * 32 + dir * 16 + (i & 15)];
    __syncthreads();
    const int j = tid;
    const int h = j >> 7, d = j & 127;
    const float* wa = dir ? p.wa_bw : p.wa_fw;
    float wr[16];
#pragma unroll
    for (int r = 0; r < 16; ++r) wr[r] = wa[r * 512 + j];
    const float ba = (dir ? p.ba_bw : p.ba_fw)[j];
    u16* qe = (dir ? p.qe_bw : p.qe_fw) + t0 * 512 + j;
    u16* ke = (dir ? p.ke_bw : p.ke_fw) + t0 * 512 + j;
    const u16* gq = p.gq + t0 * 512 + j;
    const u16* gk = p.gk + t0 * 512 + j;
    u16* keT = p.keT + (size_t)dir * (16ull * 128 * 8192) + ((size_t)(b * 4 + h) * 128 + d) * 8192 + ch * 64;
    float bsum = 0.f;
#pragma unroll 1
    for (int g8 = 0; g8 < 8; ++g8) {
      u16 qraw[8], kraw[8];
#pragma unroll
      for (int u = 0; u < 8; ++u) {
        const int tt = g8 * 8 + u;
        const int t = dir ? 63 - tt : tt;
        qraw[u] = gq[t * 512]; kraw[u] = gk[t * 512];
      }
      unsigned kk[8];
#pragma unroll
      for (int u = 0; u < 8; ++u) {
        const int tt = g8 * 8 + u;
        const int t = dir ? 63 - tt : tt;
        float pre = ba;
#pragma unroll
        for (int r = 0; r < 16; ++r) pre += slr[t * 16 + r] * wr[r];
        bsum += logsig(pre) * (1.f / 16.f);
        const float eb = __expf(bsum);
        const u16 qo = f2bf(bf2f(qraw[u]) * eb);
        const u16 ko = f2bf(bf2f(kraw[u]) * __expf(-bsum));
        qe[t * 512] = qo;
        ke[t * 512] = ko;
        kk[u] = ko;
      }
      u32x4 v;
      if (!dir) {
        v[0] = kk[0] | (kk[1] << 16); v[1] = kk[2] | (kk[3] << 16); v[2] = kk[4] | (kk[5] << 16); v[3] = kk[6] | (kk[7] << 16);
        *(u32x4*)(keT + g8 * 8) = v;
      } else {
        v[0] = kk[7] | (kk[6] << 16); v[1] = kk[5] | (kk[4] << 16); v[2] = kk[3] | (kk[2] << 16); v[3] = kk[1] | (kk[0] << 16);
        *(u32x4*)(keT + (56 - g8 * 8)) = v;
      }
    }
    p.dec[((size_t)(dir * 4 + b) * 128 + ch) * 512 + j] = __expf(bsum);
  }
}

constexpr int QLD = 136, TLD = 72;
DI void gla_scan_block(const Params& p, int g, char* smem, int tid) {
  const int dir = g & 1, bh = g >> 1;
  const int b = bh >> 2, h = bh & 3;
  const int w = tid >> 6, lane = tid & 63, c = lane & 31, hh = lane >> 5;
  const int slice = w;
  u16* sQ = (u16*)smem;
  u16* sK = sQ + 64 * QLD;
  u16* sKT = sK + 64 * QLD;
  u16* sVT = sKT + 128 * TLD;
  const u16* qe = (dir ? p.qe_bw : p.qe_fw) + (size_t)b * 8192 * 512 + h * 128;
  const u16* ke = (dir ? p.ke_bw : p.ke_fw) + (size_t)b * 8192 * 512 + h * 128;
  const u16* keT = p.keT + (size_t)dir * (16ull * 128 * 8192) + (size_t)bh * 128 * 8192;
  const u16* vT = p.gvT + (size_t)bh * 256 * 8192;
  const float* dec = p.dec + ((size_t)(dir * 4 + b) * 128) * 512 + h * 128;
  u16* o = dir ? p.o_bw : p.o_fw;
  f32x16 st[4];
#pragma unroll
  for (int i = 0; i < 4; ++i) st[i] = zero16();
  u32x4 rq[2], rk[2], rt[2];
  unsigned offq[2], offt[2];
#pragma unroll
  for (int r = 0; r < 2; ++r) {
    int id = tid + 512 * r;
    offq[r] = (unsigned)(((id >> 4) * 512 + (id & 15) * 8) * 2);
    offt[r] = (unsigned)(((id >> 3) * 8192 + (id & 7) * 8) * 2);
  }
  const unsigned offv = (unsigned)(((w * 32 + c) * 8192 + 4 * hh) * 2);
  {
    const int ch = dir ? 127 : 0;
#pragma unroll
    for (int r = 0; r < 2; ++r) {
      int id = tid + 512 * r;
      rq[r] = *(const u32x4*)((const char*)(qe + (size_t)ch * 64 * 512) + offq[r]);
      rk[r] = *(const u32x4*)((const char*)(ke + (size_t)ch * 64 * 512) + offq[r]);
      rt[r] = *(const u32x4*)((const char*)(keT + ch * 64) + offt[r]);
    }
  }
#pragma unroll 1
  for (int ci = 0; ci < 128; ++ci) {
    const int ch = dir ? 127 - ci : ci;
    const size_t t0 = (size_t)b * 8192 + ch * 64;
    __syncthreads();
#pragma unroll
    for (int r = 0; r < 2; ++r) {
      int id = tid + 512 * r;
      st_perm(sQ + (id >> 4) * QLD, id & 15, rq[r]);
      st_perm(sK + (id >> 4) * QLD, id & 15, rk[r]);
      st_perm(sKT + (id >> 3) * TLD, id & 7, rt[r]);
    }
    __syncthreads();
    if (ci + 1 < 128) {
      const int chn = dir ? ch - 1 : ch + 1;
#pragma unroll
      for (int r = 0; r < 2; ++r) {
        int id = tid + 512 * r;
        rq[r] = *(const u32x4*)((const char*)(qe + (size_t)chn * 64 * 512) + offq[r]);
        rk[r] = *(const u32x4*)((const char*)(ke + (size_t)chn * 64 * 512) + offq[r]);
        rt[r] = *(const u32x4*)((const char*)(keT + chn * 64) + offt[r]);
      }
    }
    bf16x8 vf[4];
#pragma unroll
    for (int k4 = 0; k4 < 4; ++k4) vf[k4] = ld_frag8x2((const u16*)((const char*)(vT + ch * 64 + 16 * k4) + offv));
#pragma unroll 1
    for (int qt = 0; qt < 2; ++qt) {
      f32x16 oacc = zero16();
#pragma unroll
      for (int ks = 0; ks < 8; ++ks) {
        bf16x8 sf = pack_step(st[ks >> 1], ks & 1);
        bf16x8 q0 = ld_frag16(sQ + (qt * 32 + c) * QLD + ks * 16 + 8 * hh);
        oacc = MFMA(q0, sf, oacc);
        if (ks & 1) __builtin_amdgcn_sched_barrier(0);
      }
#pragma unroll
      for (int kt = 0; kt < 2; ++kt) {
        bool skip = dir ? (kt < qt) : (kt > qt);
        if (skip) continue;
        f32x16 X = zero16();
#pragma unroll 1
        for (int ks = 0; ks < 8; ++ks) {
          bf16x8 kf = ld_frag16(sK + (kt * 32 + c) * QLD + ks * 16 + 8 * hh);
          bf16x8 qf = ld_frag16(sQ + (qt * 32 + c) * QLD + ks * 16 + 8 * hh);
          X = MFMA(kf, qf, X);
        }
        if (kt == qt) {
#pragma unroll
          for (int i = 0; i < 16; ++i) {
            int key = crow(i, hh);
            bool keep = dir ? (key >= c) : (key <= c);
            X[i] = keep ? X[i] : 0.f;
          }
        }
        oacc = MFMA(pack_step(X, 0), vf[kt * 2 + 0], oacc);
        oacc = MFMA(pack_step(X, 1), vf[kt * 2 + 1], oacc);
        __builtin_amdgcn_sched_barrier(0);
      }
#pragma unroll
      for (int i = 0; i < 16; ++i)
        o[(t0 + qt * 32 + crow(i, hh)) * 1024 + h * 256 + slice * 32 + c] = f2bf(oacc[i]);
      __builtin_amdgcn_sched_barrier(0);
    }
#pragma unroll
    for (int dt = 0; dt < 4; ++dt) {
#pragma unroll
      for (int k4 = 0; k4 < 4; ++k4) {
        bf16x8 kt_f = ld_frag16(sKT + (dt * 32 + c) * TLD + 16 * k4 + 8 * hh);
        st[dt] = MFMA(kt_f, vf[k4], st[dt]);
      }
#pragma unroll
      for (int gg = 0; gg < 4; ++gg) {
        float4 dv = *(const float4*)(dec + (size_t)ch * 512 + dt * 32 + 8 * gg + 4 * hh);
        st[dt][4 * gg + 0] *= dv.x; st[dt][4 * gg + 1] *= dv.y; st[dt][4 * gg + 2] *= dv.z; st[dt][4 * gg + 3] *= dv.w;
      }
      __builtin_amdgcn_sched_barrier(0);
    }
  }
}

constexpr int KLD = 136, VLD = 72;
constexpr int ATT_BUF = 64 * KLD + 128 * VLD;
DI void attn_item(const Params& p, int item, char* smem, int tid) {
  const int qb = item & 63, bh = item >> 6;
  const int b = bh >> 3, h = bh & 7;
  const int w = tid >> 6, lane = tid & 63, c = lane & 31, hh = lane >> 5;
  const int qg = w & 3, mp = w >> 2;
  u16* sbase = (u16*)smem;
  float* sex = (float*)(smem + 2 * ATT_BUF * 2);
  const size_t tq = (size_t)b * 8192 + qb * 128 + qg * 32 + c;
  bf16x8 qf[4];
#pragma unroll
  for (int s = 0; s < 4; ++s) qf[s] = ld_frag16(p.dq + tq * 1024 + h * 128 + mp * 64 + 16 * s + 8 * hh);
  f32x16 O[4];
#pragma unroll
  for (int dt = 0; dt < 4; ++dt) O[dt] = zero16();
  float lrun = 0.f;
  float negmb;
  {
    float qn = 0.f;
#pragma unroll
    for (int s = 0; s < 4; ++s) {
      u32x4 qq = __builtin_bit_cast(u32x4, qf[s]);
#pragma unroll
      for (int i = 0; i < 4; ++i) { float x0 = bflo(qq[i]), x1 = bfhi(qq[i]); qn += x0 * x0 + x1 * x1; }
    }
    qn += __shfl_xor(qn, 32);
    float kn = __int_as_float(p.kmax[(b * 8 + h) * 2 + mp]);
    float mb = sqrtf(qn * kn) * 1.01f + 1e-3f;
    negmb = -mb;
  }
  const u16* Kg = p.dk + (size_t)b * 8192 * 1024 + h * 128;
  const u16* Vg = p.dvT + (size_t)bh * 128 * 8192;
  u32x4 rk[2], rv[2];
#pragma unroll
  for (int r = 0; r < 2; ++r) {
    int id = tid + 512 * r;
    rk[r] = *(const u32x4*)(Kg + (size_t)(id >> 4) * 1024 + (id & 15) * 8);
    rv[r] = *(const u32x4*)(Vg + (size_t)(id >> 3) * 8192 + (id & 7) * 8);
  }
  __syncthreads();
#pragma unroll
  for (int r = 0; r < 2; ++r) {
    int id = tid + 512 * r;
    *(u32x4*)(sbase + (id >> 4) * KLD + (id & 15) * 8) = rk[r];
    st_perm(sbase + 64 * KLD + (id >> 3) * VLD, id & 7, rv[r]);
  }
#pragma unroll
  for (int r = 0; r < 2; ++r) {
    int id = tid + 512 * r;
    rk[r] = *(const u32x4*)(Kg + (size_t)(64 + (id >> 4)) * 1024 + (id & 15) * 8);
    rv[r] = *(const u32x4*)(Vg + (size_t)(id >> 3) * 8192 + 64 + (id & 7) * 8);
  }
  __syncthreads();
#pragma unroll 1
  for (int kt = 0; kt < 128; ++kt) {
    const u16* sK = sbase + (kt & 1) * ATT_BUF;
    const u16* sV = sK + 64 * KLD;
    f32x16 sacc[2];
    bf16x8 kf[8];
#pragma unroll
    for (int s = 0; s < 4; ++s)
#pragma unroll
      for (int k2 = 0; k2 < 2; ++k2) kf[s * 2 + k2] = ld_frag16(sK + (k2 * 32 + c) * KLD + mp * 64 + 16 * s + 8 * hh);
    __builtin_amdgcn_sched_barrier(0);
#pragma unroll
    for (int i = 0; i < 16; ++i) { sacc[0][i] = negmb; sacc[1][i] = negmb; }
#pragma unroll
    for (int s = 0; s < 4; ++s) {
      sacc[0] = MFMA(kf[s * 2 + 0], qf[s], sacc[0]);
      sacc[1] = MFMA(kf[s * 2 + 1], qf[s], sacc[1]);
    }
    bf16x8 vfA[4], vfB[4];
#define VLOAD(dst, k2, s2) { _Pragma("unroll") for (int dt = 0; dt < 4; ++dt) dst[dt] = ld_frag16(sV + (dt * 32 + c) * VLD + (k2) * 32 + (s2) * 16 + 8 * hh); }
#define PVMM(vf, pf) { _Pragma("unroll") for (int dt = 0; dt < 4; ++dt) O[dt] = MFMA(vf[dt], pf, O[dt]); }
#define EXPS(k2) { _Pragma("unroll") for (int i = 0; i < 8; ++i) { \
        float e0 = __builtin_amdgcn_exp2f(sacc[k2][2 * i]), e1 = __builtin_amdgcn_exp2f(sacc[k2][2 * i + 1]); \
        sacc[k2][2 * i] = e0; sacc[k2][2 * i + 1] = e1; f32x2_t ev = {e0, e1}; ls2 += ev; } }
    VLOAD(vfA, 0, 0);
    __builtin_amdgcn_sched_barrier(0);
    if (kt + 1 < 128) {
      u16* nK = sbase + ((kt + 1) & 1) * ATT_BUF;
      u16* nV = nK + 64 * KLD;
#pragma unroll
      for (int r = 0; r < 2; ++r) {
        int id = tid + 512 * r;
        *(u32x4*)(nK + (id >> 4) * KLD + (id & 15) * 8) = rk[r];
        st_perm(nV + (id >> 3) * VLD, id & 7, rv[r]);
      }
      if (kt + 2 < 128) {
#pragma unroll
        for (int r = 0; r < 2; ++r) {
          int id = tid + 512 * r;
          rk[r] = *(const u32x4*)(Kg + (size_t)((kt + 2) * 64 + (id >> 4)) * 1024 + (id & 15) * 8);
          rv[r] = *(const u32x4*)(Vg + (size_t)(id >> 3) * 8192 + (kt + 2) * 64 + (id & 7) * 8);
        }
      }
    }
    __builtin_amdgcn_sched_barrier(0);
    f32x2_t ls2 = {0.f, 0.f};
    EXPS(0);
    bf16x8 p0 = pack_step(sacc[0], 0), p1 = pack_step(sacc[0], 1);
    __builtin_amdgcn_sched_barrier(0);
    VLOAD(vfB, 0, 1);
    PVMM(vfA, p0);
    __builtin_amdgcn_sched_barrier(0);
    VLOAD(vfA, 1, 0);
    PVMM(vfB, p1);
    __builtin_amdgcn_sched_barrier(0);
    EXPS(1);
    p0 = pack_step(sacc[1], 0); p1 = pack_step(sacc[1], 1);
    __builtin_amdgcn_sched_barrier(0);
    VLOAD(vfB, 1, 1);
    PVMM(vfA, p0);
    __builtin_amdgcn_sched_barrier(0);
    PVMM(vfB, p1);
    lrun += ls2[0] + ls2[1];
#undef VLOAD
#undef PVMM
#undef EXPS
    __syncthreads();
  }
  float ltot = lrun + __shfl_xor(lrun, 32);
  if (mp == 1) {
    float sc = p.lam[0] / ltot;
#pragma unroll
    for (int dt = 0; dt < 4; ++dt)
#pragma unroll
      for (int i = 0; i < 16; ++i) sex[(qg * 64 + dt * 16 + i) * 64 + lane] = O[dt][i] * sc;
  }
  __syncthreads();
  if (mp == 0) {
    float i0 = 1.f / ltot;
    float ss = 0.f;
#pragma unroll
    for (int dt = 0; dt < 4; ++dt)
#pragma unroll
      for (int i = 0; i < 16; ++i) { float v = O[dt][i] * i0 - sex[(qg * 64 + dt * 16 + i) * 64 + lane]; O[dt][i] = v; ss += v * v; }
    ss += __shfl_xor(ss, 32);
    float rstd = rsqrtf(ss * (1.f / 128.f) + RMS_EPS) * 0.8f;
#pragma unroll
    for (int dt = 0; dt < 4; ++dt)
#pragma unroll
      for (int g = 0; g < 4; ++g) {
        int dv = dt * 32 + 8 * g + 4 * hh;
        float4 gg = *(const float4*)(p.diff_norm_g + h * 128 + dv);
        u32x2 v = {pack2(O[dt][4 * g] * rstd * gg.x, O[dt][4 * g + 1] * rstd * gg.y),
                   pack2(O[dt][4 * g + 2] * rstd * gg.z, O[dt][4 * g + 3] * rstd * gg.w)};
        *(u32x2*)(p.dq + tq * 1024 + h * 128 + dv) = v;
      }
  }
}

DI void phase_mixers(const Params& p, char* smem, int tid) {
  if (blockIdx.x < 32) gla_scan_block(p, blockIdx.x, smem, opq(tid));
  xcd_queue(p.counter + 56, 256, smem, tid, [&](int xq, int qn) {
    const int bh = xq + 8 * (qn >> 6);
    attn_item(p, bh * 64 + (qn & 63), smem, opq(tid));
  });
}

DI void phase_post_mixers(const Params& p, int tid) {
  int w = tid >> 6, lane = tid & 63;
  for (int row = blockIdx.x * 8 + w; row < T; row += gridDim.x * 8) {
#pragma unroll
    for (int hd = 0; hd < 4; ++hd) {
      u32x2 a = *(const u32x2*)(p.o_fw + (size_t)row * 1024 + hd * 256 + lane * 4);
      u32x2 bq = *(const u32x2*)(p.o_bw + (size_t)row * 1024 + hd * 256 + lane * 4);
      float v0 = bflo(a[0]) + bflo(bq[0]), v1 = bfhi(a[0]) + bfhi(bq[0]), v2 = bflo(a[1]) + bflo(bq[1]), v3 = bfhi(a[1]) + bfhi(bq[1]);
      float ss = wave_sum(v0 * v0 + v1 * v1 + v2 * v2 + v3 * v3);
      if (lane == 0) p.rstd[row * 4 + hd] = rsqrtf(ss * (1.f / 256.f) + RMS_EPS);
    }
  }
  phase_norm_mod(p.x, p.norm1_g, p.mod, 0, 1024, p.hA, tid);
  for (int row = blockIdx.x * 8 + w; row < 32768; row += gridDim.x * 8) {
    const bool isv = row >= 16384;
    const int r = row & 16383;
    const float* srcp = (isv ? p.peer_v : p.peer_u) + (size_t)r * 1024 + lane * 16;
    float4 a0 = *(const float4*)(srcp), a1 = *(const float4*)(srcp + 4), a2 = *(const float4*)(srcp + 8), a3 = *(const float4*)(srcp + 12);
    float am = fmaxf(fmaxf(fmaxf(fabsf(a0.x), fabsf(a0.y)), fmaxf(fabsf(a0.z), fabsf(a0.w))), fmaxf(fmaxf(fabsf(a1.x), fabsf(a1.y)), fmaxf(fabsf(a1.z), fabsf(a1.w))));
    am = fmaxf(am, fmaxf(fmaxf(fmaxf(fabsf(a2.x), fabsf(a2.y)), fmaxf(fabsf(a2.z), fabsf(a2.w))), fmaxf(fmaxf(fabsf(a3.x), fabsf(a3.y)), fmaxf(fabsf(a3.z), fabsf(a3.w)))));
#pragma unroll
    for (int o = 32; o >= 1; o >>= 1) am = fmaxf(am, __shfl_xor(am, o));
    am = fmaxf(am, 1e-30f);
    const float sc = 256.f / am;
    u32x4 v;
    int t0 = __builtin_amdgcn_cvt_pk_fp8_f32(a0.x * sc, a0.y * sc, 0, false); t0 = __builtin_amdgcn_cvt_pk_fp8_f32(a0.z * sc, a0.w * sc, t0, true);
    int t1 = __builtin_amdgcn_cvt_pk_fp8_f32(a1.x * sc, a1.y * sc, 0, false); t1 = __builtin_amdgcn_cvt_pk_fp8_f32(a1.z * sc, a1.w * sc, t1, true);
    int t2 = __builtin_amdgcn_cvt_pk_fp8_f32(a2.x * sc, a2.y * sc, 0, false); t2 = __builtin_amdgcn_cvt_pk_fp8_f32(a2.z * sc, a2.w * sc, t2, true);
    int t3 = __builtin_amdgcn_cvt_pk_fp8_f32(a3.x * sc, a3.y * sc, 0, false); t3 = __builtin_amdgcn_cvt_pk_fp8_f32(a3.z * sc, a3.w * sc, t3, true);
    v[0] = (unsigned)t0; v[1] = (unsigned)t1; v[2] = (unsigned)t2; v[3] = (unsigned)t3;
    unsigned char* dst = (unsigned char*)(isv ? p.vB : p.uB) + (size_t)r * 1024 + lane * 16;
    *(u32x4*)dst = v;
    if (lane == 0) (isv ? p.vs : p.us)[r] = am * (1.f / 256.f);
  }
}

DI void phase_gr(const Params& p, char* smem, int tid) {
  const int w = tid >> 6, lane_inv = tid & 63;
  const int wm = w >> 2, wn = w & 3;
  float* wl = wave_stage(smem, w);
  xcd_static(p, 16 * 12, smem, [&](int xq, int qn) {
    int mt = xq + 8 * (qn / 12), nt = qn % 12;
    int m0 = mt * 256, n0 = nt * 256;
    f32x16 acc[4][2]; zero_acc(acc);
    gemm_kloop(p.hA + (size_t)m0 * 1024, 1024, p.wgrT + (size_t)n0 * 1024, 1024, 1024, acc, (u16*)smem, opq(tid));
    const int lane = opq(lane_inv);
    const int c = lane & 31, hh = lane >> 5;
#pragma unroll
    for (int half = 0; half < 2; ++half) {
      const int rb = m0 + wm * 128 + half * 64;
      stage_acc<EPS>(acc, half, wl, c, hh);
      if (n0 < 1024) {
        const int cb = n0 + wn * 64;
        epi_rows(wl, lane, [&](int r, int cc, float (&v)[8]) {
          const size_t off = (size_t)(rb + r) * 1024 + cb + cc;
          float of[8], ob[8];
          ld_bf16x8(p.o_fw + off, of); ld_bf16x8(p.o_bw + off, ob);
          const float rs = p.rstd[(rb + r) * 4 + ((cb + cc) >> 8)];
          float4 g0 = *(const float4*)(p.gla_norm_g + cb + cc), g1 = *(const float4*)(p.gla_norm_g + cb + cc + 4);
          const float gg[8] = {g0.x, g0.y, g0.z, g0.w, g1.x, g1.y, g1.z, g1.w};
#pragma unroll
          for (int j = 0; j < 8; ++j) { float a = v[j]; v[j] = (of[j] + ob[j]) * rs * gg[j] * (a / (1.f + __expf(-a))); }
          st_bf16x8(p.A1 + off, v);
        });
      } else {
        u16* dst = ((n0 < 2048) ? p.sga : p.sgb) + (size_t)rb * 1024 + (n0 & 1023) + wn * 64;
        epi_rows(wl, lane, [&](int r, int cc, float (&v)[8]) {
#pragma unroll
          for (int j = 0; j < 8; ++j) v[j] = 1.f / (1.f + __expf(-v[j]));
          st_bf16x8(dst + (size_t)r * 1024 + cc, v);
        });
      }
    }
  });
}

DI void phase_merge(const Params& p, char* smem, int tid) {
  const int w = tid >> 6, lane_inv = tid & 63;
  const int wm = w >> 2, wn = w & 3;
  float* wl = wave_stage(smem, w);
  xcd_static(p, 16 * 4, smem, [&](int xq, int qn) {
    int mt = xq + 8 * (qn >> 2), nt = qn & 3;
    int m0 = mt * 256, n0 = nt * 256;
    f32x16 acc[4][2];
    zero_acc(acc);
    gemm_kloop(p.A1 + (size_t)m0 * 1024, 1024, p.wglaT + (size_t)n0 * 1024, 1024, 1024, acc, (u16*)smem, opq(tid));
    {
      const int lane = opq(lane_inv);
      const int c = lane & 31, hh = lane >> 5;
#pragma unroll
      for (int half = 0; half < 2; ++half) {
        const size_t tb = (size_t)(m0 + wm * 128 + half * 64) * 1024 + n0 + wn * 64;
        stage_acc<EPS>(acc, half, wl, c, hh);
        epi_rows(wl, lane, [&](int r, int cc, float (&v)[8]) {
          float gv[8];
          ld_bf16x8(p.sga + tb + (size_t)r * 1024 + cc, gv);
#pragma unroll
          for (int j = 0; j < 8; ++j) v[j] *= gv[j];
          st_bf16x8(p.sga + tb + (size_t)r * 1024 + cc, v);
        });
      }
    }
    zero_acc(acc);
    gemm_kloop(p.dq + (size_t)m0 * 1024, 1024, p.wdiffT + (size_t)n0 * 1024, 1024, 1024, acc, (u16*)smem, opq(tid));
    {
      const int lane = opq(lane_inv);
      const int c = lane & 31, hh = lane >> 5;
#pragma unroll
      for (int half = 0; half < 2; ++half) {
        const size_t tb = (size_t)(m0 + wm * 128 + half * 64) * 1024 + n0 + wn * 64;
        stage_acc<EPS>(acc, half, wl, c, hh);
        epi_rows(wl, lane, [&](int r, int cc, float (&v)[8]) {
          float gv[8], mv[8];
          ld_bf16x8(p.sgb + tb + (size_t)r * 1024 + cc, gv);
          ld_bf16x8(p.sga + tb + (size_t)r * 1024 + cc, mv);
#pragma unroll
          for (int j = 0; j < 8; ++j) v[j] = mv[j] + v[j] * gv[j];
          st_bf16x8(p.merged + tb + (size_t)r * 1024 + cc, v);
        });
      }
    }
  });
}

DI void phase_out(const Params& p, char* smem, int tid) {
  const int w = tid >> 6, lane_inv = tid & 63;
  const int wm = w >> 2, wn = w & 3;
  float* wl = wave_stage(smem, w);
  xcd_static(p, 16 * 4, smem, [&](int xq, int qn) {
    int mt = xq + 8 * (qn >> 2), nt = qn & 3;
    int m0 = mt * 256, n0 = nt * 256;
    f32x16 acc[4][2]; zero_acc(acc);
    gemm_kloop(p.merged + (size_t)m0 * 1024, 1024, p.woutT + (size_t)n0 * 1024, 1024, 1024, acc, (u16*)smem, opq(tid));
    const int lane = opq(lane_inv);
    const int c = lane & 31, hh = lane >> 5;
    const int b = m0 >> 13;
    const int cb = n0 + wn * 64;
#pragma unroll
    for (int half = 0; half < 2; ++half) {
      const size_t tb = (size_t)(m0 + wm * 128 + half * 64) * 1024 + cb;
      stage_acc<EPS>(acc, half, wl, c, hh);
      epi_rows(wl, lane, [&](int r, int cc, float (&v)[8]) {
        const float* xp = p.x + tb + (size_t)r * 1024 + cc;
        const float* gp = p.mod + b * 6144 + 2048 + cb + cc;
        float4 x0 = *(const float4*)xp, x1v = *(const float4*)(xp + 4);
        float4 g0 = *(const float4*)gp, g1 = *(const float4*)(gp + 4);
        float4 o0 = {x0.x + g0.x * v[0], x0.y + g0.y * v[1], x0.z + g0.z * v[2], x0.w + g0.w * v[3]};
        float4 o1 = {x1v.x + g1.x * v[4], x1v.y + g1.y * v[5], x1v.z + g1.z * v[6], x1v.w + g1.w * v[7]};
        float* op = p.x1 + tb + (size_t)r * 1024 + cc;
        *(float4*)op = o0; *(float4*)(op + 4) = o1;
      });
    }
  });
}

DI void phase_peerq(const Params& p, char* smem, int tid) {
  const int w = tid >> 6, lane_inv = tid & 63;
  const int wm = w >> 2, wn = w & 3;
  float* wl = wave_stage(smem, w);
  xcd_static(p, 16 * 8, smem, [&](int xq, int qn) {
    int mt = xq + 8 * (qn >> 3), nt = qn & 7;
    int m0 = mt * 256, n0 = nt * 256;
    f32x16 acc[4][2]; zero_acc(acc);
    gemm_kloop(p.h2 + (size_t)m0 * 1024, 1024, p.wqT + (size_t)n0 * 1024, 1024, 1024, acc, (u16*)smem, opq(tid));
    const int lane = opq(lane_inv);
    const int c = lane & 31, hh = lane >> 5;
#pragma unroll
    for (int half = 0; half < 2; ++half) {
      u16* dst = p.qp + (size_t)(m0 + wm * 128 + half * 64) * 2048 + n0 + wn * 64;
      stage_acc<EPS>(acc, half, wl, c, hh);
      epi_rows(wl, lane, [&](int r, int cc, float (&v)[8]) { st_bf16x8(dst + (size_t)r * 2048 + cc, v); });
    }
  });
}

DI unsigned fkey(float f) { unsigned u = __float_as_uint(f); return (u & 0x80000000u) ? ~u : (u | 0x80000000u); }
DI void phase_topk(const Params& p, char* smem, int tid) {
  float* sc = (float*)smem;
  float* ts = sc + 128 * 132;
  int* ti = (int*)(ts + 128 * 32);
  const int w = tid >> 6, lane = tid & 63, c = lane & 31, hh = lane >> 5;
  const int l16 = tid & 15, grp = tid >> 4;
  const int nt = w & 3, mt = w >> 2;
  bf16x8 af[8], af2[8], bfq[8];
#define TK_LOAD(item_, pp_) { const int h_ = (item_) & 7; const u16* Aq_ = p.qp + (size_t)((item_) >> 3) * 128 * 2048 + h_ * 256 + (pp_) * 128; \
    const u16* Bk_ = p.subk + (size_t)(h_ * 2 + (pp_)) * 128 * 128; \
    _Pragma("unroll") for (int s = 0; s < 8; ++s) { bfq[s] = ld_frag16(Bk_ + (32 * nt + c) * 128 + 16 * s + 8 * hh); af[s] = ld_frag16(Aq_ + (size_t)(32 * mt + c) * 2048 + 16 * s + 8 * hh); af2[s] = ld_frag16(Aq_ + (size_t)(64 + 32 * mt + c) * 2048 + 16 * s + 8 * hh); } }
  if (blockIdx.x < 2048) TK_LOAD(blockIdx.x, 0);
  for (int item = blockIdx.x; item < 2048; item += gridDim.x) {
    const int h = item & 7;
    const size_t t0 = (size_t)(item >> 3) * 128;
#pragma unroll 1
    for (int pp = 0; pp < 2; ++pp) {
      f32x16 acc = zero16(), accb = zero16();
#pragma unroll
      for (int s = 0; s < 8; ++s) { acc = MFMA(af[s], bfq[s], acc); accb = MFMA(af2[s], bfq[s], accb); }
      if (pp == 0) { TK_LOAD(item, 1); }
      else { const int nitem = item + gridDim.x; if (nitem < 2048) TK_LOAD(nitem, 0); }
      __syncthreads();
#pragma unroll
      for (int i = 0; i < 16; ++i) { sc[(mt * 32 + crow(i, hh)) * 132 + 32 * nt + c] = acc[i]; sc[(64 + mt * 32 + crow(i, hh)) * 132 + 32 * nt + c] = accb[i]; }
      __syncthreads();
      unsigned k[4][8], sel[4];
#pragma unroll
      for (int rr = 0; rr < 4; ++rr) {
        sel[rr] = 0;
#pragma unroll
        for (int m = 0; m < 8; ++m) { int n = l16 + 16 * m; k[rr][m] = (fkey(sc[(grp + 32 * rr) * 132 + n]) & ~127u) | (unsigned)(127 - n); }
      }
#pragma unroll 1
      for (int round = 0; round < 16; ++round) {
#pragma unroll
        for (int rr = 0; rr < 4; ++rr) {
          unsigned mx = max(max(max(k[rr][0], k[rr][1]), max(k[rr][2], k[rr][3])), max(max(k[rr][4], k[rr][5]), max(k[rr][6], k[rr][7])));
          mx = gmax16(mx);
          sel[rr] = (l16 == round) ? mx : sel[rr];
#pragma unroll
          for (int m = 0; m < 8; ++m) k[rr][m] = (k[rr][m] == mx) ? 0u : k[rr][m];
        }
      }
#pragma unroll
      for (int rr = 0; rr < 4; ++rr) {
        const int row = grp + 32 * rr;
        int n = 127 - (int)(sel[rr] & 127u);
        ti[(row * 2 + pp) * 16 + l16] = n;
        ts[(row * 2 + pp) * 16 + l16] = sc[row * 132 + n];
      }
    }
    __syncthreads();
    {
      float s0v[4]; int ptr[4]; unsigned selk[4];
#pragma unroll
      for (int rr = 0; rr < 4; ++rr) { s0v[rr] = ts[((grp + 32 * rr) * 2) * 16 + l16]; ptr[rr] = 0; selk[rr] = 0; }
#pragma unroll 1
      for (int round = 0; round < 16; ++round) {
#pragma unroll
        for (int rr = 0; rr < 4; ++rr) {
          const int row = grp + 32 * rr;
          float v = s0v[rr] + ts[(row * 2 + 1) * 16 + (ptr[rr] & 15)];
          unsigned key = (ptr[rr] < 16) ? ((fkey(v) & ~255u) | (unsigned)(255 - (l16 * 16 + ptr[rr]))) : 0u;
          unsigned mx = gmax16(key);
          selk[rr] = (l16 == round) ? mx : selk[rr];
          int aw = (255 - (int)(mx & 255u)) >> 4;
          ptr[rr] += (l16 == aw) ? 1 : 0;
        }
      }
#pragma unroll
      for (int rr = 0; rr < 4; ++rr) {
        const int row = grp + 32 * rr;
        int flat = 255 - (int)(selk[rr] & 255u);
        int aw = flat >> 4, bw = flat & 15;
        int my_idx = ti[(row * 2) * 16 + aw] * 128 + ti[(row * 2 + 1) * 16 + bw];
        float my_s = ts[(row * 2) * 16 + aw] + ts[(row * 2 + 1) * 16 + bw];
        float mxs = gmaxf16(my_s);
        float e = __expf(my_s - mxs);
        float sum = gsum16(e);
        p.idx[(t0 + row) * 128 + h * 16 + l16] = my_idx;
        p.g[(t0 + row) * 128 + h * 16 + l16] = e / sum;
      }
    }
    __syncthreads();
  }
#undef TK_LOAD
}

DI void peer_load_batch(const unsigned char* tab, const float* rsc, int ireg, int ebase, int q, int gq, u32x4 (&buf)[4], float (&scl)[1]) {
#pragma unroll
  for (int rr = 0; rr < 1; ++rr) {
    int e = ebase + 4 * rr + gq;
    int row = __shfl(ireg, e & 63);
    const unsigned char* rp = tab + (size_t)row * 1024 + q * 16;
#pragma unroll
    for (int j = 0; j < 4; ++j) buf[rr * 4 + j] = *(const u32x4*)(rp + j * 256);
    scl[rr] = rsc[row];
  }
}
DI void peer_u_compute(const u32x4 (&buf)[4], const float (&scl)[1], const float (&hf)[64], float* wl, int ebase, int q, int gq) {
#pragma unroll
  for (int rr = 0; rr < 1; ++rr) {
    float acc = 0.f;
#pragma unroll
    for (int j = 0; j < 4; ++j)
#pragma unroll
      for (int i = 0; i < 4; ++i) {
        f32x2_t lo = __builtin_amdgcn_cvt_pk_f32_fp8((int)buf[rr * 4 + j][i], false);
        f32x2_t hi = __builtin_amdgcn_cvt_pk_f32_fp8((int)buf[rr * 4 + j][i], true);
        acc += lo[0] * hf[j * 16 + 4 * i] + lo[1] * hf[j * 16 + 4 * i + 1] + hi[0] * hf[j * 16 + 4 * i + 2] + hi[1] * hf[j * 16 + 4 * i + 3];
      }
    acc = gsum16(acc) * scl[rr];
    float act = 0.5f * acc * (1.f + erff(acc * 0.7071067811865476f));
    if (q == 0) wl[ebase + 4 * rr + gq] = act;
  }
}
DI void peer_v_compute(const u32x4 (&buf)[4], const float (&scl)[1], float (&o)[64], const float* wl, float greg, int ebase, int gq) {
#pragma unroll
  for (int rr = 0; rr < 1; ++rr) {
    const int e = ebase + 4 * rr + gq;
    float ge = __shfl(greg, e & 63);
    float wg = wl[e] * ge * scl[rr];
#pragma unroll
    for (int j = 0; j < 4; ++j)
#pragma unroll
      for (int i = 0; i < 4; ++i) {
        f32x2_t lo = __builtin_amdgcn_cvt_pk_f32_fp8((int)buf[rr * 4 + j][i], false);
        f32x2_t hi = __builtin_amdgcn_cvt_pk_f32_fp8((int)buf[rr * 4 + j][i], true);
        o[j * 16 + 4 * i] += wg * lo[0]; o[j * 16 + 4 * i + 1] += wg * lo[1];
        o[j * 16 + 4 * i + 2] += wg * hi[0]; o[j * 16 + 4 * i + 3] += wg * hi[1];
      }
  }
}
DI void phase_peer_final(const Params& p, char* smem, int tid) {
  const int w = tid >> 6, lane = tid & 63, q = lane & 15, gq = lane >> 4;
  float* wl = (float*)smem + w * 128;
  const unsigned char* U8 = (const unsigned char*)p.uB;
  const unsigned char* V8 = (const unsigned char*)p.vB;
  for (int item = blockIdx.x; item < T / 8; item += gridDim.x) {
    const size_t t = (size_t)item * 8 + w;
    const int b = (int)(t >> 13);
    float hf[64];
#pragma unroll
    for (int j = 0; j < 4; ++j) {
      u32x4 ha = *(const u32x4*)(p.h2 + t * 1024 + (q + 16 * j) * 16);
      u32x4 hb = *(const u32x4*)(p.h2 + t * 1024 + (q + 16 * j) * 16 + 8);
#pragma unroll
      for (int i = 0; i < 4; ++i) { hf[j * 16 + 2 * i] = bflo(ha[i]); hf[j * 16 + 2 * i + 1] = bfhi(ha[i]); hf[j * 16 + 8 + 2 * i] = bflo(hb[i]); hf[j * 16 + 8 + 2 * i + 1] = bfhi(hb[i]); }
    }
    const int i0 = p.idx[t * 128 + lane], i1 = p.idx[t * 128 + 64 + lane];
    const float g0 = p.g[t * 128 + lane], g1 = p.g[t * 128 + 64 + lane];
    u32x4 bA[4], bB[4]; float sA[1], sB[1];
    peer_load_batch(U8, p.us, i0, 0, q, gq, bA, sA);
#pragma unroll 1
    for (int it = 0; it < 16; ++it) {
      const int e0 = 8 * it;
      peer_load_batch(U8, p.us, (e0 & 64) ? i1 : i0, e0 + 4, q, gq, bB, sB);
      peer_u_compute(bA, sA, hf, wl, e0, q, gq);
      if (it < 15) peer_load_batch(U8, p.us, ((e0 + 8) & 64) ? i1 : i0, e0 + 8, q, gq, bA, sA);
      else peer_load_batch(V8, p.vs, i0, 0, q, gq, bA, sA);
      peer_u_compute(bB, sB, hf, wl, e0 + 4, q, gq);
    }
    __syncthreads();
    float o[64];
#pragma unroll
    for (int i = 0; i < 64; ++i) o[i] = 0.f;
#pragma unroll 1
    for (int it = 0; it < 16; ++it) {
      const int e0 = 8 * it;
      peer_load_batch(V8, p.vs, (e0 & 64) ? i1 : i0, e0 + 4, q, gq, bB, sB);
      peer_v_compute(bA, sA, o, wl, (e0 & 64) ? g1 : g0, e0, gq);
      if (it < 15) peer_load_batch(V8, p.vs, ((e0 + 8) & 64) ? i1 : i0, e0 + 8, q, gq, bA, sA);
      peer_v_compute(bB, sB, o, wl, (e0 & 64) ? g1 : g0, e0 + 4, gq);
    }
    float h1[32];
#pragma unroll
    for (int i = 0; i < 32; ++i) {
      float send = (gq < 2) ? o[32 + i] : o[i];
      float keep = (gq < 2) ? o[i] : o[32 + i];
      h1[i] = keep + __shfl_xor(send, 32);
    }
    float fin[16];
#pragma unroll
    for (int i = 0; i < 16; ++i) {
      float send = (gq & 1) ? h1[i] : h1[16 + i];
      float keep = (gq & 1) ? h1[16 + i] : h1[i];
      fin[i] = keep + __shfl_xor(send, 16);
    }
    const int colb = (q + 16 * gq) * 16;
    float ss = 0.f;
#pragma unroll
    for (int i4 = 0; i4 < 4; ++i4) {
      float4 xa = *(const float4*)(p.x1 + t * 1024 + colb + 4 * i4);
      float4 ga = *(const float4*)(p.mod + b * 6144 + 5120 + colb + 4 * i4);
      fin[4 * i4 + 0] = xa.x + ga.x * fin[4 * i4 + 0]; fin[4 * i4 + 1] = xa.y + ga.y * fin[4 * i4 + 1];
      fin[4 * i4 + 2] = xa.z + ga.z * fin[4 * i4 + 2]; fin[4 * i4 + 3] = xa.w + ga.w * fin[4 * i4 + 3];
      ss += fin[4 * i4] * fin[4 * i4] + fin[4 * i4 + 1] * fin[4 * i4 + 1] + fin[4 * i4 + 2] * fin[4 * i4 + 2] + fin[4 * i4 + 3] * fin[4 * i4 + 3];
    }
    ss = wave_sum(ss);
    const float rstd = rsqrtf(ss * (1.f / 1024.f) + RMS_EPS);
#pragma unroll
    for (int i4 = 0; i4 < 4; ++i4) {
      int col = colb + 4 * i4;
      float4 gg = *(const float4*)(p.normf_g + col);
      float4 sh = *(const float4*)(p.fmod + b * 2048 + col);
      float4 sc = *(const float4*)(p.fmod + b * 2048 + 1024 + col);
      float4 r;
      r.x = fin[4 * i4 + 0] * rstd * gg.x * (1.f + sc.x) + sh.x;
      r.y = fin[4 * i4 + 1] * rstd * gg.y * (1.f + sc.y) + sh.y;
      r.z = fin[4 * i4 + 2] * rstd * gg.z * (1.f + sc.z) + sh.z;
      r.w = fin[4 * i4 + 3] * rstd * gg.w * (1.f + sc.w) + sh.w;
      *(float4*)(p.out + t * 1024 + col) = r;
    }
    __syncthreads();
  }
}

#define XB_TMO      128
#define XB_XCNT(j)  (256  + 64 * (j))
#define XB_XSUB(j)  (1280 + 64 * (j))
#define XB_XGEN(j)  (2304 + 64 * (j))
#define XB_TOP      3328
#define XB_TOPGEN   3392
#define XCD_BAR_WORDS 3456
#define XB_SPIN_CAP (1u << 18)
#define LAS __attribute__((address_space(3)))

__device__ __forceinline__ unsigned xb_ld(unsigned* p)              { return __hip_atomic_load(p, __ATOMIC_RELAXED, __HIP_MEMORY_SCOPE_AGENT); }
__device__ __forceinline__ unsigned xb_add(unsigned* p, unsigned v) { return __hip_atomic_fetch_add(p, v, __ATOMIC_RELAXED, __HIP_MEMORY_SCOPE_AGENT); }
__device__ __forceinline__ unsigned xb_xcc_id() { return (unsigned)__builtin_amdgcn_s_getreg((3 << 11) | 20) & 0xFu; }
#define XB_SPIN(cond, bar) do { unsigned _sp = 0; while (cond) { __builtin_amdgcn_s_sleep(1); \
    if ((++_sp & 255u) == 0u) { if (xb_ld(&(bar)[XB_TMO])) break; if (_sp > XB_SPIN_CAP) { atomicAdd(&(bar)[XB_TMO], 1u); break; } } } } while (0)

struct XcdBarrier {
    unsigned* bar; unsigned x;
    volatile LAS unsigned* st;
};

__device__ __forceinline__ XcdBarrier xcd_barrier_post(unsigned* bar, volatile LAS unsigned* st) {
    XcdBarrier b; b.bar = bar; b.x = xb_xcc_id(); b.st = st;
    if (threadIdx.x == 0) (void)xb_add(&bar[XB_XCNT(b.x)], 1u);
    return b;
}
__device__ __forceinline__ void xcd_barrier_complete(unsigned* bar, unsigned x, unsigned& nloc, unsigned& nx) {
    const unsigned G = gridDim.x * gridDim.y * gridDim.z;
    unsigned sum, cnt, mine, sp = 0u;
    for (;;) {
        sum = 0u; cnt = 0u; mine = 0u;
#pragma unroll
        for (unsigned j = 0; j < 16; ++j) { const unsigned c = xb_ld(&bar[XB_XCNT(j)]); sum += c; cnt += (c > 0u) ? 1u : 0u; mine = (j == x) ? c : mine; }
        if (sum == G) break;
        __builtin_amdgcn_s_sleep(1);
        if ((++sp & 255u) == 0u) { if (xb_ld(&bar[XB_TMO])) break; if (sp > XB_SPIN_CAP) { atomicAdd(&bar[XB_TMO], 1u); break; } }
    }
    nloc = mine > 0u ? mine : 1u; nx = cnt > 0u ? cnt : 1u;
}

__device__ __forceinline__ void xcd_barrier(const XcdBarrier& b) {
    asm volatile("s_waitcnt vmcnt(0)" ::: "memory");
    __syncthreads();
    if (threadIdx.x == 0) {
        unsigned* bar = b.bar;
        __builtin_amdgcn_s_waitcnt(0);
        unsigned nloc = b.st[0], nx = b.st[1];
        if (nloc == 0u) { xcd_barrier_complete(bar, b.x, nloc, nx); b.st[0] = nloc; b.st[1] = nx; }
        const unsigned old = xb_add(&bar[XB_XSUB(b.x)], 1u);
        const unsigned gen = old / nloc;
        if (old + 1u == (gen + 1u) * nloc) {
            __builtin_amdgcn_fence(__ATOMIC_RELEASE, "agent");
            asm volatile("s_waitcnt vmcnt(0)" ::: "memory");
            const unsigned og = xb_add(&bar[XB_TOP], 1u);
            const unsigned tg = og / nx;
            if (og + 1u == (tg + 1u) * nx) xb_add(&bar[XB_TOPGEN], 1u);
            else XB_SPIN(xb_ld(&bar[XB_TOPGEN]) == tg, bar);
            __builtin_amdgcn_fence(__ATOMIC_ACQUIRE, "agent");
            xb_add(&bar[XB_XGEN(b.x)], 1u);
            asm volatile("s_waitcnt vmcnt(0)" ::: "memory");
        } else {
            XB_SPIN(xb_ld(&bar[XB_XGEN(b.x)]) == gen, bar);
            __builtin_amdgcn_fence(__ATOMIC_ACQUIRE, "agent");
            asm volatile("s_waitcnt vmcnt(0)" ::: "memory");
        }
    }
    __syncthreads();
}

__global__ void __launch_bounds__(512) fwd_megakernel(Params p) {
  cg::grid_group grid = cg::this_grid();
  extern __shared__ __attribute__((aligned(16))) char smem[];
  const int tid = threadIdx.x;
  volatile LAS unsigned* xst = (volatile LAS unsigned*)(smem + LDS_BYTES - 16);
  if (tid == 0) { xst[0] = 0u; xst[1] = 0u; }
  __syncthreads();
  XcdBarrier xb = xcd_barrier_post(p.bar, xst);
  if (tid == 0) xst[2] = atomicAdd(p.bar + 3600 + (xb_xcc_id() & 7u) * 16, 1u);
  phase_prep(p, smem, opq(tid));
  grid.sync();
  phase_norm_mod(p.x, p.norm1_g, p.mod, 0, 1024, p.hA, opq(tid));
  xcd_barrier(xb);
  phase_proj(p, smem, opq(tid));
  xcd_barrier(xb);
  phase_gla_pre(p, smem, opq(tid));
  xcd_barrier(xb);
  phase_mixers(p, smem, opq(tid));
  xcd_barrier(xb);
  phase_post_mixers(p, opq(tid));
  xcd_barrier(xb);
  phase_gr(p, smem, opq(tid));
  xcd_barrier(xb);
  phase_merge(p, smem, opq(tid));
  xcd_barrier(xb);
  phase_out(p, smem, opq(tid));
  xcd_barrier(xb);
  phase_norm_mod(p.x1, p.norm2_g, p.mod, 3072, 4096, p.h2, opq(tid));
  xcd_barrier(xb);
  phase_peerq(p, smem, opq(tid));
  xcd_barrier(xb);
  phase_topk(p, smem, opq(tid));
  xcd_barrier(xb);
  phase_peer_final(p, smem, opq(tid));
}

extern "C" void kernel_launch(void* const* d_in, const int* in_sizes, int n_in, void* d_out, int out_size, void* d_ws,
                              size_t ws_size, hipStream_t stream) {
  static int grid_blocks = 0;
  if (!grid_blocks) {
    int dev = 0, cus = 0, per_cu = 0;
    hipGetDevice(&dev);
    hipDeviceGetAttribute(&cus, hipDeviceAttributeMultiprocessorCount, dev);
    if (hipFuncSetAttribute((const void*)fwd_megakernel, hipFuncAttributeMaxDynamicSharedMemorySize, LDS_BYTES) != hipSuccess) { fprintf(stderr, "hipFuncSetAttribute failed\n"); }
    hipOccupancyMaxActiveBlocksPerMultiprocessor(&per_cu, fwd_megakernel, 512, LDS_BYTES);
    if (per_cu < 1) per_cu = 1;
    grid_blocks = cus * per_cu;
  }
  if (ws_size < 492 * MB) { fprintf(stderr, "ws too small: %zu\n", ws_size); return; }
  Params p{};
  p.x = (const float*)d_in[0]; p.c = (const float*)d_in[1]; p.pos = (const int*)d_in[2];
  p.w_ada = (const float*)d_in[3]; p.b_ada = (const float*)d_in[4]; p.norm1_g = (const float*)d_in[5];
  p.w_in = (const float*)d_in[6]; p.wa_fw = (const float*)d_in[7]; p.ba_fw = (const float*)d_in[8];
  p.wa_bw = (const float*)d_in[9]; p.ba_bw = (const float*)d_in[10]; p.gla_norm_g = (const float*)d_in[11];
  p.lq1 = (const float*)d_in[12]; p.lk1 = (const float*)d_in[13]; p.lq2 = (const float*)d_in[14]; p.lk2 = (const float*)d_in[15];
  p.diff_norm_g = (const float*)d_in[16]; p.w_gla = (const float*)d_in[17]; p.w_diff = (const float*)d_in[18];
  p.w_out = (const float*)d_in[19]; p.norm2_g = (const float*)d_in[20]; p.peer_wq = (const float*)d_in[21];
  p.subkeys = (const float*)d_in[22]; p.peer_u = (const float*)d_in[23]; p.peer_v = (const float*)d_in[24];
  p.w_fada = (const float*)d_in[25]; p.b_fada = (const float*)d_in[26]; p.normf_g = (const float*)d_in[27];
  p.out = (float*)d_out;
  char* ws = (char*)d_ws;
  p.winT = (u16*)(ws + 0 * MB); p.wgrT = (u16*)(ws + 11 * MB); p.wgaT = (u16*)(ws + 13 * MB); p.wgbT = (u16*)(ws + 15 * MB);
  p.wglaT = (u16*)(ws + 17 * MB); p.wdiffT = (u16*)(ws + 19 * MB); p.woutT = (u16*)(ws + 21 * MB); p.wqT = (u16*)(ws + 23 * MB);
  p.subk = (u16*)(ws + 27 * MB); p.rope = (float*)(ws + 28 * MB);
  p.mod = (float*)(ws + 36 * MB); p.fmod = (float*)(ws + 36 * MB + 128 * 1024); p.lam = (float*)(ws + 36 * MB + 192 * 1024);
  p.counter = (int*)(ws + 36 * MB + 196 * 1024);
  p.kmax = (int*)(ws + 36 * MB + 200 * 1024);
  p.bar = (unsigned*)(ws + 36 * MB + 256 * 1024);
  hipMemsetAsync(p.bar, 0, 4096 * sizeof(unsigned), stream);
  p.lr = (float*)(ws + 37 * MB); p.dec = (float*)(ws + 41 * MB); p.rstd = (float*)(ws + 43 * MB);
  char* slot[9];
  for (int i = 0; i < 7; ++i) slot[i] = ws + (44 + 64 * (size_t)i) * MB;
  slot[7] = (char*)d_out; slot[8] = (char*)d_out + 64 * MB;
  p.hA = (u16*)slot[0];
  p.gq = (u16*)slot[1]; p.gk = (u16*)(slot[1] + 32 * MB);
  p.gvT = (u16*)slot[2]; p.dq = (u16*)slot[3]; p.dk = (u16*)slot[4]; p.dvT = (u16*)slot[5];
  p.qe_fw = (u16*)slot[0]; p.ke_fw = (u16*)(slot[0] + 32 * MB);
  p.qe_bw = (u16*)slot[6]; p.ke_bw = (u16*)(slot[6] + 32 * MB);
  p.keT = (u16*)slot[7];
  p.o_fw = (u16*)slot[1]; p.o_bw = (u16*)slot[8];
  p.uB = (u16*)slot[6]; p.vB = (u16*)(slot[6] + 16 * MB);
  p.A1 = (u16*)slot[2]; p.merged = (u16*)slot[4];
  p.sga = (u16*)slot[5]; p.sgb = (u16*)slot[7];
  p.x1 = (float*)slot[0];
  p.h2 = (u16*)slot[2]; p.qp = (u16*)slot[3];
  p.us = (float*)(slot[6] + 32 * MB); p.vs = (float*)(slot[6] + 33 * MB);
  p.idx = (int*)slot[5]; p.g = (float*)(slot[5] + 16 * MB);
  void* args[] = {&p};
  hipError_t e = hipLaunchCooperativeKernel((void*)fwd_megakernel, dim3(grid_blocks), dim3(512), args, LDS_BYTES, stream);
  if (e != hipSuccess) fprintf(stderr, "cooperative launch failed: %s (grid %d)\n", hipGetErrorString(e), grid_blocks);
}
```

```cpp
#include <hip/hip_runtime.h>
#include <hip/hip_cooperative_groups.h>
#include <cstdio>
namespace cg = cooperative_groups;

#define DI __device__ __forceinline__
typedef unsigned short u16;
using bf16x8 = __attribute__((ext_vector_type(8))) short;
using f32x16 = __attribute__((ext_vector_type(16))) float;
using u32x4 = __attribute__((ext_vector_type(4))) unsigned;
using u32x2 = __attribute__((ext_vector_type(2))) unsigned;
typedef __bf16 bf16x2_t __attribute__((ext_vector_type(2)));
typedef float f32x2_t __attribute__((ext_vector_type(2)));

constexpr int T = 32768, D = 1024, S = 8192;
constexpr size_t MB = 1ull << 20;
constexpr float RMS_EPS = 1e-6f;
constexpr int LDS_BYTES = 160 * 1024;
constexpr int SITEM_OFF = 150 * 1024;

#define MFMA(a, b, c) __builtin_amdgcn_mfma_f32_32x32x16_bf16((a), (b), (c), 0, 0, 0)

struct Params {
  const float *x, *c; const int* pos;
  const float *w_ada, *b_ada, *norm1_g, *w_in, *wa_fw, *ba_fw, *wa_bw, *ba_bw, *gla_norm_g;
  const float *lq1, *lk1, *lq2, *lk2, *diff_norm_g, *w_gla, *w_diff, *w_out, *norm2_g, *peer_wq, *subkeys, *peer_u, *peer_v;
  const float *w_fada, *b_fada, *normf_g;
  float* out;
  u16 *winT, *wgrT, *wgaT, *wgbT, *wglaT, *wdiffT, *woutT, *wqT, *subk;
  float* rope;
  float* mod;
  float* fmod;
  float* lam;
  int* counter;
  float* lr;
  float* dec;
  float* rstd;
  u16 *hA, *gq, *gk, *gvT, *dq, *dk, *dvT;
  u16 *qe_fw, *ke_fw, *qe_bw, *ke_bw, *keT;
  u16 *o_fw, *o_bw, *A1, *merged, *h2, *qp, *uB, *vB;
  float* x1;
  int* idx; float* g;
  float *us, *vs;
  u16 *sga, *sgb;
  unsigned* bar;
  int* kmax;
};

DI u16 f2bf(float x) { unsigned u = __float_as_uint(x); u += 0x7fffu + ((u >> 16) & 1u); return (u16)(u >> 16); }
DI float bf2f(u16 b) { return __uint_as_float(((unsigned)b) << 16); }
DI unsigned pack2(float a, float b) {
  f32x2_t v = {a, b};
  bf16x2_t r = __builtin_convertvector(v, bf16x2_t);
  return __builtin_bit_cast(unsigned, r);
}
DI float bflo(unsigned u) { return __uint_as_float(u << 16); }
DI float bfhi(unsigned u) { return __uint_as_float(u & 0xffff0000u); }
DI int crow(int i, int h) { return (i & 3) + 8 * (i >> 2) + 4 * h; }
DI bf16x8 pack_step(const f32x16& x, int s) {
  u32x4 p;
  p[0] = pack2(x[8 * s + 0], x[8 * s + 1]);
  p[1] = pack2(x[8 * s + 2], x[8 * s + 3]);
  p[2] = pack2(x[8 * s + 4], x[8 * s + 5]);
  p[3] = pack2(x[8 * s + 6], x[8 * s + 7]);
  return __builtin_bit_cast(bf16x8, p);
}
DI bf16x8 ld_frag16(const u16* p) { return __builtin_bit_cast(bf16x8, *(const u32x4*)p); }
DI bf16x8 ld_frag8x2(const u16* p) {
  u32x2 lo = *(const u32x2*)p; u32x2 hi = *(const u32x2*)(p + 8);
  u32x4 v = {lo[0], lo[1], hi[0], hi[1]};
  return __builtin_bit_cast(bf16x8, v);
}
DI void st_perm(u16* rowp, int ch, u32x4 v) {
  u16* d = rowp + (ch >> 1) * 16 + (ch & 1) * 4;
  u32x2 lo = {v[0], v[1]}, hi = {v[2], v[3]};
  *(u32x2*)d = lo;
  *(u32x2*)(d + 8) = hi;
}
DI float wave_sum(float v) {
#pragma unroll
  for (int o = 32; o >= 1; o >>= 1) v += __shfl_xor(v, o);
  return v;
}

template <int CTRL> DI float dpp_f(float v) { return __builtin_bit_cast(float, __builtin_amdgcn_update_dpp(0, __builtin_bit_cast(int, v), CTRL, 0xF, 0xF, false)); }
template <int CTRL> DI unsigned dpp_u(unsigned v) { return (unsigned)__builtin_amdgcn_update_dpp(0, (int)v, CTRL, 0xF, 0xF, false); }
DI float gsum16(float v) { v += dpp_f<0x121>(v); v += dpp_f<0x122>(v); v += dpp_f<0x124>(v); v += dpp_f<0x128>(v); return v; }
DI float gmaxf16(float v) { v = fmaxf(v, dpp_f<0x121>(v)); v = fmaxf(v, dpp_f<0x122>(v)); v = fmaxf(v, dpp_f<0x124>(v)); v = fmaxf(v, dpp_f<0x128>(v)); return v; }
DI unsigned gmax16(unsigned v) { v = max(v, dpp_u<0x121>(v)); v = max(v, dpp_u<0x122>(v)); v = max(v, dpp_u<0x124>(v)); v = max(v, dpp_u<0x128>(v)); return v; }
DI int opq(int x) { asm volatile("" : "+v"(x)); return x; }
DI f32x16 zero16() { f32x16 z; for (int i = 0; i < 16; ++i) z[i] = 0.f; return z; }

DI void tconv_tile(const float* src, int ld, int c0, int nc, u16* dst, int ct, int kt, float* sm, int tid) {
  __syncthreads();
  int cl = tid & 63, r0 = tid >> 6;
#pragma unroll
  for (int r = 0; r < 8; ++r) {
    int k = kt * 64 + r0 + 8 * r;
    int col = ct * 64 + cl;
    float v = (col < nc) ? src[(size_t)k * ld + c0 + col] : 0.f;
    sm[(r0 + 8 * r) * 65 + cl] = v;
  }
  __syncthreads();
#pragma unroll
  for (int r = 0; r < 8; ++r) {
    int col = r0 + 8 * r;
    int k = cl;
    dst[(size_t)(ct * 64 + col) * 1024 + kt * 64 + k] = f2bf(sm[k * 65 + col]);
  }
}

DI void phase_prep(const Params& p, char* smem, int tid) {
  float* sm = (float*)smem;
  const int nblk = gridDim.x, bid = blockIdx.x;
  const int NCT = 32 + 48 + 2 + 16 * 6 + 32;
  for (int it = bid; it < NCT * 16; it += nblk) {
    int ctg = it >> 4, kt = it & 15;
    const float* src; int ld, c0, nc; u16* dst; int ct;
    if (ctg < 32) { src = p.w_in; ld = 8224; c0 = 0; nc = 2048; dst = p.winT; ct = ctg; }
    else if (ctg < 80) { src = p.w_in; ld = 8224; c0 = 3104; nc = 3072; dst = p.winT + (size_t)2048 * 1024; ct = ctg - 32; }
    else if (ctg < 82) { src = p.w_in; ld = 8224; c0 = 3072; nc = 32; dst = p.winT + (size_t)5120 * 1024; ct = ctg - 80; }
    else if (ctg < 98) { src = p.w_in; ld = 8224; c0 = 2048; nc = 1024; dst = p.wgrT; ct = ctg - 82; }
    else if (ctg < 114) { src = p.w_in; ld = 8224; c0 = 6176; nc = 1024; dst = p.wgaT; ct = ctg - 98; }
    else if (ctg < 130) { src = p.w_in; ld = 8224; c0 = 7200; nc = 1024; dst = p.wgbT; ct = ctg - 114; }
    else if (ctg < 146) { src = p.w_gla; ld = 1024; c0 = 0; nc = 1024; dst = p.wglaT; ct = ctg - 130; }
    else if (ctg < 162) { src = p.w_diff; ld = 1024; c0 = 0; nc = 1024; dst = p.wdiffT; ct = ctg - 146; }
    else if (ctg < 178) { src = p.w_out; ld = 1024; c0 = 0; nc = 1024; dst = p.woutT; ct = ctg - 162; }
    else { src = p.peer_wq; ld = 2048; c0 = 0; nc = 2048; dst = p.wqT; ct = ctg - 178; }
    tconv_tile(src, ld, c0, nc, dst, ct, kt, sm, tid);
  }
  __syncthreads();
  const int gtid = bid * 512 + tid, gsz = nblk * 512;
  for (int i = gtid; i < 8 * 2 * 128 * 128; i += gsz) p.subk[i] = f2bf(p.subkeys[i]);
  for (int i = gtid; i < 128 * 1024 / 2; i += gsz) ((unsigned*)(p.winT + (size_t)5248 * 1024))[i] = 0u;
  for (int i = gtid; i < T * 32; i += gsz) {
    int t = i >> 5, d = i & 31;
    float inv = powf(10000.f, -(float)d / 32.f);
    float ang = (float)p.pos[t] * inv;
    double r = (double)ang * 0.15915494309189535;
    r -= rint(r);
    float rf = (float)r;
    p.rope[2 * i] = __builtin_amdgcn_cosf(rf);
    p.rope[2 * i + 1] = __builtin_amdgcn_sinf(rf);
  }
  if (gtid == 0) {
    float s1 = 0.f, s2 = 0.f;
    for (int i = 0; i < 64; ++i) { s1 += p.lq1[i] * p.lk1[i]; s2 += p.lq2[i] * p.lk2[i]; }
    p.lam[0] = expf(s1) - expf(s2) + 0.2f;
    for (int i = 0; i < 128; ++i) p.counter[i] = 0;
    for (int i = 0; i < 64; ++i) p.kmax[i] = 0;
  }
  {
    float* cact = sm;
    float* red = sm + 4096;
    __syncthreads();
    for (int i = tid; i < 4096; i += 512) { float v = p.c[i]; cact[i] = v / (1.f + __expf(-v)); }
    __syncthreads();
    int w = tid >> 6, lane = tid & 63;
    for (int it = bid; it < 128; it += nblk) {
      int col = it * 64 + lane;
      const float* W; int ld, cc;
      if (col < 6144) { W = p.w_ada; ld = 6144; cc = col; } else { W = p.w_fada; ld = 2048; cc = col - 6144; }
      float a0 = 0, a1 = 0, a2 = 0, a3 = 0;
#pragma unroll 8
      for (int k = w * 128; k < w * 128 + 128; ++k) {
        float wv = W[(size_t)k * ld + cc];
        a0 += cact[k] * wv; a1 += cact[1024 + k] * wv; a2 += cact[2048 + k] * wv; a3 += cact[3072 + k] * wv;
      }
      red[(w * 4 + 0) * 64 + lane] = a0; red[(w * 4 + 1) * 64 + lane] = a1;
      red[(w * 4 + 2) * 64 + lane] = a2; red[(w * 4 + 3) * 64 + lane] = a3;
      __syncthreads();
      if (tid < 256) {
        int b = w;
        float s = 0.f;
#pragma unroll
        for (int ww = 0; ww < 8; ++ww) s += red[(ww * 4 + b) * 64 + lane];
        if (col < 6144) p.mod[b * 6144 + cc] = s + p.b_ada[cc];
        else p.fmod[b * 2048 + cc] = s + p.b_fada[cc];
      }
      __syncthreads();
    }
  }
}

DI void phase_norm_mod(const float* src, const float* g, const float* mod, int sh_off, int sc_off, u16* dst, int tid) {
  int w = tid >> 6, lane = tid & 63;
  for (int row = blockIdx.x * 8 + w; row < T; row += gridDim.x * 8) {
    int b = row >> 13;
    const float* xr = src + (size_t)row * 1024;
    float4 v[4]; float ss = 0.f;
#pragma unroll
    for (int m = 0; m < 4; ++m) { v[m] = *(const float4*)(xr + (m * 64 + lane) * 4); ss += v[m].x * v[m].x + v[m].y * v[m].y + v[m].z * v[m].z + v[m].w * v[m].w; }
    ss = wave_sum(ss);
    float rstd = rsqrtf(ss * (1.f / 1024.f) + RMS_EPS);
#pragma unroll
    for (int m = 0; m < 4; ++m) {
      int col = (m * 64 + lane) * 4;
      float4 gg = *(const float4*)(g + col);
      float4 sh = *(const float4*)(mod + b * 6144 + sh_off + col);
      float4 sc = *(const float4*)(mod + b * 6144 + sc_off + col);
      float y0 = v[m].x * rstd * gg.x * (1.f + sc.x) + sh.x;
      float y1 = v[m].y * rstd * gg.y * (1.f + sc.y) + sh.y;
      float y2 = v[m].z * rstd * gg.z * (1.f + sc.z) + sh.z;
      float y3 = v[m].w * rstd * gg.w * (1.f + sc.w) + sh.w;
      u32x2 o = {pack2(y0, y1), pack2(y2, y3)};
      *(u32x2*)(dst + (size_t)row * 1024 + col) = o;
    }
  }
}

constexpr int GLD = 72;
constexpr int GSTAGE = (256 + 256) * GLD;
DI void gemm_kloop(const u16* A, int lda, const u16* Bt, int ldb, int K, f32x16 (&acc)[4][2], u16* smem, int tid) {
  const int w = tid >> 6, lane = tid & 63, c = lane & 31, hh = lane >> 5;
  const int wm = w >> 2, wn = w & 3;
  const int lrow = tid >> 3, lcol = (tid & 7) * 8;
  u32x4 ra[4], rb[4];
  const int nk = K >> 6;
#pragma unroll
  for (int r = 0; r < 4; ++r) { ra[r] = *(const u32x4*)(A + (size_t)(r * 64 + lrow) * lda + lcol); rb[r] = *(const u32x4*)(Bt + (size_t)(r * 64 + lrow) * ldb + lcol); }
  __syncthreads();
  {
    u16* sA = smem; u16* sB = smem + 256 * GLD;
#pragma unroll
    for (int r = 0; r < 4; ++r) { *(u32x4*)(sA + (r * 64 + lrow) * GLD + lcol) = ra[r]; *(u32x4*)(sB + (r * 64 + lrow) * GLD + lcol) = rb[r]; }
  }
#pragma unroll
  for (int r = 0; r < 4; ++r) { ra[r] = *(const u32x4*)(A + (size_t)(r * 64 + lrow) * lda + 64 + lcol); rb[r] = *(const u32x4*)(Bt + (size_t)(r * 64 + lrow) * ldb + 64 + lcol); }
  __syncthreads();
  for (int kt = 0; kt < nk; ++kt) {
    const u16* sA = smem + (kt & 1) * GSTAGE; const u16* sB = sA + 256 * GLD;
    bf16x8 fr[1][6];
#define GLOADF(set, s) { _Pragma("unroll") for (int mi = 0; mi < 4; ++mi) fr[set][mi] = ld_frag16(sA + (wm * 128 + mi * 32 + c) * GLD + (s) * 16 + hh * 8); \
                         _Pragma("unroll") for (int ni = 0; ni < 2; ++ni) fr[set][4 + ni] = ld_frag16(sB + (wn * 64 + ni * 32 + c) * GLD + (s) * 16 + hh * 8); }
#define GMM(set) { _Pragma("unroll") for (int mi = 0; mi < 4; ++mi) _Pragma("unroll") for (int ni = 0; ni < 2; ++ni) acc[mi][ni] = MFMA(fr[set][mi], fr[set][4 + ni], acc[mi][ni]); }
    GLOADF(0, 0);
    __builtin_amdgcn_sched_barrier(0);
    GMM(0);
    __builtin_amdgcn_sched_barrier(0);
    GLOADF(0, 1);
    __builtin_amdgcn_sched_barrier(0);
    if (kt + 1 < nk) {
      u16* nA = smem + ((kt + 1) & 1) * GSTAGE;
#pragma unroll
      for (int r = 0; r < 4; ++r) *(u32x4*)(nA + (r * 64 + lrow) * GLD + lcol) = ra[r];
      if (kt + 2 < nk) {
#pragma unroll
        for (int r = 0; r < 4; ++r) ra[r] = *(const u32x4*)(A + (size_t)(r * 64 + lrow) * lda + (kt + 2) * 64 + lcol);
      }
    }
    __builtin_amdgcn_sched_barrier(0);
    GMM(0);
    __builtin_amdgcn_sched_barrier(0);
    GLOADF(0, 2);
    __builtin_amdgcn_sched_barrier(0);
    if (kt + 1 < nk) {
      u16* nB = smem + ((kt + 1) & 1) * GSTAGE + 256 * GLD;
#pragma unroll
      for (int r = 0; r < 4; ++r) *(u32x4*)(nB + (r * 64 + lrow) * GLD + lcol) = rb[r];
      if (kt + 2 < nk) {
#pragma unroll
        for (int r = 0; r < 4; ++r) rb[r] = *(const u32x4*)(Bt + (size_t)(r * 64 + lrow) * ldb + (kt + 2) * 64 + lcol);
      }
    }
    __builtin_amdgcn_sched_barrier(0);
    GMM(0);
    __builtin_amdgcn_sched_barrier(0);
    GLOADF(0, 3);
    __builtin_amdgcn_sched_barrier(0);
    GMM(0);
#undef GLOADF
#undef GMM
    __syncthreads();
  }
}
DI void zero_acc(f32x16 (&acc)[4][2]) {
#pragma unroll
  for (int a = 0; a < 4; ++a)
#pragma unroll
    for (int b = 0; b < 2; ++b) acc[a][b] = zero16();
}

constexpr int EPS = 68, EPT = 65;
__device__ __forceinline__ unsigned xb_xcc_id();

template <class F> DI void xcd_queue(int* counters, int per_xcd, char* smem, int tid, F f) {
  int* sitem = (int*)(smem + SITEM_OFF);
  const int myx = (int)xb_xcc_id() & 7;
  for (int qi = 0; qi < 8; ++qi) {
    const int xq = (myx + qi) & 7;
    for (;;) {
      __syncthreads();
      if (tid == 0) *sitem = atomicAdd(counters + xq, 1);
      __syncthreads();
      const int qn = *sitem;
      if (qn >= per_xcd) break;
      f(xq, qn);
    }
  }
}

template <class F> DI void xcd_static(const Params& p, int per_xcd, char* smem, F f) {
  const int myx = (int)xb_xcc_id() & 7;
  const int rank = (int)((volatile unsigned*)(smem + LDS_BYTES - 16))[2];
  const int nloc = (int)__hip_atomic_load(p.bar + 3600 + myx * 16, __ATOMIC_RELAXED, __HIP_MEMORY_SCOPE_AGENT);
  for (int qn = rank; qn < per_xcd; qn += nloc) f(myx, qn);
  for (int j = 0; j < 8; ++j) {
    const int nj = (int)__hip_atomic_load(p.bar + 3600 + j * 16, __ATOMIC_RELAXED, __HIP_MEMORY_SCOPE_AGENT);
    if (nj == 0) for (int qn = blockIdx.x; qn < per_xcd; qn += gridDim.x) f(j, qn);
  }
}
DI float* wave_stage(char* smem, int w) { return (float*)smem + w * (64 * EPS); }
template <int STR> DI void stage_acc(const f32x16 (&acc)[4][2], int half, float* wl, int c, int hh) {
#pragma unroll
  for (int mi = 0; mi < 2; ++mi)
#pragma unroll
    for (int ni = 0; ni < 2; ++ni)
#pragma unroll
      for (int i = 0; i < 16; ++i) wl[(mi * 32 + crow(i, hh)) * STR + ni * 32 + c] = (half ? acc[2 + mi][ni][i] : acc[mi][ni][i]);
}
DI void st_bf16x8(u16* dst, const float (&v)[8]) {
  u32x4 o = {pack2(v[0], v[1]), pack2(v[2], v[3]), pack2(v[4], v[5]), pack2(v[6], v[7])};
  *(u32x4*)dst = o;
}
DI void ld_bf16x8(const u16* srcp, float (&v)[8]) {
  u32x4 o = *(const u32x4*)srcp;
#pragma unroll
  for (int i = 0; i < 4; ++i) { v[2 * i] = bflo(o[i]); v[2 * i + 1] = bfhi(o[i]); }
}
template <class F> DI void epi_rows(const float* wl, int lane, F f) {
#pragma unroll
  for (int ps = 0; ps < 8; ++ps) {
    const int r = (lane >> 3) + 8 * ps, cc = (lane & 7) * 8;
    float4 v0 = *(const float4*)(wl + r * EPS + cc), v1 = *(const float4*)(wl + r * EPS + cc + 4);
    float v[8] = {v0.x, v0.y, v0.z, v0.w, v1.x, v1.y, v1.z, v1.w};
    f(r, cc, v);
  }
}
DI void epi_cols_bf16(const float* wl, int lane, u16* dstT, size_t ldt) {
#pragma unroll
  for (int ps = 0; ps < 8; ++ps) {
    const int col = (lane >> 3) + 8 * ps, r0 = (lane & 7) * 8;
    float v[8];
#pragma unroll
    for (int j = 0; j < 8; ++j) v[j] = wl[(r0 + j) * EPT + col];
    st_bf16x8(dstT + (size_t)col * ldt + r0, v);
  }
}

DI void phase_proj(const Params& p, char* smem, int tid) {
  const int w = tid >> 6, lane_inv = tid & 63;
  const int wm = w >> 2, wn = w & 3;
  float* wl = wave_stage(smem, w);
  const int NT = 21;
  xcd_static(p, 16 * NT, smem, [&](int xq, int qn) {
    int mt = xq + 8 * (qn / NT), nt = qn % NT;
    int m0 = mt * 256, n0 = nt * 256;
    f32x16 acc[4][2]; zero_acc(acc);
    gemm_kloop(p.hA + (size_t)m0 * 1024, 1024, p.winT + (size_t)n0 * 1024, 1024, 1024, acc, (u16*)smem, opq(tid));
    const int lane = opq(lane_inv);
    const int c = lane & 31, hh = lane >> 5;
    const int cb = n0 + wn * 64;
#pragma unroll
    for (int half = 0; half < 2; ++half) {
      const int rb = m0 + wm * 128 + half * 64;
      if (n0 < 1024) {
        const float sc = (n0 < 512) ? 0.08838834764831845f : 1.f;
        u16* dst = ((n0 < 512) ? p.gq : p.gk) + (size_t)rb * 512 + (cb & 511);
        stage_acc<EPS>(acc, half, wl, c, hh);
        epi_rows(wl, lane, [&](int r, int cc, float (&v)[8]) {
#pragma unroll
          for (int j = 0; j < 8; ++j) v[j] *= sc;
          st_bf16x8(dst + (size_t)r * 512 + cc, v);
        });
      } else if (n0 < 2048 || (n0 >= 4096 && n0 < 5120)) {
        const bool isg = n0 < 2048;
        const int b = rb >> 13;
        u16* dstT;
        if (isg) { int cc0 = cb - 1024; dstT = p.gvT + ((size_t)(b * 4 + (cc0 >> 8)) * 256 + (cc0 & 255)) * 8192 + (rb & 8191); }
        else { int cc0 = cb - 4096; dstT = p.dvT + ((size_t)(b * 8 + (cc0 >> 7)) * 128 + (cc0 & 127)) * 8192 + (rb & 8191); }
        stage_acc<EPT>(acc, half, wl, c, hh);
        epi_cols_bf16(wl, lane, dstT, 8192);
      } else if (n0 < 4096) {
        const bool isq = n0 < 3072;
        const float sc = isq ? (0.125f * 1.4426950408889634f) : 1.f;
        const int cbb = cb - (isq ? 2048 : 3072);
        float knmax = 0.f;
#pragma unroll
        for (int mi = 0; mi < 2; ++mi)
#pragma unroll
          for (int i = 0; i < 16; ++i) {
            int row = rb + mi * 32 + crow(i, hh);
            float2 cs = *(const float2*)(p.rope + ((size_t)row * 32 + c) * 2);
            float x1 = half ? acc[2 + mi][0][i] : acc[mi][0][i], x2 = half ? acc[2 + mi][1][i] : acc[mi][1][i];
            float o1 = (x1 * cs.x - x2 * cs.y) * sc;
            float o2 = (x2 * cs.x + x1 * cs.y) * sc;
            wl[(mi * 32 + crow(i, hh)) * EPS + c] = o1;
            wl[(mi * 32 + crow(i, hh)) * EPS + 32 + c] = o2;
            if (!isq) {
              float ssq = o1 * o1 + o2 * o2;
              ssq += __shfl_xor(ssq, 1); ssq += __shfl_xor(ssq, 2); ssq += __shfl_xor(ssq, 4); ssq += __shfl_xor(ssq, 8); ssq += __shfl_xor(ssq, 16);
              knmax = fmaxf(knmax, ssq);
            }
            if ((i & 3) == 3) __builtin_amdgcn_sched_barrier(0);
          }
        if (!isq && c == 0) atomicMax(p.kmax + ((rb >> 13) * 8 + (cbb >> 7)) * 2 + ((cbb >> 6) & 1), __float_as_int(knmax));
        u16* dst = (isq ? p.dq : p.dk) + (size_t)rb * 1024 + cbb;
        epi_rows(wl, lane, [&](int r, int cc, float (&v)[8]) { st_bf16x8(dst + (size_t)r * 1024 + cc, v); });
      } else {
        if (wn == 0) {
#pragma unroll
          for (int mi = 0; mi < 2; ++mi)
#pragma unroll
            for (int i = 0; i < 16; ++i) {
              int row = rb + mi * 32 + crow(i, hh);
              p.lr[(size_t)row * 32 + c] = half ? acc[2 + mi][0][i] : acc[mi][0][i];
            }
        }
      }
    }
  });
}

DI float logsig(float x) { return fminf(x, 0.f) - __logf(1.f + __expf(-fabsf(x))); }

DI void phase_gla_pre(const Params& p, char* smem, int tid) {
  float* slr = (float*)smem;
  for (int it = blockIdx.x; it < 1024; it += gridDim.x) {
    const int dir = it & 1, ch = (it >> 1) & 127, b = it >> 8;
    const size_t t0 = (size_t)b * 8192 + ch * 64;
    __syncthreads();
    for (int i = tid; i < 1024; i += 512) slr[i] = p.lr[t0 * 32 + (i >> 4) * 32 + dir * 16 + (i & 15)];
    __syncthreads();
    const int j = tid;
    const int h = j >> 7, d = j & 127;
    const float* wa = dir ? p.wa_bw : p.wa_fw;
    float wr[16];
#pragma unroll
    for (int r = 0; r < 16; ++r) wr[r] = wa[r * 512 + j];
    const float ba = (dir ? p.ba_bw : p.ba_fw)[j];
    u16* qe = (dir ? p.qe_bw : p.qe_fw) + t0 * 512 + j;
    u16* ke = (dir ? p.ke_bw : p.ke_fw) + t0 * 512 + j;
    const u16* gq = p.gq + t0 * 512 + j;
    const u16* gk = p.gk + t0 * 512 + j;
    u16* keT = p.keT + (size_t)dir * (16ull * 128 * 8192) + ((size_t)(b * 4 + h) * 128 + d) * 8192 + ch * 64;
    float bsum = 0.f;
#pragma unroll 1
    for (int g8 = 0; g8 < 8; ++g8) {
      u16 qraw[8], kraw[8];
#pragma unroll
      for (int u = 0; u < 8; ++u) {
        const int tt = g8 * 8 + u;
        const int t = dir ? 63 - tt : tt;
        qraw[u] = gq[t * 512]; kraw[u] = gk[t * 512];
      }
      unsigned kk[8];
#pragma unroll
      for (int u = 0; u < 8; ++u) {
        const int tt = g8 * 8 + u;
        const int t = dir ? 63 - tt : tt;
        float pre = ba;
#pragma unroll
        for (int r = 0; r < 16; ++r) pre += slr[t * 16 + r] * wr[r];
        bsum += logsig(pre) * (1.f / 16.f);
        const float eb = __expf(bsum);
        const u16 qo = f2bf(bf2f(qraw[u]) * eb);
        const u16 ko = f2bf(bf2f(kraw[u]) * __expf(-bsum));
        qe[t * 512] = qo;
        ke[t * 512] = ko;
        kk[u] = ko;
      }
      u32x4 v;
      if (!dir) {
        v[0] = kk[0] | (kk[1] << 16); v[1] = kk[2] | (kk[3] << 16); v[2] = kk[4] | (kk[5] << 16); v[3] = kk[6] | (kk[7] << 16);
        *(u32x4*)(keT + g8 * 8) = v;
      } else {
        v[0] = kk[7] | (kk[6] << 16); v[1] = kk[5] | (kk[4] << 16); v[2] = kk[3] | (kk[2] << 16); v[3] = kk[1] | (kk[0] << 16);
        *(u32x4*)(keT + (56 - g8 * 8)) = v;
      }
    }
    p.dec[((size_t)(dir * 4 + b) * 128 + ch) * 512 + j] = __expf(bsum);
  }
}

constexpr int QLD = 136, TLD = 72;
DI void gla_scan_block(const Params& p, int g, char* smem, int tid) {
  const int dir = g & 1, bh = g >> 1;
  const int b = bh >> 2, h = bh & 3;
  const int w = tid >> 6, lane = tid & 63, c = lane & 31, hh = lane >> 5;
  const int slice = w;
  u16* sQ = (u16*)smem;
  u16* sK = sQ + 64 * QLD;
  u16* sKT = sK + 64 * QLD;
  u16* sVT = sKT + 128 * TLD;
  const u16* qe = (dir ? p.qe_bw : p.qe_fw) + (size_t)b * 8192 * 512 + h * 128;
  const u16* ke = (dir ? p.ke_bw : p.ke_fw) + (size_t)b * 8192 * 512 + h * 128;
  const u16* keT = p.keT + (size_t)dir * (16ull * 128 * 8192) + (size_t)bh * 128 * 8192;
  const u16* vT = p.gvT + (size_t)bh * 256 * 8192;
  const float* dec = p.dec + ((size_t)(dir * 4 + b) * 128) * 512 + h * 128;
  u16* o = dir ? p.o_bw : p.o_fw;
  f32x16 st[4];
#pragma unroll
  for (int i = 0; i < 4; ++i) st[i] = zero16();
  u32x4 rq[2], rk[2], rt[2];
  unsigned offq[2], offt[2];
#pragma unroll
  for (int r = 0; r < 2; ++r) {
    int id = tid + 512 * r;
    offq[r] = (unsigned)(((id >> 4) * 512 + (id & 15) * 8) * 2);
    offt[r] = (unsigned)(((id >> 3) * 8192 + (id & 7) * 8) * 2);
  }
  const unsigned offv = (unsigned)(((w * 32 + c) * 8192 + 4 * hh) * 2);
  {
    const int ch = dir ? 127 : 0;
#pragma unroll
    for (int r = 0; r < 2; ++r) {
      int id = tid + 512 * r;
      rq[r] = *(const u32x4*)((const char*)(qe + (size_t)ch * 64 * 512) + offq[r]);
      rk[r] = *(const u32x4*)((const char*)(ke + (size_t)ch * 64 * 512) + offq[r]);
      rt[r] = *(const u32x4*)((const char*)(keT + ch * 64) + offt[r]);
    }
  }
#pragma unroll 1
  for (int ci = 0; ci < 128; ++ci) {
    const int ch = dir ? 127 - ci : ci;
    const size_t t0 = (size_t)b * 8192 + ch * 64;
    __syncthreads();
#pragma unroll
    for (int r = 0; r < 2; ++r) {
      int id = tid + 512 * r;
      st_perm(sQ + (id >> 4) * QLD, id & 15, rq[r]);
      st_perm(sK + (id >> 4) * QLD, id & 15, rk[r]);
      st_perm(sKT + (id >> 3) * TLD, id & 7, rt[r]);
    }
    __syncthreads();
    if (ci + 1 < 128) {
      const int chn = dir ? ch - 1 : ch + 1;
#pragma unroll
      for (int r = 0; r < 2; ++r) {
        int id = tid + 512 * r;
        rq[r] = *(const u32x4*)((const char*)(qe + (size_t)chn * 64 * 512) + offq[r]);
        rk[r] = *(const u32x4*)((const char*)(ke + (size_t)chn * 64 * 512) + offq[r]);
        rt[r] = *(const u32x4*)((const char*)(keT + chn * 64) + offt[r]);
      }
    }
    bf16x8 vf[4];
#pragma unroll
    for (int k4 = 0; k4 < 4; ++k4) vf[k4] = ld_frag8x2((const u16*)((const char*)(vT + ch * 64 + 16 * k4) + offv));
#pragma unroll 1
    for (int qt = 0; qt < 2; ++qt) {
      f32x16 oacc = zero16();
#pragma unroll
      for (int ks = 0; ks < 8; ++ks) {
        bf16x8 sf = pack_step(st[ks >> 1], ks & 1);
        bf16x8 q0 = ld_frag16(sQ + (qt * 32 + c) * QLD + ks * 16 + 8 * hh);
        oacc = MFMA(q0, sf, oacc);
        if (ks & 1) __builtin_amdgcn_sched_barrier(0);
      }
#pragma unroll
      for (int kt = 0; kt < 2; ++kt) {
        bool skip = dir ? (kt < qt) : (kt > qt);
        if (skip) continue;
        f32x16 X = zero16();
#pragma unroll 1
        for (int ks = 0; ks < 8; ++ks) {
          bf16x8 kf = ld_frag16(sK + (kt * 32 + c) * QLD + ks * 16 + 8 * hh);
          bf16x8 qf = ld_frag16(sQ + (qt * 32 + c) * QLD + ks * 16 + 8 * hh);
          X = MFMA(kf, qf, X);
        }
        if (kt == qt) {
#pragma unroll
          for (int i = 0; i < 16; ++i) {
            int key = crow(i, hh);
            bool keep = dir ? (key >= c) : (key <= c);
            X[i] = keep ? X[i] : 0.f;
          }
        }
        oacc = MFMA(pack_step(X, 0), vf[kt * 2 + 0], oacc);
        oacc = MFMA(pack_step(X, 1), vf[kt * 2 + 1], oacc);
        __builtin_amdgcn_sched_barrier(0);
      }
#pragma unroll
      for (int i = 0; i < 16; ++i)
        o[(t0 + qt * 32 + crow(i, hh)) * 1024 + h * 256 + slice * 32 + c] = f2bf(oacc[i]);
      __builtin_amdgcn_sched_barrier(0);
    }
#pragma unroll
    for (int dt = 0; dt < 4; ++dt) {
#pragma unroll
      for (int k4 = 0; k4 < 4; ++k4) {
        bf16x8 kt_f = ld_frag16(sKT + (dt * 32 + c) * TLD + 16 * k4 + 8 * hh);
        st[dt] = MFMA(kt_f, vf[k4], st[dt]);
      }
#pragma unroll
      for (int gg = 0; gg < 4; ++gg) {
        float4 dv = *(const float4*)(dec + (size_t)ch * 512 + dt * 32 + 8 * gg + 4 * hh);
        st[dt][4 * gg + 0] *= dv.x; st[dt][4 * gg + 1] *= dv.y; st[dt][4 * gg + 2] *= dv.z; st[dt][4 * gg + 3] *= dv.w;
      }
      __builtin_amdgcn_sched_barrier(0);
    }
  }
}

constexpr int KLD = 136, VLD = 72;
constexpr int ATT_BUF = 64 * KLD + 128 * VLD;
DI void attn_item(const Params& p, int item, char* smem, int tid) {
  const int qb = item & 63, bh = item >> 6;
  const int b = bh >> 3, h = bh & 7;
  const int w = tid >> 6, lane = tid & 63, c = lane & 31, hh = lane >> 5;
  const int qg = w & 3, mp = w >> 2;
  u16* sbase = (u16*)smem;
  float* sex = (float*)(smem + 2 * ATT_BUF * 2);
  const size_t tq = (size_t)b * 8192 + qb * 128 + qg * 32 + c;
  bf16x8 qf[4];
#pragma unroll
  for (int s = 0; s < 4; ++s) qf[s] = ld_frag16(p.dq + tq * 1024 + h * 128 + mp * 64 + 16 * s + 8 * hh);
  f32x16 O[4];
#pragma unroll
  for (int dt = 0; dt < 4; ++dt) O[dt] = zero16();
  float lrun = 0.f;
  float negmb;
  {
    float qn = 0.f;
#pragma unroll
    for (int s = 0; s < 4; ++s) {
      u32x4 qq = __builtin_bit_cast(u32x4, qf[s]);
#pragma unroll
      for (int i = 0; i < 4; ++i) { float x0 = bflo(qq[i]), x1 = bfhi(qq[i]); qn += x0 * x0 + x1 * x1; }
    }
    qn += __shfl_xor(qn, 32);
    float kn = __int_as_float(p.kmax[(b * 8 + h) * 2 + mp]);
    float mb = sqrtf(qn * kn) * 1.01f + 1e-3f;
    negmb = -mb;
  }
  const u16* Kg = p.dk + (size_t)b * 8192 * 1024 + h * 128;
  const u16* Vg = p.dvT + (size_t)bh * 128 * 8192;
  u32x4 rk[2], rv[2];
#pragma unroll
  for (int r = 0; r < 2; ++r) {
    int id = tid + 512 * r;
    rk[r] = *(const u32x4*)(Kg + (size_t)(id >> 4) * 1024 + (id & 15) * 8);
    rv[r] = *(const u32x4*)(Vg + (size_t)(id >> 3) * 8192 + (id & 7) * 8);
  }
  __syncthreads();
#pragma unroll
  for (int r = 0; r < 2; ++r) {
    int id = tid + 512 * r;
    *(u32x4*)(sbase + (id >> 4) * KLD + (id & 15) * 8) = rk[r];
    st_perm(sbase + 64 * KLD + (id >> 3) * VLD, id & 7, rv[r]);
  }
#pragma unroll
  for (int r = 0; r < 2; ++r) {
    int id = tid + 512 * r;
    rk[r] = *(const u32x4*)(Kg + (size_t)(64 + (id >> 4)) * 1024 + (id & 15) * 8);
    rv[r] = *(const u32x4*)(Vg + (size_t)(id >> 3) * 8192 + 64 + (id & 7) * 8);
  }
  __syncthreads();
#pragma unroll 1
  for (int kt = 0; kt < 128; ++kt) {
    const u16* sK = sbase + (kt & 1) * ATT_BUF;
    const u16* sV = sK + 64 * KLD;
    f32x16 sacc[2];
    bf16x8 kf[8];
#pragma unroll
    for (int s = 0; s < 4; ++s)
#pragma unroll
      for (int k2 = 0; k2 < 2; ++k2) kf[s * 2 + k2] = ld_frag16(sK + (k2 * 32 + c) * KLD + mp * 64 + 16 * s + 8 * hh);
    __builtin_amdgcn_sched_barrier(0);
#pragma unroll
    for (int i = 0; i < 16; ++i) { sacc[0][i] = negmb; sacc[1][i] = negmb; }
#pragma unroll
    for (int s = 0; s < 4; ++s) {
      sacc[0] = MFMA(kf[s * 2 + 0], qf[s], sacc[0]);
      sacc[1] = MFMA(kf[s * 2 + 1], qf[s], sacc[1]);
    }
    bf16x8 vfA[4], vfB[4];
#define VLOAD(dst, k2, s2) { _Pragma("unroll") for (int dt = 0; dt < 4; ++dt) dst[dt] = ld_frag16(sV + (dt * 32 + c) * VLD + (k2) * 32 + (s2) * 16 + 8 * hh); }
#define PVMM(vf, pf) { _Pragma("unroll") for (int dt = 0; dt < 4; ++dt) O[dt] = MFMA(vf[dt], pf, O[dt]); }
#define EXPS(k2) { _Pragma("unroll") for (int i = 0; i < 8; ++i) { \
        float e0 = __builtin_amdgcn_exp2f(sacc[k2][2 * i]), e1 = __builtin_amdgcn_exp2f(sacc[k2][2 * i + 1]); \
        sacc[k2][2 * i] = e0; sacc[k2][2 * i + 1] = e1; f32x2_t ev = {e0, e1}; ls2 += ev; } }
    VLOAD(vfA, 0, 0);
    __builtin_amdgcn_sched_barrier(0);
    if (kt + 1 < 128) {
      u16* nK = sbase + ((kt + 1) & 1) * ATT_BUF;
      u16* nV = nK + 64 * KLD;
#pragma unroll
      for (int r = 0; r < 2; ++r) {
        int id = tid + 512 * r;
        *(u32x4*)(nK + (id >> 4) * KLD + (id & 15) * 8) = rk[r];
        st_perm(nV + (id >> 3) * VLD, id & 7, rv[r]);
      }
      if (kt + 2 < 128) {
#pragma unroll
        for (int r = 0; r < 2; ++r) {
          int id = tid + 512 * r;
          rk[r] = *(const u32x4*)(Kg + (size_t)((kt + 2) * 64 + (id >> 4)) * 1024 + (id & 15) * 8);
          rv[r] = *(const u32x4*)(Vg + (size_t)(id >> 3) * 8192 + (kt + 2) * 64 + (id & 7) * 8);
        }
      }
    }
    __builtin_amdgcn_sched_barrier(0);
    f32x2_t ls2 = {0.f, 0.f};
    EXPS(0);
    bf16x8 p0 = pack_step(sacc[0], 0), p1 = pack_step(sacc[0], 1);
    __builtin_amdgcn_sched_barrier(0);
    VLOAD(vfB, 0, 1);
    PVMM(vfA, p0);
    __builtin_amdgcn_sched_barrier(0);
    VLOAD(vfA, 1, 0);
    PVMM(vfB, p1);
    __builtin_amdgcn_sched_barrier(0);
    EXPS(1);
    p0 = pack_step(sacc[1], 0); p1 = pack_step(sacc[1], 1);
    __builtin_amdgcn_sched_barrier(0);
    VLOAD(vfB, 1, 1);
    PVMM(vfA, p0);
    __builtin_amdgcn_sched_barrier(0);
    PVMM(vfB, p1);
    lrun += ls2[0] + ls2[1];
#undef VLOAD
#undef PVMM
#undef EXPS
    __syncthreads();
  }
  float ltot = lrun + __shfl_xor(lrun, 32);
  if (mp == 1) {
    float sc = p.lam[0] / ltot;
#pragma unroll
    for (int dt = 0; dt < 4; ++dt)
#pragma unroll
      for (int i = 0; i < 16; ++i) sex[(qg * 64 + dt * 16 + i) * 64 + lane] = O[dt][i] * sc;
  }
  __syncthreads();
  if (mp == 0) {
    float i0 = 1.f / ltot;
    float ss = 0.f;
#pragma unroll
    for (int dt = 0; dt < 4; ++dt)
#pragma unroll
      for (int i = 0; i < 16; ++i) { float v = O[dt][i] * i0 - sex[(qg * 64 + dt * 16 + i) * 64 + lane]; O[dt][i] = v; ss += v * v; }
    ss += __shfl_xor(ss, 32);
    float rstd = rsqrtf(ss * (1.f / 128.f) + RMS_EPS) * 0.8f;
#pragma unroll
    for (int dt = 0; dt < 4; ++dt)
#pragma unroll
      for (int g = 0; g < 4; ++g) {
        int dv = dt * 32 + 8 * g + 4 * hh;
        float4 gg = *(const float4*)(p.diff_norm_g + h * 128 + dv);
        u32x2 v = {pack2(O[dt][4 * g] * rstd * gg.x, O[dt][4 * g + 1] * rstd * gg.y),
                   pack2(O[dt][4 * g + 2] * rstd * gg.z, O[dt][4 * g + 3] * rstd * gg.w)};
        *(u32x2*)(p.dq + tq * 1024 + h * 128 + dv) = v;
      }
  }
}

DI void phase_mixers(const Params& p, char* smem, int tid) {
  if (blockIdx.x < 32) gla_scan_block(p, blockIdx.x, smem, opq(tid));
  xcd_queue(p.counter + 56, 256, smem, tid, [&](int xq, int qn) {
    const int bh = xq + 8 * (qn >> 6);
    attn_item(p, bh * 64 + (qn & 63), smem, opq(tid));
  });
}

DI void phase_post_mixers(const Params& p, int tid) {
  int w = tid >> 6, lane = tid & 63;
  for (int row = blockIdx.x * 8 + w; row < T; row += gridDim.x * 8) {
#pragma unroll
    for (int hd = 0; hd < 4; ++hd) {
      u32x2 a = *(const u32x2*)(p.o_fw + (size_t)row * 1024 + hd * 256 + lane * 4);
      u32x2 bq = *(const u32x2*)(p.o_bw + (size_t)row * 1024 + hd * 256 + lane * 4);
      float v0 = bflo(a[0]) + bflo(bq[0]), v1 = bfhi(a[0]) + bfhi(bq[0]), v2 = bflo(a[1]) + bflo(bq[1]), v3 = bfhi(a[1]) + bfhi(bq[1]);
      float ss = wave_sum(v0 * v0 + v1 * v1 + v2 * v2 + v3 * v3);
      if (lane == 0) p.rstd[row * 4 + hd] = rsqrtf(ss * (1.f / 256.f) + RMS_EPS);
    }
  }
  phase_norm_mod(p.x, p.norm1_g, p.mod, 0, 1024, p.hA, tid);
  for (int row = blockIdx.x * 8 + w; row < 32768; row += gridDim.x * 8) {
    const bool isv = row >= 16384;
    const int r = row & 16383;
    const float* srcp = (isv ? p.peer_v : p.peer_u) + (size_t)r * 1024 + lane * 16;
    float4 a0 = *(const float4*)(srcp), a1 = *(const float4*)(srcp + 4), a2 = *(const float4*)(srcp + 8), a3 = *(const float4*)(srcp + 12);
    float am = fmaxf(fmaxf(fmaxf(fabsf(a0.x), fabsf(a0.y)), fmaxf(fabsf(a0.z), fabsf(a0.w))), fmaxf(fmaxf(fabsf(a1.x), fabsf(a1.y)), fmaxf(fabsf(a1.z), fabsf(a1.w))));
    am = fmaxf(am, fmaxf(fmaxf(fmaxf(fabsf(a2.x), fabsf(a2.y)), fmaxf(fabsf(a2.z), fabsf(a2.w))), fmaxf(fmaxf(fabsf(a3.x), fabsf(a3.y)), fmaxf(fabsf(a3.z), fabsf(a3.w)))));
#pragma unroll
    for (int o = 32; o >= 1; o >>= 1) am = fmaxf(am, __shfl_xor(am, o));
    am = fmaxf(am, 1e-30f);
    const float sc = 256.f / am;
    u32x4 v;
    int t0 = __builtin_amdgcn_cvt_pk_fp8_f32(a0.x * sc, a0.y * sc, 0, false); t0 = __builtin_amdgcn_cvt_pk_fp8_f32(a0.z * sc, a0.w * sc, t0, true);
    int t1 = __builtin_amdgcn_cvt_pk_fp8_f32(a1.x * sc, a1.y * sc, 0, false); t1 = __builtin_amdgcn_cvt_pk_fp8_f32(a1.z * sc, a1.w * sc, t1, true);
    int t2 = __builtin_amdgcn_cvt_pk_fp8_f32(a2.x * sc, a2.y * sc, 0, false); t2 = __builtin_amdgcn_cvt_pk_fp8_f32(a2.z * sc, a2.w * sc, t2, true);
    int t3 = __builtin_amdgcn_cvt_pk_fp8_f32(a3.x * sc, a3.y * sc, 0, false); t3 = __builtin_amdgcn_cvt_pk_fp8_f32(a3.z * sc, a3.w * sc, t3, true);
    v[0] = (unsigned)t0; v[1] = (unsigned)t1; v[2] = (unsigned)t2; v[3] = (unsigned)t3;
    unsigned char* dst = (unsigned char*)(isv ? p.vB : p.uB) + (size_t)r * 1024 + lane * 16;
    *(u32x4*)dst = v;
    if (lane == 0) (isv ? p.vs : p.us)[r] = am * (1.f / 256.f);
  }
}

DI void phase_gr(const Params& p, char* smem, int tid) {
  const int w = tid >> 6, lane_inv = tid & 63;
  const int wm = w >> 2, wn = w & 3;
  float* wl = wave_stage(smem, w);
  xcd_static(p, 16 * 12, smem, [&](int xq, int qn) {
    int mt = xq + 8 * (qn / 12), nt = qn % 12;
    int m0 = mt * 256, n0 = nt * 256;
    f32x16 acc[4][2]; zero_acc(acc);
    gemm_kloop(p.hA + (size_t)m0 * 1024, 1024, p.wgrT + (size_t)n0 * 1024, 1024, 1024, acc, (u16*)smem, opq(tid));
    const int lane = opq(lane_inv);
    const int c = lane & 31, hh = lane >> 5;
#pragma unroll
    for (int half = 0; half < 2; ++half) {
      const int rb = m0 + wm * 128 + half * 64;
      stage_acc<EPS>(acc, half, wl, c, hh);
      if (n0 < 1024) {
        const int cb = n0 + wn * 64;
        epi_rows(wl, lane, [&](int r, int cc, float (&v)[8]) {
          const size_t off = (size_t)(rb + r) * 1024 + cb + cc;
          float of[8], ob[8];
          ld_bf16x8(p.o_fw + off, of); ld_bf16x8(p.o_bw + off, ob);
          const float rs = p.rstd[(rb + r) * 4 + ((cb + cc) >> 8)];
          float4 g0 = *(const float4*)(p.gla_norm_g + cb + cc), g1 = *(const float4*)(p.gla_norm_g + cb + cc + 4);
          const float gg[8] = {g0.x, g0.y, g0.z, g0.w, g1.x, g1.y, g1.z, g1.w};
#pragma unroll
          for (int j = 0; j < 8; ++j) { float a = v[j]; v[j] = (of[j] + ob[j]) * rs * gg[j] * (a / (1.f + __expf(-a))); }
          st_bf16x8(p.A1 + off, v);
        });
      } else {
        u16* dst = ((n0 < 2048) ? p.sga : p.sgb) + (size_t)rb * 1024 + (n0 & 1023) + wn * 64;
        epi_rows(wl, lane, [&](int r, int cc, float (&v)[8]) {
#pragma unroll
          for (int j = 0; j < 8; ++j) v[j] = 1.f / (1.f + __expf(-v[j]));
          st_bf16x8(dst + (size_t)r * 1024 + cc, v);
        });
      }
    }
  });
}

DI void phase_merge(const Params& p, char* smem, int tid) {
  const int w = tid >> 6, lane_inv = tid & 63;
  const int wm = w >> 2, wn = w & 3;
  float* wl = wave_stage(smem, w);
  xcd_static(p, 16 * 4, smem, [&](int xq, int qn) {
    int mt = xq + 8 * (qn >> 2), nt = qn & 3;
    int m0 = mt * 256, n0 = nt * 256;
    f32x16 acc[4][2];
    zero_acc(acc);
    gemm_kloop(p.A1 + (size_t)m0 * 1024, 1024, p.wglaT + (size_t)n0 * 1024, 1024, 1024, acc, (u16*)smem, opq(tid));
    {
      const int lane = opq(lane_inv);
      const int c = lane & 31, hh = lane >> 5;
#pragma unroll
      for (int half = 0; half < 2; ++half) {
        const size_t tb = (size_t)(m0 + wm * 128 + half * 64) * 1024 + n0 + wn * 64;
        stage_acc<EPS>(acc, half, wl, c, hh);
        epi_rows(wl, lane, [&](int r, int cc, float (&v)[8]) {
          float gv[8];
          ld_bf16x8(p.sga + tb + (size_t)r * 1024 + cc, gv);
#pragma unroll
          for (int j = 0; j < 8; ++j) v[j] *= gv[j];
          st_bf16x8(p.sga + tb + (size_t)r * 1024 + cc, v);
        });
      }
    }
    zero_acc(acc);
    gemm_kloop(p.dq + (size_t)m0 * 1024, 1024, p.wdiffT + (size_t)n0 * 1024, 1024, 1024, acc, (u16*)smem, opq(tid));
    {
      const int lane = opq(lane_inv);
      const int c = lane & 31, hh = lane >> 5;
#pragma unroll
      for (int half = 0; half < 2; ++half) {
        const size_t tb = (size_t)(m0 + wm * 128 + half * 64) * 1024 + n0 + wn * 64;
        stage_acc<EPS>(acc, half, wl, c, hh);
        epi_rows(wl, lane, [&](int r, int cc, float (&v)[8]) {
          float gv[8], mv[8];
          ld_bf16x8(p.sgb + tb + (size_t)r * 1024 + cc, gv);
          ld_bf16x8(p.sga + tb + (size_t)r * 1024 + cc, mv);
#pragma unroll
          for (int j = 0; j < 8; ++j) v[j] = mv[j] + v[j] * gv[j];
          st_bf16x8(p.merged + tb + (size_t)r * 1024 + cc, v);
        });
      }
    }
  });
}

DI void phase_out(const Params& p, char* smem, int tid) {
  const int w = tid >> 6, lane_inv = tid & 63;
  const int wm = w >> 2, wn = w & 3;
  float* wl = wave_stage(smem, w);
  xcd_static(p, 16 * 4, smem, [&](int xq, int qn) {
    int mt = xq + 8 * (qn >> 2), nt = qn & 3;
    int m0 = mt * 256, n0 = nt * 256;
    f32x16 acc[4][2]; zero_acc(acc);
    gemm_kloop(p.merged + (size_t)m0 * 1024, 1024, p.woutT + (size_t)n0 * 1024, 1024, 1024, acc, (u16*)smem, opq(tid));
    const int lane = opq(lane_inv);
    const int c = lane & 31, hh = lane >> 5;
    const int b = m0 >> 13;
    const int cb = n0 + wn * 64;
#pragma unroll
    for (int half = 0; half < 2; ++half) {
      const size_t tb = (size_t)(m0 + wm * 128 + half * 64) * 1024 + cb;
      stage_acc<EPS>(acc, half, wl, c, hh);
      epi_rows(wl, lane, [&](int r, int cc, float (&v)[8]) {
        const float* xp = p.x + tb + (size_t)r * 1024 + cc;
        const float* gp = p.mod + b * 6144 + 2048 + cb + cc;
        float4 x0 = *(const float4*)xp, x1v = *(const float4*)(xp + 4);
        float4 g0 = *(const float4*)gp, g1 = *(const float4*)(gp + 4);
        float4 o0 = {x0.x + g0.x * v[0], x0.y + g0.y * v[1], x0.z + g0.z * v[2], x0.w + g0.w * v[3]};
        float4 o1 = {x1v.x + g1.x * v[4], x1v.y + g1.y * v[5], x1v.z + g1.z * v[6], x1v.w + g1.w * v[7]};
        float* op = p.x1 + tb + (size_t)r * 1024 + cc;
        *(float4*)op = o0; *(float4*)(op + 4) = o1;
      });
    }
  });
}

DI void phase_peerq(const Params& p, char* smem, int tid) {
  const int w = tid >> 6, lane_inv = tid & 63;
  const int wm = w >> 2, wn = w & 3;
  float* wl = wave_stage(smem, w);
  xcd_static(p, 16 * 8, smem, [&](int xq, int qn) {
    int mt = xq + 8 * (qn >> 3), nt = qn & 7;
    int m0 = mt * 256, n0 = nt * 256;
    f32x16 acc[4][2]; zero_acc(acc);
    gemm_kloop(p.h2 + (size_t)m0 * 1024, 1024, p.wqT + (size_t)n0 * 1024, 1024, 1024, acc, (u16*)smem, opq(tid));
    const int lane = opq(lane_inv);
    const int c = lane & 31, hh = lane >> 5;
#pragma unroll
    for (int half = 0; half < 2; ++half) {
      u16* dst = p.qp + (size_t)(m0 + wm * 128 + half * 64) * 2048 + n0 + wn * 64;
      stage_acc<EPS>(acc, half, wl, c, hh);
      epi_rows(wl, lane, [&](int r, int cc, float (&v)[8]) { st_bf16x8(dst + (size_t)r * 2048 + cc, v); });
    }
  });
}

DI unsigned fkey(float f) { unsigned u = __float_as_uint(f); return (u & 0x80000000u) ? ~u : (u | 0x80000000u); }
DI void phase_topk(const Params& p, char* smem, int tid) {
  float* sc = (float*)smem;
  float* ts = sc + 128 * 132;
  int* ti = (int*)(ts + 128 * 32);
  const int w = tid >> 6, lane = tid & 63, c = lane & 31, hh = lane >> 5;
  const int l16 = tid & 15, grp = tid >> 4;
  const int nt = w & 3, mt = w >> 2;
  bf16x8 af[8], af2[8], bfq[8];
#define TK_LOAD(item_, pp_) { const int h_ = (item_) & 7; const u16* Aq_ = p.qp + (size_t)((item_) >> 3) * 128 * 2048 + h_ * 256 + (pp_) * 128; \
    const u16* Bk_ = p.subk + (size_t)(h_ * 2 + (pp_)) * 128 * 128; \
    _Pragma("unroll") for (int s = 0; s < 8; ++s) { bfq[s] = ld_frag16(Bk_ + (32 * nt + c) * 128 + 16 * s + 8 * hh); af[s] = ld_frag16(Aq_ + (size_t)(32 * mt + c) * 2048 + 16 * s + 8 * hh); af2[s] = ld_frag16(Aq_ + (size_t)(64 + 32 * mt + c) * 2048 + 16 * s + 8 * hh); } }
  if (blockIdx.x < 2048) TK_LOAD(blockIdx.x, 0);
  for (int item = blockIdx.x; item < 2048; item += gridDim.x) {
    const int h = item & 7;
    const size_t t0 = (size_t)(item >> 3) * 128;
#pragma unroll 1
    for (int pp = 0; pp < 2; ++pp) {
      f32x16 acc = zero16(), accb = zero16();
#pragma unroll
      for (int s = 0; s < 8; ++s) { acc = MFMA(af[s], bfq[s], acc); accb = MFMA(af2[s], bfq[s], accb); }
      if (pp == 0) { TK_LOAD(item, 1); }
      else { const int nitem = item + gridDim.x; if (nitem < 2048) TK_LOAD(nitem, 0); }
      __syncthreads();
#pragma unroll
      for (int i = 0; i < 16; ++i) { sc[(mt * 32 + crow(i, hh)) * 132 + 32 * nt + c] = acc[i]; sc[(64 + mt * 32 + crow(i, hh)) * 132 + 32 * nt + c] = accb[i]; }
      __syncthreads();
      unsigned k[4][8], sel[4];
#pragma unroll
      for (int rr = 0; rr < 4; ++rr) {
        sel[rr] = 0;
#pragma unroll
        for (int m = 0; m < 8; ++m) { int n = l16 + 16 * m; k[rr][m] = (fkey(sc[(grp + 32 * rr) * 132 + n]) & ~127u) | (unsigned)(127 - n); }
      }
#pragma unroll 1
      for (int round = 0; round < 16; ++round) {
#pragma unroll
        for (int rr = 0; rr < 4; ++rr) {
          unsigned mx = max(max(max(k[rr][0], k[rr][1]), max(k[rr][2], k[rr][3])), max(max(k[rr][4], k[rr][5]), max(k[rr][6], k[rr][7])));
          mx = gmax16(mx);
          sel[rr] = (l16 == round) ? mx : sel[rr];
#pragma unroll
          for (int m = 0; m < 8; ++m) k[rr][m] = (k[rr][m] == mx) ? 0u : k[rr][m];
        }
      }
#pragma unroll
      for (int rr = 0; rr < 4; ++rr) {
        const int row = grp + 32 * rr;
        int n = 127 - (int)(sel[rr] & 127u);
        ti[(row * 2 + pp) * 16 + l16] = n;
        ts[(row * 2 + pp) * 16 + l16] = sc[row * 132 + n];
      }
    }
    __syncthreads();
    {
      float s0v[4]; int ptr[4]; unsigned selk[4];
#pragma unroll
      for (int rr = 0; rr < 4; ++rr) { s0v[rr] = ts[((grp + 32 * rr) * 2) * 16 + l16]; ptr[rr] = 0; selk[rr] = 0; }
#pragma unroll 1
      for (int round = 0; round < 16; ++round) {
#pragma unroll
        for (int rr = 0; rr < 4; ++rr) {
          const int row = grp + 32 * rr;
          float v = s0v[rr] + ts[(row * 2 + 1) * 16 + (ptr[rr] & 15)];
          unsigned key = (ptr[rr] < 16) ? ((fkey(v) & ~255u) | (unsigned)(255 - (l16 * 16 + ptr[rr]))) : 0u;
          unsigned mx = gmax16(key);
          selk[rr] = (l16 == round) ? mx : selk[rr];
          int aw = (255 - (int)(mx & 255u)) >> 4;
          ptr[rr] += (l16 == aw) ? 1 : 0;
        }
      }
#pragma unroll
      for (int rr = 0; rr < 4; ++rr) {
        const int row = grp + 32 * rr;
        int flat = 255 - (int)(selk[rr] & 255u);
        int aw = flat >> 4, bw = flat & 15;
        int my_idx = ti[(row * 2) * 16 + aw] * 128 + ti[(row * 2 + 1) * 16 + bw];
        float my_s = ts[(row * 2) * 16 + aw] + ts[(row * 2 + 1) * 16 + bw];
        float mxs = gmaxf16(my_s);
        float e = __expf(my_s - mxs);
        float sum = gsum16(e);
        p.idx[(t0 + row) * 128 + h * 16 + l16] = my_idx;
        p.g[(t0 + row) * 128 + h * 16 + l16] = e / sum;
      }
    }
    __syncthreads();
  }
#undef TK_LOAD
}

DI void peer_load_batch(const unsigned char* tab, const float* rsc, int ireg, int ebase, int q, int gq, u32x4 (&buf)[4], float (&scl)[1]) {
#pragma unroll
  for (int rr = 0; rr < 1; ++rr) {
    int e = ebase + 4 * rr + gq;
    int row = __shfl(ireg, e & 63);
    const unsigned char* rp = tab + (size_t)row * 1024 + q * 16;
#pragma unroll
    for (int j = 0; j < 4; ++j) buf[rr * 4 + j] = *(const u32x4*)(rp + j * 256);
    scl[rr] = rsc[row];
  }
}
DI void peer_u_compute(const u32x4 (&buf)[4], const float (&scl)[1], const float (&hf)[64], float* wl, int ebase, int q, int gq) {
#pragma unroll
  for (int rr = 0; rr < 1; ++rr) {
    float acc = 0.f;
#pragma unroll
    for (int j = 0; j < 4; ++j)
#pragma unroll
      for (int i = 0; i < 4; ++i) {
        f32x2_t lo = __builtin_amdgcn_cvt_pk_f32_fp8((int)buf[rr * 4 + j][i], false);
        f32x2_t hi = __builtin_amdgcn_cvt_pk_f32_fp8((int)buf[rr * 4 + j][i], true);
        acc += lo[0] * hf[j * 16 + 4 * i] + lo[1] * hf[j * 16 + 4 * i + 1] + hi[0] * hf[j * 16 + 4 * i + 2] + hi[1] * hf[j * 16 + 4 * i + 3];
      }
    acc = gsum16(acc) * scl[rr];
    float act = 0.5f * acc * (1.f + erff(acc * 0.7071067811865476f));
    if (q == 0) wl[ebase + 4 * rr + gq] = act;
  }
}
DI void peer_v_compute(const u32x4 (&buf)[4], const float (&scl)[1], float (&o)[64], const float* wl, float greg, int ebase, int gq) {
#pragma unroll
  for (int rr = 0; rr < 1; ++rr) {
    const int e = ebase + 4 * rr + gq;
    float ge = __shfl(greg, e & 63);
    float wg = wl[e] * ge * scl[rr];
#pragma unroll
    for (int j = 0; j < 4; ++j)
#pragma unroll
      for (int i = 0; i < 4; ++i) {
        f32x2_t lo = __builtin_amdgcn_cvt_pk_f32_fp8((int)buf[rr * 4 + j][i], false);
        f32x2_t hi = __builtin_amdgcn_cvt_pk_f32_fp8((int)buf[rr * 4 + j][i], true);
        o[j * 16 + 4 * i] += wg * lo[0]; o[j * 16 + 4 * i + 1] += wg * lo[1];
        o[j * 16 + 4 * i + 2] += wg * hi[0]; o[j * 16 + 4 * i + 3] += wg * hi[1];
      }
  }
}
DI void phase_peer_final(const Params& p, char* smem, int tid) {
  const int w = tid >> 6, lane = tid & 63, q = lane & 15, gq = lane >> 4;
  float* wl = (float*)smem + w * 128;
  const unsigned char* U8 = (const unsigned char*)p.uB;
  const unsigned char* V8 = (const unsigned char*)p.vB;
  for (int item = blockIdx.x; item < T / 8; item += gridDim.x) {
    const size_t t = (size_t)item * 8 + w;
    const int b = (int)(t >> 13);
    float hf[64];
#pragma unroll
    for (int j = 0; j < 4; ++j) {
      u32x4 ha = *(const u32x4*)(p.h2 + t * 1024 + (q + 16 * j) * 16);
      u32x4 hb = *(const u32x4*)(p.h2 + t * 1024 + (q + 16 * j) * 16 + 8);
#pragma unroll
      for (int i = 0; i < 4; ++i) { hf[j * 16 + 2 * i] = bflo(ha[i]); hf[j * 16 + 2 * i + 1] = bfhi(ha[i]); hf[j * 16 + 8 + 2 * i] = bflo(hb[i]); hf[j * 16 + 8 + 2 * i + 1] = bfhi(hb[i]); }
    }
    const int i0 = p.idx[t * 128 + lane], i1 = p.idx[t * 128 + 64 + lane];
    const float g0 = p.g[t * 128 + lane], g1 = p.g[t * 128 + 64 + lane];
    u32x4 bA[4], bB[4]; float sA[1], sB[1];
    peer_load_batch(U8, p.us, i0, 0, q, gq, bA, sA);
#pragma unroll 1
    for (int it = 0; it < 16; ++it) {
      const int e0 = 8 * it;
      peer_load_batch(U8, p.us, (e0 & 64) ? i1 : i0, e0 + 4, q, gq, bB, sB);
      peer_u_compute(bA, sA, hf, wl, e0, q, gq);
      if (it < 15) peer_load_batch(U8, p.us, ((e0 + 8) & 64) ? i1 : i0, e0 + 8, q, gq, bA, sA);
      else peer_load_batch(V8, p.vs, i0, 0, q, gq, bA, sA);
      peer_u_compute(bB, sB, hf, wl, e0 + 4, q, gq);
    }
    __syncthreads();
    float o[64];
#pragma unroll
    for (int i = 0; i < 64; ++i) o[i] = 0.f;
#pragma unroll 1
    for (int it = 0; it < 16; ++it) {
      const int e0 = 8 * it;
      peer_load_batch(V8, p.vs, (e0 & 64) ? i1 : i0, e0 + 4, q, gq, bB, sB);
      peer_v_compute(bA, sA, o, wl, (e0 & 64) ? g1 : g0, e0, gq);
      if (it < 15) peer_load_batch(V8, p.vs, ((e0 + 8) & 64) ? i1 : i0, e0 + 8, q, gq, bA, sA);
      peer_v_compute(bB, sB, o, wl, (e0 & 64) ? g1 : g0, e0 + 4, gq);
    }
    float h1[32];
#pragma unroll
    for (int i = 0; i < 32; ++i) {
      float send = (gq < 2) ? o[32 + i] : o[i];
      float keep = (gq < 2) ? o[i] : o[32 + i];
      h1[i] = keep + __shfl_xor(send, 32);
    }
    float fin[16];
#pragma unroll
    for (int i = 0; i < 16; ++i) {
      float send = (gq & 1) ? h1[i] : h1[16 + i];
      float keep = (gq & 1) ? h1[16 + i] : h1[i];
      fin[i] = keep + __shfl_xor(send, 16);
    }
    const int colb = (q + 16 * gq) * 16;
    float ss = 0.f;
#pragma unroll
    for (int i4 = 0; i4 < 4; ++i4) {
      float4 xa = *(const float4*)(p.x1 + t * 1024 + colb + 4 * i4);
      float4 ga = *(const float4*)(p.mod + b * 6144 + 5120 + colb + 4 * i4);
      fin[4 * i4 + 0] = xa.x + ga.x * fin[4 * i4 + 0]; fin[4 * i4 + 1] = xa.y + ga.y * fin[4 * i4 + 1];
      fin[4 * i4 + 2] = xa.z + ga.z * fin[4 * i4 + 2]; fin[4 * i4 + 3] = xa.w + ga.w * fin[4 * i4 + 3];
      ss += fin[4 * i4] * fin[4 * i4] + fin[4 * i4 + 1] * fin[4 * i4 + 1] + fin[4 * i4 + 2] * fin[4 * i4 + 2] + fin[4 * i4 + 3] * fin[4 * i4 + 3];
    }
    ss = wave_sum(ss);
    const float rstd = rsqrtf(ss * (1.f / 1024.f) + RMS_EPS);
#pragma unroll
    for (int i4 = 0; i4 < 4; ++i4) {
      int col = colb + 4 * i4;
      float4 gg = *(const float4*)(p.normf_g + col);
      float4 sh = *(const float4*)(p.fmod + b * 2048 + col);
      float4 sc = *(const float4*)(p.fmod + b * 2048 + 1024 + col);
      float4 r;
      r.x = fin[4 * i4 + 0] * rstd * gg.x * (1.f + sc.x) + sh.x;
      r.y = fin[4 * i4 + 1] * rstd * gg.y * (1.f + sc.y) + sh.y;
      r.z = fin[4 * i4 + 2] * rstd * gg.z * (1.f + sc.z) + sh.z;
      r.w = fin[4 * i4 + 3] * rstd * gg.w * (1.f + sc.w) + sh.w;
      *(float4*)(p.out + t * 1024 + col) = r;
    }
    __syncthreads();
  }
}

#define XB_TMO      128
#define XB_XCNT(j)  (256  + 64 * (j))
#define XB_XSUB(j)  (1280 + 64 * (j))
#define XB_XGEN(j)  (2304 + 64 * (j))
#define XB_TOP      3328
#define XB_TOPGEN   3392
#define XCD_BAR_WORDS 3456
#define XB_SPIN_CAP (1u << 18)
#define LAS __attribute__((address_space(3)))

__device__ __forceinline__ unsigned xb_ld(unsigned* p)              { return __hip_atomic_load(p, __ATOMIC_RELAXED, __HIP_MEMORY_SCOPE_AGENT); }
__device__ __forceinline__ unsigned xb_add(unsigned* p, unsigned v) { return __hip_atomic_fetch_add(p, v, __ATOMIC_RELAXED, __HIP_MEMORY_SCOPE_AGENT); }
__device__ __forceinline__ unsigned xb_xcc_id() { return (unsigned)__builtin_amdgcn_s_getreg((3 << 11) | 20) & 0xFu; }
#define XB_SPIN(cond, bar) do { unsigned _sp = 0; while (cond) { __builtin_amdgcn_s_sleep(1); \
    if ((++_sp & 255u) == 0u) { if (xb_ld(&(bar)[XB_TMO])) break; if (_sp > XB_SPIN_CAP) { atomicAdd(&(bar)[XB_TMO], 1u); break; } } } } while (0)

struct XcdBarrier {
    unsigned* bar; unsigned x;
    volatile LAS unsigned* st;
};

__device__ __forceinline__ XcdBarrier xcd_barrier_post(unsigned* bar, volatile LAS unsigned* st) {
    XcdBarrier b; b.bar = bar; b.x = xb_xcc_id(); b.st = st;
    if (threadIdx.x == 0) (void)xb_add(&bar[XB_XCNT(b.x)], 1u);
    return b;
}
__device__ __forceinline__ void xcd_barrier_complete(unsigned* bar, unsigned x, unsigned& nloc, unsigned& nx) {
    const unsigned G = gridDim.x * gridDim.y * gridDim.z;
    unsigned sum, cnt, mine, sp = 0u;
    for (;;) {
        sum = 0u; cnt = 0u; mine = 0u;
#pragma unroll
        for (unsigned j = 0; j < 16; ++j) { const unsigned c = xb_ld(&bar[XB_XCNT(j)]); sum += c; cnt += (c > 0u) ? 1u : 0u; mine = (j == x) ? c : mine; }
        if (sum == G) break;
        __builtin_amdgcn_s_sleep(1);
        if ((++sp & 255u) == 0u) { if (xb_ld(&bar[XB_TMO])) break; if (sp > XB_SPIN_CAP) { atomicAdd(&bar[XB_TMO], 1u); break; } }
    }
    nloc = mine > 0u ? mine : 1u; nx = cnt > 0u ? cnt : 1u;
}

__device__ __forceinline__ void xcd_barrier(const XcdBarrier& b) {
    asm volatile("s_waitcnt vmcnt(0)" ::: "memory");
    __syncthreads();
    if (threadIdx.x == 0) {
        unsigned* bar = b.bar;
        __builtin_amdgcn_s_waitcnt(0);
        unsigned nloc = b.st[0], nx = b.st[1];
        if (nloc == 0u) { xcd_barrier_complete(bar, b.x, nloc, nx); b.st[0] = nloc; b.st[1] = nx; }
        const unsigned old = xb_add(&bar[XB_XSUB(b.x)], 1u);
        const unsigned gen = old / nloc;
        if (old + 1u == (gen + 1u) * nloc) {
            __builtin_amdgcn_fence(__ATOMIC_RELEASE, "agent");
            asm volatile("s_waitcnt vmcnt(0)" ::: "memory");
            const unsigned og = xb_add(&bar[XB_TOP], 1u);
            const unsigned tg = og / nx;
            if (og + 1u == (tg + 1u) * nx) xb_add(&bar[XB_TOPGEN], 1u);
            else XB_SPIN(xb_ld(&bar[XB_TOPGEN]) == tg, bar);
            __builtin_amdgcn_fence(__ATOMIC_ACQUIRE, "agent");
            xb_add(&bar[XB_XGEN(b.x)], 1u);
            asm volatile("s_waitcnt vmcnt(0)" ::: "memory");
        } else {
            XB_SPIN(xb_ld(&bar[XB_XGEN(b.x)]) == gen, bar);
            __builtin_amdgcn_fence(__ATOMIC_ACQUIRE, "agent");
            asm volatile("s_waitcnt vmcnt(0)" ::: "memory");
        }
    }
    __syncthreads();
}

__global__ void __launch_bounds__(512) fwd_megakernel(Params p) {
  cg::grid_group grid = cg::this_grid();
  extern __shared__ __attribute__((aligned(16))) char smem[];
  const int tid = threadIdx.x;
  volatile LAS unsigned* xst = (volatile LAS unsigned*)(smem + LDS_BYTES - 16);
  if (tid == 0) { xst[0] = 0u; xst[1] = 0u; }
  __syncthreads();
  XcdBarrier xb = xcd_barrier_post(p.bar, xst);
  if (tid == 0) xst[2] = atomicAdd(p.bar + 3600 + (xb_xcc_id() & 7u) * 16, 1u);
  phase_prep(p, smem, opq(tid));
  grid.sync();
  phase_norm_mod(p.x, p.norm1_g, p.mod, 0, 1024, p.hA, opq(tid));
  xcd_barrier(xb);
  phase_proj(p, smem, opq(tid));
  xcd_barrier(xb);
  phase_gla_pre(p, smem, opq(tid));
  xcd_barrier(xb);
  phase_mixers(p, smem, opq(tid));
  xcd_barrier(xb);
  phase_post_mixers(p, opq(tid));
  xcd_barrier(xb);
  phase_gr(p, smem, opq(tid));
  xcd_barrier(xb);
  phase_merge(p, smem, opq(tid));
  xcd_barrier(xb);
  phase_out(p, smem, opq(tid));
  xcd_barrier(xb);
  phase_norm_mod(p.x1, p.norm2_g, p.mod, 3072, 4096, p.h2, opq(tid));
  xcd_barrier(xb);
  phase_peerq(p, smem, opq(tid));
  xcd_barrier(xb);
  phase_topk(p, smem, opq(tid));
  xcd_barrier(xb);
  phase_peer_final(p, smem, opq(tid));
}

extern "C" void kernel_launch(void* const* d_in, const int* in_sizes, int n_in, void* d_out, int out_size, void* d_ws,
                              size_t ws_size, hipStream_t stream) {
  static int grid_blocks = 0;
  if (!grid_blocks) {
    int dev = 0, cus = 0, per_cu = 0;
    hipGetDevice(&dev);
    hipDeviceGetAttribute(&cus, hipDeviceAttributeMultiprocessorCount, dev);
    if (hipFuncSetAttribute((const void*)fwd_megakernel, hipFuncAttributeMaxDynamicSharedMemorySize, LDS_BYTES) != hipSuccess) { fprintf(stderr, "hipFuncSetAttribute failed\n"); }
    hipOccupancyMaxActiveBlocksPerMultiprocessor(&per_cu, fwd_megakernel, 512, LDS_BYTES);
    if (per_cu < 1) per_cu = 1;
    grid_blocks = cus * per_cu;
  }
  if (ws_size < 492 * MB) { fprintf(stderr, "ws too small: %zu\n", ws_size); return; }
  Params p{};
  p.x = (const float*)d_in[0]; p.c = (const float*)d_in[1]; p.pos = (const int*)d_in[2];
  p.w_ada = (const float*)d_in[3]; p.b_ada = (const float*)d_in[4]; p.norm1_g = (const float*)d_in[5];
  p.w_in = (const float*)d_in[6]; p.wa_fw = (const float*)d_in[7]; p.ba_fw = (const float*)d_in[8];
  p.wa_bw = (const float*)d_in[9]; p.ba_bw = (const float*)d_in[10]; p.gla_norm_g = (const float*)d_in[11];
  p.lq1 = (const float*)d_in[12]; p.lk1 = (const float*)d_in[13]; p.lq2 = (const float*)d_in[14]; p.lk2 = (const float*)d_in[15];
  p.diff_norm_g = (const float*)d_in[16]; p.w_gla = (const float*)d_in[17]; p.w_diff = (const float*)d_in[18];
  p.w_out = (const float*)d_in[19]; p.norm2_g = (const float*)d_in[20]; p.peer_wq = (const float*)d_in[21];
  p.subkeys = (const float*)d_in[22]; p.peer_u = (const float*)d_in[23]; p.peer_v = (const float*)d_in[24];
  p.w_fada = (const float*)d_in[25]; p.b_fada = (const float*)d_in[26]; p.normf_g = (const float*)d_in[27];
  p.out = (float*)d_out;
  char* ws = (char*)d_ws;
  p.winT = (u16*)(ws + 0 * MB); p.wgrT = (u16*)(ws + 11 * MB); p.wgaT = (u16*)(ws + 13 * MB); p.wgbT = (u16*)(ws + 15 * MB);
  p.wglaT = (u16*)(ws + 17 * MB); p.wdiffT = (u16*)(ws + 19 * MB); p.woutT = (u16*)(ws + 21 * MB); p.wqT = (u16*)(ws + 23 * MB);
  p.subk = (u16*)(ws + 27 * MB); p.rope = (float*)(ws + 28 * MB);
  p.mod = (float*)(ws + 36 * MB); p.fmod = (float*)(ws + 36 * MB + 128 * 1024); p.lam = (float*)(ws + 36 * MB + 192 * 1024);
  p.counter = (int*)(ws + 36 * MB + 196 * 1024);
  p.kmax = (int*)(ws + 36 * MB + 200 * 1024);
  p.bar = (unsigned*)(ws + 36 * MB + 256 * 1024);
  hipMemsetAsync(p.bar, 0, 4096 * sizeof(unsigned), stream);
  p.lr = (float*)(ws + 37 * MB); p.dec = (float*)(ws + 41 * MB); p.rstd = (float*)(ws + 43 * MB);
  char* slot[9];
  for (int i = 0; i < 7; ++i) slot[i] = ws + (44 + 64 * (size_t)i) * MB;
  slot[7] = (char*)d_out; slot[8] = (char*)d_out + 64 * MB;
  p.hA = (u16*)slot[0];
  p.gq = (u16*)slot[1]; p.gk = (u16*)(slot[1] + 32 * MB);
  p.gvT = (u16*)slot[2]; p.dq = (u16*)slot[3]; p.dk = (u16*)slot[4]; p.dvT = (u16*)slot[5];
  p.qe_fw = (u16*)slot[0]; p.ke_fw = (u16*)(slot[0] + 32 * MB);
  p.qe_bw = (u16*)slot[6]; p.ke_bw = (u16*)(slot[6] + 32 * MB);
  p.keT = (u16*)slot[7];
  p.o_fw = (u16*)slot[1]; p.o_bw = (u16*)slot[8];
  p.uB = (u16*)slot[6]; p.vB = (u16*)(slot[6] + 16 * MB);
  p.A1 = (u16*)slot[2]; p.merged = (u16*)slot[4];
  p.sga = (u16*)slot[5]; p.sgb = (u16*)slot[7];
  p.x1 = (float*)slot[0];
  p.h2 = (u16*)slot[2]; p.qp = (u16*)slot[3];
  p.us = (float*)(slot[6] + 32 * MB); p.vs = (float*)(slot[6] + 33 * MB);
  p.idx = (int*)slot[5]; p.g = (float*)(slot[5] + 16 * MB);
  void* args[] = {&p};
  hipError_t e = hipLaunchCooperativeKernel((void*)fwd_megakernel, dim3(grid_blocks), dim3(512), args, LDS_BYTES, stream);
  if (e != hipSuccess) fprintf(stderr, "cooperative launch failed: %s (grid %d)\n", hipGetErrorString(e), grid_blocks);
}
```
